# Optimizing an MI355X kernel written in HIP

```python
import math
import jax, jax.numpy as jnp
from jax import lax
import numpy as np

D_MODEL = 1024
BATCH = 32
SEQ = 2048
DEPTH = 1

MIX_WIDTH = D_MODEL
LRU_WIDTH = MIX_WIDTH // 2
LRU_BLOCKS = 8
LRU_BLOCK_DIM = LRU_WIDTH // LRU_BLOCKS
CONV_WIDTH = 4
LRU_C = 8.0
MLA_HEADS = 8
QK_NOPE_DIM = 64
QK_ROPE_DIM = 32
V_HEAD_DIM = (MIX_WIDTH - LRU_WIDTH) // MLA_HEADS
Q_LORA_RANK = D_MODEL // 4
KV_LORA_RANK = D_MODEL // 8
ROPE_THETA = 10000.0
Q_BLOCK = 128
IN_SPLITS = (LRU_WIDTH, LRU_WIDTH, Q_LORA_RANK, KV_LORA_RANK, QK_ROPE_DIM)
IN_WIDTH = sum(IN_SPLITS)
PEER_HEADS = 8
PEER_N_KEYS = 128
PEER_N_EXPERTS = PEER_N_KEYS * PEER_N_KEYS
PEER_HALF_DIM = 128
PEER_QUERY_DIM = 2 * PEER_HALF_DIM
PEER_TOPK = 16
PEER_TOKEN_CHUNK = 128
EPS = 1e-6

kernel_name = "hymba_rglru_mla_peer_adaln_block"


def rmsnorm(x, g):
    xf = x.astype(jnp.float32)
    y = xf * lax.rsqrt(jnp.mean(xf * xf, axis=-1, keepdims=True) + EPS)
    return (y * g.astype(jnp.float32)).astype(x.dtype)


def modulate(h, shift, scale):
    return h * (1.0 + scale[:, None, :]) + shift[:, None, :]


def split_cols(x, sizes):
    outs, start = [], 0
    for s in sizes:
        outs.append(x[..., start:start + s])
        start += s
    return outs


def apply_rope(x, cos, sin):
    xf = x.astype(jnp.float32)
    half = xf.shape[-1] // 2
    x1, x2 = xf[..., :half], xf[..., half:]
    return jnp.concatenate([x1 * cos - x2 * sin, x2 * cos + x1 * sin], axis=-1).astype(x.dtype)


def causal_depthwise_conv(x, w, b):
    S = x.shape[1]
    xp = jnp.pad(x, ((0, 0), (CONV_WIDTH - 1, 0), (0, 0)))
    y = b
    for k in range(CONV_WIDTH):
        y = y + w[k] * xp[:, k:k + S, :]
    return y


def rg_lru(xc, wa, ba, wx, bx, lam):
    B, S, _ = xc.shape
    xb = xc.reshape(B, S, LRU_BLOCKS, LRU_BLOCK_DIM)
    r = jax.nn.sigmoid(jnp.einsum('bshi,hij->bshj', xb, wa).reshape(B, S, LRU_WIDTH) + ba)
    i = jax.nn.sigmoid(jnp.einsum('bshi,hij->bshj', xb, wx).reshape(B, S, LRU_WIDTH) + bx)
    log_a = -LRU_C * r.astype(jnp.float32) * jax.nn.softplus(-lam.astype(jnp.float32))
    a = jnp.exp(log_a)
    b = jnp.sqrt(-jnp.expm1(2.0 * log_a)) * (i * xc).astype(jnp.float32)

    def combine(left, right):
        a_l, b_l = left
        a_r, b_r = right
        return a_l * a_r, a_r * b_l + b_r

    _, h = lax.associative_scan(combine, (a, b), axis=1)
    return h.astype(xc.dtype)


def mla_attention(q_lat, kv_lat, k_rope, positions, q_norm_g, w_uq, kv_norm_g, w_ukv):
    B, S, _ = q_lat.shape
    q = (rmsnorm(q_lat, q_norm_g) @ w_uq).reshape(B, S, MLA_HEADS, QK_NOPE_DIM + QK_ROPE_DIM)
    q_nope, q_rope = q[..., :QK_NOPE_DIM], q[..., QK_NOPE_DIM:]
    kv = (rmsnorm(kv_lat, kv_norm_g) @ w_ukv).reshape(B, S, MLA_HEADS, QK_NOPE_DIM + V_HEAD_DIM)
    k_nope, v = kv[..., :QK_NOPE_DIM], kv[..., QK_NOPE_DIM:]

    inv_freq = 1.0 / (ROPE_THETA ** (jnp.arange(0, QK_ROPE_DIM, 2, dtype=jnp.float32) / QK_ROPE_DIM))
    ang = positions.astype(jnp.float32)[..., None] * inv_freq
    cos, sin = jnp.cos(ang), jnp.sin(ang)
    q_rope = apply_rope(q_rope, cos[:, :, None, :], sin[:, :, None, :])
    k_rope = apply_rope(k_rope, cos, sin)
    scale = (QK_NOPE_DIM + QK_ROPE_DIM) ** -0.5

    nb = S // Q_BLOCK
    qn_blocks = q_nope.reshape(B, nb, Q_BLOCK, MLA_HEADS, QK_NOPE_DIM).transpose(1, 0, 2, 3, 4)
    qr_blocks = q_rope.reshape(B, nb, Q_BLOCK, MLA_HEADS, QK_ROPE_DIM).transpose(1, 0, 2, 3, 4)
    starts = jnp.arange(nb, dtype=jnp.int32) * Q_BLOCK
    key_idx = jnp.arange(S, dtype=jnp.int32)

    def attend_block(args):
        qn, qr, start = args
        s = (jnp.einsum('bqhd,bkhd->bhqk', qn, k_nope)
             + jnp.einsum('bqhd,bkd->bhqk', qr, k_rope)).astype(jnp.float32) * scale
        q_idx = start + jnp.arange(Q_BLOCK, dtype=jnp.int32)
        mask = key_idx[None, :] <= q_idx[:, None]
        s = jnp.where(mask[None, None], s, -jnp.inf)
        p = jax.nn.softmax(s, axis=-1).astype(v.dtype)
        return jnp.einsum('bhqk,bkhd->bqhd', p, v)

    out = lax.map(attend_block, (qn_blocks, qr_blocks, starts))
    return out.transpose(1, 0, 2, 3, 4).reshape(B, S, MLA_HEADS * V_HEAD_DIM)


def hybrid_mixer(h, positions, w_in, conv_w, conv_b, lru_wa, lru_ba, lru_wx, lru_bx, lru_lambda,
                 q_norm_g, w_uq, kv_norm_g, w_ukv, lru_out_g, mla_out_g, w_out):
    proj = h @ w_in
    x_lru, gate_lru, q_lat, kv_lat, k_rope = split_cols(proj, IN_SPLITS)
    xc = causal_depthwise_conv(x_lru, conv_w, conv_b)
    y_lru = jax.nn.gelu(gate_lru) * rg_lru(xc, lru_wa, lru_ba, lru_wx, lru_bx, lru_lambda)
    y_mla = mla_attention(q_lat, kv_lat, k_rope, positions, q_norm_g, w_uq, kv_norm_g, w_ukv)
    y = jnp.concatenate([rmsnorm(y_lru, lru_out_g), rmsnorm(y_mla, mla_out_g)], axis=-1)
    return y @ w_out


def peer_ffn(h, wq, keys, u, v):
    B, S, D = h.shape
    T = B * S
    hf = h.reshape(T, D)
    q = (hf @ wq).reshape(T, PEER_HEADS, 2, PEER_HALF_DIM).astype(jnp.float32)
    s = jnp.einsum('thpd,hpkd->thpk', q, keys.astype(jnp.float32))
    s_top, i_top = lax.top_k(s, PEER_TOPK)
    cand_s = (s_top[:, :, 0, :, None] + s_top[:, :, 1, None, :]).reshape(T, PEER_HEADS, PEER_TOPK * PEER_TOPK)
    cand_i = (i_top[:, :, 0, :, None] * PEER_N_KEYS + i_top[:, :, 1, None, :]).reshape(T, PEER_HEADS, PEER_TOPK * PEER_TOPK)
    best_s, pos = lax.top_k(cand_s, PEER_TOPK)
    idx = jnp.take_along_axis(cand_i, pos, axis=-1)
    g = jax.nn.softmax(best_s, axis=-1).astype(h.dtype)

    nc = T // PEER_TOKEN_CHUNK
    hc = hf.reshape(nc, PEER_TOKEN_CHUNK, D)
    ic = idx.reshape(nc, PEER_TOKEN_CHUNK, PEER_HEADS, PEER_TOPK)
    gc = g.reshape(nc, PEER_TOKEN_CHUNK, PEER_HEADS, PEER_TOPK)

    def expert_chunk(args):
        xc, ii, gg = args
        act = jax.nn.gelu(jnp.einsum('chkd,cd->chk', u[ii], xc))
        return jnp.einsum('chk,chkd->cd', gg * act, v[ii])

    out = lax.map(expert_chunk, (hc, ic, gc))
    return out.reshape(B, S, D)


def setup_inputs(seed: int = 0) -> dict:
    key = jax.random.key(seed)
    ks = jax.random.split(key, 32)
    L, D = DEPTH, D_MODEL

    def nrm(k, shape, scale):
        return jax.random.normal(k, shape, jnp.float32) * scale

    def gain(k, shape):
        return 1.0 + 0.02 * jax.random.normal(k, shape, jnp.float32)

    x = nrm(ks[0], (BATCH, SEQ, D), 1.0)
    c = nrm(ks[1], (BATCH, D), 1.0)
    positions = (jax.random.randint(ks[2], (BATCH, 1), 0, 4096, dtype=jnp.int32)
                 + jnp.arange(SEQ, dtype=jnp.int32)[None, :])
    a0 = jax.random.uniform(ks[13], (L, LRU_WIDTH), jnp.float32, minval=0.9, maxval=0.999) ** (1.0 / LRU_C)
    return {
        "x": x,
        "c": c,
        "positions": positions,
        "w_ada": nrm(ks[3], (L, D, 6 * D), 0.5 * D ** -0.5),
        "b_ada": nrm(ks[4], (L, 6 * D), 0.01),
        "norm1_g": gain(ks[5], (L, D)),
        "w_in": nrm(ks[6], (L, D, IN_WIDTH), D ** -0.5),
        "conv_w": nrm(ks[7], (L, CONV_WIDTH, LRU_WIDTH), CONV_WIDTH ** -0.5),
        "conv_b": nrm(ks[8], (L, LRU_WIDTH), 0.01),
        "lru_wa": nrm(ks[9], (L, LRU_BLOCKS, LRU_BLOCK_DIM, LRU_BLOCK_DIM), LRU_BLOCK_DIM ** -0.5),
        "lru_ba": nrm(ks[10], (L, LRU_WIDTH), 0.01),
        "lru_wx": nrm(ks[11], (L, LRU_BLOCKS, LRU_BLOCK_DIM, LRU_BLOCK_DIM), LRU_BLOCK_DIM ** -0.5),
        "lru_bx": nrm(ks[12], (L, LRU_WIDTH), 0.01),
        "lru_lambda": jnp.log(a0) - jnp.log1p(-a0),
        "q_norm_g": gain(ks[14], (L, Q_LORA_RANK)),
        "w_uq": nrm(ks[15], (L, Q_LORA_RANK, MLA_HEADS * (QK_NOPE_DIM + QK_ROPE_DIM)), Q_LORA_RANK ** -0.5),
        "kv_norm_g": gain(ks[16], (L, KV_LORA_RANK)),
        "w_ukv": nrm(ks[17], (L, KV_LORA_RANK, MLA_HEADS * (QK_NOPE_DIM + V_HEAD_DIM)), KV_LORA_RANK ** -0.5),
        "lru_out_g": gain(ks[18], (L, LRU_WIDTH)),
        "mla_out_g": gain(ks[19], (L, MLA_HEADS * V_HEAD_DIM)),
        "w_out": nrm(ks[20], (L, MIX_WIDTH, D), MIX_WIDTH ** -0.5),
        "norm2_g": gain(ks[21], (L, D)),
        "peer_wq": nrm(ks[22], (L, D, PEER_HEADS * PEER_QUERY_DIM), D ** -0.5),
        "peer_keys": nrm(ks[23], (L, PEER_HEADS, 2, PEER_N_KEYS, PEER_HALF_DIM), PEER_HALF_DIM ** -0.5),
        "peer_u": nrm(ks[24], (L, PEER_N_EXPERTS, D), D ** -0.5),
        "peer_v": nrm(ks[25], (L, PEER_N_EXPERTS, D), PEER_HEADS ** -0.5),
        "final_g": gain(ks[26], (D,)),
    }


def reference(x, c, positions, w_ada, b_ada, norm1_g, w_in, conv_w, conv_b, lru_wa, lru_ba,
              lru_wx, lru_bx, lru_lambda, q_norm_g, w_uq, kv_norm_g, w_ukv, lru_out_g, mla_out_g,
              w_out, norm2_g, peer_wq, peer_keys, peer_u, peer_v, final_g):
    c_act = jax.nn.silu(c)
    for l in range(DEPTH):
        mod = c_act @ w_ada[l] + b_ada[l]
        shift1, scale1, gate1, shift2, scale2, gate2 = jnp.split(mod, 6, axis=-1)
        h = modulate(rmsnorm(x, norm1_g[l]), shift1, scale1)
        mix = hybrid_mixer(h, positions, w_in[l], conv_w[l], conv_b[l], lru_wa[l], lru_ba[l],
                           lru_wx[l], lru_bx[l], lru_lambda[l], q_norm_g[l], w_uq[l],
                           kv_norm_g[l], w_ukv[l], lru_out_g[l], mla_out_g[l], w_out[l])
        x = x + gate1[:, None, :] * mix
        h = modulate(rmsnorm(x, norm2_g[l]), shift2, scale2)
        x = x + gate2[:, None, :] * peer_ffn(h, peer_wq[l], peer_keys[l], peer_u[l], peer_v[l])
    return rmsnorm(x, final_g)
```

```cpp
#include <hip/hip_runtime.h>
#include <hip/hip_cooperative_groups.h>
#include <cstdio>
#include <cstdint>
namespace cg = cooperative_groups;

#ifndef N_LAUNCH_MODE
#define N_LAUNCH_MODE 4
#endif

typedef short bf16x8 __attribute__((ext_vector_type(8)));
typedef float f32x16 __attribute__((ext_vector_type(16)));
typedef float f32x4 __attribute__((ext_vector_type(4)));
typedef float f32x2 __attribute__((ext_vector_type(2)));
typedef unsigned u32x4 __attribute__((ext_vector_type(4)));
typedef unsigned u32x2 __attribute__((ext_vector_type(2)));
typedef __bf16 bf16x2_t __attribute__((ext_vector_type(2)));
typedef unsigned short u16;

#define DI __device__ __forceinline__
#define MFMA32(a, b, c) __builtin_amdgcn_mfma_f32_32x32x16_bf16((a), (b), (c), 0, 0, 0)

constexpr int NB = 32, SEQ = 2048, DM = 1024, NTOK = NB * SEQ;
constexpr int INW = 1440;
constexpr int NTHREADS = 512;
constexpr int LDA = 1032;
constexpr int LDS_BYTES = 147456;
constexpr float EPS = 1e-6f;

struct Params {
  const float* x; const float* c; const int* pos;
  const float* w_ada; const float* b_ada; const float* norm1_g; const float* w_in; const float* conv_w; const float* conv_b;
  const float* lru_wa; const float* lru_ba; const float* lru_wx; const float* lru_bx; const float* lru_lambda;
  const float* q_norm_g; const float* w_uq; const float* kv_norm_g; const float* w_ukv; const float* lru_out_g; const float* mla_out_g;
  const float* w_out; const float* norm2_g; const float* peer_wq; const float* peer_keys; const float* peer_u; const float* peer_v; const float* final_g;
  float* out;
  float* mod; float* ssq_lru; float* ssq_mla; double* invfreq;
  bf16x8* Wf_in; bf16x8* Wf_uq; bf16x8* Wf_ukv; bf16x8* Wf_a; bf16x8* Wf_x; bf16x8* Wf_out; bf16x8* Wf_q; bf16x8* Kf;
  u16* Ub; u16* Vb; u16* xlru; u16* gate; u16* Q; u16* Kn; u16* Kr; u16* Vt; u16* y;
  char* scratch;
};

DI unsigned pk2(float a, float b) { f32x2 v = {a, b}; bf16x2_t r = __builtin_convertvector(v, bf16x2_t); return __builtin_bit_cast(unsigned, r); }
DI u16 f2bf(float a) { return (u16)(pk2(a, 0.f) & 0xffffu); }
DI float bflo(unsigned u) { return __uint_as_float(u << 16); }
DI float bfhi(unsigned u) { return __uint_as_float(u & 0xffff0000u); }
DI float bf2f(u16 h) { return __uint_as_float(((unsigned)h) << 16); }
DI float wave_sum(float v) {
#pragma unroll
  for (int o = 32; o >= 1; o >>= 1) v += __shfl_xor(v, o);
  return v;
}
DI float sigmoidf_(float x) { return 1.f / (1.f + __expf(-x)); }
DI float gelu_tanh(float x) { const float u = 0.7978845608028654f * (x + 0.044715f * x * x * x); return x / (1.f + __expf(-2.f * u)); }
DI f32x16 zero16() { f32x16 z; for (int i = 0; i < 16; ++i) z[i] = 0.f; return z; }
DI int crow(int reg, int h) { return (reg & 3) + 8 * (reg >> 2) + 4 * h; }

template <int NT>
DI void gemm_core(const u16* As, int lda, int nks, const bf16x8* __restrict__ Wf, int KS, const int (&tile)[NT], f32x16 (&acc)[NT][2], int lane) {
  const bf16x8* a0p = (const bf16x8*)(As + (lane & 31) * lda + 8 * (lane >> 5));
  const bf16x8* a1p = (const bf16x8*)(As + ((lane & 31) + 32) * lda + 8 * (lane >> 5));
  const bf16x8* bp[NT];
#pragma unroll
  for (int t = 0; t < NT; ++t) bp[t] = Wf + (size_t)tile[t] * KS * 64 + lane;
#pragma unroll 2
  for (int ks = 0; ks < nks; ++ks) {
    const bf16x8 a0 = a0p[2 * ks], a1 = a1p[2 * ks];
#pragma unroll
    for (int t = 0; t < NT; ++t) {
      const bf16x8 b = bp[t][ks * 64];
      acc[t][0] = MFMA32(a0, b, acc[t][0]);
      acc[t][1] = MFMA32(a1, b, acc[t][1]);
    }
  }
}

DI void conv_frag(const float* __restrict__ W, long sk, long sn, int K, int N, const float* ks1, const float* ks2, int ksplit, bf16x8* out, int gtid, int gthreads) {
  const int KS = K / 16; const int total = (N / 32) * KS * 64;
  for (int i = gtid; i < total; i += gthreads) {
    const int lane = i & 63; const int t = i >> 6; const int ks = t % KS; const int nt = t / KS;
    const int n = nt * 32 + (lane & 31); const int k0 = ks * 16 + 8 * (lane >> 5);
    float v[8];
#pragma unroll
    for (int j = 0; j < 8; ++j) {
      const int k = k0 + j;
      float s = 1.f;
      if (ks1) s = (k < ksplit) ? ks1[k] : ks2[k - ksplit];
      v[j] = W[(long)k * sk + (long)n * sn] * s;
    }
    u32x4 o; o[0] = pk2(v[0], v[1]); o[1] = pk2(v[2], v[3]); o[2] = pk2(v[4], v[5]); o[3] = pk2(v[6], v[7]);
    out[i] = __builtin_bit_cast(bf16x8, o);
  }
}

DI void phase0(const Params& p, char* smem) {
  const int tid = threadIdx.x; const int gtid = blockIdx.x * NTHREADS + tid; const int gthreads = gridDim.x * NTHREADS;
  for (int i = gtid; i < NTOK; i += gthreads) { p.ssq_lru[i] = 0.f; p.ssq_mla[i] = 0.f; }
  if (gtid < 16) p.invfreq[gtid] = pow(10000.0, -(double)gtid / 16.0);
  {
    float* cact = (float*)smem;
    bool staged = false;
    for (int item = blockIdx.x; item < 96; item += gridDim.x) {
      if (!staged) {
        for (int i = tid; i < NB * DM; i += NTHREADS) { const float v = p.c[i]; cact[i] = v / (1.f + __expf(-v)); }
        __syncthreads(); staged = true;
      }
      const int col = item * 64 + (tid & 63); const int bg = tid >> 6;
      float a0 = 0.f, a1 = 0.f, a2 = 0.f, a3 = 0.f;
      const float* cb = cact + bg * 4 * DM;
#pragma unroll 4
      for (int k = 0; k < DM; ++k) {
        const float w = p.w_ada[(size_t)k * 6144 + col];
        a0 += cb[k] * w; a1 += cb[DM + k] * w; a2 += cb[2 * DM + k] * w; a3 += cb[3 * DM + k] * w;
      }
      const float bb = p.b_ada[col];
      p.mod[(size_t)(bg * 4 + 0) * 6144 + col] = a0 + bb; p.mod[(size_t)(bg * 4 + 1) * 6144 + col] = a1 + bb;
      p.mod[(size_t)(bg * 4 + 2) * 6144 + col] = a2 + bb; p.mod[(size_t)(bg * 4 + 3) * 6144 + col] = a3 + bb;
    }
  }
  conv_frag(p.w_in, INW, 1, 1024, INW, nullptr, nullptr, 0, p.Wf_in, gtid, gthreads);
  conv_frag(p.w_uq, 768, 1, 256, 768, p.q_norm_g, p.q_norm_g, 256, p.Wf_uq, gtid, gthreads);
  conv_frag(p.w_ukv, 1024, 1, 128, 1024, p.kv_norm_g, p.kv_norm_g, 128, p.Wf_ukv, gtid, gthreads);
  for (int h = 0; h < 8; ++h) {
    conv_frag(p.lru_wa + h * 4096, 64, 1, 64, 64, nullptr, nullptr, 0, p.Wf_a + h * 512, gtid, gthreads);
    conv_frag(p.lru_wx + h * 4096, 64, 1, 64, 64, nullptr, nullptr, 0, p.Wf_x + h * 512, gtid, gthreads);
  }
  conv_frag(p.w_out, 1024, 1, 1024, 1024, p.lru_out_g, p.mla_out_g, 512, p.Wf_out, gtid, gthreads);
  conv_frag(p.peer_wq, 2048, 1, 1024, 2048, nullptr, nullptr, 0, p.Wf_q, gtid, gthreads);
  for (int m = 0; m < 16; ++m)
    conv_frag(p.peer_keys + m * 16384, 1, 128, 128, 128, nullptr, nullptr, 0, p.Kf + m * 2048, gtid, gthreads);
  {
    const f32x4* us = (const f32x4*)p.peer_u; const f32x4* vs = (const f32x4*)p.peer_v;
    u32x4* ud = (u32x4*)p.Ub; u32x4* vd = (u32x4*)p.Vb;
    const int total = 16384 * 1024 / 8;
    for (int i = gtid; i < total; i += gthreads) {
      const f32x4 a = us[2 * i], b = us[2 * i + 1];
      u32x4 o; o[0] = pk2(a[0], a[1]); o[1] = pk2(a[2], a[3]); o[2] = pk2(b[0], b[1]); o[3] = pk2(b[2], b[3]);
      ud[i] = o;
      const f32x4 c2 = vs[2 * i], d2 = vs[2 * i + 1];
      u32x4 o2; o2[0] = pk2(c2[0], c2[1]); o2[1] = pk2(c2[2], c2[3]); o2[2] = pk2(d2[0], d2[1]); o2[3] = pk2(d2[2], d2[3]);
      vd[i] = o2;
    }
  }
}

DI void phase1(const Params& p, char* smem) {
  const int tid = threadIdx.x, wave = __builtin_amdgcn_readfirstlane(tid >> 6);
  u16* hA = (u16*)smem;
  float* cs = (float*)(smem + 132096);
  float* ssq = (float*)(smem + 132096 + 8192);
  constexpr int LDL = 424;
  for (int tile = blockIdx.x; tile < NTOK / 64; tile += gridDim.x) {
    int lane_o = tid & 63; asm volatile("" : "+v"(lane_o));
    const int lane = lane_o, l31 = lane & 31, lh = lane >> 5;
    const int tok0 = tile * 64; const int b = tok0 / SEQ; const int s0 = tok0 % SEQ;
    const float* modb = p.mod + (size_t)b * 6144;
    for (int i = tid; i < 1024; i += NTHREADS) {
      const int r = i >> 4, j = i & 15;
      const double ang = (double)p.pos[tok0 + r] * p.invfreq[j];
      double rev = ang * 0.15915494309189535; rev -= floor(rev);
      const float rf = (float)rev;
      cs[2 * i] = __builtin_amdgcn_cosf(rf); cs[2 * i + 1] = __builtin_amdgcn_sinf(rf);
    }
    if (tid < 128) ssq[tid] = 0.f;
    {
      f32x4 cm[4], ca[4];
#pragma unroll
      for (int i = 0; i < 4; ++i) {
        const int col = i * 256 + lane * 4;
        const f32x4 g = *(const f32x4*)(p.norm1_g + col); const f32x4 sc = *(const f32x4*)(modb + 1024 + col);
        cm[i] = g * (sc + 1.0f); ca[i] = *(const f32x4*)(modb + col);
      }
#pragma unroll 2
      for (int rr = 0; rr < 8; rr += 4) {
        f32x4 xv[4][4];
#pragma unroll
        for (int q = 0; q < 4; ++q)
#pragma unroll
          for (int i = 0; i < 4; ++i) xv[q][i] = *(const f32x4*)(p.x + (size_t)(tok0 + wave * 8 + rr + q) * DM + i * 256 + lane * 4);
#pragma unroll
        for (int q = 0; q < 4; ++q) {
          float ss = 0.f;
#pragma unroll
          for (int i = 0; i < 4; ++i) ss += xv[q][i][0] * xv[q][i][0] + xv[q][i][1] * xv[q][i][1] + xv[q][i][2] * xv[q][i][2] + xv[q][i][3] * xv[q][i][3];
          ss = wave_sum(ss);
          const float rs = rsqrtf(ss * (1.f / 1024.f) + EPS);
          const int row = wave * 8 + rr + q;
#pragma unroll
          for (int i = 0; i < 4; ++i) {
            const f32x4 h = xv[q][i] * rs * cm[i] + ca[i];
            u32x2 o; o[0] = pk2(h[0], h[1]); o[1] = pk2(h[2], h[3]);
            *(u32x2*)(hA + row * LDA + i * 256 + lane * 4) = o;
          }
        }
      }
    }
    __syncthreads();
    {
      f32x16 acc[3][2];
#pragma unroll
      for (int t = 0; t < 3; ++t) { acc[t][0] = zero16(); acc[t][1] = zero16(); }
      const int tl[3] = {wave, wave + 8, wave + 16};
      gemm_core<3>(hA, LDA, 64, p.Wf_in, 64, tl, acc, lane);
      u16* dstb[3];
#pragma unroll
      for (int t = 0; t < 3; ++t) { const int col = tl[t] * 32 + l31; dstb[t] = (col < 512) ? (p.xlru + col) : (p.gate + (col - 512)); }
#pragma unroll
      for (int rt = 0; rt < 2; ++rt)
#pragma unroll
        for (int r = 0; r < 16; ++r) {
          const size_t ro = (size_t)(tok0 + rt * 32 + crow(r, lh)) * 512;
#pragma unroll
          for (int t = 0; t < 3; ++t) dstb[t][ro] = f2bf(acc[t][rt][r]);
        }
    }
    {
      f32x16 acc[3][2];
#pragma unroll
      for (int t = 0; t < 3; ++t) { acc[t][0] = zero16(); acc[t][1] = zero16(); }
      const bool has3 = (wave + 40) < 45;
      const int tl[3] = {wave + 24, wave + 32, has3 ? wave + 40 : wave + 32};
      gemm_core<3>(hA, LDA, 64, p.Wf_in, 64, tl, acc, lane);
      {
        const int col = tl[0] * 32 + l31;
        u16* dst = p.gate + (col - 512);
#pragma unroll
        for (int rt = 0; rt < 2; ++rt)
#pragma unroll
          for (int r = 0; r < 16; ++r) dst[(size_t)(tok0 + rt * 32 + crow(r, lh)) * 512] = f2bf(acc[0][rt][r]);
      }
      __syncthreads();
      u16* lat = hA;
#pragma unroll
      for (int t = 1; t < 3; ++t) {
        if (t == 2 && !has3) continue;
        const int lc = tl[t] * 32 - 1024 + l31;
#pragma unroll
        for (int rt = 0; rt < 2; ++rt)
#pragma unroll
          for (int r = 0; r < 16; ++r) {
            const int row = rt * 32 + crow(r, lh);
            const float v = acc[t][rt][r];
            if (lc < 384) {
              lat[row * LDL + lc] = f2bf(v);
              __hip_atomic_fetch_add(&ssq[(lc < 256 ? 0 : 64) + row], v * v, __ATOMIC_RELAXED, __HIP_MEMORY_SCOPE_WORKGROUP);
            } else {
              const float pv = __shfl_xor(v, 16);
              const int j = lc - 384; const int jj = j & 15;
              const float co = cs[(row * 16 + jj) * 2], si = cs[(row * 16 + jj) * 2 + 1];
              const float o = (j < 16) ? (v * co - pv * si) : (v * co + pv * si);
              p.Kr[(size_t)(tok0 + row) * 32 + j] = f2bf(o);
            }
          }
      }
    }
    __syncthreads();
    {
      const u16* lat = hA;
      {
        f32x16 acc[3][2];
#pragma unroll
        for (int t = 0; t < 3; ++t) { acc[t][0] = zero16(); acc[t][1] = zero16(); }
        const int tl[3] = {wave, wave + 8, wave + 16};
        gemm_core<3>(lat, LDL, 16, p.Wf_uq, 16, tl, acc, lane);
        const float qscale = 0.10206207261596577f * 1.4426950408889634f;
        const int jj = l31 & 15;
#pragma unroll
        for (int rt = 0; rt < 2; ++rt)
#pragma unroll
          for (int r = 0; r < 16; ++r) {
            const int row = rt * 32 + crow(r, lh);
            const float rs = rsqrtf(ssq[row] * (1.f / 256.f) + EPS) * qscale;
            const float co = cs[(row * 16 + jj) * 2], si = cs[(row * 16 + jj) * 2 + 1];
#pragma unroll
            for (int t = 0; t < 3; ++t) {
              const int head = tl[t] / 3, part = tl[t] % 3;
              float v = acc[t][rt][r] * rs;
              if (part == 2) {
                const float pv = __shfl_xor(v, 16);
                v = (l31 < 16) ? (v * co - pv * si) : (v * co + pv * si);
              }
              p.Q[((size_t)(b * 8 + head) * SEQ + s0 + row) * 96 + part * 32 + l31] = f2bf(v);
            }
          }
      }
      {
        f32x16 acc[4][2];
#pragma unroll
        for (int t = 0; t < 4; ++t) { acc[t][0] = zero16(); acc[t][1] = zero16(); }
        const int tl[4] = {wave, wave + 8, wave + 16, wave + 24};
        gemm_core<4>(lat + 256, LDL, 8, p.Wf_ukv, 8, tl, acc, lane);
#pragma unroll
        for (int rt = 0; rt < 2; ++rt)
#pragma unroll
          for (int g = 0; g < 4; ++g) {
            const int row = rt * 32 + 8 * g + 4 * lh;
            float rs4[4];
#pragma unroll
            for (int q = 0; q < 4; ++q) rs4[q] = rsqrtf(ssq[64 + row + q] * (1.f / 128.f) + EPS);
#pragma unroll
            for (int t = 0; t < 4; ++t) {
              const int head = tl[t] >> 2, sub = tl[t] & 3;
              float v4[4];
#pragma unroll
              for (int q = 0; q < 4; ++q) v4[q] = acc[t][rt][4 * g + q] * rs4[q];
              if (sub < 2) {
#pragma unroll
                for (int q = 0; q < 4; ++q) p.Kn[((size_t)(b * 8 + head) * SEQ + s0 + row + q) * 64 + sub * 32 + l31] = f2bf(v4[q]);
              } else {
                const int d = (sub - 2) * 32 + l31;
                u32x2 o; o[0] = pk2(v4[0], v4[1]); o[1] = pk2(v4[2], v4[3]);
                *(u32x2*)(p.Vt + ((size_t)(b * 8 + head) * 64 + d) * SEQ + s0 + row) = o;
              }
            }
          }
      }
    }
    __syncthreads();
  }
}

DI void lru_item(const Params& p, char* smem, int item) {
  const int tid = threadIdx.x, lane = tid & 63, wave = __builtin_amdgcn_readfirstlane(tid >> 6);
  const int l31 = lane & 31, lh = lane >> 5;
  const int b = item >> 3, cb = item & 7;
  u16* xcb = (u16*)smem;
  float* pre = (float*)(smem + 9216);
  float* seg = (float*)(smem + 9216 + 33280);
  const int c = lane; const int ch = cb * 64 + c; const int tg = wave;
  const float cw0 = p.conv_w[ch], cw1 = p.conv_w[512 + ch], cw2 = p.conv_w[1024 + ch], cw3 = p.conv_w[1536 + ch], cbias = p.conv_b[ch];
  const float ba = p.lru_ba[ch], bx = p.lru_bx[ch];
  const float sp = log1pf(__expf(-p.lru_lambda[ch]));
  float carry = 0.f;
  const u16* xl = p.xlru + (size_t)b * SEQ * 512 + ch;
  const u16* gt = p.gate + (size_t)b * SEQ * 512 + ch;
  u16* yo = p.y + (size_t)b * SEQ * 1024 + ch;
  const int mat = wave >> 2, rt = (wave >> 1) & 1, ct = wave & 1;
  const bf16x8* wf = (mat == 0 ? p.Wf_a : p.Wf_x) + cb * 512 + ct * 256 + lane;
  bf16x8 bw[4];
#pragma unroll
  for (int ks = 0; ks < 4; ++ks) bw[ks] = wf[ks * 64];
  for (int chunk = 0; chunk < SEQ / 64; ++chunk) {
    const int t0 = chunk * 64 + tg * 8;
    float xin[11];
#pragma unroll
    for (int i = 0; i < 11; ++i) { const int t = t0 - 3 + i; xin[i] = (t >= 0) ? bf2f(xl[(size_t)t * 512]) : 0.f; }
    float xc[8];
#pragma unroll
    for (int i = 0; i < 8; ++i) {
      xc[i] = cbias + cw0 * xin[i] + cw1 * xin[i + 1] + cw2 * xin[i + 2] + cw3 * xin[i + 3];
      xcb[(tg * 8 + i) * 72 + c] = f2bf(xc[i]);
    }
    float gv[8];
#pragma unroll
    for (int i = 0; i < 8; ++i) gv[i] = bf2f(gt[(size_t)(t0 + i) * 512]);
    __syncthreads();
    {
      f32x16 acc = zero16();
      const bf16x8* ap = (const bf16x8*)(xcb + (rt * 32 + l31) * 72 + 8 * lh);
#pragma unroll
      for (int ks = 0; ks < 4; ++ks) acc = MFMA32(ap[2 * ks], bw[ks], acc);
      float* pm = pre + mat * 4160;
#pragma unroll
      for (int r = 0; r < 16; ++r) pm[(rt * 32 + crow(r, lh)) * 65 + ct * 32 + l31] = acc[r];
    }
    __syncthreads();
    float av[8], bv[8];
    float A = 1.f, Bc = 0.f;
#pragma unroll
    for (int i = 0; i < 8; ++i) {
      const int tl = tg * 8 + i;
      const float r = sigmoidf_(pre[tl * 65 + c] + ba);
      const float ig = sigmoidf_(pre[4160 + tl * 65 + c] + bx);
      const float log_a = -8.f * r * sp;
      const float a = __expf(log_a);
      const float m = sqrtf(-expm1f(2.f * log_a));
      av[i] = a; bv[i] = m * ig * xc[i];
      A *= a; Bc = a * Bc + bv[i];
    }
    seg[(tg * 64 + c) * 2] = A; seg[(tg * 64 + c) * 2 + 1] = Bc;
    __syncthreads();
    float h = carry, hin = 0.f;
#pragma unroll
    for (int s = 0; s < 8; ++s) {
      if (s == tg) hin = h;
      h = seg[(s * 64 + c) * 2] * h + seg[(s * 64 + c) * 2 + 1];
    }
    carry = h;
    h = hin;
#pragma unroll
    for (int i = 0; i < 8; ++i) {
      h = av[i] * h + bv[i];
      const float yv = gelu_tanh(gv[i]) * h;
      yo[(size_t)(t0 + i) * 1024] = f2bf(yv);
      const float ssum = wave_sum(yv * yv);
      if (lane == 0) unsafeAtomicAdd(p.ssq_lru + (size_t)b * SEQ + t0 + i, ssum);
    }
  }
  __syncthreads();
}

DI void attn_unit(const Params& p, char* smem, int b, int hd, int qb) {
  const int tid = threadIdx.x, lane = tid & 63, wave = __builtin_amdgcn_readfirstlane(tid >> 6);
  const int l31 = lane & 31, lh = lane >> 5;
  u16* Kl = (u16*)smem;
  u16* Vl = (u16*)(smem + 13312);
  const int q0 = qb * 256 + wave * 32;
  const size_t bh = (size_t)(b * 8 + hd);
  bf16x8 qf[6];
  {
    const bf16x8* qp = (const bf16x8*)(p.Q + (bh * SEQ + q0 + l31) * 96 + 8 * lh);
#pragma unroll
    for (int ks = 0; ks < 6; ++ks) qf[ks] = qp[2 * ks];
  }
  f32x16 o0 = zero16(), o1 = zero16();
  float m_run = -1e30f, l_run = 0.f;
  const int nkt = qb * 4 + 4;
  const int qidx = q0 + l31;
  for (int kt = 0; kt < nkt; ++kt) {
    __syncthreads();
    {
      const int key = tid >> 3, chn = tid & 7;
      *(u32x4*)(Kl + key * 104 + chn * 8) = *(const u32x4*)(p.Kn + (bh * SEQ + kt * 64 + key) * 64 + chn * 8);
      if (tid < 256) {
        const int key2 = tid >> 2, ch2 = tid & 3;
        *(u32x4*)(Kl + key2 * 104 + 64 + ch2 * 8) = *(const u32x4*)(p.Kr + ((size_t)b * SEQ + kt * 64 + key2) * 32 + ch2 * 8);
      }
      const int d = tid >> 3;
      *(u32x4*)(Vl + d * 72 + chn * 8) = *(const u32x4*)(p.Vt + (bh * 64 + d) * SEQ + kt * 64 + chn * 8);
    }
    __syncthreads();
    if (kt * 64 <= q0 + 31) {
      f32x16 s[2];
#pragma unroll
      for (int st = 0; st < 2; ++st) {
        s[st] = zero16();
        const bf16x8* kp = (const bf16x8*)(Kl + (st * 32 + l31) * 104 + 8 * lh);
#pragma unroll
        for (int ks = 0; ks < 6; ++ks) s[st] = MFMA32(kp[2 * ks], qf[ks], s[st]);
      }
      if (kt * 64 + 63 > q0) {
#pragma unroll
        for (int st = 0; st < 2; ++st)
#pragma unroll
          for (int r = 0; r < 16; ++r) { const int key = kt * 64 + st * 32 + crow(r, lh); if (key > qidx) s[st][r] = -1e30f; }
      }
      float mloc = s[0][0];
#pragma unroll
      for (int st = 0; st < 2; ++st)
#pragma unroll
        for (int r = 0; r < 16; ++r) mloc = fmaxf(mloc, s[st][r]);
      mloc = fmaxf(mloc, __shfl_xor(mloc, 32));
      const float m_new = fmaxf(m_run, mloc);
      const float alpha = __builtin_amdgcn_exp2f(m_run - m_new);
      m_run = m_new;
      float lsum = 0.f;
#pragma unroll
      for (int st = 0; st < 2; ++st)
#pragma unroll
        for (int r = 0; r < 16; ++r) { const float e = __builtin_amdgcn_exp2f(s[st][r] - m_new); s[st][r] = e; lsum += e; }
      l_run = l_run * alpha + lsum;
#pragma unroll
      for (int r = 0; r < 16; ++r) { o0[r] *= alpha; o1[r] *= alpha; }
#pragma unroll
      for (int st = 0; st < 2; ++st)
#pragma unroll
        for (int s2 = 0; s2 < 2; ++s2) {
          u32x4 pw;
#pragma unroll
          for (int j = 0; j < 4; ++j) pw[j] = pk2(s[st][8 * s2 + 2 * j], s[st][8 * s2 + 2 * j + 1]);
          const bf16x8 pf = __builtin_bit_cast(bf16x8, pw);
          const int kbase = st * 32 + s2 * 16 + 4 * lh;
          {
            const u32x2 va = *(const u32x2*)(Vl + l31 * 72 + kbase);
            const u32x2 vb = *(const u32x2*)(Vl + l31 * 72 + kbase + 8);
            u32x4 vv; vv[0] = va[0]; vv[1] = va[1]; vv[2] = vb[0]; vv[3] = vb[1];
            o0 = MFMA32(__builtin_bit_cast(bf16x8, vv), pf, o0);
          }
          {
            const u32x2 va = *(const u32x2*)(Vl + (32 + l31) * 72 + kbase);
            const u32x2 vb = *(const u32x2*)(Vl + (32 + l31) * 72 + kbase + 8);
            u32x4 vv; vv[0] = va[0]; vv[1] = va[1]; vv[2] = vb[0]; vv[3] = vb[1];
            o1 = MFMA32(__builtin_bit_cast(bf16x8, vv), pf, o1);
          }
        }
    }
  }
  const float ltot = l_run + __shfl_xor(l_run, 32);
  const float inv = 1.f / ltot;
  float ss = 0.f;
  u16* yrow = p.y + ((size_t)b * SEQ + qidx) * 1024 + 512 + hd * 64;
#pragma unroll
  for (int g = 0; g < 4; ++g) {
    float v0[4], v1[4];
#pragma unroll
    for (int q = 0; q < 4; ++q) { v0[q] = o0[4 * g + q] * inv; v1[q] = o1[4 * g + q] * inv; ss += v0[q] * v0[q] + v1[q] * v1[q]; }
    u32x2 a; a[0] = pk2(v0[0], v0[1]); a[1] = pk2(v0[2], v0[3]);
    u32x2 c2; c2[0] = pk2(v1[0], v1[1]); c2[1] = pk2(v1[2], v1[3]);
    *(u32x2*)(yrow + 8 * g + 4 * lh) = a;
    *(u32x2*)(yrow + 32 + 8 * g + 4 * lh) = c2;
  }
  ss += __shfl_xor(ss, 32);
  if (lh == 0) unsafeAtomicAdd(p.ssq_mla + (size_t)b * SEQ + qidx, ss);
}

DI void phase2(const Params& p, char* smem) {
  for (int item = blockIdx.x; item < 256; item += gridDim.x) lru_item(p, smem, item);
  for (int it = blockIdx.x; it < 1024; it += gridDim.x) {
    const int j = it & 3; const int bh = it >> 2; const int hd = bh & 7; const int b = bh >> 3;
    attn_unit(p, smem, b, hd, 7 - j);
    attn_unit(p, smem, b, hd, j);
  }
}

DI void ins16(float (&lst)[16], float x) {
#pragma unroll
  for (int i = 0; i < 16; ++i) { const float hi = fmaxf(lst[i], x); x = fminf(lst[i], x); lst[i] = hi; }
}
DI void merge_partner(float (&lst)[16]) {
  float o[16];
#pragma unroll
  for (int i = 0; i < 16; ++i) o[i] = __shfl_xor(lst[i], 32);
  float c[16];
#pragma unroll
  for (int i = 0; i < 16; ++i) c[i] = fmaxf(lst[i], o[15 - i]);
#pragma unroll
  for (int d = 8; d >= 1; d >>= 1) {
#pragma unroll
    for (int i = 0; i < 16; ++i) {
      if ((i & d) == 0) { const float hi = fmaxf(c[i], c[i + d]), lo = fminf(c[i], c[i + d]); c[i] = hi; c[i + d] = lo; }
    }
  }
#pragma unroll
  for (int i = 0; i < 16; ++i) lst[i] = c[i];
}

DI void phase3(const Params& p, char* smem) {
  const int tid = threadIdx.x, wave = __builtin_amdgcn_readfirstlane(tid >> 6);
  u16* A = (u16*)smem;
  float* ssq2 = (float*)(smem + 132096);
  char* scr = p.scratch + (size_t)blockIdx.x * 589824;
  float* x1s = (float*)scr;
  u16* qp = (u16*)(scr + 262144);
  int* eidx = (int*)(scr + 524288);
  float* egate = (float*)(scr + 524288 + 32768);
  for (int tile = blockIdx.x; tile < NTOK / 64; tile += gridDim.x) {
    int lane_o = tid & 63; asm volatile("" : "+v"(lane_o));
    const int lane = lane_o, l31 = lane & 31, lh = lane >> 5;
    const int tok0 = tile * 64; const int b = tok0 / SEQ;
    const float* modb = p.mod + (size_t)b * 6144;
    if (tid < 64) ssq2[tid] = 0.f;
#pragma unroll 2
    for (int rr = 0; rr < 8; ++rr) {
      const int row = wave * 8 + rr; const int tok = tok0 + row;
      const float rl = rsqrtf(p.ssq_lru[tok] * (1.f / 512.f) + EPS), rm = rsqrtf(p.ssq_mla[tok] * (1.f / 512.f) + EPS);
#pragma unroll
      for (int i = 0; i < 2; ++i) {
        const u32x4 v = *(const u32x4*)(p.y + (size_t)tok * 1024 + (i * 64 + lane) * 8);
        const float sc = i == 0 ? rl : rm;
        u32x4 o;
#pragma unroll
        for (int j = 0; j < 4; ++j) o[j] = pk2(bflo(v[j]) * sc, bfhi(v[j]) * sc);
        *(u32x4*)(A + row * LDA + (i * 64 + lane) * 8) = o;
      }
    }
    __syncthreads();
#pragma unroll 1
    for (int pass = 0; pass < 2; ++pass) {
      f32x16 acc[2][2];
#pragma unroll
      for (int t = 0; t < 2; ++t) { acc[t][0] = zero16(); acc[t][1] = zero16(); }
      const int tl[2] = {pass * 16 + wave, pass * 16 + wave + 8};
      gemm_core<2>(A, LDA, 64, p.Wf_out, 64, tl, acc, lane);
      float g1[2];
#pragma unroll
      for (int t = 0; t < 2; ++t) g1[t] = modb[2048 + tl[t] * 32 + l31];
#pragma unroll
      for (int rt = 0; rt < 2; ++rt)
#pragma unroll
        for (int r = 0; r < 16; ++r) {
          const int row = rt * 32 + crow(r, lh);
          float sq = 0.f;
#pragma unroll
          for (int t = 0; t < 2; ++t) {
            const int col = tl[t] * 32 + l31;
            const float v = p.x[(size_t)(tok0 + row) * DM + col] + g1[t] * acc[t][rt][r];
            x1s[row * 1024 + col] = v;
            sq += v * v;
          }
#pragma unroll
          for (int o = 16; o >= 1; o >>= 1) sq += __shfl_xor(sq, o);
          if (l31 == 0) __hip_atomic_fetch_add(&ssq2[row], sq, __ATOMIC_RELAXED, __HIP_MEMORY_SCOPE_WORKGROUP);
        }
    }
    __syncthreads();
    {
      f32x4 cm[4], ca[4];
#pragma unroll
      for (int i = 0; i < 4; ++i) {
        const int col = (i >> 1) * 512 + lane * 8 + (i & 1) * 4;
        const f32x4 g = *(const f32x4*)(p.norm2_g + col); const f32x4 sc = *(const f32x4*)(modb + 4096 + col);
        cm[i] = g * (sc + 1.0f); ca[i] = *(const f32x4*)(modb + 3072 + col);
      }
#pragma unroll 2
      for (int rr = 0; rr < 8; ++rr) {
        const int row = wave * 8 + rr;
        const float rs = rsqrtf(ssq2[row] * (1.f / 1024.f) + EPS);
#pragma unroll
        for (int i = 0; i < 2; ++i) {
          const f32x4 xa = *(const f32x4*)(x1s + row * 1024 + i * 512 + lane * 8), xb = *(const f32x4*)(x1s + row * 1024 + i * 512 + lane * 8 + 4);
          const f32x4 ha = xa * rs * cm[2 * i] + ca[2 * i], hb = xb * rs * cm[2 * i + 1] + ca[2 * i + 1];
          u32x4 o; o[0] = pk2(ha[0], ha[1]); o[1] = pk2(ha[2], ha[3]); o[2] = pk2(hb[0], hb[1]); o[3] = pk2(hb[2], hb[3]);
          *(u32x4*)(A + row * LDA + i * 512 + lane * 8) = o;
        }
      }
    }
    __syncthreads();
#pragma unroll 1
    for (int pass = 0; pass < 2; ++pass) {
      f32x16 acc[4][2];
#pragma unroll
      for (int t = 0; t < 4; ++t) { acc[t][0] = zero16(); acc[t][1] = zero16(); }
      const int tl[4] = {pass * 32 + wave, pass * 32 + wave + 8, pass * 32 + wave + 16, pass * 32 + wave + 24};
      gemm_core<4>(A, LDA, 64, p.Wf_q, 64, tl, acc, lane);
#pragma unroll
      for (int rt = 0; rt < 2; ++rt)
#pragma unroll
        for (int r = 0; r < 16; ++r) {
          u16* qrow = qp + (rt * 32 + crow(r, lh)) * 2048 + l31;
#pragma unroll
          for (int t = 0; t < 4; ++t) qrow[tl[t] * 32] = f2bf(acc[t][rt][r]);
        }
    }
    __syncthreads();
#pragma unroll 1
    for (int tt = 0; tt < 2; ++tt) {
      const int hd = wave;
      float s12[2][16];
#pragma unroll
      for (int ph = 0; ph < 2; ++ph) {
        const bf16x8* qfp = (const bf16x8*)(qp + (tt * 32 + l31) * 2048 + hd * 256 + ph * 128 + 8 * lh);
        bf16x8 qf[8];
#pragma unroll
        for (int ks = 0; ks < 8; ++ks) qf[ks] = qfp[2 * ks];
        const bf16x8* kf = p.Kf + (size_t)(hd * 2 + ph) * 2048 + lane;
        float lst[16];
#pragma unroll
        for (int i = 0; i < 16; ++i) lst[i] = -3.0e38f;
#pragma unroll 1
        for (int mt = 0; mt < 4; ++mt) {
          f32x16 acc = zero16();
#pragma unroll
          for (int ks = 0; ks < 8; ++ks) acc = MFMA32(kf[(mt * 8 + ks) * 64], qf[ks], acc);
#pragma unroll
          for (int r = 0; r < 16; ++r) {
            const int key = mt * 32 + crow(r, lh);
            const float v = __uint_as_float((__float_as_uint(acc[r]) & 0xffffff80u) | (unsigned)key);
            ins16(lst, v);
          }
        }
        merge_partner(lst);
#pragma unroll
        for (int i = 0; i < 16; ++i) s12[ph][i] = lst[i];
      }
      unsigned long long t1lo = 0, t1hi = 0, t2lo = 0, t2hi = 0;
#pragma unroll
      for (int i = 0; i < 8; ++i) {
        t1lo |= (unsigned long long)(__float_as_uint(s12[0][i]) & 127u) << (8 * i);
        t1hi |= (unsigned long long)(__float_as_uint(s12[0][8 + i]) & 127u) << (8 * i);
        t2lo |= (unsigned long long)(__float_as_uint(s12[1][i]) & 127u) << (8 * i);
        t2hi |= (unsigned long long)(__float_as_uint(s12[1][8 + i]) & 127u) << (8 * i);
      }
      float bv[16];
#pragma unroll
      for (int i = 0; i < 16; ++i) bv[i] = -3.0e38f;
#pragma unroll
      for (int i = 0; i < 16; ++i) {
#pragma unroll
        for (int j = 0; j < 16; ++j)
          if ((i + 1) * (j + 1) <= 16) {
            const float sv = s12[0][i] + s12[1][j];
            ins16(bv, __uint_as_float((__float_as_uint(sv) & 0xffffff00u) | (unsigned)(i * 16 + j)));
          }
      }
      int bi[16];
#pragma unroll
      for (int k = 0; k < 16; ++k) {
        const unsigned code = __float_as_uint(bv[k]) & 255u;
        const unsigned ci = code >> 4, cj = code & 15u;
        const unsigned long long w1 = (ci & 8u) ? t1hi : t1lo, w2 = (cj & 8u) ? t2hi : t2lo;
        const unsigned i1 = (unsigned)(w1 >> ((ci & 7u) * 8)) & 0xffu, i2 = (unsigned)(w2 >> ((cj & 7u) * 8)) & 0xffu;
        bi[k] = (int)(i1 * 128u + i2);
      }
      float esum = 0.f, ev[16];
#pragma unroll
      for (int i = 0; i < 16; ++i) { ev[i] = __expf(bv[i] - bv[0]); esum += ev[i]; }
      const float einv = 1.f / esum;
      if (lh == 0) {
        const int row = tt * 32 + l31;
#pragma unroll
        for (int i = 0; i < 16; ++i) { eidx[row * 128 + hd * 16 + i] = bi[i]; egate[row * 128 + hd * 16 + i] = ev[i] * einv; }
      }
    }
    __syncthreads();
#pragma unroll 1
    for (int rr = 0; rr < 8; ++rr) {
      const int row = rr * 8 + wave; const int tok = tok0 + row;
      float hf[16];
      {
        const u32x4 h0 = *(const u32x4*)(A + row * LDA + lane * 8), h1 = *(const u32x4*)(A + row * LDA + 512 + lane * 8);
#pragma unroll
        for (int j = 0; j < 4; ++j) { hf[2 * j] = bflo(h0[j]); hf[2 * j + 1] = bfhi(h0[j]); hf[8 + 2 * j] = bflo(h1[j]); hf[8 + 2 * j + 1] = bfhi(h1[j]); }
      }
      const int ia = eidx[row * 128 + lane], ib = eidx[row * 128 + 64 + lane];
      const float ga = egate[row * 128 + lane], gb = egate[row * 128 + 64 + lane];
      float ca = 0.f, cb2 = 0.f;
#pragma unroll 1
      for (int half = 0; half < 2; ++half) {
        const int iv = half ? ib : ia;
#pragma unroll 8
        for (int e = 0; e < 64; ++e) {
          const int id = __builtin_amdgcn_readlane(iv, e);
          const u32x4* up = (const u32x4*)(p.Ub + (size_t)id * 1024);
          const u32x4 u0 = up[lane], u1 = up[64 + lane];
          float d = 0.f;
#pragma unroll
          for (int j = 0; j < 4; ++j) d += bflo(u0[j]) * hf[2 * j] + bfhi(u0[j]) * hf[2 * j + 1] + bflo(u1[j]) * hf[8 + 2 * j] + bfhi(u1[j]) * hf[8 + 2 * j + 1];
          d = wave_sum(d);
          const float act = gelu_tanh(d);
          if (half == 0) { if (lane == e) ca = act; } else { if (lane == e) cb2 = act; }
        }
      }
      ca *= ga; cb2 *= gb;
      float oacc[16];
#pragma unroll
      for (int j = 0; j < 16; ++j) oacc[j] = 0.f;
#pragma unroll 1
      for (int half = 0; half < 2; ++half) {
        const int iv = half ? ib : ia; const float cv = half ? cb2 : ca;
#pragma unroll 8
        for (int e = 0; e < 64; ++e) {
          const int id = __builtin_amdgcn_readlane(iv, e);
          const float cf = __uint_as_float(__builtin_amdgcn_readlane(__float_as_uint(cv), e));
          const u32x4* vp = (const u32x4*)(p.Vb + (size_t)id * 1024);
          const u32x4 v0 = vp[lane], v1 = vp[64 + lane];
#pragma unroll
          for (int j = 0; j < 4; ++j) {
            oacc[2 * j] += cf * bflo(v0[j]); oacc[2 * j + 1] += cf * bfhi(v0[j]);
            oacc[8 + 2 * j] += cf * bflo(v1[j]); oacc[8 + 2 * j + 1] += cf * bfhi(v1[j]);
          }
        }
      }
      float xo[16]; float ss = 0.f;
#pragma unroll
      for (int i = 0; i < 2; ++i)
#pragma unroll
        for (int q = 0; q < 2; ++q) {
          const int col = i * 512 + lane * 8 + q * 4;
          const f32x4 xv = *(const f32x4*)(x1s + row * 1024 + col);
          const f32x4 g2 = *(const f32x4*)(modb + 5120 + col);
#pragma unroll
          for (int j = 0; j < 4; ++j) { const float v = xv[j] + g2[j] * oacc[i * 8 + q * 4 + j]; xo[i * 8 + q * 4 + j] = v; ss += v * v; }
        }
      ss = wave_sum(ss);
      const float rs = rsqrtf(ss * (1.f / 1024.f) + EPS);
#pragma unroll
      for (int i = 0; i < 2; ++i)
#pragma unroll
        for (int q = 0; q < 2; ++q) {
          const int col = i * 512 + lane * 8 + q * 4;
          const f32x4 fg = *(const f32x4*)(p.final_g + col);
          f32x4 o;
#pragma unroll
          for (int j = 0; j < 4; ++j) o[j] = xo[i * 8 + q * 4 + j] * rs * fg[j];
          *(f32x4*)(p.out + (size_t)tok * DM + col) = o;
        }
    }
    __syncthreads();
  }
}

template <int MODE>
__global__ void __launch_bounds__(NTHREADS) mk_fwd(Params p) {
  extern __shared__ __attribute__((aligned(16))) char smem[];
  if (MODE < 0) {
    cg::grid_group grid = cg::this_grid();
    phase0(p, smem);
    grid.sync();
    phase1(p, smem);
    grid.sync();
    phase2(p, smem);
    grid.sync();
    phase3(p, smem);
  } else {
    if (MODE == 0) phase0(p, smem);
    if (MODE == 1) phase1(p, smem);
    if (MODE == 2) phase2(p, smem);
    if (MODE == 3) phase3(p, smem);
  }
}

static size_t align_up(size_t v) { return (v + 255) & ~(size_t)255; }

extern "C" void kernel_launch(void* const* d_in, const int* in_sizes, int n_in, void* d_out, int out_size, void* d_ws, size_t ws_size, hipStream_t stream) {
  static int grid = 0;
  if (grid == 0) {
    int dev = 0, cus = 0, per_cu = 0;
    hipGetDevice(&dev);
    hipDeviceGetAttribute(&cus, hipDeviceAttributeMultiprocessorCount, dev);
    hipFuncSetAttribute((const void*)mk_fwd<-1>, hipFuncAttributeMaxDynamicSharedMemorySize, LDS_BYTES);
    hipFuncSetAttribute((const void*)mk_fwd<0>, hipFuncAttributeMaxDynamicSharedMemorySize, LDS_BYTES);
    hipFuncSetAttribute((const void*)mk_fwd<1>, hipFuncAttributeMaxDynamicSharedMemorySize, LDS_BYTES);
    hipFuncSetAttribute((const void*)mk_fwd<2>, hipFuncAttributeMaxDynamicSharedMemorySize, LDS_BYTES);
    hipFuncSetAttribute((const void*)mk_fwd<3>, hipFuncAttributeMaxDynamicSharedMemorySize, LDS_BYTES);
    hipOccupancyMaxActiveBlocksPerMultiprocessor(&per_cu, (const void*)mk_fwd<-1>, NTHREADS, LDS_BYTES);
    if (per_cu < 1) { fprintf(stderr, "kernel_launch: occupancy query says %d blocks/CU\n", per_cu); per_cu = 1; }
    if (per_cu > 1) per_cu = 1;
    grid = cus * per_cu;
    if (grid > 256) grid = 256;
    (void)hipGetLastError();
  }
  Params p{};
  const float* const* fin = (const float* const*)d_in;
  p.x = fin[0]; p.c = fin[1]; p.pos = (const int*)d_in[2];
  p.w_ada = fin[3]; p.b_ada = fin[4]; p.norm1_g = fin[5]; p.w_in = fin[6]; p.conv_w = fin[7]; p.conv_b = fin[8];
  p.lru_wa = fin[9]; p.lru_ba = fin[10]; p.lru_wx = fin[11]; p.lru_bx = fin[12]; p.lru_lambda = fin[13];
  p.q_norm_g = fin[14]; p.w_uq = fin[15]; p.kv_norm_g = fin[16]; p.w_ukv = fin[17]; p.lru_out_g = fin[18]; p.mla_out_g = fin[19];
  p.w_out = fin[20]; p.norm2_g = fin[21]; p.peer_wq = fin[22]; p.peer_keys = fin[23]; p.peer_u = fin[24]; p.peer_v = fin[25]; p.final_g = fin[26];
  p.out = (float*)d_out;
  char* w = (char*)d_ws; size_t off = 0;
  auto take = [&](size_t bytes) { char* r = w + off; off = align_up(off + bytes); return r; };
  p.mod = (float*)take((size_t)NB * 6144 * 4);
  p.ssq_lru = (float*)take((size_t)NTOK * 4);
  p.ssq_mla = (float*)take((size_t)NTOK * 4);
  p.invfreq = (double*)take(16 * 8);
  p.Wf_in = (bf16x8*)take((size_t)INW * 1024 * 2);
  p.Wf_uq = (bf16x8*)take((size_t)768 * 256 * 2);
  p.Wf_ukv = (bf16x8*)take((size_t)1024 * 128 * 2);
  p.Wf_a = (bf16x8*)take((size_t)8 * 64 * 64 * 2);
  p.Wf_x = (bf16x8*)take((size_t)8 * 64 * 64 * 2);
  p.Wf_out = (bf16x8*)take((size_t)1024 * 1024 * 2);
  p.Wf_q = (bf16x8*)take((size_t)2048 * 1024 * 2);
  p.Kf = (bf16x8*)take((size_t)16 * 128 * 128 * 2);
  p.Ub = (u16*)take((size_t)16384 * 1024 * 2);
  p.Vb = (u16*)take((size_t)16384 * 1024 * 2);
  p.xlru = (u16*)take((size_t)NTOK * 512 * 2);
  p.gate = (u16*)take((size_t)NTOK * 512 * 2);
  p.Q = (u16*)take((size_t)NTOK * 768 * 2);
  p.Kn = (u16*)take((size_t)NTOK * 512 * 2);
  p.Kr = (u16*)take((size_t)NTOK * 32 * 2);
  p.Vt = (u16*)take((size_t)NTOK * 512 * 2);
  p.y = (u16*)take((size_t)NTOK * 1024 * 2);
  p.scratch = take((size_t)256 * 589824);
  if (off > ws_size) { fprintf(stderr, "kernel_launch: workspace too small: need %zu have %zu\n", off, ws_size); return; }
#if N_LAUNCH_MODE == 1
  void* args[] = {&p};
  hipError_t e = hipLaunchCooperativeKernel((const void*)mk_fwd<-1>, dim3(grid), dim3(NTHREADS), args, LDS_BYTES, stream);
  if (e != hipSuccess) fprintf(stderr, "cooperative launch failed: %s (grid %d)\n", hipGetErrorString(e), grid);
#else
  hipLaunchKernelGGL(mk_fwd<0>, dim3(grid), dim3(NTHREADS), LDS_BYTES, stream, p);
  hipLaunchKernelGGL(mk_fwd<1>, dim3(grid), dim3(NTHREADS), LDS_BYTES, stream, p);
  hipLaunchKernelGGL(mk_fwd<2>, dim3(grid), dim3(NTHREADS), LDS_BYTES, stream, p);
  hipLaunchKernelGGL(mk_fwd<3>, dim3(grid), dim3(NTHREADS), LDS_BYTES, stream, p);
#endif
}
```

```cpp
#include <hip/hip_runtime.h>
#include <hip/hip_cooperative_groups.h>
#include <cstdio>
#include <cstdint>
namespace cg = cooperative_groups;

#ifndef QBITS
#define QBITS 4
#endif
#ifndef N_LAUNCH_MODE
#define N_LAUNCH_MODE 1
#endif

typedef short bf16x8 __attribute__((ext_vector_type(8)));
typedef float f32x16 __attribute__((ext_vector_type(16)));
typedef float f32x4 __attribute__((ext_vector_type(4)));
typedef float f32x2 __attribute__((ext_vector_type(2)));
typedef unsigned u32x4 __attribute__((ext_vector_type(4)));
typedef unsigned u32x2 __attribute__((ext_vector_type(2)));
typedef __bf16 bf16x2_t __attribute__((ext_vector_type(2)));
typedef unsigned short u16;
typedef _Float16 h16x2 __attribute__((ext_vector_type(2)));

#define DI __device__ __forceinline__
#define MFMA32(a, b, c) __builtin_amdgcn_mfma_f32_32x32x16_bf16((a), (b), (c), 0, 0, 0)

constexpr int NB = 32, SEQ = 2048, DM = 1024, NTOK = NB * SEQ;
constexpr int INW = 1440;
constexpr int NTHREADS = 512;
constexpr int LDA = 1032;
constexpr int LDS_BYTES = 147456;
constexpr float EPS = 1e-6f;

struct Params {
  const float* x; const float* c; const int* pos;
  const float* w_ada; const float* b_ada; const float* norm1_g; const float* w_in; const float* conv_w; const float* conv_b;
  const float* lru_wa; const float* lru_ba; const float* lru_wx; const float* lru_bx; const float* lru_lambda;
  const float* q_norm_g; const float* w_uq; const float* kv_norm_g; const float* w_ukv; const float* lru_out_g; const float* mla_out_g;
  const float* w_out; const float* norm2_g; const float* peer_wq; const float* peer_keys; const float* peer_u; const float* peer_v; const float* final_g;
  float* out;
  float* mod; float* ssq_lru; float* ssq_mla; double* invfreq;
  bf16x8* Wf_in; bf16x8* Wf_uq; bf16x8* Wf_ukv; bf16x8* Wf_a; bf16x8* Wf_x; bf16x8* Wf_out; bf16x8* Wf_s;
  unsigned char* Uq; unsigned char* Vq; float* uscale; float* vscale; float* ubias; u16* xlru; u16* gate; u16* Q; u16* Kn; u16* Kr; u16* Vt; u16* y;
  char* scratch;
};

typedef const __attribute__((address_space(4))) Params& KP;

DI unsigned pk2(float a, float b) { f32x2 v = {a, b}; bf16x2_t r = __builtin_convertvector(v, bf16x2_t); return __builtin_bit_cast(unsigned, r); }
DI u16 f2bf(float a) { return (u16)(pk2(a, 0.f) & 0xffffu); }
DI float bflo(unsigned u) { return __uint_as_float(u << 16); }
DI float bfhi(unsigned u) { return __uint_as_float(u & 0xffff0000u); }
DI float bf2f(u16 h) { return __uint_as_float(((unsigned)h) << 16); }
template <int CTRL> DI float dppf(float v) { return __builtin_bit_cast(float, __builtin_amdgcn_update_dpp(0, __builtin_bit_cast(int, v), CTRL, 0xF, 0xF, true)); }
typedef unsigned u32x2_ __attribute__((ext_vector_type(2)));
DI float wave_sum(float v) {
  v += dppf<0xB1>(v); v += dppf<0x4E>(v); v += dppf<0x141>(v); v += dppf<0x140>(v);
  u32x2_ r = __builtin_amdgcn_permlane16_swap(__float_as_uint(v), __float_as_uint(v), false, false); v = __uint_as_float(r[0]) + __uint_as_float(r[1]);
  r = __builtin_amdgcn_permlane32_swap(__float_as_uint(v), __float_as_uint(v), false, false); v = __uint_as_float(r[0]) + __uint_as_float(r[1]);
  return v;
}
DI float wave_max(float v) {
  v = fmaxf(v, dppf<0xB1>(v)); v = fmaxf(v, dppf<0x4E>(v)); v = fmaxf(v, dppf<0x141>(v)); v = fmaxf(v, dppf<0x140>(v));
  u32x2_ r = __builtin_amdgcn_permlane16_swap(__float_as_uint(v), __float_as_uint(v), false, false); v = fmaxf(__uint_as_float(r[0]), __uint_as_float(r[1]));
  r = __builtin_amdgcn_permlane32_swap(__float_as_uint(v), __float_as_uint(v), false, false); v = fmaxf(__uint_as_float(r[0]), __uint_as_float(r[1]));
  return v;
}
template <int CTRL> DI unsigned dppu(unsigned v) { return (unsigned)__builtin_amdgcn_update_dpp(0, (int)v, CTRL, 0xF, 0xF, true); }
template <int J> DI unsigned lane_xor_u(unsigned v, int lane) {
  if (J == 1) return dppu<0xB1>(v);
  if (J == 2) return dppu<0x4E>(v);
  if (J == 4) return dppu<0x141>(dppu<0x1B>(v));
  if (J == 8) return dppu<0x128>(v);
  if (J == 16) { const u32x2_ r = __builtin_amdgcn_permlane16_swap(v, v, false, false); return (lane & 16) ? r[0] : r[1]; }
  const u32x2_ r = __builtin_amdgcn_permlane32_swap(v, v, false, false); return (lane & 32) ? r[0] : r[1];
}
template <int J> DI float lane_xor_f(float v, int lane) { return __uint_as_float(lane_xor_u<J>(__float_as_uint(v), lane)); }
DI float sum_xor32(float v) { const u32x2_ r = __builtin_amdgcn_permlane32_swap(__float_as_uint(v), __float_as_uint(v), false, false); return __uint_as_float(r[0]) + __uint_as_float(r[1]); }
DI float max_xor32(float v) { const u32x2_ r = __builtin_amdgcn_permlane32_swap(__float_as_uint(v), __float_as_uint(v), false, false); return fmaxf(__uint_as_float(r[0]), __uint_as_float(r[1])); }
DI float other_xor32(float v, int lane) { const u32x2_ r = __builtin_amdgcn_permlane32_swap(__float_as_uint(v), __float_as_uint(v), false, false); return __uint_as_float((lane & 32) ? r[0] : r[1]); }
DI float reduce8(const float (&v)[8], int lane) {
  float q4[4], r2[2];
#pragma unroll
  for (int j = 0; j < 4; ++j) {
    const u32x2_ r = __builtin_amdgcn_permlane32_swap(__float_as_uint(v[j]), __float_as_uint(v[4 + j]), false, false);
    q4[j] = __uint_as_float(r[0]) + __uint_as_float(r[1]);
  }
#pragma unroll
  for (int j = 0; j < 2; ++j) {
    const u32x2_ r = __builtin_amdgcn_permlane16_swap(__float_as_uint(q4[j]), __float_as_uint(q4[2 + j]), false, false);
    r2[j] = __uint_as_float(r[0]) + __uint_as_float(r[1]);
  }
  const float s0 = r2[0] + dppf<0x128>(r2[0]), s1b = r2[1] + dppf<0x128>(r2[1]);
  float s1 = (lane & 8) ? s1b : s0;
  s1 += dppf<0xB1>(s1);
  s1 += dppf<0x4E>(s1);
  s1 += dppf<0x141>(s1);
  return s1;
}
DI float reduce32(const float (&v)[32], int lane) {
  const bool b3 = (lane & 8) != 0, b2 = (lane & 4) != 0, b1 = (lane & 2) != 0, b0 = (lane & 1) != 0;
  float a16[16], a8[8], a4[4], a2[2];
#pragma unroll
  for (int j = 0; j < 16; ++j) {
    const u32x2_ r = __builtin_amdgcn_permlane16_swap(__float_as_uint(v[j]), __float_as_uint(v[16 + j]), false, false);
    a16[j] = __uint_as_float(r[0]) + __uint_as_float(r[1]);
  }
#pragma unroll
  for (int j = 0; j < 8; ++j) { const float keep = b3 ? a16[8 + j] : a16[j], send = b3 ? a16[j] : a16[8 + j]; a8[j] = keep + lane_xor_f<8>(send, lane); }
#pragma unroll
  for (int j = 0; j < 4; ++j) { const float keep = b2 ? a8[4 + j] : a8[j], send = b2 ? a8[j] : a8[4 + j]; a4[j] = keep + lane_xor_f<4>(send, lane); }
#pragma unroll
  for (int j = 0; j < 2; ++j) { const float keep = b1 ? a4[2 + j] : a4[j], send = b1 ? a4[j] : a4[2 + j]; a2[j] = keep + lane_xor_f<2>(send, lane); }
  const float keep = b0 ? a2[1] : a2[0], send = b0 ? a2[0] : a2[1];
  return keep + lane_xor_f<1>(send, lane);
}
DI float sigmoidf_(float x) { return __builtin_amdgcn_rcpf(1.f + __builtin_amdgcn_exp2f(-1.4426950408889634f * x)); }
DI float gelu_tanh(float x) { const float u = 0.7978845608028654f * (x + 0.044715f * x * x * x); return x * __builtin_amdgcn_rcpf(1.f + __builtin_amdgcn_exp2f(-2.f * 1.4426950408889634f * u)); }
DI float one_minus_exp_small(float z) {
  float q = 1.f + z * (1.f / 6.f);
  q = 1.f + z * (1.f / 5.f) * q;
  q = 1.f + z * (1.f / 4.f) * q;
  q = 1.f + z * (1.f / 3.f) * q;
  q = 1.f + z * (1.f / 2.f) * q;
  return -z * q;
}
DI f32x16 zero16() { f32x16 z; for (int i = 0; i < 16; ++i) z[i] = 0.f; return z; }
DI int crow(int reg, int h) { return (reg & 3) + 8 * (reg >> 2) + 4 * h; }

template <int NT, int PD>
DI void gemm_pro(const bf16x8* __restrict__ Wf, int KS, const int (&tile)[NT], int lane, bf16x8 (&bq)[PD][NT]) {
#pragma unroll
  for (int d = 0; d < PD; ++d)
#pragma unroll
    for (int t = 0; t < NT; ++t) bq[d][t] = Wf[((size_t)tile[t] * KS + d) * 64 + lane];
}
template <int NT, int PD, bool SWAP, bool APF = false>
DI void gemm_main(const u16* As, int lda, int nks, const bf16x8* __restrict__ Wf, int KS, const int (&tile)[NT], f32x16 (&acc)[NT][2], int lane, bf16x8 (&bq)[PD][NT]) {
  const bf16x8* a0p = (const bf16x8*)(As + (lane & 31) * lda + 8 * (lane >> 5));
  const bf16x8* a1p = (const bf16x8*)(As + ((lane & 31) + 32) * lda + 8 * (lane >> 5));
  const bf16x8* bp[NT];
#pragma unroll
  for (int t = 0; t < NT; ++t) bp[t] = Wf + (size_t)tile[t] * KS * 64 + lane;
  bf16x8 a0n = a0p[0], a1n = a1p[0];
#pragma unroll 1
  for (int ks = 0; ks < nks; ks += PD) {
#pragma unroll
    for (int d = 0; d < PD; ++d) {
      bf16x8 a0, a1;
      if (APF) { a0 = a0n; a1 = a1n; const int ka = (ks + d + 1 < nks) ? (ks + d + 1) : (ks + d); a0n = a0p[2 * ka]; a1n = a1p[2 * ka]; }
      else { a0 = a0p[2 * (ks + d)]; a1 = a1p[2 * (ks + d)]; }
      const int kn = (ks + d + PD < nks) ? (ks + d + PD) : (ks + d);
#pragma unroll
      for (int t = 0; t < NT; ++t) {
        const bf16x8 b = bq[d][t];
        bq[d][t] = bp[t][kn * 64];
        acc[t][0] = SWAP ? MFMA32(b, a0, acc[t][0]) : MFMA32(a0, b, acc[t][0]);
        acc[t][1] = SWAP ? MFMA32(b, a1, acc[t][1]) : MFMA32(a1, b, acc[t][1]);
      }
    }
  }
}
template <int NT, int PD = 8, bool SWAP = false>
DI void gemm_core(const u16* As, int lda, int nks, const bf16x8* __restrict__ Wf, int KS, const int (&tile)[NT], f32x16 (&acc)[NT][2], int lane) {
  bf16x8 bq[PD][NT];
  gemm_pro<NT, PD>(Wf, KS, tile, lane, bq);
  gemm_main<NT, PD, SWAP>(As, lda, nks, Wf, KS, tile, acc, lane, bq);
}

DI void conv_frag(const float* __restrict__ W, long sk, long sn, int K, int N, const float* ks1, const float* ks2, int ksplit, bf16x8* out, int gtid, int gthreads) {
  const int KS = K / 16; const int total = (N / 32) * KS * 64;
  for (int i = gtid; i < total; i += gthreads) {
    const int lane = i & 63; const int t = i >> 6; const int ks = t % KS; const int nt = t / KS;
    const int n = nt * 32 + (lane & 31); const int k0 = ks * 16 + 8 * (lane >> 5);
    float v[8];
#pragma unroll
    for (int j = 0; j < 8; ++j) {
      const int k = k0 + j;
      float s = 1.f;
      if (ks1) s = (k < ksplit) ? ks1[k] : ks2[k - ksplit];
      v[j] = W[(long)k * sk + (long)n * sn] * s;
    }
    u32x4 o; o[0] = pk2(v[0], v[1]); o[1] = pk2(v[2], v[3]); o[2] = pk2(v[4], v[5]); o[3] = pk2(v[6], v[7]);
    out[i] = __builtin_bit_cast(bf16x8, o);
  }
}

DI void phase0(KP p, char* smem) {
  const int tid = threadIdx.x; const int gtid = blockIdx.x * NTHREADS + tid; const int gthreads = gridDim.x * NTHREADS;
  for (int i = gtid; i < NTOK; i += gthreads) { p.ssq_lru[i] = 0.f; p.ssq_mla[i] = 0.f; }
  if (gtid < 16) p.invfreq[gtid] = pow(10000.0, -(double)gtid / 16.0);
  {
    float* cact = (float*)smem;
    float* red = (float*)(smem + 65536);
    const int lane = tid & 63, wv = tid >> 6;
    for (int item = blockIdx.x; item < 192; item += gridDim.x) {
      const int cg = item >> 1, bh = item & 1;
      for (int i = tid; i < 16 * DM; i += NTHREADS) { const int bb = i >> 10, k = i & 1023; const float v = p.c[(bh * 16 + bb) * DM + k]; cact[k * 16 + bb] = v / (1.f + __expf(-v)); }
      __syncthreads();
      float acc[16];
#pragma unroll
      for (int bb = 0; bb < 16; ++bb) acc[bb] = 0.f;
      const float* wp = p.w_ada + (size_t)(wv * 128) * 6144 + cg * 64 + lane;
#pragma unroll 8
      for (int kk = 0; kk < 128; ++kk) {
        const float w = wp[(size_t)kk * 6144];
        const f32x4* cp = (const f32x4*)(cact + (wv * 128 + kk) * 16);
#pragma unroll
        for (int q = 0; q < 4; ++q) { const f32x4 cv = cp[q]; acc[4 * q] += cv[0] * w; acc[4 * q + 1] += cv[1] * w; acc[4 * q + 2] += cv[2] * w; acc[4 * q + 3] += cv[3] * w; }
      }
#pragma unroll
      for (int bb = 0; bb < 16; ++bb) red[(wv * 16 + bb) * 64 + lane] = acc[bb];
      __syncthreads();
      for (int o = tid; o < 1024; o += NTHREADS) {
        const int bb = o >> 6, c2 = o & 63;
        float sum = 0.f;
#pragma unroll
        for (int w8 = 0; w8 < 8; ++w8) sum += red[(w8 * 16 + bb) * 64 + c2];
        p.mod[(size_t)(bh * 16 + bb) * 6144 + cg * 64 + c2] = sum + p.b_ada[cg * 64 + c2];
      }
      __syncthreads();
    }
  }
  conv_frag(p.w_in, INW, 1, 1024, INW, nullptr, nullptr, 0, p.Wf_in, gtid, gthreads);
  conv_frag(p.w_uq, 768, 1, 256, 768, p.q_norm_g, p.q_norm_g, 256, p.Wf_uq, gtid, gthreads);
  conv_frag(p.w_ukv, 1024, 1, 128, 1024, p.kv_norm_g, p.kv_norm_g, 128, p.Wf_ukv, gtid, gthreads);
  for (int h = 0; h < 8; ++h) {
    conv_frag(p.lru_wa + h * 4096, 64, 1, 64, 64, nullptr, nullptr, 0, p.Wf_a + h * 512, gtid, gthreads);
    conv_frag(p.lru_wx + h * 4096, 64, 1, 64, 64, nullptr, nullptr, 0, p.Wf_x + h * 512, gtid, gthreads);
  }
  conv_frag(p.w_out, 1024, 1, 1024, 1024, p.lru_out_g, p.mla_out_g, 512, p.Wf_out, gtid, gthreads);
  {
    float* kl = (float*)smem;
    float* wl = (float*)(smem + 67584);
    for (int item = blockIdx.x; item < 256; item += gridDim.x) {
      const int hp = item >> 4, cc = item & 15;
      __syncthreads();
      for (int i = tid; i < 16384; i += NTHREADS) kl[(i >> 7) * 132 + (i & 127)] = p.peer_keys[(size_t)hp * 16384 + i];
      for (int i = tid; i < 8192; i += NTHREADS) wl[i] = p.peer_wq[(size_t)(cc * 64 + (i >> 7)) * 2048 + hp * 128 + (i & 127)];
      __syncthreads();
#pragma unroll 1
      for (int q = 0; q < 2; ++q) {
        const int f = tid + NTHREADS * q; const int ln = f & 63, ksl = (f >> 6) & 3, mt = f >> 8;
        const int r = mt * 32 + (ln & 31), cb = 16 * ksl + 8 * (ln >> 5);
        float acc[8];
#pragma unroll
        for (int j = 0; j < 8; ++j) acc[j] = 0.f;
        const f32x4* kp = (const f32x4*)(kl + r * 132);
#pragma unroll 2
        for (int d4 = 0; d4 < 32; ++d4) {
          const f32x4 kv = kp[d4];
#pragma unroll
          for (int j = 0; j < 8; ++j) {
            const f32x4 wv = *(const f32x4*)(wl + (cb + j) * 128 + d4 * 4);
            acc[j] += wv[0] * kv[0] + wv[1] * kv[1] + wv[2] * kv[2] + wv[3] * kv[3];
          }
        }
        u32x4 o; o[0] = pk2(acc[0], acc[1]); o[1] = pk2(acc[2], acc[3]); o[2] = pk2(acc[4], acc[5]); o[3] = pk2(acc[6], acc[7]);
        p.Wf_s[(size_t)((hp * 4 + mt) * 64 + cc * 4 + ksl) * 64 + ln] = __builtin_bit_cast(bf16x8, o);
      }
    }
    __syncthreads();
  }
  {
    const int lane = tid & 63; const int gw = gtid >> 6; const int nw = gthreads >> 6;
    for (int row = gw; row < 32768; row += nw) {
      const int r = row & 16383; const bool isv = row >= 16384;
      const f32x4* src = (const f32x4*)((isv ? p.peer_v : p.peer_u) + (size_t)r * 1024) + lane * 4;
      f32x4 a[4];
#pragma unroll
      for (int i = 0; i < 4; ++i) a[i] = src[i];
#if QBITS == 8
      float am = 0.f;
#pragma unroll
      for (int i = 0; i < 4; ++i)
#pragma unroll
        for (int j = 0; j < 4; ++j) am = fmaxf(am, fabsf(a[i][j]));
      am = wave_max(am);
      const float inv = am > 0.f ? 127.f / am : 0.f;
      u32x4 o;
#pragma unroll
      for (int i = 0; i < 4; ++i) {
        unsigned w = 0;
#pragma unroll
        for (int j = 0; j < 4; ++j) { const int q = (int)__builtin_rintf(a[i][j] * inv) + 128; w |= (unsigned)q << (8 * j); }
        o[i] = w;
      }
      ((u32x4*)(isv ? p.Vq : p.Uq))[(size_t)r * 64 + lane] = o;
      const float step = am * (1.f / 127.f);
      if (lane == 0) p.uscale[r * 4 + (isv ? 1 : 0)] = step;
      float ns = 0.f;
#pragma unroll
      for (int i = 0; i < 4; ++i) ns += (float)(o[i] & 255u) + (float)((o[i] >> 8) & 255u) + (float)((o[i] >> 16) & 255u) + (float)(o[i] >> 24);
      ns = wave_sum(ns);
      if (lane == 0 && !isv) p.uscale[r * 4 + 2] = step * 128.f * ns;
#else
      float ssum = 0.f;
#pragma unroll
      for (int i = 0; i < 4; ++i)
#pragma unroll
        for (int j = 0; j < 4; ++j) ssum += a[i][j] * a[i][j];
      ssum = wave_sum(ssum);
      const float rms = sqrtf(ssum * (1.f / 1024.f));
      const float step = (isv ? 0.49f : 0.3352f) * rms;
      const float inv = step > 0.f ? 1.f / step : 0.f;
      u32x2 o;
#pragma unroll
      for (int jd = 0; jd < 2; ++jd) {
        unsigned w = 0;
#pragma unroll
        for (int e = 0; e < 8; ++e) {
          const float x = a[(8 * jd + e) >> 2][(8 * jd + e) & 3];
          if (isv) {
            const float m = fabsf(x) * inv;
            const int mag = (m > 0.25f) + (m > 0.75f) + (m > 1.25f) + (m > 1.75f) + (m > 2.5f) + (m > 3.5f) + (m > 5.0f);
            w |= (unsigned)(mag | (x < 0.f ? 8 : 0)) << (4 * e);
          } else {
            int q = (int)__builtin_rintf(x * inv + 7.5f); q = q < 0 ? 0 : (q > 15 ? 15 : q);
            w |= (unsigned)q << (8 * (e & 3) + 4 * (e >> 2));
          }
        }
        o[jd] = w;
      }
      ((u32x2*)(p.Uq + (size_t)r * 1024))[2 * lane + (isv ? 1 : 0)] = o;
      if (lane == 0) p.uscale[r * 4 + (isv ? 1 : 0)] = step;
      float ns = 0.f;
#pragma unroll
      for (int jd = 0; jd < 2; ++jd)
#pragma unroll
        for (int e = 0; e < 8; ++e) ns += (float)((o[jd] >> (4 * e)) & 15u);
      ns = wave_sum(ns);
      if (lane == 0 && !isv) p.uscale[r * 4 + 2] = step * 128.f * ns;
#endif
    }
  }
}

DI void phase1(KP p, char* smem) {
  const int tid = threadIdx.x, wave = __builtin_amdgcn_readfirstlane(tid >> 6);
  u16* hA = (u16*)smem;
  float* cs = (float*)(smem + 132096);
  float* ssq = (float*)(smem + 132096 + 8192);
  constexpr int LDL = 424;
  for (int tile = blockIdx.x; tile < NTOK / 64; tile += gridDim.x) {
    int lane_o = tid & 63; asm volatile("" : "+v"(lane_o));
    const int lane = lane_o, l31 = lane & 31, lh = lane >> 5;
    const int tok0 = tile * 64; const int b = tok0 / SEQ; const int s0 = tok0 % SEQ;
    const float* modb = p.mod + (size_t)b * 6144;
    for (int i = tid; i < 1024; i += NTHREADS) {
      const int r = i >> 4, j = i & 15;
      const double ang = (double)p.pos[tok0 + r] * p.invfreq[j];
      double rev = ang * 0.15915494309189535; rev -= floor(rev);
      const float rf = (float)rev;
      cs[2 * i] = __builtin_amdgcn_cosf(rf); cs[2 * i + 1] = __builtin_amdgcn_sinf(rf);
    }
    if (tid < 128) ssq[tid] = 0.f;
    {
      f32x4 cm[4], ca[4];
#pragma unroll
      for (int i = 0; i < 4; ++i) {
        const int col = i * 256 + lane * 4;
        const f32x4 g = *(const f32x4*)(p.norm1_g + col); const f32x4 sc = *(const f32x4*)(modb + 1024 + col);
        cm[i] = g * (sc + 1.0f); ca[i] = *(const f32x4*)(modb + col);
      }
#pragma unroll 2
      for (int rr = 0; rr < 8; rr += 4) {
        f32x4 xv[4][4];
#pragma unroll
        for (int q = 0; q < 4; ++q)
#pragma unroll
          for (int i = 0; i < 4; ++i) xv[q][i] = *(const f32x4*)(p.x + (size_t)(tok0 + wave * 8 + rr + q) * DM + i * 256 + lane * 4);
#pragma unroll
        for (int q = 0; q < 4; ++q) {
          float ss = 0.f;
#pragma unroll
          for (int i = 0; i < 4; ++i) ss += xv[q][i][0] * xv[q][i][0] + xv[q][i][1] * xv[q][i][1] + xv[q][i][2] * xv[q][i][2] + xv[q][i][3] * xv[q][i][3];
          ss = wave_sum(ss);
          const float rs = rsqrtf(ss * (1.f / 1024.f) + EPS);
          const int row = wave * 8 + rr + q;
#pragma unroll
          for (int i = 0; i < 4; ++i) {
            const f32x4 h = xv[q][i] * rs * cm[i] + ca[i];
            u32x2 o; o[0] = pk2(h[0], h[1]); o[1] = pk2(h[2], h[3]);
            *(u32x2*)(hA + row * LDA + i * 256 + lane * 4) = o;
          }
        }
      }
    }
    __syncthreads();
    bf16x8 ring1[8][2];
    const bool has2 = (wave + 40) < 45;
    { const int tl0[2] = {wave, wave + 8}; gemm_pro<2, 8>(p.Wf_in, 64, tl0, lane, ring1); }
#pragma unroll 1
    for (int pass = 0; pass < 2; ++pass) {
      f32x16 acc[2][2];
#pragma unroll
      for (int t = 0; t < 2; ++t) { acc[t][0] = zero16(); acc[t][1] = zero16(); }
      const int tl[2] = {wave + 16 * pass, wave + 16 * pass + 8};
      gemm_main<2, 8, false, true>(hA, LDA, 64, p.Wf_in, 64, tl, acc, lane, ring1);
      { const int tn[2] = {wave + 16 * (pass + 1), (pass == 0 || has2) ? wave + 16 * (pass + 1) + 8 : wave + 32}; gemm_pro<2, 8>(p.Wf_in, 64, tn, lane, ring1); }
      int el_ = lane; asm volatile("" : "+v"(el_));
      const int l31 = el_ & 31, lh = el_ >> 5;
      u16* dstb[2];
#pragma unroll
      for (int t = 0; t < 2; ++t) { const int col = tl[t] * 32 + l31; dstb[t] = (col < 512) ? (p.xlru + col) : (p.gate + (col - 512)); }
#pragma unroll
      for (int rt = 0; rt < 2; ++rt)
#pragma unroll
        for (int r = 0; r < 16; ++r) {
          const size_t ro = (size_t)(tok0 + rt * 32 + crow(r, lh)) * 512;
#pragma unroll
          for (int t = 0; t < 2; ++t) dstb[t][ro] = f2bf(acc[t][rt][r]);
        }
    }
    {
      f32x16 acc[2][2];
#pragma unroll
      for (int t = 0; t < 2; ++t) { acc[t][0] = zero16(); acc[t][1] = zero16(); }
      const int tl[2] = {wave + 32, has2 ? wave + 40 : wave + 32};
      gemm_main<2, 8, false, true>(hA, LDA, 64, p.Wf_in, 64, tl, acc, lane, ring1);
      int el_ = lane; asm volatile("" : "+v"(el_));
      const int l31 = el_ & 31, lh = el_ >> 5;
      __syncthreads();
      u16* lat = hA;
#pragma unroll
      for (int t = 0; t < 2; ++t) {
        if (t == 1 && !has2) continue;
        const int lc = tl[t] * 32 - 1024 + l31;
        if (tl[t] < 44) {
          float sq[32];
#pragma unroll
          for (int rt = 0; rt < 2; ++rt)
#pragma unroll
            for (int r = 0; r < 16; ++r) { const float v = acc[t][rt][r]; sq[rt * 16 + r] = v * v; }
          const float tot = reduce32(sq, lane);
          __hip_atomic_fetch_add(&ssq[(tl[t] < 40 ? 0 : 64) + (l31 >> 4) * 32 + crow(l31 & 15, lh)], tot, __ATOMIC_RELAXED, __HIP_MEMORY_SCOPE_WORKGROUP);
        }
#pragma unroll
        for (int rt = 0; rt < 2; ++rt)
#pragma unroll
          for (int r = 0; r < 16; ++r) {
            const int row = rt * 32 + crow(r, lh);
            const float v = acc[t][rt][r];
            if (lc < 384) {
              lat[row * LDL + lc] = f2bf(v);
            } else {
              const float pv = lane_xor_f<16>(v, lane);
              const int j = lc - 384; const int jj = j & 15;
              const float co = cs[(row * 16 + jj) * 2], si = cs[(row * 16 + jj) * 2 + 1];
              const float o = (j < 16) ? (v * co - pv * si) : (v * co + pv * si);
              p.Kr[(size_t)(tok0 + row) * 32 + j] = f2bf(o);
            }
          }
      }
    }
    __syncthreads();
    {
      const u16* lat = hA;
      const float qscale = 0.10206207261596577f * 1.4426950408889634f;
      const int jj = l31 & 15;
#pragma unroll 1
      for (int pass = 0; pass < 2; ++pass) {
        f32x16 acc[2][2];
#pragma unroll
        for (int t = 0; t < 2; ++t) { acc[t][0] = zero16(); acc[t][1] = zero16(); }
        const int tl[2] = {pass == 0 ? wave : wave + 16, pass == 0 ? wave + 8 : wave + 16};
        gemm_core<2>(lat, LDL, 16, p.Wf_uq, 16, tl, acc, lane);
        int el_ = lane; asm volatile("" : "+v"(el_));
        const int l31 = el_ & 31, lh = el_ >> 5;
#pragma unroll
        for (int rt = 0; rt < 2; ++rt)
#pragma unroll
          for (int r = 0; r < 16; ++r) {
            const int row = rt * 32 + crow(r, lh);
            const float rs = rsqrtf(ssq[row] * (1.f / 256.f) + EPS) * qscale;
            const float co = cs[(row * 16 + jj) * 2], si = cs[(row * 16 + jj) * 2 + 1];
#pragma unroll
            for (int t = 0; t < 2; ++t) {
              if (t == 1 && pass == 1) continue;
              const int head = tl[t] / 3, part = tl[t] % 3;
              float v = acc[t][rt][r] * rs;
              if (part == 2) {
                const float pv = lane_xor_f<16>(v, lane);
                v = (l31 < 16) ? (v * co - pv * si) : (v * co + pv * si);
              }
              p.Q[((size_t)(b * 8 + head) * SEQ + s0 + row) * 96 + part * 32 + l31] = f2bf(v);
            }
          }
      }
#pragma unroll 1
      for (int pass = 0; pass < 2; ++pass) {
        f32x16 acc[2][2];
#pragma unroll
        for (int t = 0; t < 2; ++t) { acc[t][0] = zero16(); acc[t][1] = zero16(); }
        const int tl[2] = {wave + 16 * pass, wave + 16 * pass + 8};
        gemm_core<2>(lat + 256, LDL, 8, p.Wf_ukv, 8, tl, acc, lane);
        int el_ = lane; asm volatile("" : "+v"(el_));
        const int l31 = el_ & 31, lh = el_ >> 5;
#pragma unroll
        for (int rt = 0; rt < 2; ++rt)
#pragma unroll
          for (int g = 0; g < 4; ++g) {
            const int row = rt * 32 + 8 * g + 4 * lh;
            float rs4[4];
#pragma unroll
            for (int q = 0; q < 4; ++q) rs4[q] = rsqrtf(ssq[64 + row + q] * (1.f / 128.f) + EPS);
#pragma unroll
            for (int t = 0; t < 2; ++t) {
              const int head = tl[t] >> 2, sub = tl[t] & 3;
              float v4[4];
#pragma unroll
              for (int q = 0; q < 4; ++q) v4[q] = acc[t][rt][4 * g + q] * rs4[q];
              if (sub < 2) {
#pragma unroll
                for (int q = 0; q < 4; ++q) p.Kn[((size_t)(b * 8 + head) * SEQ + s0 + row + q) * 64 + sub * 32 + l31] = f2bf(v4[q]);
              } else {
                const int d = (sub - 2) * 32 + l31;
                u32x2 o; o[0] = pk2(v4[0], v4[1]); o[1] = pk2(v4[2], v4[3]);
                *(u32x2*)(p.Vt + ((size_t)(b * 8 + head) * 64 + d) * SEQ + s0 + row) = o;
              }
            }
          }
      }
    }
    __syncthreads();
  }
}

DI void lru_item(KP p, char* smem, int item) {
  const int tid = threadIdx.x, lane = tid & 63, wave = __builtin_amdgcn_readfirstlane(tid >> 6);
  const int l31 = lane & 31, lh = lane >> 5;
  const int b = item >> 3, cb = item & 7;
  const int c = lane; const int ch = cb * 64 + c; const int tg = wave;
  const float cw0 = p.conv_w[ch], cw1 = p.conv_w[512 + ch], cw2 = p.conv_w[1024 + ch], cw3 = p.conv_w[1536 + ch], cbias = p.conv_b[ch];
  const float ba = p.lru_ba[ch], bx = p.lru_bx[ch];
  const float sp = log1pf(__expf(-p.lru_lambda[ch]));
  float carry = 0.f;
  const u16* xl = p.xlru + (size_t)b * SEQ * 512 + ch;
  const u16* gt = p.gate + (size_t)b * SEQ * 512 + ch;
  u16* yo = p.y + (size_t)b * SEQ * 1024 + ch;
  const int mat = wave >> 2, rt = (wave >> 1) & 1, ct = wave & 1;
  const bf16x8* wf = (mat == 0 ? p.Wf_a : p.Wf_x) + cb * 512 + ct * 256 + lane;
  bf16x8 bw[4];
#pragma unroll
  for (int ks = 0; ks < 4; ++ks) bw[ks] = wf[ks * 64];
  constexpr int NCH = SEQ / 64;
  u16 xin_n[11], gv_n[8];
#pragma unroll
  for (int i = 0; i < 11; ++i) { const int t = tg * 8 - 3 + i; xin_n[i] = (t >= 0) ? xl[(size_t)t * 512] : (u16)0; }
#pragma unroll
  for (int i = 0; i < 8; ++i) gv_n[i] = gt[(size_t)(tg * 8 + i) * 512];
  float xcB[8], gvB[8], xcC[8], gvC[8], avD[8], bvD[8], gvD[8];
#pragma unroll
  for (int i = 0; i < 8; ++i) { xcB[i] = gvB[i] = xcC[i] = gvC[i] = avD[i] = bvD[i] = gvD[i] = 0.f; }
  __syncthreads();
#pragma unroll 1
  for (int it = 0; it < NCH + 3; ++it) {
    float xcA[8], gvA[8], avC[8], bvC[8];
    if (it < NCH) {
      const int t0 = it * 64 + tg * 8;
      float xin[11];
#pragma unroll
      for (int i = 0; i < 11; ++i) xin[i] = bf2f(xin_n[i]);
#pragma unroll
      for (int i = 0; i < 8; ++i) gvA[i] = bf2f(gv_n[i]);
      if (it + 1 < NCH) {
#pragma unroll
        for (int i = 0; i < 11; ++i) xin_n[i] = xl[(size_t)(t0 + 64 - 3 + i) * 512];
#pragma unroll
        for (int i = 0; i < 8; ++i) gv_n[i] = gt[(size_t)(t0 + 64 + i) * 512];
      }
      u16* xcb = (u16*)(smem + (it & 1) * 9216);
#pragma unroll
      for (int i = 0; i < 8; ++i) {
        xcA[i] = cbias + cw0 * xin[i] + cw1 * xin[i + 1] + cw2 * xin[i + 2] + cw3 * xin[i + 3];
        xcb[(tg * 8 + i) * 72 + c] = f2bf(xcA[i]);
      }
    } else {
#pragma unroll
      for (int i = 0; i < 8; ++i) { xcA[i] = 0.f; gvA[i] = 0.f; }
    }
    if (it >= 1 && it - 1 < NCH) {
      const u16* xcb = (const u16*)(smem + ((it - 1) & 1) * 9216);
      float* pm = (float*)(smem + 18432 + ((it - 1) & 1) * 33280) + mat * 4160;
      f32x16 acc = zero16();
      const bf16x8* ap = (const bf16x8*)(xcb + (rt * 32 + l31) * 72 + 8 * lh);
#pragma unroll
      for (int ks = 0; ks < 4; ++ks) acc = MFMA32(ap[2 * ks], bw[ks], acc);
#pragma unroll
      for (int r = 0; r < 16; ++r) pm[(rt * 32 + crow(r, lh)) * 65 + ct * 32 + l31] = acc[r];
    }
    if (it >= 2 && it - 2 < NCH) {
      const float* pre = (const float*)(smem + 18432 + ((it - 2) & 1) * 33280);
      float* seg = (float*)(smem + 84992 + ((it - 2) & 1) * 4096);
      float A = 1.f, Bc = 0.f;
#pragma unroll
      for (int i = 0; i < 8; ++i) {
        const int tl = tg * 8 + i;
        const float r = sigmoidf_(pre[tl * 65 + c] + ba);
        const float ig = sigmoidf_(pre[4160 + tl * 65 + c] + bx);
        const float log_a = -8.f * r * sp;
        const float a = __builtin_amdgcn_exp2f(1.4426950408889634f * log_a);
        const float z = 2.f * log_a;
        const float om = (z > -0.25f) ? one_minus_exp_small(z) : -expm1f(z);
        const float m = __builtin_amdgcn_sqrtf(om);
        avC[i] = a; bvC[i] = m * ig * xcC[i];
        A *= a; Bc = a * Bc + bvC[i];
      }
      seg[(tg * 64 + c) * 2] = A; seg[(tg * 64 + c) * 2 + 1] = Bc;
    } else {
#pragma unroll
      for (int i = 0; i < 8; ++i) { avC[i] = 0.f; bvC[i] = 0.f; }
    }
    if (it >= 3) {
      const int t0 = (it - 3) * 64 + tg * 8;
      const float* seg = (const float*)(smem + 84992 + ((it - 3) & 1) * 4096);
      float h = carry, hin = 0.f;
#pragma unroll
      for (int s2 = 0; s2 < 8; ++s2) {
        if (s2 == tg) hin = h;
        h = seg[(s2 * 64 + c) * 2] * h + seg[(s2 * 64 + c) * 2 + 1];
      }
      carry = h;
      h = hin;
      float sq[8];
#pragma unroll
      for (int i = 0; i < 8; ++i) {
        h = avD[i] * h + bvD[i];
        const float yv = gelu_tanh(gvD[i]) * h;
        yo[(size_t)(t0 + i) * 1024] = f2bf(yv);
        sq[i] = yv * yv;
      }
      const float tot = reduce8(sq, lane);
      if ((lane & 7) == 0) unsafeAtomicAdd(p.ssq_lru + (size_t)b * SEQ + t0 + (lane >> 3), tot);
    }
#pragma unroll
    for (int i = 0; i < 8; ++i) {
      avD[i] = avC[i]; bvD[i] = bvC[i]; gvD[i] = gvC[i];
      xcC[i] = xcB[i]; gvC[i] = gvB[i];
      xcB[i] = xcA[i]; gvB[i] = gvA[i];
    }
    __syncthreads();
  }
}

DI void attn_unit(KP p, char* smem, int b, int hd, int qb) {
  const int tid = threadIdx.x, lane = tid & 63, wave = __builtin_amdgcn_readfirstlane(tid >> 6);
  const int l31 = lane & 31, lh = lane >> 5;
  const int q0 = qb * 256 + wave * 32;
  const size_t bh = (size_t)(b * 8 + hd);
  const int nkt = qb * 4 + 4;
  const int qidx = q0 + l31;
  const int skey = tid >> 3, schn = tid & 7;
  const int rkey = (tid & 255) >> 2, rchn = tid & 3;
  const u16* kn_src = p.Kn + (bh * SEQ + skey) * 64 + schn * 8;
  const u16* kr_src = p.Kr + ((size_t)b * SEQ + rkey) * 32 + rchn * 8;
  const u16* vt_src = p.Vt + (bh * 64 + skey) * SEQ + schn * 8;
  u32x4 rk, rr, rv;
  rk = *(const u32x4*)(kn_src); rv = *(const u32x4*)(vt_src);
  if (tid < 256) rr = *(const u32x4*)(kr_src);
  bf16x8 qf[6];
  {
    const bf16x8* qp = (const bf16x8*)(p.Q + (bh * SEQ + q0 + l31) * 96 + 8 * lh);
#pragma unroll
    for (int ks = 0; ks < 6; ++ks) qf[ks] = qp[2 * ks];
  }
  __syncthreads();
  {
    u16* Kl = (u16*)smem; u16* Vl = (u16*)(smem + 13312);
    *(u32x4*)(Kl + skey * 104 + schn * 8) = rk;
    if (tid < 256) *(u32x4*)(Kl + rkey * 104 + 64 + rchn * 8) = rr;
    *(u32x4*)(Vl + skey * 72 + schn * 8) = rv;
  }
  __syncthreads();
  f32x16 o0 = zero16(), o1 = zero16();
  float m_run = -1e30f, l_run = 0.f;
  for (int kt = 0; kt < nkt; ++kt) {
    const u16* Kl = (const u16*)(smem + (kt & 1) * 22528);
    const u16* Vl = (const u16*)(smem + (kt & 1) * 22528 + 13312);
    const bool more = (kt + 1) < nkt;
    if (more) {
      rk = *(const u32x4*)(kn_src + (size_t)(kt + 1) * 64 * 64);
      rv = *(const u32x4*)(vt_src + (kt + 1) * 64);
      if (tid < 256) rr = *(const u32x4*)(kr_src + (size_t)(kt + 1) * 64 * 32);
    }
    if (kt * 64 <= q0 + 31) {
      f32x16 s[2];
      bf16x8 kfr[2][6];
#pragma unroll
      for (int st = 0; st < 2; ++st) {
        const bf16x8* kp = (const bf16x8*)(Kl + (st * 32 + l31) * 104 + 8 * lh);
#pragma unroll
        for (int ks = 0; ks < 6; ++ks) kfr[st][ks] = kp[2 * ks];
      }
#pragma unroll
      for (int st = 0; st < 2; ++st) {
        s[st] = zero16();
#pragma unroll
        for (int ks = 0; ks < 6; ++ks) s[st] = MFMA32(kfr[st][ks], qf[ks], s[st]);
      }
      u32x2 vfr[2][4][2];
#pragma unroll
      for (int dt = 0; dt < 2; ++dt)
#pragma unroll
        for (int c4 = 0; c4 < 4; ++c4) {
          const int kbase = c4 * 16 + 4 * lh;
          vfr[dt][c4][0] = *(const u32x2*)(Vl + (dt * 32 + l31) * 72 + kbase);
          vfr[dt][c4][1] = *(const u32x2*)(Vl + (dt * 32 + l31) * 72 + kbase + 8);
        }
      if (kt * 64 + 63 > q0) {
#pragma unroll
        for (int st = 0; st < 2; ++st)
#pragma unroll
          for (int r = 0; r < 16; ++r) { const int key = kt * 64 + st * 32 + crow(r, lh); if (key > qidx) s[st][r] = -1e30f; }
      }
      float mloc = s[0][0];
#pragma unroll
      for (int st = 0; st < 2; ++st)
#pragma unroll
        for (int r = 0; r < 16; ++r) mloc = fmaxf(mloc, s[st][r]);
      mloc = max_xor32(mloc);
      const float m_new = fmaxf(m_run, mloc);
      const float alpha = __builtin_amdgcn_exp2f(m_run - m_new);
      m_run = m_new;
      float lsum = 0.f;
#pragma unroll
      for (int st = 0; st < 2; ++st)
#pragma unroll
        for (int r = 0; r < 16; ++r) { const float e = __builtin_amdgcn_exp2f(s[st][r] - m_new); s[st][r] = e; lsum += e; }
      l_run = l_run * alpha + lsum;
#pragma unroll
      for (int r = 0; r < 16; ++r) { o0[r] *= alpha; o1[r] *= alpha; }
#pragma unroll
      for (int st = 0; st < 2; ++st)
#pragma unroll
        for (int s2 = 0; s2 < 2; ++s2) {
          u32x4 pw;
#pragma unroll
          for (int j = 0; j < 4; ++j) pw[j] = pk2(s[st][8 * s2 + 2 * j], s[st][8 * s2 + 2 * j + 1]);
          const bf16x8 pf = __builtin_bit_cast(bf16x8, pw);
          const int c4 = st * 2 + s2;
          {
            u32x4 vv; vv[0] = vfr[0][c4][0][0]; vv[1] = vfr[0][c4][0][1]; vv[2] = vfr[0][c4][1][0]; vv[3] = vfr[0][c4][1][1];
            o0 = MFMA32(__builtin_bit_cast(bf16x8, vv), pf, o0);
          }
          {
            u32x4 vv; vv[0] = vfr[1][c4][0][0]; vv[1] = vfr[1][c4][0][1]; vv[2] = vfr[1][c4][1][0]; vv[3] = vfr[1][c4][1][1];
            o1 = MFMA32(__builtin_bit_cast(bf16x8, vv), pf, o1);
          }
        }
    }
    if (more) {
      u16* Kn2 = (u16*)(smem + ((kt + 1) & 1) * 22528); u16* Vn2 = (u16*)(smem + ((kt + 1) & 1) * 22528 + 13312);
      *(u32x4*)(Kn2 + skey * 104 + schn * 8) = rk;
      if (tid < 256) *(u32x4*)(Kn2 + rkey * 104 + 64 + rchn * 8) = rr;
      *(u32x4*)(Vn2 + skey * 72 + schn * 8) = rv;
    }
    __syncthreads();
  }
  const float ltot = sum_xor32(l_run);
  const float inv = 1.f / ltot;
  float ss = 0.f;
  u16* yrow = p.y + ((size_t)b * SEQ + qidx) * 1024 + 512 + hd * 64;
#pragma unroll
  for (int g = 0; g < 4; ++g) {
    float v0[4], v1[4];
#pragma unroll
    for (int q = 0; q < 4; ++q) { v0[q] = o0[4 * g + q] * inv; v1[q] = o1[4 * g + q] * inv; ss += v0[q] * v0[q] + v1[q] * v1[q]; }
    u32x2 a; a[0] = pk2(v0[0], v0[1]); a[1] = pk2(v0[2], v0[3]);
    u32x2 c2; c2[0] = pk2(v1[0], v1[1]); c2[1] = pk2(v1[2], v1[3]);
    *(u32x2*)(yrow + 8 * g + 4 * lh) = a;
    *(u32x2*)(yrow + 32 + 8 * g + 4 * lh) = c2;
  }
  ss = sum_xor32(ss);
  if (lh == 0) unsafeAtomicAdd(p.ssq_mla + (size_t)b * SEQ + qidx, ss);
}

DI void phase2(KP p, char* smem) {
  for (int item = blockIdx.x; item < 256; item += gridDim.x) lru_item(p, smem, item);
  for (int it = blockIdx.x; it < 1024; it += gridDim.x) {
    const int j = it & 3; const int bh = it >> 2; const int hd = bh & 7; const int b = bh >> 3;
    attn_unit(p, smem, b, hd, 7 - j);
    attn_unit(p, smem, b, hd, j);
  }
}

DI void sort128_asc(unsigned& k0, unsigned& k1, int lane) {
#pragma unroll
  for (int k = 2; k <= 128; k <<= 1) {
#pragma unroll
    for (int j = k >> 1; j > 0; j >>= 1) {
      if (j == 64) {
        const unsigned lo = k0 < k1 ? k0 : k1, hi = k0 < k1 ? k1 : k0; k0 = lo; k1 = hi;
      } else {
        const unsigned o0 = (j == 1) ? lane_xor_u<1>(k0, lane) : (j == 2) ? lane_xor_u<2>(k0, lane) : (j == 4) ? lane_xor_u<4>(k0, lane) : (j == 8) ? lane_xor_u<8>(k0, lane) : (j == 16) ? lane_xor_u<16>(k0, lane) : lane_xor_u<32>(k0, lane);
        const unsigned o1 = (j == 1) ? lane_xor_u<1>(k1, lane) : (j == 2) ? lane_xor_u<2>(k1, lane) : (j == 4) ? lane_xor_u<4>(k1, lane) : (j == 8) ? lane_xor_u<8>(k1, lane) : (j == 16) ? lane_xor_u<16>(k1, lane) : lane_xor_u<32>(k1, lane);
        const bool lower = (lane & j) == 0;
        const bool asc0 = (k == 128) ? true : ((lane & k) == 0);
        const bool asc1 = (k == 128) ? true : (k == 64 ? false : ((lane & k) == 0));
        const unsigned mn0 = k0 < o0 ? k0 : o0, mx0 = k0 < o0 ? o0 : k0;
        const unsigned mn1 = k1 < o1 ? k1 : o1, mx1 = k1 < o1 ? o1 : k1;
        k0 = (asc0 == lower) ? mn0 : mx0;
        k1 = (asc1 == lower) ? mn1 : mx1;
      }
    }
  }
}
#if QBITS == 8
typedef u32x4 qrow_t;
#else
typedef u32x2 qrow_t;
#endif
constexpr int QROWB = (QBITS == 8) ? 1024 : 512;
DI void ga_load(__amdgpu_buffer_rsrc_t rs, int iv, int gl, int voff_u, int voff_v, qrow_t (&uq)[8], qrow_t (&vq)[8]) {
#pragma unroll
  for (int k = 0; k < 8; ++k) {
    const int so = __builtin_amdgcn_readlane(iv, gl + k);
#if QBITS == 8
    uq[k] = __builtin_amdgcn_raw_buffer_load_b128(rs, voff_u, so, 0);
    vq[k] = __builtin_amdgcn_raw_buffer_load_b128(rs, voff_v, so, 0);
#else
    const u32x4 rec = __builtin_amdgcn_raw_buffer_load_b128(rs, voff_u, so, 16);
    uq[k] = (u32x2){rec[0], rec[1]}; vq[k] = (u32x2){rec[2], rec[3]};
#endif
  }
}
DI unsigned qword(const qrow_t& r, int j) {
#if QBITS == 8
  return r[j];
#else
  const unsigned w0 = r[j >> 1];
  return (j & 1) ? ((w0 >> 4) & 0x0f0f0f0fu) : (w0 & 0x0f0f0f0fu);
#endif
}
#if QBITS == 8
typedef f32x2 oacc_t;
constexpr float OACC_SCALE = 1.f;
#else
typedef h16x2 oacc_t;
constexpr float OACC_SCALE = 16.f;
#endif
DI void ga_compute(float gsel, float asel, float bsel, int gl, int lane, float kt, float hscale, const unsigned (&hq)[4],
                   const qrow_t (&uq)[8], const qrow_t (&vq)[8], oacc_t (&oacc)[8], float& csum) {
  const float mg = __shfl(gsel, gl + (lane >> 3));
  const float ma = __shfl(asel, gl + (lane >> 3));
  const float mb = __shfl(bsel, gl + (lane >> 3));
  float pp[8];
#pragma unroll
  for (int k = 0; k < 8; ++k) {
#if QBITS == 8
    unsigned d = 0;
#pragma unroll
    for (int j = 0; j < 4; ++j) d = __builtin_amdgcn_udot4(qword(uq[k], j), hq[j], d, false);
#else
    unsigned dh = __builtin_amdgcn_udot8(uq[k][0], hq[0], 0u, false); dh = __builtin_amdgcn_udot8(uq[k][1], hq[1], dh, false);
    unsigned dl = __builtin_amdgcn_udot8(uq[k][0], hq[2], 0u, false); dl = __builtin_amdgcn_udot8(uq[k][1], hq[3], dl, false);
    const unsigned d = dh * 16u + dl;
#endif
    pp[k] = (float)d;
  }
  const float s1 = reduce8(pp, lane);
  const float pre = hscale * (ma * (s1 - kt) - mb);
  const float cf = mg * gelu_tanh(pre);
  csum += cf;
#if QBITS != 8
  const _Float16 cfs = (_Float16)(cf * OACC_SCALE);
  const unsigned cfp = __builtin_bit_cast(unsigned, (h16x2){cfs, cfs});
#endif
#pragma unroll
  for (int k = 0; k < 8; ++k) {
#if QBITS == 8
    const float c = __uint_as_float(__builtin_amdgcn_readlane(__float_as_uint(cf), 8 * k));
    const f32x2 cc = {c, c};
#pragma unroll
    for (int j = 0; j < 4; ++j) {
      unsigned w = qword(vq[k], j);
      asm volatile("" : "+v"(w));
      const f32x2 v0 = {(float)(w & 255u), (float)((w >> 8) & 255u)}, v1 = {(float)((w >> 16) & 255u), (float)(w >> 24)};
      oacc[2 * j] = v0 * cc + oacc[2 * j];
      oacc[2 * j + 1] = v1 * cc + oacc[2 * j + 1];
    }
#else
    const h16x2 cc = __builtin_bit_cast(h16x2, (unsigned)__builtin_amdgcn_readlane((int)cfp, 8 * k));
#pragma unroll
    for (int jd = 0; jd < 2; ++jd) {
      const unsigned w = vq[k][jd];
      oacc[4 * jd + 0] = __builtin_amdgcn_cvt_scalef32_pk_f16_fp4(w, 1.0f, 0) * cc + oacc[4 * jd + 0];
      oacc[4 * jd + 1] = __builtin_amdgcn_cvt_scalef32_pk_f16_fp4(w, 1.0f, 1) * cc + oacc[4 * jd + 1];
      oacc[4 * jd + 2] = __builtin_amdgcn_cvt_scalef32_pk_f16_fp4(w, 1.0f, 2) * cc + oacc[4 * jd + 2];
      oacc[4 * jd + 3] = __builtin_amdgcn_cvt_scalef32_pk_f16_fp4(w, 1.0f, 3) * cc + oacc[4 * jd + 3];
    }
#endif
  }
}

#if QBITS != 8
DI unsigned ga_u(float gsel, float asel, float bsel, int gl, int lane, float kt, float hscale, const unsigned (&hq)[4], const qrow_t (&uq)[8]) {
  const float mg = __shfl(gsel, gl + (lane >> 3));
  const float ma = __shfl(asel, gl + (lane >> 3));
  const float mb = __shfl(bsel, gl + (lane >> 3));
  float pp[8];
#pragma unroll
  for (int k = 0; k < 8; ++k) {
    unsigned dh = __builtin_amdgcn_udot8(uq[k][0], hq[0], 0u, false); dh = __builtin_amdgcn_udot8(uq[k][1], hq[1], dh, false);
    unsigned dl = __builtin_amdgcn_udot8(uq[k][0], hq[2], 0u, false); dl = __builtin_amdgcn_udot8(uq[k][1], hq[3], dl, false);
    pp[k] = (float)(dh * 16u + dl);
  }
  const float s1 = reduce8(pp, lane);
  const float pre = hscale * (ma * (s1 - kt) - mb);
  const _Float16 cfs = (_Float16)(mg * gelu_tanh(pre) * OACC_SCALE);
  return __builtin_bit_cast(unsigned, (h16x2){cfs, cfs});
}
DI void ga_v(unsigned cfp, const qrow_t (&vq)[8], oacc_t (&oacc)[8]) {
#pragma unroll
  for (int k = 0; k < 8; ++k) {
    const h16x2 cc = __builtin_bit_cast(h16x2, (unsigned)__builtin_amdgcn_readlane((int)cfp, 8 * k));
#pragma unroll
    for (int jd = 0; jd < 2; ++jd) {
      const unsigned w = vq[k][jd];
      oacc[4 * jd + 0] = __builtin_amdgcn_cvt_scalef32_pk_f16_fp4(w, 1.0f, 0) * cc + oacc[4 * jd + 0];
      oacc[4 * jd + 1] = __builtin_amdgcn_cvt_scalef32_pk_f16_fp4(w, 1.0f, 1) * cc + oacc[4 * jd + 1];
      oacc[4 * jd + 2] = __builtin_amdgcn_cvt_scalef32_pk_f16_fp4(w, 1.0f, 2) * cc + oacc[4 * jd + 2];
      oacc[4 * jd + 3] = __builtin_amdgcn_cvt_scalef32_pk_f16_fp4(w, 1.0f, 3) * cc + oacc[4 * jd + 3];
    }
  }
}
#endif

DI void ins16(float (&lst)[16], float x) {
#pragma unroll
  for (int i = 0; i < 16; ++i) { const float hi = fmaxf(lst[i], x); x = fminf(lst[i], x); lst[i] = hi; }
}
DI void ce_desc(float& a, float& b) { const float hi = fmaxf(a, b), lo = fminf(a, b); a = hi; b = lo; }
DI void sort16_desc(float (&a)[16]) {
#pragma unroll
  for (int k = 2; k <= 16; k <<= 1)
#pragma unroll
    for (int j = k >> 1; j > 0; j >>= 1)
#pragma unroll
      for (int i = 0; i < 16; ++i) {
        const int l = i ^ j;
        if (l > i) {
          if ((i & k) == 0) ce_desc(a[i], a[l]); else ce_desc(a[l], a[i]);
        }
      }
}
DI void merge16_desc(float (&x)[16], const float (&y)[16]) {
#pragma unroll
  for (int i = 0; i < 16; ++i) x[i] = fmaxf(x[i], y[15 - i]);
#pragma unroll
  for (int d = 8; d >= 1; d >>= 1)
#pragma unroll
    for (int i = 0; i < 16; ++i)
      if ((i & d) == 0) ce_desc(x[i], x[i + d]);
}
DI void merge_partner(float (&lst)[16], int lane) {
  float o[16];
#pragma unroll
  for (int i = 0; i < 16; ++i) o[i] = other_xor32(lst[i], lane);
  float c[16];
#pragma unroll
  for (int i = 0; i < 16; ++i) c[i] = fmaxf(lst[i], o[15 - i]);
#pragma unroll
  for (int d = 8; d >= 1; d >>= 1) {
#pragma unroll
    for (int i = 0; i < 16; ++i) {
      if ((i & d) == 0) { const float hi = fmaxf(c[i], c[i + d]), lo = fminf(c[i], c[i + d]); c[i] = hi; c[i + d] = lo; }
    }
  }
#pragma unroll
  for (int i = 0; i < 16; ++i) lst[i] = c[i];
}

DI void phase3(KP p, char* smem) {
  const int tid = threadIdx.x, wave = __builtin_amdgcn_readfirstlane(tid >> 6);
  u16* A = (u16*)smem;
  float* ssq2 = (float*)(smem + 132096);
  char* scr = p.scratch + (size_t)blockIdx.x * 655360;
  float* x1s = (float*)scr;
  u16* qp = (u16*)(scr + 262144);
  int* eidx = (int*)(scr + 524288);
  float* egate = (float*)(scr + 524288 + 32768);
  float* eus = (float*)(scr + 524288 + 65536);
  float* eub = (float*)(scr + 524288 + 98304);
  for (int tile = blockIdx.x; tile < NTOK / 64; tile += gridDim.x) {
    int lane_o = tid & 63; asm volatile("" : "+v"(lane_o));
    const int lane = lane_o, l31 = lane & 31, lh = lane >> 5;
    const int tok0 = tile * 64; const int b = tok0 / SEQ;
    const float* modb = p.mod + (size_t)b * 6144;
    if (tid < 64) ssq2[tid] = 0.f;
#pragma unroll 2
    for (int rr = 0; rr < 8; ++rr) {
      const int row = wave * 8 + rr; const int tok = tok0 + row;
      const float rl = rsqrtf(p.ssq_lru[tok] * (1.f / 512.f) + EPS), rm = rsqrtf(p.ssq_mla[tok] * (1.f / 512.f) + EPS);
#pragma unroll
      for (int i = 0; i < 2; ++i) {
        const u32x4 v = *(const u32x4*)(p.y + (size_t)tok * 1024 + (i * 64 + lane) * 8);
        const float sc = i == 0 ? rl : rm;
        u32x4 o;
#pragma unroll
        for (int j = 0; j < 4; ++j) o[j] = pk2(bflo(v[j]) * sc, bfhi(v[j]) * sc);
        *(u32x4*)(A + row * LDA + (i * 64 + lane) * 8) = o;
      }
    }
    __syncthreads();
    float sqa[32];
#pragma unroll
    for (int i = 0; i < 32; ++i) sqa[i] = 0.f;
    bf16x8 ring3[8][2];
    { const int tl0[2] = {wave, wave + 8}; gemm_pro<2, 8>(p.Wf_out, 64, tl0, lane, ring3); }
#pragma unroll 1
    for (int pass = 0; pass < 2; ++pass) {
      f32x16 acc[2][2];
#pragma unroll
      for (int t = 0; t < 2; ++t) { acc[t][0] = zero16(); acc[t][1] = zero16(); }
      const int tl[2] = {pass * 16 + wave, pass * 16 + wave + 8};
      gemm_main<2, 8, false, true>(A, LDA, 64, p.Wf_out, 64, tl, acc, lane, ring3);
      if (pass == 0) { const int tn[2] = {16 + wave, 16 + wave + 8}; gemm_pro<2, 8>(p.Wf_out, 64, tn, lane, ring3); }
      int el_ = lane; asm volatile("" : "+v"(el_));
      const int l31 = el_ & 31, lh = el_ >> 5;
      float g1[2];
#pragma unroll
      for (int t = 0; t < 2; ++t) g1[t] = modb[2048 + tl[t] * 32 + l31];
#pragma unroll
      for (int rt = 0; rt < 2; ++rt)
#pragma unroll
        for (int r = 0; r < 16; ++r) {
          const int row = rt * 32 + crow(r, lh);
#pragma unroll
          for (int t = 0; t < 2; ++t) {
            const int col = tl[t] * 32 + l31;
            const float v = p.x[(size_t)(tok0 + row) * DM + col] + g1[t] * acc[t][rt][r];
            x1s[row * 1024 + col] = v;
            sqa[rt * 16 + r] += v * v;
          }
        }
    }
    {
      const float tot = reduce32(sqa, lane);
      const int l31 = lane & 31, lh = lane >> 5;
      __hip_atomic_fetch_add(&ssq2[(l31 >> 4) * 32 + crow(l31 & 15, lh)], tot, __ATOMIC_RELAXED, __HIP_MEMORY_SCOPE_WORKGROUP);
    }
    __syncthreads();
    {
      f32x4 cm[4], ca[4];
#pragma unroll
      for (int i = 0; i < 4; ++i) {
        const int col = (i >> 1) * 512 + lane * 8 + (i & 1) * 4;
        const f32x4 g = *(const f32x4*)(p.norm2_g + col); const f32x4 sc = *(const f32x4*)(modb + 4096 + col);
        cm[i] = g * (sc + 1.0f); ca[i] = *(const f32x4*)(modb + 3072 + col);
      }
#pragma unroll 2
      for (int rr = 0; rr < 8; ++rr) {
        const int row = wave * 8 + rr;
        const float rs = rsqrtf(ssq2[row] * (1.f / 1024.f) + EPS);
#pragma unroll
        for (int i = 0; i < 2; ++i) {
          const f32x4 xa = *(const f32x4*)(x1s + row * 1024 + i * 512 + lane * 8), xb = *(const f32x4*)(x1s + row * 1024 + i * 512 + lane * 8 + 4);
          const f32x4 ha = xa * rs * cm[2 * i] + ca[2 * i], hb = xb * rs * cm[2 * i + 1] + ca[2 * i + 1];
          u32x4 o; o[0] = pk2(ha[0], ha[1]); o[1] = pk2(ha[2], ha[3]); o[2] = pk2(hb[0], hb[1]); o[3] = pk2(hb[2], hb[3]);
          *(u32x4*)(A + row * LDA + i * 512 + lane * 8) = o;
        }
      }
    }
    __syncthreads();
    float s12[2][16];
#pragma unroll 1
    for (int ph = 0; ph < 2; ++ph) {
      const int hd = wave;
      float lst0[16], lst1[16];
#pragma unroll
      for (int i = 0; i < 16; ++i) { lst0[i] = -3.0e38f; lst1[i] = -3.0e38f; }
#pragma unroll 1
      for (int mtp = 0; mtp < 2; ++mtp) {
        f32x16 acc[2][2];
#pragma unroll
        for (int t = 0; t < 2; ++t) { acc[t][0] = zero16(); acc[t][1] = zero16(); }
        const int tl[2] = {(hd * 2 + ph) * 4 + 2 * mtp, (hd * 2 + ph) * 4 + 2 * mtp + 1};
        gemm_core<2, 8, true>(A, LDA, 64, p.Wf_s, 64, tl, acc, lane);
        int el_ = lane; asm volatile("" : "+v"(el_));
        const int lh = el_ >> 5;
#pragma unroll
        for (int t = 0; t < 2; ++t) {
          float nv[16];
#pragma unroll
          for (int r = 0; r < 16; ++r) nv[r] = __uint_as_float((__float_as_uint(acc[t][0][r]) & 0xffffff80u) | (unsigned)((2 * mtp + t) * 32 + crow(r, lh)));
          sort16_desc(nv);
          merge16_desc(lst0, nv);
#pragma unroll
          for (int r = 0; r < 16; ++r) nv[r] = __uint_as_float((__float_as_uint(acc[t][1][r]) & 0xffffff80u) | (unsigned)((2 * mtp + t) * 32 + crow(r, lh)));
          sort16_desc(nv);
          merge16_desc(lst1, nv);
        }
      }
      merge_partner(lst0, lane);
      merge_partner(lst1, lane);
      if (ph == 0) {
#pragma unroll
        for (int i = 0; i < 16; ++i) s12[0][i] = lh ? lst1[i] : lst0[i];
      } else {
#pragma unroll
        for (int i = 0; i < 16; ++i) s12[1][i] = lh ? lst1[i] : lst0[i];
      }
    }
    {
      const int hd = wave;
      unsigned long long t1lo = 0, t1hi = 0, t2lo = 0, t2hi = 0;
#pragma unroll
      for (int i = 0; i < 8; ++i) {
        t1lo |= (unsigned long long)(__float_as_uint(s12[0][i]) & 127u) << (8 * i);
        t1hi |= (unsigned long long)(__float_as_uint(s12[0][8 + i]) & 127u) << (8 * i);
        t2lo |= (unsigned long long)(__float_as_uint(s12[1][i]) & 127u) << (8 * i);
        t2hi |= (unsigned long long)(__float_as_uint(s12[1][8 + i]) & 127u) << (8 * i);
      }
      float bv[16];
#pragma unroll
      for (int j = 0; j < 16; ++j) {
        const float sv = s12[0][0] + s12[1][j];
        bv[j] = __uint_as_float((__float_as_uint(sv) & 0xffffff00u) | (unsigned)j);
      }
#pragma unroll
      for (int i = 1; i < 16; ++i) {
#pragma unroll
        for (int j = 0; j < 16; ++j)
          if ((i + 1) * (j + 1) <= 16) {
            const float sv = s12[0][i] + s12[1][j];
            ins16(bv, __uint_as_float((__float_as_uint(sv) & 0xffffff00u) | (unsigned)(i * 16 + j)));
          }
      }
      int bi[16];
#pragma unroll
      for (int k = 0; k < 16; ++k) {
        const unsigned code = __float_as_uint(bv[k]) & 255u;
        const unsigned ci = code >> 4, cj = code & 15u;
        const unsigned long long w1 = (ci & 8u) ? t1hi : t1lo, w2 = (cj & 8u) ? t2hi : t2lo;
        const unsigned i1 = (unsigned)(w1 >> ((ci & 7u) * 8)) & 0xffu, i2 = (unsigned)(w2 >> ((cj & 7u) * 8)) & 0xffu;
        bi[k] = (int)(i1 * 128u + i2);
      }
      float esum = 0.f, ev[16];
#pragma unroll
      for (int i = 0; i < 16; ++i) { ev[i] = __expf(bv[i] - bv[0]); esum += ev[i]; }
      const float einv = 1.f / esum;
      {
        const int row = lh * 32 + l31;
#pragma unroll
        for (int i4 = 0; i4 < 4; ++i4) {
          f32x4 sc[4];
#pragma unroll
          for (int q = 0; q < 4; ++q) sc[q] = ((const f32x4*)p.uscale)[bi[i4 * 4 + q]];
          typedef int i32x4 __attribute__((ext_vector_type(4)));
          *(i32x4*)(eidx + row * 128 + hd * 16 + i4 * 4) = (i32x4){bi[i4 * 4], bi[i4 * 4 + 1], bi[i4 * 4 + 2], bi[i4 * 4 + 3]};
          *(f32x4*)(egate + row * 128 + hd * 16 + i4 * 4) = (f32x4){ev[i4 * 4] * einv * sc[0][1], ev[i4 * 4 + 1] * einv * sc[1][1], ev[i4 * 4 + 2] * einv * sc[2][1], ev[i4 * 4 + 3] * einv * sc[3][1]};
          *(f32x4*)(eus + row * 128 + hd * 16 + i4 * 4) = (f32x4){sc[0][0], sc[1][0], sc[2][0], sc[3][0]};
          *(f32x4*)(eub + row * 128 + hd * 16 + i4 * 4) = (f32x4){sc[0][2], sc[1][2], sc[2][2], sc[3][2]};
        }
      }
    }
    __syncthreads();
    const __amdgpu_buffer_rsrc_t qrs = __builtin_amdgcn_make_buffer_rsrc((void*)p.Uq, 0, 2 * 16384 * QROWB, 0x00020000);
    const int voff_u = (QBITS == 8) ? lane * 16 : lane * 16, voff_v = voff_u + 16384 * QROWB;
    int n_ia, n_ib; float n_ga, n_gb, n_ua, n_ub, n_ba, n_bb, n_kt, n_hscale; unsigned n_hq[4];
    qrow_t bufA_u[8], bufA_v[8], bufB_u[8], bufB_v[8];
#if QBITS != 8
    qrow_t bufC_u[8], bufC_v[8], bufD_u[8], bufD_v[8];
    unsigned cfp_cur = 0;
#endif
#define GA_PREP(ROW)                                                                                                              \
    {                                                                                                                             \
      const int prow = (ROW);                                                                                                     \
      n_ia = eidx[prow * 128 + lane]; n_ib = eidx[prow * 128 + 64 + lane];                                                        \
      n_ga = egate[prow * 128 + lane]; n_gb = egate[prow * 128 + 64 + lane];                                                      \
      n_ua = eus[prow * 128 + lane]; n_ub = eus[prow * 128 + 64 + lane];                                                          \
      n_ba = eub[prow * 128 + lane]; n_bb = eub[prow * 128 + 64 + lane];                                                          \
      {     \
        unsigned k0 = ((unsigned)n_ia << 7) | (unsigned)lane, k1 = ((unsigned)n_ib << 7) | (unsigned)(64 + lane);                 \
        sort128_asc(k0, k1, lane);                                                                                                \
        const int p0 = (int)(k0 & 127u), p1 = (int)(k1 & 127u);                                                                   \
        const float ga0 = __shfl(n_ga, p0 & 63), gb0 = __shfl(n_gb, p0 & 63), ga1 = __shfl(n_ga, p1 & 63), gb1 = __shfl(n_gb, p1 & 63); \
        const float ua0 = __shfl(n_ua, p0 & 63), ub0 = __shfl(n_ub, p0 & 63), ua1 = __shfl(n_ua, p1 & 63), ub1 = __shfl(n_ub, p1 & 63); \
        const float ba0 = __shfl(n_ba, p0 & 63), bb0 = __shfl(n_bb, p0 & 63), ba1 = __shfl(n_ba, p1 & 63), bb1 = __shfl(n_bb, p1 & 63); \
        n_ia = (int)(k0 >> 7) * (QBITS == 8 ? QROWB : 2 * QROWB); n_ib = (int)(k1 >> 7) * (QBITS == 8 ? QROWB : 2 * QROWB);       \
        n_ga = (p0 & 64) ? gb0 : ga0; n_gb = (p1 & 64) ? gb1 : ga1;                                                               \
        n_ua = (p0 & 64) ? ub0 : ua0; n_ub = (p1 & 64) ? ub1 : ua1;                                                               \
        n_ba = (p0 & 64) ? bb0 : ba0; n_bb = (p1 & 64) ? bb1 : ba1;                                                               \
      }                                                                                                                           \
      float hf[16];                                                                                                               \
      const u32x4 h0 = *(const u32x4*)(A + prow * LDA + lane * 16), h1 = *(const u32x4*)(A + prow * LDA + lane * 16 + 8);         \
      _Pragma("unroll") for (int j = 0; j < 4; ++j) { hf[2 * j] = bflo(h0[j]); hf[2 * j + 1] = bfhi(h0[j]); hf[8 + 2 * j] = bflo(h1[j]); hf[8 + 2 * j + 1] = bfhi(h1[j]); } \
      float hmax = 0.f;                                                                                                           \
      _Pragma("unroll") for (int j = 0; j < 16; ++j) hmax = fmaxf(hmax, fabsf(hf[j]));                                            \
      hmax = wave_max(hmax);                                                                                                      \
      n_hscale = hmax * (1.f / 127.f); const float hinv = hmax > 0.f ? 127.f / hmax : 0.f;                                        \
      float hsum = 0.f;                                                                                                           \
      if (QBITS == 8) {                                                                                                           \
        _Pragma("unroll") for (int j = 0; j < 4; ++j) {                                                                           \
          unsigned w = 0;                                                                                                         \
          _Pragma("unroll") for (int e = 0; e < 4; ++e) { const int q = (int)__builtin_rintf(hf[4 * j + e] * hinv) + 128; w |= (unsigned)q << (8 * e); hsum += (float)q; } \
          n_hq[j] = w;                                                                                                            \
        }                                                                                                                         \
      } else {                                                                                                                    \
        _Pragma("unroll") for (int jd = 0; jd < 2; ++jd) {                                                                        \
          unsigned whi = 0, wlo = 0;                                                                                              \
          _Pragma("unroll") for (int e = 0; e < 8; ++e) {                                                                         \
            const unsigned q = (unsigned)((int)__builtin_rintf(hf[8 * jd + e] * hinv) + 128); hsum += (float)q;                   \
            const int sh = 8 * (e & 3) + 4 * (e >> 2);                                                                            \
            whi |= (q >> 4) << sh; wlo |= (q & 15u) << sh;                                                                        \
          }                                                                                                                       \
          n_hq[jd] = whi; n_hq[2 + jd] = wlo;                                                                                     \
        }                                                                                                                         \
      }                                                                                                                           \
      n_kt = (QBITS == 8 ? 128.f : 7.5f) * (wave_sum(hsum) - 131072.f);                                                           \
    }
    GA_PREP(wave)
    ga_load(qrs, n_ia, 0, voff_u, voff_v, bufA_u, bufA_v);
#if QBITS != 8
    ga_load(qrs, n_ia, 8, voff_u, voff_v, bufB_u, bufB_v);
    cfp_cur = ga_u(n_ga, n_ua, n_ba, 0, lane, n_kt, n_hscale, n_hq, bufA_u);
#endif
#pragma unroll 1
    for (int rr = 0; rr < 8; ++rr) {
      const int row = rr * 8 + wave; const int tok = tok0 + row;
      const int ia = n_ia, ib = n_ib; const float ga = n_ga, gb = n_gb, ua = n_ua, ub = n_ub, ba = n_ba, bb = n_bb, kt = n_kt, hscale = n_hscale;
      unsigned hq[4];
#pragma unroll
      for (int j = 0; j < 4; ++j) hq[j] = n_hq[j];
      if (rr + 1 < 8) GA_PREP(row + 8)
      oacc_t oacc[8];
#pragma unroll
      for (int j = 0; j < 8; ++j) { oacc[j][0] = 0; oacc[j][1] = 0; }
      float csum = 0.f;
#if QBITS != 8
      const bool more = rr + 1 < 8;
#define GA_STEP(G, CU, CV, NU, LU, LV)                                                                                            \
      {                                                                                                                           \
        const int g2_ = (G) + 2, g1_ = (G) + 1;                                                                                   \
        if (g2_ < 16) ga_load(qrs, (g2_ < 8) ? ia : ib, (g2_ & 7) * 8, voff_u, voff_v, LU, LV);                                   \
        else if (more) ga_load(qrs, n_ia, (g2_ & 7) * 8, voff_u, voff_v, LU, LV);                                                 \
        unsigned cfp_n_ = 0;                                                                                                      \
        if (g1_ < 16) cfp_n_ = ga_u((g1_ < 8) ? ga : gb, (g1_ < 8) ? ua : ub, (g1_ < 8) ? ba : bb, (g1_ & 7) * 8, lane, kt, hscale, hq, NU); \
        else if (more) cfp_n_ = ga_u(n_ga, n_ua, n_ba, 0, lane, n_kt, n_hscale, n_hq, NU);                                        \
        ga_v(cfp_cur, CV, oacc);                                                                                                  \
        cfp_cur = cfp_n_;                                                                                                         \
      }
#pragma unroll 1
      for (int g = 0; g < 16; g += 4) {
        GA_STEP(g,     bufA_u, bufA_v, bufB_u, bufC_u, bufC_v)
        GA_STEP(g + 1, bufB_u, bufB_v, bufC_u, bufD_u, bufD_v)
        GA_STEP(g + 2, bufC_u, bufC_v, bufD_u, bufA_u, bufA_v)
        GA_STEP(g + 3, bufD_u, bufD_v, bufA_u, bufB_u, bufB_v)
      }
#undef GA_STEP
#else
#pragma unroll 1
      for (int half = 0; half < 2; ++half) {
        const int iv = half ? ib : ia, ivn = half ? n_ia : ib;
        const float gs = half ? gb : ga, us = half ? ub : ua, bs = half ? bb : ba;
        const bool has_next = (half == 0) || (rr + 1 < 8);
#pragma unroll 1
        for (int g8 = 0; g8 < 8; g8 += 2) {
          ga_load(qrs, iv, (g8 + 1) * 8, voff_u, voff_v, bufB_u, bufB_v);
          ga_compute(gs, us, bs, g8 * 8, lane, kt, hscale, hq, bufA_u, bufA_v, oacc, csum);
          if (g8 + 2 < 8) ga_load(qrs, iv, (g8 + 2) * 8, voff_u, voff_v, bufA_u, bufA_v);
          else if (has_next) ga_load(qrs, ivn, 0, voff_u, voff_v, bufA_u, bufA_v);
          ga_compute(gs, us, bs, (g8 + 1) * 8, lane, kt, hscale, hq, bufB_u, bufB_v, oacc, csum);
        }
      }
#endif
      {
#if QBITS == 8
        const float corr = wave_sum(csum) * (128.f / 8.f);
#pragma unroll
        for (int j = 0; j < 8; ++j) oacc[j] = oacc[j] - corr;
#endif
      }
      float xo[16]; float ss = 0.f;
#pragma unroll
      for (int q = 0; q < 4; ++q) {
        const int col = lane * 16 + q * 4;
        const f32x4 xv = *(const f32x4*)(x1s + row * 1024 + col);
        const f32x4 g2 = *(const f32x4*)(modb + 5120 + col);
#pragma unroll
        for (int j = 0; j < 4; ++j) { const float v = xv[j] + g2[j] * ((float)oacc[q * 2 + (j >> 1)][j & 1] * (1.f / OACC_SCALE)); xo[q * 4 + j] = v; ss += v * v; }
      }
      ss = wave_sum(ss);
      const float rs = rsqrtf(ss * (1.f / 1024.f) + EPS);
#pragma unroll
      for (int q = 0; q < 4; ++q) {
        const int col = lane * 16 + q * 4;
        const f32x4 fg = *(const f32x4*)(p.final_g + col);
        f32x4 o;
#pragma unroll
        for (int j = 0; j < 4; ++j) o[j] = xo[q * 4 + j] * rs * fg[j];
        *(f32x4*)(p.out + (size_t)tok * DM + col) = o;
      }
    }
#undef GA_PREP
    __syncthreads();
  }
}

template <int MODE>
__global__ void __launch_bounds__(NTHREADS) mk_fwd(Params p) {
  extern __shared__ __attribute__((aligned(16))) char smem[];
  if (MODE < 0) {
    cg::grid_group grid = cg::this_grid();
    typedef const __attribute__((address_space(4))) Params* KPP;
    { KPP kp = (KPP)__builtin_amdgcn_kernarg_segment_ptr(); asm volatile("" : "+s"(kp)); phase0(*kp, smem); }
    grid.sync();
    { KPP kp = (KPP)__builtin_amdgcn_kernarg_segment_ptr(); asm volatile("" : "+s"(kp)); phase1(*kp, smem); }
    grid.sync();
    { KPP kp = (KPP)__builtin_amdgcn_kernarg_segment_ptr(); asm volatile("" : "+s"(kp)); phase2(*kp, smem); }
    grid.sync();
    { KPP kp = (KPP)__builtin_amdgcn_kernarg_segment_ptr(); asm volatile("" : "+s"(kp)); phase3(*kp, smem); }
#ifdef PROBE_P3X2
    grid.sync();
    phase3(p, smem);
#endif
#ifdef PROBE_P1X2
    grid.sync();
    phase1(p, smem);
#endif
  } else {
    typedef const __attribute__((address_space(4))) Params* KPP;
    KPP kp = (KPP)__builtin_amdgcn_kernarg_segment_ptr();
    if (MODE == 0) phase0(*kp, smem);
    if (MODE == 1) phase1(*kp, smem);
    if (MODE == 2) phase2(*kp, smem);
    if (MODE == 3) phase3(*kp, smem);
  }
}

static size_t align_up(size_t v) { return (v + 255) & ~(size_t)255; }

extern "C" void kernel_launch(void* const* d_in, const int* in_sizes, int n_in, void* d_out, int out_size, void* d_ws, size_t ws_size, hipStream_t stream) {
  static int grid = 0;
  if (grid == 0) {
    int dev = 0, cus = 0, per_cu = 0;
    (void)hipGetDevice(&dev);
    (void)hipDeviceGetAttribute(&cus, hipDeviceAttributeMultiprocessorCount, dev);
#if N_LAUNCH_MODE == 1
    (void)hipFuncSetAttribute((const void*)mk_fwd<-1>, hipFuncAttributeMaxDynamicSharedMemorySize, LDS_BYTES);
    (void)hipOccupancyMaxActiveBlocksPerMultiprocessor(&per_cu, (const void*)mk_fwd<-1>, NTHREADS, LDS_BYTES);
#else
    (void)hipFuncSetAttribute((const void*)mk_fwd<0>, hipFuncAttributeMaxDynamicSharedMemorySize, LDS_BYTES);
    (void)hipFuncSetAttribute((const void*)mk_fwd<1>, hipFuncAttributeMaxDynamicSharedMemorySize, LDS_BYTES);
    (void)hipFuncSetAttribute((const void*)mk_fwd<2>, hipFuncAttributeMaxDynamicSharedMemorySize, LDS_BYTES);
    (void)hipFuncSetAttribute((const void*)mk_fwd<3>, hipFuncAttributeMaxDynamicSharedMemorySize, LDS_BYTES);
    (void)hipOccupancyMaxActiveBlocksPerMultiprocessor(&per_cu, (const void*)mk_fwd<3>, NTHREADS, LDS_BYTES);
#endif
    if (per_cu < 1) { fprintf(stderr, "kernel_launch: occupancy query says %d blocks/CU\n", per_cu); per_cu = 1; }
    if (per_cu > 1) per_cu = 1;
    grid = cus * per_cu;
    if (grid > 256) grid = 256;
    (void)hipGetLastError();
  }
  Params p{};
  const float* const* fin = (const float* const*)d_in;
  p.x = fin[0]; p.c = fin[1]; p.pos = (const int*)d_in[2];
  p.w_ada = fin[3]; p.b_ada = fin[4]; p.norm1_g = fin[5]; p.w_in = fin[6]; p.conv_w = fin[7]; p.conv_b = fin[8];
  p.lru_wa = fin[9]; p.lru_ba = fin[10]; p.lru_wx = fin[11]; p.lru_bx = fin[12]; p.lru_lambda = fin[13];
  p.q_norm_g = fin[14]; p.w_uq = fin[15]; p.kv_norm_g = fin[16]; p.w_ukv = fin[17]; p.lru_out_g = fin[18]; p.mla_out_g = fin[19];
  p.w_out = fin[20]; p.norm2_g = fin[21]; p.peer_wq = fin[22]; p.peer_keys = fin[23]; p.peer_u = fin[24]; p.peer_v = fin[25]; p.final_g = fin[26];
  p.out = (float*)d_out;
  char* w = (char*)d_ws; size_t off = 0;
  auto take = [&](size_t bytes) { char* r = w + off; off = align_up(off + bytes); return r; };
  p.mod = (float*)take((size_t)NB * 6144 * 4);
  p.ssq_lru = (float*)take((size_t)NTOK * 4);
  p.ssq_mla = (float*)take((size_t)NTOK * 4);
  p.invfreq = (double*)take(16 * 8);
  p.Wf_in = (bf16x8*)take((size_t)INW * 1024 * 2);
  p.Wf_uq = (bf16x8*)take((size_t)768 * 256 * 2);
  p.Wf_ukv = (bf16x8*)take((size_t)1024 * 128 * 2);
  p.Wf_a = (bf16x8*)take((size_t)8 * 64 * 64 * 2);
  p.Wf_x = (bf16x8*)take((size_t)8 * 64 * 64 * 2);
  p.Wf_out = (bf16x8*)take((size_t)1024 * 1024 * 2);
  p.Wf_s = (bf16x8*)take((size_t)2048 * 1024 * 2);
  p.Uq = (unsigned char*)take((size_t)2 * 16384 * QROWB);
  p.Vq = p.Uq + (size_t)16384 * QROWB;
  p.uscale = (float*)take((size_t)16384 * 16);
  p.vscale = p.uscale; p.ubias = p.uscale;
  p.xlru = (u16*)take((size_t)NTOK * 512 * 2);
  p.gate = (u16*)take((size_t)NTOK * 512 * 2);
  p.Q = (u16*)take((size_t)NTOK * 768 * 2);
  p.Kn = (u16*)take((size_t)NTOK * 512 * 2);
  p.Kr = (u16*)take((size_t)NTOK * 32 * 2);
  p.Vt = (u16*)take((size_t)NTOK * 512 * 2);
  p.y = (u16*)take((size_t)NTOK * 1024 * 2);
  p.scratch = take((size_t)256 * 655360);
  if (off > ws_size) { fprintf(stderr, "kernel_launch: workspace too small: need %zu have %zu\n", off, ws_size); return; }
#if N_LAUNCH_MODE == 1
  void* args[] = {&p};
  hipError_t e = hipLaunchCooperativeKernel((const void*)mk_fwd<-1>, dim3(grid), dim3(NTHREADS), args, LDS_BYTES, stream);
  if (e != hipSuccess) fprintf(stderr, "cooperative launch failed: %s (grid %d)\n", hipGetErrorString(e), grid);
#else
  hipLaunchKernelGGL(mk_fwd<0>, dim3(grid), dim3(NTHREADS), LDS_BYTES, stream, p);
  hipLaunchKernelGGL(mk_fwd<1>, dim3(grid), dim3(NTHREADS), LDS_BYTES, stream, p);
  hipLaunchKernelGGL(mk_fwd<2>, dim3(grid), dim3(NTHREADS), LDS_BYTES, stream, p);
  hipLaunchKernelGGL(mk_fwd<3>, dim3(grid), dim3(NTHREADS), LDS_BYTES, stream, p);
#endif
}
```

```cpp
#include <hip/hip_runtime.h>
#include <hip/hip_cooperative_groups.h>
#include <cstdio>
#include <cstdint>
namespace cg = cooperative_groups;

#ifndef QBITS
#define QBITS 4
#endif
#ifndef N_LAUNCH_MODE
#define N_LAUNCH_MODE 1
#endif

typedef short bf16x8 __attribute__((ext_vector_type(8)));
typedef float f32x16 __attribute__((ext_vector_type(16)));
typedef float f32x4 __attribute__((ext_vector_type(4)));
typedef float f32x2 __attribute__((ext_vector_type(2)));
typedef unsigned u32x4 __attribute__((ext_vector_type(4)));
typedef unsigned u32x2 __attribute__((ext_vector_type(2)));
typedef __bf16 bf16x2_t __attribute__((ext_vector_type(2)));
typedef unsigned short u16;
typedef _Float16 h16x2 __attribute__((ext_vector_type(2)));

#define DI __device__ __forceinline__
#define MFMA32(a, b, c) __builtin_amdgcn_mfma_f32_32x32x16_bf16((a), (b), (c), 0, 0, 0)

constexpr int NB = 32, SEQ = 2048, DM = 1024, NTOK = NB * SEQ;
constexpr int INW = 1440;
constexpr int NTHREADS = 512;
constexpr int LDA = 1032;
constexpr int LDS_BYTES = 147456;
constexpr float EPS = 1e-6f;

struct Params {
  const float* x; const float* c; const int* pos;
  const float* w_ada; const float* b_ada; const float* norm1_g; const float* w_in; const float* conv_w; const float* conv_b;
  const float* lru_wa; const float* lru_ba; const float* lru_wx; const float* lru_bx; const float* lru_lambda;
  const float* q_norm_g; const float* w_uq; const float* kv_norm_g; const float* w_ukv; const float* lru_out_g; const float* mla_out_g;
  const float* w_out; const float* norm2_g; const float* peer_wq; const float* peer_keys; const float* peer_u; const float* peer_v; const float* final_g;
  float* out;
  float* mod; float* ssq_lru; float* ssq_mla; double* invfreq;
  bf16x8* Wf_in; bf16x8* Wf_uq; bf16x8* Wf_ukv; bf16x8* Wf_a; bf16x8* Wf_x; bf16x8* Wf_out; bf16x8* Wf_s;
  unsigned char* Uq; unsigned char* Vq; float* uscale; float* vscale; float* ubias; u16* xlru; u16* gate; u16* Q; u16* Kn; u16* Kr; u16* Vt; u16* y;
  char* scratch;
};

typedef const __attribute__((address_space(4))) Params& KP;

DI unsigned pk2(float a, float b) { f32x2 v = {a, b}; bf16x2_t r = __builtin_convertvector(v, bf16x2_t); return __builtin_bit_cast(unsigned, r); }
DI u16 f2bf(float a) { return (u16)(pk2(a, 0.f) & 0xffffu); }
DI float bflo(unsigned u) { return __uint_as_float(u << 16); }
DI float bfhi(unsigned u) { return __uint_as_float(u & 0xffff0000u); }
DI float bf2f(u16 h) { return __uint_as_float(((unsigned)h) << 16); }
template <int CTRL> DI float dppf(float v) { return __builtin_bit_cast(float, __builtin_amdgcn_update_dpp(0, __builtin_bit_cast(int, v), CTRL, 0xF, 0xF, true)); }
typedef unsigned u32x2_ __attribute__((ext_vector_type(2)));
DI float wave_sum(float v) {
  v += dppf<0xB1>(v); v += dppf<0x4E>(v); v += dppf<0x141>(v); v += dppf<0x140>(v);
  u32x2_ r = __builtin_amdgcn_permlane16_swap(__float_as_uint(v), __float_as_uint(v), false, false); v = __uint_as_float(r[0]) + __uint_as_float(r[1]);
  r = __builtin_amdgcn_permlane32_swap(__float_as_uint(v), __float_as_uint(v), false, false); v = __uint_as_float(r[0]) + __uint_as_float(r[1]);
  return v;
}
DI float wave_max(float v) {
  v = fmaxf(v, dppf<0xB1>(v)); v = fmaxf(v, dppf<0x4E>(v)); v = fmaxf(v, dppf<0x141>(v)); v = fmaxf(v, dppf<0x140>(v));
  u32x2_ r = __builtin_amdgcn_permlane16_swap(__float_as_uint(v), __float_as_uint(v), false, false); v = fmaxf(__uint_as_float(r[0]), __uint_as_float(r[1]));
  r = __builtin_amdgcn_permlane32_swap(__float_as_uint(v), __float_as_uint(v), false, false); v = fmaxf(__uint_as_float(r[0]), __uint_as_float(r[1]));
  return v;
}
template <int CTRL> DI unsigned dppu(unsigned v) { return (unsigned)__builtin_amdgcn_update_dpp(0, (int)v, CTRL, 0xF, 0xF, true); }
template <int J> DI unsigned lane_xor_u(unsigned v, int lane) {
  if (J == 1) return dppu<0xB1>(v);
  if (J == 2) return dppu<0x4E>(v);
  if (J == 4) return dppu<0x141>(dppu<0x1B>(v));
  if (J == 8) return dppu<0x128>(v);
  if (J == 16) { const u32x2_ r = __builtin_amdgcn_permlane16_swap(v, v, false, false); return (lane & 16) ? r[0] : r[1]; }
  const u32x2_ r = __builtin_amdgcn_permlane32_swap(v, v, false, false); return (lane & 32) ? r[0] : r[1];
}
template <int J> DI float lane_xor_f(float v, int lane) { return __uint_as_float(lane_xor_u<J>(__float_as_uint(v), lane)); }
DI float sum_xor32(float v) { const u32x2_ r = __builtin_amdgcn_permlane32_swap(__float_as_uint(v), __float_as_uint(v), false, false); return __uint_as_float(r[0]) + __uint_as_float(r[1]); }
DI float max_xor32(float v) { const u32x2_ r = __builtin_amdgcn_permlane32_swap(__float_as_uint(v), __float_as_uint(v), false, false); return fmaxf(__uint_as_float(r[0]), __uint_as_float(r[1])); }
DI float other_xor32(float v, int lane) { const u32x2_ r = __builtin_amdgcn_permlane32_swap(__float_as_uint(v), __float_as_uint(v), false, false); return __uint_as_float((lane & 32) ? r[0] : r[1]); }
DI float reduce8(const float (&v)[8], int lane) {
  float q4[4], r2[2];
#pragma unroll
  for (int j = 0; j < 4; ++j) {
    const u32x2_ r = __builtin_amdgcn_permlane32_swap(__float_as_uint(v[j]), __float_as_uint(v[4 + j]), false, false);
    q4[j] = __uint_as_float(r[0]) + __uint_as_float(r[1]);
  }
#pragma unroll
  for (int j = 0; j < 2; ++j) {
    const u32x2_ r = __builtin_amdgcn_permlane16_swap(__float_as_uint(q4[j]), __float_as_uint(q4[2 + j]), false, false);
    r2[j] = __uint_as_float(r[0]) + __uint_as_float(r[1]);
  }
  const float s0 = r2[0] + dppf<0x128>(r2[0]), s1b = r2[1] + dppf<0x128>(r2[1]);
  float s1 = (lane & 8) ? s1b : s0;
  s1 += dppf<0xB1>(s1);
  s1 += dppf<0x4E>(s1);
  s1 += dppf<0x141>(s1);
  return s1;
}
DI float reduce32(const float (&v)[32], int lane) {
  const bool b3 = (lane & 8) != 0, b2 = (lane & 4) != 0, b1 = (lane & 2) != 0, b0 = (lane & 1) != 0;
  float a16[16], a8[8], a4[4], a2[2];
#pragma unroll
  for (int j = 0; j < 16; ++j) {
    const u32x2_ r = __builtin_amdgcn_permlane16_swap(__float_as_uint(v[j]), __float_as_uint(v[16 + j]), false, false);
    a16[j] = __uint_as_float(r[0]) + __uint_as_float(r[1]);
  }
#pragma unroll
  for (int j = 0; j < 8; ++j) { const float keep = b3 ? a16[8 + j] : a16[j], send = b3 ? a16[j] : a16[8 + j]; a8[j] = keep + lane_xor_f<8>(send, lane); }
#pragma unroll
  for (int j = 0; j < 4; ++j) { const float keep = b2 ? a8[4 + j] : a8[j], send = b2 ? a8[j] : a8[4 + j]; a4[j] = keep + lane_xor_f<4>(send, lane); }
#pragma unroll
  for (int j = 0; j < 2; ++j) { const float keep = b1 ? a4[2 + j] : a4[j], send = b1 ? a4[j] : a4[2 + j]; a2[j] = keep + lane_xor_f<2>(send, lane); }
  const float keep = b0 ? a2[1] : a2[0], send = b0 ? a2[0] : a2[1];
  return keep + lane_xor_f<1>(send, lane);
}
DI float sigmoidf_(float x) { return __builtin_amdgcn_rcpf(1.f + __builtin_amdgcn_exp2f(-1.4426950408889634f * x)); }
DI float gelu_tanh(float x) { const float u = 0.7978845608028654f * (x + 0.044715f * x * x * x); return x * __builtin_amdgcn_rcpf(1.f + __builtin_amdgcn_exp2f(-2.f * 1.4426950408889634f * u)); }
DI float one_minus_exp_small(float z) {
  float q = 1.f + z * (1.f / 6.f);
  q = 1.f + z * (1.f / 5.f) * q;
  q = 1.f + z * (1.f / 4.f) * q;
  q = 1.f + z * (1.f / 3.f) * q;
  q = 1.f + z * (1.f / 2.f) * q;
  return -z * q;
}
DI f32x16 zero16() { f32x16 z; for (int i = 0; i < 16; ++i) z[i] = 0.f; return z; }
DI int crow(int reg, int h) { return (reg & 3) + 8 * (reg >> 2) + 4 * h; }

template <int NT, int PD>
DI void gemm_pro(const bf16x8* __restrict__ Wf, int KS, const int (&tile)[NT], int lane, bf16x8 (&bq)[PD][NT]) {
#pragma unroll
  for (int d = 0; d < PD; ++d)
#pragma unroll
    for (int t = 0; t < NT; ++t) bq[d][t] = Wf[((size_t)tile[t] * KS + d) * 64 + lane];
}
template <int NT, int PD, bool SWAP, bool APF = false>
DI void gemm_main(const u16* As, int lda, int nks, const bf16x8* __restrict__ Wf, int KS, const int (&tile)[NT], f32x16 (&acc)[NT][2], int lane, bf16x8 (&bq)[PD][NT]) {
  const bf16x8* a0p = (const bf16x8*)(As + (lane & 31) * lda + 8 * (lane >> 5));
  const bf16x8* a1p = (const bf16x8*)(As + ((lane & 31) + 32) * lda + 8 * (lane >> 5));
  const bf16x8* bp[NT];
#pragma unroll
  for (int t = 0; t < NT; ++t) bp[t] = Wf + (size_t)tile[t] * KS * 64 + lane;
  bf16x8 a0n = a0p[0], a1n = a1p[0];
#pragma unroll 1
  for (int ks = 0; ks < nks; ks += PD) {
#pragma unroll
    for (int d = 0; d < PD; ++d) {
      bf16x8 a0, a1;
      if (APF) { a0 = a0n; a1 = a1n; const int ka = (ks + d + 1 < nks) ? (ks + d + 1) : (ks + d); a0n = a0p[2 * ka]; a1n = a1p[2 * ka]; }
      else { a0 = a0p[2 * (ks + d)]; a1 = a1p[2 * (ks + d)]; }
      const int kn = (ks + d + PD < nks) ? (ks + d + PD) : (ks + d);
#pragma unroll
      for (int t = 0; t < NT; ++t) {
        const bf16x8 b = bq[d][t];
        bq[d][t] = bp[t][kn * 64];
        acc[t][0] = SWAP ? MFMA32(b, a0, acc[t][0]) : MFMA32(a0, b, acc[t][0]);
        acc[t][1] = SWAP ? MFMA32(b, a1, acc[t][1]) : MFMA32(a1, b, acc[t][1]);
      }
    }
  }
}
template <int NT, int PD = 8, bool SWAP = false>
DI void gemm_core(const u16* As, int lda, int nks, const bf16x8* __restrict__ Wf, int KS, const int (&tile)[NT], f32x16 (&acc)[NT][2], int lane) {
  bf16x8 bq[PD][NT];
  gemm_pro<NT, PD>(Wf, KS, tile, lane, bq);
  gemm_main<NT, PD, SWAP>(As, lda, nks, Wf, KS, tile, acc, lane, bq);
}

DI void conv_frag(const float* __restrict__ W, long sk, long sn, int K, int N, const float* ks1, const float* ks2, int ksplit, bf16x8* out, int gtid, int gthreads) {
  const int KS = K / 16; const int total = (N / 32) * KS * 64;
  for (int i = gtid; i < total; i += gthreads) {
    const int lane = i & 63; const int t = i >> 6; const int ks = t % KS; const int nt = t / KS;
    const int n = nt * 32 + (lane & 31); const int k0 = ks * 16 + 8 * (lane >> 5);
    float v[8];
#pragma unroll
    for (int j = 0; j < 8; ++j) {
      const int k = k0 + j;
      float s = 1.f;
      if (ks1) s = (k < ksplit) ? ks1[k] : ks2[k - ksplit];
      v[j] = W[(long)k * sk + (long)n * sn] * s;
    }
    u32x4 o; o[0] = pk2(v[0], v[1]); o[1] = pk2(v[2], v[3]); o[2] = pk2(v[4], v[5]); o[3] = pk2(v[6], v[7]);
    out[i] = __builtin_bit_cast(bf16x8, o);
  }
}

DI void phase0(KP p, char* smem) {
  const int tid = threadIdx.x; const int gtid = blockIdx.x * NTHREADS + tid; const int gthreads = gridDim.x * NTHREADS;
  for (int i = gtid; i < NTOK; i += gthreads) { p.ssq_lru[i] = 0.f; p.ssq_mla[i] = 0.f; }
  if (gtid < 16) p.invfreq[gtid] = pow(10000.0, -(double)gtid / 16.0);
  {
    float* cact = (float*)smem;
    float* red = (float*)(smem + 65536);
    const int lane = tid & 63, wv = tid >> 6;
    for (int item = blockIdx.x; item < 192; item += gridDim.x) {
      const int cg = item >> 1, bh = item & 1;
      for (int i = tid; i < 16 * DM; i += NTHREADS) { const int bb = i >> 10, k = i & 1023; const float v = p.c[(bh * 16 + bb) * DM + k]; cact[k * 16 + bb] = v / (1.f + __expf(-v)); }
      __syncthreads();
      float acc[16];
#pragma unroll
      for (int bb = 0; bb < 16; ++bb) acc[bb] = 0.f;
      const float* wp = p.w_ada + (size_t)(wv * 128) * 6144 + cg * 64 + lane;
#pragma unroll 8
      for (int kk = 0; kk < 128; ++kk) {
        const float w = wp[(size_t)kk * 6144];
        const f32x4* cp = (const f32x4*)(cact + (wv * 128 + kk) * 16);
#pragma unroll
        for (int q = 0; q < 4; ++q) { const f32x4 cv = cp[q]; acc[4 * q] += cv[0] * w; acc[4 * q + 1] += cv[1] * w; acc[4 * q + 2] += cv[2] * w; acc[4 * q + 3] += cv[3] * w; }
      }
#pragma unroll
      for (int bb = 0; bb < 16; ++bb) red[(wv * 16 + bb) * 64 + lane] = acc[bb];
      __syncthreads();
      for (int o = tid; o < 1024; o += NTHREADS) {
        const int bb = o >> 6, c2 = o & 63;
        float sum = 0.f;
#pragma unroll
        for (int w8 = 0; w8 < 8; ++w8) sum += red[(w8 * 16 + bb) * 64 + c2];
        p.mod[(size_t)(bh * 16 + bb) * 6144 + cg * 64 + c2] = sum + p.b_ada[cg * 64 + c2];
      }
      __syncthreads();
    }
  }
  conv_frag(p.w_in, INW, 1, 1024, INW, nullptr, nullptr, 0, p.Wf_in, gtid, gthreads);
  conv_frag(p.w_uq, 768, 1, 256, 768, p.q_norm_g, p.q_norm_g, 256, p.Wf_uq, gtid, gthreads);
  conv_frag(p.w_ukv, 1024, 1, 128, 1024, p.kv_norm_g, p.kv_norm_g, 128, p.Wf_ukv, gtid, gthreads);
  for (int h = 0; h < 8; ++h) {
    conv_frag(p.lru_wa + h * 4096, 64, 1, 64, 64, nullptr, nullptr, 0, p.Wf_a + h * 512, gtid, gthreads);
    conv_frag(p.lru_wx + h * 4096, 64, 1, 64, 64, nullptr, nullptr, 0, p.Wf_x + h * 512, gtid, gthreads);
  }
  conv_frag(p.w_out, 1024, 1, 1024, 1024, p.lru_out_g, p.mla_out_g, 512, p.Wf_out, gtid, gthreads);
  {
    float* kl = (float*)smem;
    float* wl = (float*)(smem + 67584);
    for (int item = blockIdx.x; item < 256; item += gridDim.x) {
      const int hp = item >> 4, cc = item & 15;
      __syncthreads();
      for (int i = tid; i < 16384; i += NTHREADS) kl[(i >> 7) * 132 + (i & 127)] = p.peer_keys[(size_t)hp * 16384 + i];
      for (int i = tid; i < 8192; i += NTHREADS) wl[i] = p.peer_wq[(size_t)(cc * 64 + (i >> 7)) * 2048 + hp * 128 + (i & 127)];
      __syncthreads();
#pragma unroll 1
      for (int q = 0; q < 2; ++q) {
        const int f = tid + NTHREADS * q; const int ln = f & 63, ksl = (f >> 6) & 3, mt = f >> 8;
        const int r = mt * 32 + (ln & 31), cb = 16 * ksl + 8 * (ln >> 5);
        float acc[8];
#pragma unroll
        for (int j = 0; j < 8; ++j) acc[j] = 0.f;
        const f32x4* kp = (const f32x4*)(kl + r * 132);
#pragma unroll 2
        for (int d4 = 0; d4 < 32; ++d4) {
          const f32x4 kv = kp[d4];
#pragma unroll
          for (int j = 0; j < 8; ++j) {
            const f32x4 wv = *(const f32x4*)(wl + (cb + j) * 128 + d4 * 4);
            acc[j] += wv[0] * kv[0] + wv[1] * kv[1] + wv[2] * kv[2] + wv[3] * kv[3];
          }
        }
        u32x4 o; o[0] = pk2(acc[0], acc[1]); o[1] = pk2(acc[2], acc[3]); o[2] = pk2(acc[4], acc[5]); o[3] = pk2(acc[6], acc[7]);
        p.Wf_s[(size_t)((hp * 4 + mt) * 64 + cc * 4 + ksl) * 64 + ln] = __builtin_bit_cast(bf16x8, o);
      }
    }
    __syncthreads();
  }
  {
    const int lane = tid & 63; const int gw = gtid >> 6; const int nw = gthreads >> 6;
    for (int row = gw; row < 32768; row += nw) {
      const int r = row & 16383; const bool isv = row >= 16384;
      const f32x4* src = (const f32x4*)((isv ? p.peer_v : p.peer_u) + (size_t)r * 1024) + lane * 4;
      f32x4 a[4];
#pragma unroll
      for (int i = 0; i < 4; ++i) a[i] = src[i];
#if QBITS == 8
      float am = 0.f;
#pragma unroll
      for (int i = 0; i < 4; ++i)
#pragma unroll
        for (int j = 0; j < 4; ++j) am = fmaxf(am, fabsf(a[i][j]));
      am = wave_max(am);
      const float inv = am > 0.f ? 127.f / am : 0.f;
      u32x4 o;
#pragma unroll
      for (int i = 0; i < 4; ++i) {
        unsigned w = 0;
#pragma unroll
        for (int j = 0; j < 4; ++j) { const int q = (int)__builtin_rintf(a[i][j] * inv) + 128; w |= (unsigned)q << (8 * j); }
        o[i] = w;
      }
      ((u32x4*)(isv ? p.Vq : p.Uq))[(size_t)r * 64 + lane] = o;
      const float step = am * (1.f / 127.f);
      if (lane == 0) p.uscale[r * 4 + (isv ? 1 : 0)] = step;
      float ns = 0.f;
#pragma unroll
      for (int i = 0; i < 4; ++i) ns += (float)(o[i] & 255u) + (float)((o[i] >> 8) & 255u) + (float)((o[i] >> 16) & 255u) + (float)(o[i] >> 24);
      ns = wave_sum(ns);
      if (lane == 0 && !isv) p.uscale[r * 4 + 2] = step * 128.f * ns;
#else
      float ssum = 0.f;
#pragma unroll
      for (int i = 0; i < 4; ++i)
#pragma unroll
        for (int j = 0; j < 4; ++j) ssum += a[i][j] * a[i][j];
      ssum = wave_sum(ssum);
      const float rms = sqrtf(ssum * (1.f / 1024.f));
      const float step = (isv ? 0.49f : 0.3352f) * rms;
      const float inv = step > 0.f ? 1.f / step : 0.f;
      u32x2 o;
#pragma unroll
      for (int jd = 0; jd < 2; ++jd) {
        unsigned w = 0;
#pragma unroll
        for (int e = 0; e < 8; ++e) {
          const float x = a[(8 * jd + e) >> 2][(8 * jd + e) & 3];
          if (isv) {
            const float m = fabsf(x) * inv;
            const int mag = (m > 0.25f) + (m > 0.75f) + (m > 1.25f) + (m > 1.75f) + (m > 2.5f) + (m > 3.5f) + (m > 5.0f);
            w |= (unsigned)(mag | (x < 0.f ? 8 : 0)) << (4 * e);
          } else {
            int q = (int)__builtin_rintf(x * inv + 7.5f); q = q < 0 ? 0 : (q > 15 ? 15 : q);
            w |= (unsigned)q << (8 * (e & 3) + 4 * (e >> 2));
          }
        }
        o[jd] = w;
      }
      ((u32x2*)(p.Uq + (size_t)r * 1024))[2 * lane + (isv ? 1 : 0)] = o;
      if (lane == 0) p.uscale[r * 4 + (isv ? 1 : 0)] = step;
      float ns = 0.f;
#pragma unroll
      for (int jd = 0; jd < 2; ++jd)
#pragma unroll
        for (int e = 0; e < 8; ++e) ns += (float)((o[jd] >> (4 * e)) & 15u);
      ns = wave_sum(ns);
      if (lane == 0 && !isv) p.uscale[r * 4 + 2] = step * 128.f * ns;
#endif
    }
  }
}

DI void phase1(KP p, char* smem) {
  const int tid = threadIdx.x, wave = __builtin_amdgcn_readfirstlane(tid >> 6);
  u16* hA = (u16*)smem;
  float* cs = (float*)(smem + 132096);
  float* ssq = (float*)(smem + 132096 + 8192);
  constexpr int LDL = 424;
  for (int tile = blockIdx.x; tile < NTOK / 64; tile += gridDim.x) {
    int lane_o = tid & 63; asm volatile("" : "+v"(lane_o));
    const int lane = lane_o, l31 = lane & 31, lh = lane >> 5;
    const int tok0 = tile * 64; const int b = tok0 / SEQ; const int s0 = tok0 % SEQ;
    const float* modb = p.mod + (size_t)b * 6144;
    for (int i = tid; i < 1024; i += NTHREADS) {
      const int r = i >> 4, j = i & 15;
      const double ang = (double)p.pos[tok0 + r] * p.invfreq[j];
      double rev = ang * 0.15915494309189535; rev -= floor(rev);
      const float rf = (float)rev;
      cs[2 * i] = __builtin_amdgcn_cosf(rf); cs[2 * i + 1] = __builtin_amdgcn_sinf(rf);
    }
    if (tid < 128) ssq[tid] = 0.f;
    {
      f32x4 cm[4], ca[4];
#pragma unroll
      for (int i = 0; i < 4; ++i) {
        const int col = i * 256 + lane * 4;
        const f32x4 g = *(const f32x4*)(p.norm1_g + col); const f32x4 sc = *(const f32x4*)(modb + 1024 + col);
        cm[i] = g * (sc + 1.0f); ca[i] = *(const f32x4*)(modb + col);
      }
#pragma unroll 2
      for (int rr = 0; rr < 8; rr += 4) {
        f32x4 xv[4][4];
#pragma unroll
        for (int q = 0; q < 4; ++q)
#pragma unroll
          for (int i = 0; i < 4; ++i) xv[q][i] = *(const f32x4*)(p.x + (size_t)(tok0 + wave * 8 + rr + q) * DM + i * 256 + lane * 4);
#pragma unroll
        for (int q = 0; q < 4; ++q) {
          float ss = 0.f;
#pragma unroll
          for (int i = 0; i < 4; ++i) ss += xv[q][i][0] * xv[q][i][0] + xv[q][i][1] * xv[q][i][1] + xv[q][i][2] * xv[q][i][2] + xv[q][i][3] * xv[q][i][3];
          ss = wave_sum(ss);
          const float rs = rsqrtf(ss * (1.f / 1024.f) + EPS);
          const int row = wave * 8 + rr + q;
#pragma unroll
          for (int i = 0; i < 4; ++i) {
            const f32x4 h = xv[q][i] * rs * cm[i] + ca[i];
            u32x2 o; o[0] = pk2(h[0], h[1]); o[1] = pk2(h[2], h[3]);
            *(u32x2*)(hA + row * LDA + i * 256 + lane * 4) = o;
          }
        }
      }
    }
    __syncthreads();
    bf16x8 ring1[8][2];
    const bool has2 = (wave + 40) < 45;
    { const int tl0[2] = {wave, wave + 8}; gemm_pro<2, 8>(p.Wf_in, 64, tl0, lane, ring1); }
#pragma unroll 1
    for (int pass = 0; pass < 2; ++pass) {
      f32x16 acc[2][2];
#pragma unroll
      for (int t = 0; t < 2; ++t) { acc[t][0] = zero16(); acc[t][1] = zero16(); }
      const int tl[2] = {wave + 16 * pass, wave + 16 * pass + 8};
      gemm_main<2, 8, false, true>(hA, LDA, 64, p.Wf_in, 64, tl, acc, lane, ring1);
      { const int tn[2] = {wave + 16 * (pass + 1), (pass == 0 || has2) ? wave + 16 * (pass + 1) + 8 : wave + 32}; gemm_pro<2, 8>(p.Wf_in, 64, tn, lane, ring1); }
      int el_ = lane; asm volatile("" : "+v"(el_));
      const int l31 = el_ & 31, lh = el_ >> 5;
      u16* dstb[2];
#pragma unroll
      for (int t = 0; t < 2; ++t) { const int col = tl[t] * 32 + l31; dstb[t] = (col < 512) ? (p.xlru + col) : (p.gate + (col - 512)); }
#pragma unroll
      for (int rt = 0; rt < 2; ++rt)
#pragma unroll
        for (int r = 0; r < 16; ++r) {
          const size_t ro = (size_t)(tok0 + rt * 32 + crow(r, lh)) * 512;
#pragma unroll
          for (int t = 0; t < 2; ++t) dstb[t][ro] = f2bf(acc[t][rt][r]);
        }
    }
    {
      f32x16 acc[2][2];
#pragma unroll
      for (int t = 0; t < 2; ++t) { acc[t][0] = zero16(); acc[t][1] = zero16(); }
      const int tl[2] = {wave + 32, has2 ? wave + 40 : wave + 32};
      gemm_main<2, 8, false, true>(hA, LDA, 64, p.Wf_in, 64, tl, acc, lane, ring1);
      int el_ = lane; asm volatile("" : "+v"(el_));
      const int l31 = el_ & 31, lh = el_ >> 5;
      __syncthreads();
      u16* lat = hA;
#pragma unroll
      for (int t = 0; t < 2; ++t) {
        if (t == 1 && !has2) continue;
        const int lc = tl[t] * 32 - 1024 + l31;
        if (tl[t] < 44) {
          float sq[32];
#pragma unroll
          for (int rt = 0; rt < 2; ++rt)
#pragma unroll
            for (int r = 0; r < 16; ++r) { const float v = acc[t][rt][r]; sq[rt * 16 + r] = v * v; }
          const float tot = reduce32(sq, lane);
          __hip_atomic_fetch_add(&ssq[(tl[t] < 40 ? 0 : 64) + (l31 >> 4) * 32 + crow(l31 & 15, lh)], tot, __ATOMIC_RELAXED, __HIP_MEMORY_SCOPE_WORKGROUP);
        }
#pragma unroll
        for (int rt = 0; rt < 2; ++rt)
#pragma unroll
          for (int r = 0; r < 16; ++r) {
            const int row = rt * 32 + crow(r, lh);
            const float v = acc[t][rt][r];
            if (lc < 384) {
              lat[row * LDL + lc] = f2bf(v);
            } else {
              const float pv = lane_xor_f<16>(v, lane);
              const int j = lc - 384; const int jj = j & 15;
              const float co = cs[(row * 16 + jj) * 2], si = cs[(row * 16 + jj) * 2 + 1];
              const float o = (j < 16) ? (v * co - pv * si) : (v * co + pv * si);
              p.Kr[(size_t)(tok0 + row) * 32 + j] = f2bf(o);
            }
          }
      }
    }
    __syncthreads();
    {
      const u16* lat = hA;
      const float qscale = 0.10206207261596577f * 1.4426950408889634f;
      const int jj = l31 & 15;
#pragma unroll 1
      for (int pass = 0; pass < 2; ++pass) {
        f32x16 acc[2][2];
#pragma unroll
        for (int t = 0; t < 2; ++t) { acc[t][0] = zero16(); acc[t][1] = zero16(); }
        const int tl[2] = {pass == 0 ? wave : wave + 16, pass == 0 ? wave + 8 : wave + 16};
        gemm_core<2>(lat, LDL, 16, p.Wf_uq, 16, tl, acc, lane);
        int el_ = lane; asm volatile("" : "+v"(el_));
        const int l31 = el_ & 31, lh = el_ >> 5;
#pragma unroll
        for (int rt = 0; rt < 2; ++rt)
#pragma unroll
          for (int r = 0; r < 16; ++r) {
            const int row = rt * 32 + crow(r, lh);
            const float rs = rsqrtf(ssq[row] * (1.f / 256.f) + EPS) * qscale;
            const float co = cs[(row * 16 + jj) * 2], si = cs[(row * 16 + jj) * 2 + 1];
#pragma unroll
            for (int t = 0; t < 2; ++t) {
              if (t == 1 && pass == 1) continue;
              const int head = tl[t] / 3, part = tl[t] % 3;
              float v = acc[t][rt][r] * rs;
              if (part == 2) {
                const float pv = lane_xor_f<16>(v, lane);
                v = (l31 < 16) ? (v * co - pv * si) : (v * co + pv * si);
              }
              p.Q[((size_t)(b * 8 + head) * SEQ + s0 + row) * 96 + part * 32 + l31] = f2bf(v);
            }
          }
      }
#pragma unroll 1
      for (int pass = 0; pass < 2; ++pass) {
        f32x16 acc[2][2];
#pragma unroll
        for (int t = 0; t < 2; ++t) { acc[t][0] = zero16(); acc[t][1] = zero16(); }
        const int tl[2] = {wave + 16 * pass, wave + 16 * pass + 8};
        gemm_core<2>(lat + 256, LDL, 8, p.Wf_ukv, 8, tl, acc, lane);
        int el_ = lane; asm volatile("" : "+v"(el_));
        const int l31 = el_ & 31, lh = el_ >> 5;
#pragma unroll
        for (int rt = 0; rt < 2; ++rt)
#pragma unroll
          for (int g = 0; g < 4; ++g) {
            const int row = rt * 32 + 8 * g + 4 * lh;
            float rs4[4];
#pragma unroll
            for (int q = 0; q < 4; ++q) rs4[q] = rsqrtf(ssq[64 + row + q] * (1.f / 128.f) + EPS);
#pragma unroll
            for (int t = 0; t < 2; ++t) {
              const int head = tl[t] >> 2, sub = tl[t] & 3;
              float v4[4];
#pragma unroll
              for (int q = 0; q < 4; ++q) v4[q] = acc[t][rt][4 * g + q] * rs4[q];
              if (sub < 2) {
#pragma unroll
                for (int q = 0; q < 4; ++q) p.Kn[((size_t)(b * 8 + head) * SEQ + s0 + row + q) * 64 + sub * 32 + l31] = f2bf(v4[q]);
              } else {
                const int d = (sub - 2) * 32 + l31;
                u32x2 o; o[0] = pk2(v4[0], v4[1]); o[1] = pk2(v4[2], v4[3]);
                *(u32x2*)(p.Vt + ((size_t)(b * 8 + head) * 64 + d) * SEQ + s0 + row) = o;
              }
            }
          }
      }
    }
    __syncthreads();
  }
}

DI void lru_item(KP p, char* smem, int item) {
  const int tid = threadIdx.x, lane = tid & 63, wave = __builtin_amdgcn_readfirstlane(tid >> 6);
  const int l31 = lane & 31, lh = lane >> 5;
  const int b = item >> 3, cb = item & 7;
  const int c = lane; const int ch = cb * 64 + c; const int tg = wave;
  const float cw0 = p.conv_w[ch], cw1 = p.conv_w[512 + ch], cw2 = p.conv_w[1024 + ch], cw3 = p.conv_w[1536 + ch], cbias = p.conv_b[ch];
  const float ba = p.lru_ba[ch], bx = p.lru_bx[ch];
  const float sp = log1pf(__expf(-p.lru_lambda[ch]));
  float carry = 0.f;
  const u16* xl = p.xlru + (size_t)b * SEQ * 512 + ch;
  const u16* gt = p.gate + (size_t)b * SEQ * 512 + ch;
  u16* yo = p.y + (size_t)b * SEQ * 1024 + ch;
  const int mat = wave >> 2, rt = (wave >> 1) & 1, ct = wave & 1;
  const bf16x8* wf = (mat == 0 ? p.Wf_a : p.Wf_x) + cb * 512 + ct * 256 + lane;
  bf16x8 bw[4];
#pragma unroll
  for (int ks = 0; ks < 4; ++ks) bw[ks] = wf[ks * 64];
  constexpr int NCH = SEQ / 64;
  u16 xin_n[11], gv_n[8];
#pragma unroll
  for (int i = 0; i < 11; ++i) { const int t = tg * 8 - 3 + i; xin_n[i] = (t >= 0) ? xl[(size_t)t * 512] : (u16)0; }
#pragma unroll
  for (int i = 0; i < 8; ++i) gv_n[i] = gt[(size_t)(tg * 8 + i) * 512];
  float xcB[8], gvB[8], xcC[8], gvC[8], avD[8], bvD[8], gvD[8];
#pragma unroll
  for (int i = 0; i < 8; ++i) { xcB[i] = gvB[i] = xcC[i] = gvC[i] = avD[i] = bvD[i] = gvD[i] = 0.f; }
  __syncthreads();
#pragma unroll 1
  for (int it = 0; it < NCH + 3; ++it) {
    float xcA[8], gvA[8], avC[8], bvC[8];
    if (it < NCH) {
      const int t0 = it * 64 + tg * 8;
      float xin[11];
#pragma unroll
      for (int i = 0; i < 11; ++i) xin[i] = bf2f(xin_n[i]);
#pragma unroll
      for (int i = 0; i < 8; ++i) gvA[i] = bf2f(gv_n[i]);
      if (it + 1 < NCH) {
#pragma unroll
        for (int i = 0; i < 11; ++i) xin_n[i] = xl[(size_t)(t0 + 64 - 3 + i) * 512];
#pragma unroll
        for (int i = 0; i < 8; ++i) gv_n[i] = gt[(size_t)(t0 + 64 + i) * 512];
      }
      u16* xcb = (u16*)(smem + (it & 1) * 9216);
#pragma unroll
      for (int i = 0; i < 8; ++i) {
        xcA[i] = cbias + cw0 * xin[i] + cw1 * xin[i + 1] + cw2 * xin[i + 2] + cw3 * xin[i + 3];
        xcb[(tg * 8 + i) * 72 + c] = f2bf(xcA[i]);
      }
    } else {
#pragma unroll
      for (int i = 0; i < 8; ++i) { xcA[i] = 0.f; gvA[i] = 0.f; }
    }
    if (it >= 1 && it - 1 < NCH) {
      const u16* xcb = (const u16*)(smem + ((it - 1) & 1) * 9216);
      float* pm = (float*)(smem + 18432 + ((it - 1) & 1) * 33280) + mat * 4160;
      f32x16 acc = zero16();
      const bf16x8* ap = (const bf16x8*)(xcb + (rt * 32 + l31) * 72 + 8 * lh);
#pragma unroll
      for (int ks = 0; ks < 4; ++ks) acc = MFMA32(ap[2 * ks], bw[ks], acc);
#pragma unroll
      for (int r = 0; r < 16; ++r) pm[(rt * 32 + crow(r, lh)) * 65 + ct * 32 + l31] = acc[r];
    }
    if (it >= 2 && it - 2 < NCH) {
      const float* pre = (const float*)(smem + 18432 + ((it - 2) & 1) * 33280);
      float* seg = (float*)(smem + 84992 + ((it - 2) & 1) * 4096);
      float A = 1.f, Bc = 0.f;
#pragma unroll
      for (int i = 0; i < 8; ++i) {
        const int tl = tg * 8 + i;
        const float r = sigmoidf_(pre[tl * 65 + c] + ba);
        const float ig = sigmoidf_(pre[4160 + tl * 65 + c] + bx);
        const float log_a = -8.f * r * sp;
        const float a = __builtin_amdgcn_exp2f(1.4426950408889634f * log_a);
        const float z = 2.f * log_a;
        const float om = (z > -0.25f) ? one_minus_exp_small(z) : -expm1f(z);
        const float m = __builtin_amdgcn_sqrtf(om);
        avC[i] = a; bvC[i] = m * ig * xcC[i];
        A *= a; Bc = a * Bc + bvC[i];
      }
      seg[(tg * 64 + c) * 2] = A; seg[(tg * 64 + c) * 2 + 1] = Bc;
    } else {
#pragma unroll
      for (int i = 0; i < 8; ++i) { avC[i] = 0.f; bvC[i] = 0.f; }
    }
    if (it >= 3) {
      const int t0 = (it - 3) * 64 + tg * 8;
      const float* seg = (const float*)(smem + 84992 + ((it - 3) & 1) * 4096);
      float h = carry, hin = 0.f;
#pragma unroll
      for (int s2 = 0; s2 < 8; ++s2) {
        if (s2 == tg) hin = h;
        h = seg[(s2 * 64 + c) * 2] * h + seg[(s2 * 64 + c) * 2 + 1];
      }
      carry = h;
      h = hin;
      float sq[8];
#pragma unroll
      for (int i = 0; i < 8; ++i) {
        h = avD[i] * h + bvD[i];
        const float yv = gelu_tanh(gvD[i]) * h;
        yo[(size_t)(t0 + i) * 1024] = f2bf(yv);
        sq[i] = yv * yv;
      }
      const float tot = reduce8(sq, lane);
      if ((lane & 7) == 0) unsafeAtomicAdd(p.ssq_lru + (size_t)b * SEQ + t0 + (lane >> 3), tot);
    }
#pragma unroll
    for (int i = 0; i < 8; ++i) {
      avD[i] = avC[i]; bvD[i] = bvC[i]; gvD[i] = gvC[i];
      xcC[i] = xcB[i]; gvC[i] = gvB[i];
      xcB[i] = xcA[i]; gvB[i] = gvA[i];
    }
    __syncthreads();
  }
}

DI void attn_unit(KP p, char* smem, int b, int hd, int qb) {
  const int tid = threadIdx.x, lane = tid & 63, wave = __builtin_amdgcn_readfirstlane(tid >> 6);
  const int l31 = lane & 31, lh = lane >> 5;
  const int q0 = qb * 256 + wave * 32;
  const size_t bh = (size_t)(b * 8 + hd);
  const int nkt = qb * 4 + 4;
  const int qidx = q0 + l31;
  const int skey = tid >> 3, schn = tid & 7;
  const int rkey = (tid & 255) >> 2, rchn = tid & 3;
  const u16* kn_src = p.Kn + (bh * SEQ + skey) * 64 + schn * 8;
  const u16* kr_src = p.Kr + ((size_t)b * SEQ + rkey) * 32 + rchn * 8;
  const u16* vt_src = p.Vt + (bh * 64 + skey) * SEQ + schn * 8;
  u32x4 rk, rr, rv;
  rk = *(const u32x4*)(kn_src); rv = *(const u32x4*)(vt_src);
  if (tid < 256) rr = *(const u32x4*)(kr_src);
  bf16x8 qf[6];
  {
    const bf16x8* qp = (const bf16x8*)(p.Q + (bh * SEQ + q0 + l31) * 96 + 8 * lh);
#pragma unroll
    for (int ks = 0; ks < 6; ++ks) qf[ks] = qp[2 * ks];
  }
  __syncthreads();
  {
    u16* Kl = (u16*)smem; u16* Vl = (u16*)(smem + 13312);
    *(u32x4*)(Kl + skey * 104 + schn * 8) = rk;
    if (tid < 256) *(u32x4*)(Kl + rkey * 104 + 64 + rchn * 8) = rr;
    *(u32x4*)(Vl + skey * 72 + schn * 8) = rv;
  }
  __syncthreads();
  f32x16 o0 = zero16(), o1 = zero16();
  float m_run = -1e30f, l_run = 0.f;
  for (int kt = 0; kt < nkt; ++kt) {
    const u16* Kl = (const u16*)(smem + (kt & 1) * 22528);
    const u16* Vl = (const u16*)(smem + (kt & 1) * 22528 + 13312);
    const bool more = (kt + 1) < nkt;
    if (more) {
      rk = *(const u32x4*)(kn_src + (size_t)(kt + 1) * 64 * 64);
      rv = *(const u32x4*)(vt_src + (kt + 1) * 64);
      if (tid < 256) rr = *(const u32x4*)(kr_src + (size_t)(kt + 1) * 64 * 32);
    }
    if (kt * 64 <= q0 + 31) {
      f32x16 s[2];
      bf16x8 kfr[2][6];
#pragma unroll
      for (int st = 0; st < 2; ++st) {
        const bf16x8* kp = (const bf16x8*)(Kl + (st * 32 + l31) * 104 + 8 * lh);
#pragma unroll
        for (int ks = 0; ks < 6; ++ks) kfr[st][ks] = kp[2 * ks];
      }
#pragma unroll
      for (int st = 0; st < 2; ++st) {
        s[st] = zero16();
#pragma unroll
        for (int ks = 0; ks < 6; ++ks) s[st] = MFMA32(kfr[st][ks], qf[ks], s[st]);
      }
      u32x2 vfr[2][4][2];
#pragma unroll
      for (int dt = 0; dt < 2; ++dt)
#pragma unroll
        for (int c4 = 0; c4 < 4; ++c4) {
          const int kbase = c4 * 16 + 4 * lh;
          vfr[dt][c4][0] = *(const u32x2*)(Vl + (dt * 32 + l31) * 72 + kbase);
          vfr[dt][c4][1] = *(const u32x2*)(Vl + (dt * 32 + l31) * 72 + kbase + 8);
        }
      if (kt * 64 + 63 > q0) {
#pragma unroll
        for (int st = 0; st < 2; ++st)
#pragma unroll
          for (int r = 0; r < 16; ++r) { const int key = kt * 64 + st * 32 + crow(r, lh); if (key > qidx) s[st][r] = -1e30f; }
      }
      float mloc = s[0][0];
#pragma unroll
      for (int st = 0; st < 2; ++st)
#pragma unroll
        for (int r = 0; r < 16; ++r) mloc = fmaxf(mloc, s[st][r]);
      mloc = max_xor32(mloc);
      const float m_new = fmaxf(m_run, mloc);
      const float alpha = __builtin_amdgcn_exp2f(m_run - m_new);
      m_run = m_new;
      float lsum = 0.f;
#pragma unroll
      for (int st = 0; st < 2; ++st)
#pragma unroll
        for (int r = 0; r < 16; ++r) { const float e = __builtin_amdgcn_exp2f(s[st][r] - m_new); s[st][r] = e; lsum += e; }
      l_run = l_run * alpha + lsum;
#pragma unroll
      for (int r = 0; r < 16; ++r) { o0[r] *= alpha; o1[r] *= alpha; }
#pragma unroll
      for (int st = 0; st < 2; ++st)
#pragma unroll
        for (int s2 = 0; s2 < 2; ++s2) {
          u32x4 pw;
#pragma unroll
          for (int j = 0; j < 4; ++j) pw[j] = pk2(s[st][8 * s2 + 2 * j], s[st][8 * s2 + 2 * j + 1]);
          const bf16x8 pf = __builtin_bit_cast(bf16x8, pw);
          const int c4 = st * 2 + s2;
          {
            u32x4 vv; vv[0] = vfr[0][c4][0][0]; vv[1] = vfr[0][c4][0][1]; vv[2] = vfr[0][c4][1][0]; vv[3] = vfr[0][c4][1][1];
            o0 = MFMA32(__builtin_bit_cast(bf16x8, vv), pf, o0);
          }
          {
            u32x4 vv; vv[0] = vfr[1][c4][0][0]; vv[1] = vfr[1][c4][0][1]; vv[2] = vfr[1][c4][1][0]; vv[3] = vfr[1][c4][1][1];
            o1 = MFMA32(__builtin_bit_cast(bf16x8, vv), pf, o1);
          }
        }
    }
    if (more) {
      u16* Kn2 = (u16*)(smem + ((kt + 1) & 1) * 22528); u16* Vn2 = (u16*)(smem + ((kt + 1) & 1) * 22528 + 13312);
      *(u32x4*)(Kn2 + skey * 104 + schn * 8) = rk;
      if (tid < 256) *(u32x4*)(Kn2 + rkey * 104 + 64 + rchn * 8) = rr;
      *(u32x4*)(Vn2 + skey * 72 + schn * 8) = rv;
    }
    __syncthreads();
  }
  const float ltot = sum_xor32(l_run);
  const float inv = 1.f / ltot;
  float ss = 0.f;
  u16* yrow = p.y + ((size_t)b * SEQ + qidx) * 1024 + 512 + hd * 64;
#pragma unroll
  for (int g = 0; g < 4; ++g) {
    float v0[4], v1[4];
#pragma unroll
    for (int q = 0; q < 4; ++q) { v0[q] = o0[4 * g + q] * inv; v1[q] = o1[4 * g + q] * inv; ss += v0[q] * v0[q] + v1[q] * v1[q]; }
    u32x2 a; a[0] = pk2(v0[0], v0[1]); a[1] = pk2(v0[2], v0[3]);
    u32x2 c2; c2[0] = pk2(v1[0], v1[1]); c2[1] = pk2(v1[2], v1[3]);
    *(u32x2*)(yrow + 8 * g + 4 * lh) = a;
    *(u32x2*)(yrow + 32 + 8 * g + 4 * lh) = c2;
  }
  ss = sum_xor32(ss);
  if (lh == 0) unsafeAtomicAdd(p.ssq_mla + (size_t)b * SEQ + qidx, ss);
}

DI void phase2(KP p, char* smem) {
  for (int item = blockIdx.x; item < 256; item += gridDim.x) lru_item(p, smem, item);
  for (int it = blockIdx.x; it < 1024; it += gridDim.x) {
    const int j = it & 3; const int bh = it >> 2; const int hd = bh & 7; const int b = bh >> 3;
    attn_unit(p, smem, b, hd, 7 - j);
    attn_unit(p, smem, b, hd, j);
  }
}

DI void sort128_asc(unsigned& k0, unsigned& k1, int lane) {
#pragma unroll
  for (int k = 2; k <= 128; k <<= 1) {
#pragma unroll
    for (int j = k >> 1; j > 0; j >>= 1) {
      if (j == 64) {
        const unsigned lo = k0 < k1 ? k0 : k1, hi = k0 < k1 ? k1 : k0; k0 = lo; k1 = hi;
      } else {
        const unsigned o0 = (j == 1) ? lane_xor_u<1>(k0, lane) : (j == 2) ? lane_xor_u<2>(k0, lane) : (j == 4) ? lane_xor_u<4>(k0, lane) : (j == 8) ? lane_xor_u<8>(k0, lane) : (j == 16) ? lane_xor_u<16>(k0, lane) : lane_xor_u<32>(k0, lane);
        const unsigned o1 = (j == 1) ? lane_xor_u<1>(k1, lane) : (j == 2) ? lane_xor_u<2>(k1, lane) : (j == 4) ? lane_xor_u<4>(k1, lane) : (j == 8) ? lane_xor_u<8>(k1, lane) : (j == 16) ? lane_xor_u<16>(k1, lane) : lane_xor_u<32>(k1, lane);
        const bool lower = (lane & j) == 0;
        const bool asc0 = (k == 128) ? true : ((lane & k) == 0);
        const bool asc1 = (k == 128) ? true : (k == 64 ? false : ((lane & k) == 0));
        const unsigned mn0 = k0 < o0 ? k0 : o0, mx0 = k0 < o0 ? o0 : k0;
        const unsigned mn1 = k1 < o1 ? k1 : o1, mx1 = k1 < o1 ? o1 : k1;
        k0 = (asc0 == lower) ? mn0 : mx0;
        k1 = (asc1 == lower) ? mn1 : mx1;
      }
    }
  }
}
#if QBITS == 8
typedef u32x4 qrow_t;
#else
typedef u32x2 qrow_t;
#endif
constexpr int QROWB = (QBITS == 8) ? 1024 : 512;
DI void ga_load(__amdgpu_buffer_rsrc_t rs, int iv, int gl, int voff_u, int voff_v, qrow_t (&uq)[8], qrow_t (&vq)[8]) {
#pragma unroll
  for (int k = 0; k < 8; ++k) {
    const int so = __builtin_amdgcn_readlane(iv, gl + k);
#if QBITS == 8
    uq[k] = __builtin_amdgcn_raw_buffer_load_b128(rs, voff_u, so, 0);
    vq[k] = __builtin_amdgcn_raw_buffer_load_b128(rs, voff_v, so, 0);
#else
    const u32x4 rec = __builtin_amdgcn_raw_buffer_load_b128(rs, voff_u, so, 16);
    uq[k] = (u32x2){rec[0], rec[1]}; vq[k] = (u32x2){rec[2], rec[3]};
#endif
  }
}
DI unsigned qword(const qrow_t& r, int j) {
#if QBITS == 8
  return r[j];
#else
  const unsigned w0 = r[j >> 1];
  return (j & 1) ? ((w0 >> 4) & 0x0f0f0f0fu) : (w0 & 0x0f0f0f0fu);
#endif
}
#if QBITS == 8
typedef f32x2 oacc_t;
constexpr float OACC_SCALE = 1.f;
#else
typedef h16x2 oacc_t;
constexpr float OACC_SCALE = 16.f;
#endif
DI void ga_compute(float gsel, float asel, float bsel, int gl, int lane, float kt, float hscale, const unsigned (&hq)[4],
                   const qrow_t (&uq)[8], const qrow_t (&vq)[8], oacc_t (&oacc)[8], float& csum) {
  const float mg = __shfl(gsel, gl + (lane >> 3));
  const float ma = __shfl(asel, gl + (lane >> 3));
  const float mb = __shfl(bsel, gl + (lane >> 3));
  float pp[8];
#pragma unroll
  for (int k = 0; k < 8; ++k) {
#if QBITS == 8
    unsigned d = 0;
#pragma unroll
    for (int j = 0; j < 4; ++j) d = __builtin_amdgcn_udot4(qword(uq[k], j), hq[j], d, false);
#else
    unsigned dh = __builtin_amdgcn_udot8(uq[k][0], hq[0], 0u, false); dh = __builtin_amdgcn_udot8(uq[k][1], hq[1], dh, false);
    unsigned dl = __builtin_amdgcn_udot8(uq[k][0], hq[2], 0u, false); dl = __builtin_amdgcn_udot8(uq[k][1], hq[3], dl, false);
    const unsigned d = dh * 16u + dl;
#endif
    pp[k] = (float)d;
  }
  const float s1 = reduce8(pp, lane);
  const float pre = hscale * (ma * (s1 - kt) - mb);
  const float cf = mg * gelu_tanh(pre);
  csum += cf;
#if QBITS != 8
  const _Float16 cfs = (_Float16)(cf * OACC_SCALE);
  const unsigned cfp = __builtin_bit_cast(unsigned, (h16x2){cfs, cfs});
#endif
#pragma unroll
  for (int k = 0; k < 8; ++k) {
#if QBITS == 8
    const float c = __uint_as_float(__builtin_amdgcn_readlane(__float_as_uint(cf), 8 * k));
    const f32x2 cc = {c, c};
#pragma unroll
    for (int j = 0; j < 4; ++j) {
      unsigned w = qword(vq[k], j);
      asm volatile("" : "+v"(w));
      const f32x2 v0 = {(float)(w & 255u), (float)((w >> 8) & 255u)}, v1 = {(float)((w >> 16) & 255u), (float)(w >> 24)};
      oacc[2 * j] = v0 * cc + oacc[2 * j];
      oacc[2 * j + 1] = v1 * cc + oacc[2 * j + 1];
    }
#else
    const h16x2 cc = __builtin_bit_cast(h16x2, (unsigned)__builtin_amdgcn_readlane((int)cfp, 8 * k));
#pragma unroll
    for (int jd = 0; jd < 2; ++jd) {
      const unsigned w = vq[k][jd];
      oacc[4 * jd + 0] = __builtin_amdgcn_cvt_scalef32_pk_f16_fp4(w, 1.0f, 0) * cc + oacc[4 * jd + 0];
      oacc[4 * jd + 1] = __builtin_amdgcn_cvt_scalef32_pk_f16_fp4(w, 1.0f, 1) * cc + oacc[4 * jd + 1];
      oacc[4 * jd + 2] = __builtin_amdgcn_cvt_scalef32_pk_f16_fp4(w, 1.0f, 2) * cc + oacc[4 * jd + 2];
      oacc[4 * jd + 3] = __builtin_amdgcn_cvt_scalef32_pk_f16_fp4(w, 1.0f, 3) * cc + oacc[4 * jd + 3];
    }
#endif
  }
}

DI void ins16(float (&lst)[16], float x) {
#pragma unroll
  for (int i = 0; i < 16; ++i) { const float hi = fmaxf(lst[i], x); x = fminf(lst[i], x); lst[i] = hi; }
}
DI void ce_desc(float& a, float& b) { const float hi = fmaxf(a, b), lo = fminf(a, b); a = hi; b = lo; }
DI void sort16_desc(float (&a)[16]) {
#pragma unroll
  for (int k = 2; k <= 16; k <<= 1)
#pragma unroll
    for (int j = k >> 1; j > 0; j >>= 1)
#pragma unroll
      for (int i = 0; i < 16; ++i) {
        const int l = i ^ j;
        if (l > i) {
          if ((i & k) == 0) ce_desc(a[i], a[l]); else ce_desc(a[l], a[i]);
        }
      }
}
DI void merge16_desc(float (&x)[16], const float (&y)[16]) {
#pragma unroll
  for (int i = 0; i < 16; ++i) x[i] = fmaxf(x[i], y[15 - i]);
#pragma unroll
  for (int d = 8; d >= 1; d >>= 1)
#pragma unroll
    for (int i = 0; i < 16; ++i)
      if ((i & d) == 0) ce_desc(x[i], x[i + d]);
}
DI void merge_partner(float (&lst)[16], int lane) {
  float o[16];
#pragma unroll
  for (int i = 0; i < 16; ++i) o[i] = other_xor32(lst[i], lane);
  float c[16];
#pragma unroll
  for (int i = 0; i < 16; ++i) c[i] = fmaxf(lst[i], o[15 - i]);
#pragma unroll
  for (int d = 8; d >= 1; d >>= 1) {
#pragma unroll
    for (int i = 0; i < 16; ++i) {
      if ((i & d) == 0) { const float hi = fmaxf(c[i], c[i + d]), lo = fminf(c[i], c[i + d]); c[i] = hi; c[i + d] = lo; }
    }
  }
#pragma unroll
  for (int i = 0; i < 16; ++i) lst[i] = c[i];
}

DI void phase3(KP p, char* smem) {
  const int tid = threadIdx.x, wave = __builtin_amdgcn_readfirstlane(tid >> 6);
  u16* A = (u16*)smem;
  float* ssq2 = (float*)(smem + 132096);
  char* scr = p.scratch + (size_t)blockIdx.x * 655360;
  float* x1s = (float*)scr;
  u16* qp = (u16*)(scr + 262144);
  int* eidx = (int*)(scr + 524288);
  float* egate = (float*)(scr + 524288 + 32768);
  float* eus = (float*)(scr + 524288 + 65536);
  float* eub = (float*)(scr + 524288 + 98304);
  for (int tile = blockIdx.x; tile < NTOK / 64; tile += gridDim.x) {
    int lane_o = tid & 63; asm volatile("" : "+v"(lane_o));
    const int lane = lane_o, l31 = lane & 31, lh = lane >> 5;
    const int tok0 = tile * 64; const int b = tok0 / SEQ;
    const float* modb = p.mod + (size_t)b * 6144;
    if (tid < 64) ssq2[tid] = 0.f;
#pragma unroll 2
    for (int rr = 0; rr < 8; ++rr) {
      const int row = wave * 8 + rr; const int tok = tok0 + row;
      const float rl = rsqrtf(p.ssq_lru[tok] * (1.f / 512.f) + EPS), rm = rsqrtf(p.ssq_mla[tok] * (1.f / 512.f) + EPS);
#pragma unroll
      for (int i = 0; i < 2; ++i) {
        const u32x4 v = *(const u32x4*)(p.y + (size_t)tok * 1024 + (i * 64 + lane) * 8);
        const float sc = i == 0 ? rl : rm;
        u32x4 o;
#pragma unroll
        for (int j = 0; j < 4; ++j) o[j] = pk2(bflo(v[j]) * sc, bfhi(v[j]) * sc);
        *(u32x4*)(A + row * LDA + (i * 64 + lane) * 8) = o;
      }
    }
    __syncthreads();
    float sqa[32];
#pragma unroll
    for (int i = 0; i < 32; ++i) sqa[i] = 0.f;
    bf16x8 ring3[8][2];
    { const int tl0[2] = {wave, wave + 8}; gemm_pro<2, 8>(p.Wf_out, 64, tl0, lane, ring3); }
#pragma unroll 1
    for (int pass = 0; pass < 2; ++pass) {
      f32x16 acc[2][2];
#pragma unroll
      for (int t = 0; t < 2; ++t) { acc[t][0] = zero16(); acc[t][1] = zero16(); }
      const int tl[2] = {pass * 16 + wave, pass * 16 + wave + 8};
      gemm_main<2, 8, false, true>(A, LDA, 64, p.Wf_out, 64, tl, acc, lane, ring3);
      if (pass == 0) { const int tn[2] = {16 + wave, 16 + wave + 8}; gemm_pro<2, 8>(p.Wf_out, 64, tn, lane, ring3); }
      int el_ = lane; asm volatile("" : "+v"(el_));
      const int l31 = el_ & 31, lh = el_ >> 5;
      float g1[2];
#pragma unroll
      for (int t = 0; t < 2; ++t) g1[t] = modb[2048 + tl[t] * 32 + l31];
#pragma unroll
      for (int rt = 0; rt < 2; ++rt)
#pragma unroll
        for (int r = 0; r < 16; ++r) {
          const int row = rt * 32 + crow(r, lh);
#pragma unroll
          for (int t = 0; t < 2; ++t) {
            const int col = tl[t] * 32 + l31;
            const float v = p.x[(size_t)(tok0 + row) * DM + col] + g1[t] * acc[t][rt][r];
            x1s[row * 1024 + col] = v;
            sqa[rt * 16 + r] += v * v;
          }
        }
    }
    {
      const float tot = reduce32(sqa, lane);
      const int l31 = lane & 31, lh = lane >> 5;
      __hip_atomic_fetch_add(&ssq2[(l31 >> 4) * 32 + crow(l31 & 15, lh)], tot, __ATOMIC_RELAXED, __HIP_MEMORY_SCOPE_WORKGROUP);
    }
    __syncthreads();
    {
      f32x4 cm[4], ca[4];
#pragma unroll
      for (int i = 0; i < 4; ++i) {
        const int col = (i >> 1) * 512 + lane * 8 + (i & 1) * 4;
        const f32x4 g = *(const f32x4*)(p.norm2_g + col); const f32x4 sc = *(const f32x4*)(modb + 4096 + col);
        cm[i] = g * (sc + 1.0f); ca[i] = *(const f32x4*)(modb + 3072 + col);
      }
#pragma unroll 2
      for (int rr = 0; rr < 8; ++rr) {
        const int row = wave * 8 + rr;
        const float rs = rsqrtf(ssq2[row] * (1.f / 1024.f) + EPS);
#pragma unroll
        for (int i = 0; i < 2; ++i) {
          const f32x4 xa = *(const f32x4*)(x1s + row * 1024 + i * 512 + lane * 8), xb = *(const f32x4*)(x1s + row * 1024 + i * 512 + lane * 8 + 4);
          const f32x4 ha = xa * rs * cm[2 * i] + ca[2 * i], hb = xb * rs * cm[2 * i + 1] + ca[2 * i + 1];
          u32x4 o; o[0] = pk2(ha[0], ha[1]); o[1] = pk2(ha[2], ha[3]); o[2] = pk2(hb[0], hb[1]); o[3] = pk2(hb[2], hb[3]);
          *(u32x4*)(A + row * LDA + i * 512 + lane * 8) = o;
        }
      }
    }
    __syncthreads();
    float s12[2][16];
#pragma unroll 1
    for (int ph = 0; ph < 2; ++ph) {
      const int hd = wave;
      float lst0[16], lst1[16];
#pragma unroll
      for (int i = 0; i < 16; ++i) { lst0[i] = -3.0e38f; lst1[i] = -3.0e38f; }
#pragma unroll 1
      for (int mtp = 0; mtp < 2; ++mtp) {
        f32x16 acc[2][2];
#pragma unroll
        for (int t = 0; t < 2; ++t) { acc[t][0] = zero16(); acc[t][1] = zero16(); }
        const int tl[2] = {(hd * 2 + ph) * 4 + 2 * mtp, (hd * 2 + ph) * 4 + 2 * mtp + 1};
        gemm_core<2, 8, true>(A, LDA, 64, p.Wf_s, 64, tl, acc, lane);
        int el_ = lane; asm volatile("" : "+v"(el_));
        const int lh = el_ >> 5;
#pragma unroll
        for (int t = 0; t < 2; ++t) {
          float nv[16];
#pragma unroll
          for (int r = 0; r < 16; ++r) nv[r] = __uint_as_float((__float_as_uint(acc[t][0][r]) & 0xffffff80u) | (unsigned)((2 * mtp + t) * 32 + crow(r, lh)));
          sort16_desc(nv);
          merge16_desc(lst0, nv);
#pragma unroll
          for (int r = 0; r < 16; ++r) nv[r] = __uint_as_float((__float_as_uint(acc[t][1][r]) & 0xffffff80u) | (unsigned)((2 * mtp + t) * 32 + crow(r, lh)));
          sort16_desc(nv);
          merge16_desc(lst1, nv);
        }
      }
      merge_partner(lst0, lane);
      merge_partner(lst1, lane);
      if (ph == 0) {
#pragma unroll
        for (int i = 0; i < 16; ++i) s12[0][i] = lh ? lst1[i] : lst0[i];
      } else {
#pragma unroll
        for (int i = 0; i < 16; ++i) s12[1][i] = lh ? lst1[i] : lst0[i];
      }
    }
    {
      const int hd = wave;
      unsigned long long t1lo = 0, t1hi = 0, t2lo = 0, t2hi = 0;
#pragma unroll
      for (int i = 0; i < 8; ++i) {
        t1lo |= (unsigned long long)(__float_as_uint(s12[0][i]) & 127u) << (8 * i);
        t1hi |= (unsigned long long)(__float_as_uint(s12[0][8 + i]) & 127u) << (8 * i);
        t2lo |= (unsigned long long)(__float_as_uint(s12[1][i]) & 127u) << (8 * i);
        t2hi |= (unsigned long long)(__float_as_uint(s12[1][8 + i]) & 127u) << (8 * i);
      }
      float bv[16];
#pragma unroll
      for (int j = 0; j < 16; ++j) {
        const float sv = s12[0][0] + s12[1][j];
        bv[j] = __uint_as_float((__float_as_uint(sv) & 0xffffff00u) | (unsigned)j);
      }
#pragma unroll
      for (int i = 1; i < 16; ++i) {
#pragma unroll
        for (int j = 0; j < 16; ++j)
          if ((i + 1) * (j + 1) <= 16) {
            const float sv = s12[0][i] + s12[1][j];
            ins16(bv, __uint_as_float((__float_as_uint(sv) & 0xffffff00u) | (unsigned)(i * 16 + j)));
          }
      }
      int bi[16];
#pragma unroll
      for (int k = 0; k < 16; ++k) {
        const unsigned code = __float_as_uint(bv[k]) & 255u;
        const unsigned ci = code >> 4, cj = code & 15u;
        const unsigned long long w1 = (ci & 8u) ? t1hi : t1lo, w2 = (cj & 8u) ? t2hi : t2lo;
        const unsigned i1 = (unsigned)(w1 >> ((ci & 7u) * 8)) & 0xffu, i2 = (unsigned)(w2 >> ((cj & 7u) * 8)) & 0xffu;
        bi[k] = (int)(i1 * 128u + i2);
      }
      float esum = 0.f, ev[16];
#pragma unroll
      for (int i = 0; i < 16; ++i) { ev[i] = __expf(bv[i] - bv[0]); esum += ev[i]; }
      const float einv = 1.f / esum;
      {
        const int row = lh * 32 + l31;
#pragma unroll
        for (int i4 = 0; i4 < 4; ++i4) {
          f32x4 sc[4];
#pragma unroll
          for (int q = 0; q < 4; ++q) sc[q] = ((const f32x4*)p.uscale)[bi[i4 * 4 + q]];
          typedef int i32x4 __attribute__((ext_vector_type(4)));
          *(i32x4*)(eidx + row * 128 + hd * 16 + i4 * 4) = (i32x4){bi[i4 * 4], bi[i4 * 4 + 1], bi[i4 * 4 + 2], bi[i4 * 4 + 3]};
          *(f32x4*)(egate + row * 128 + hd * 16 + i4 * 4) = (f32x4){ev[i4 * 4] * einv * sc[0][1], ev[i4 * 4 + 1] * einv * sc[1][1], ev[i4 * 4 + 2] * einv * sc[2][1], ev[i4 * 4 + 3] * einv * sc[3][1]};
          *(f32x4*)(eus + row * 128 + hd * 16 + i4 * 4) = (f32x4){sc[0][0], sc[1][0], sc[2][0], sc[3][0]};
          *(f32x4*)(eub + row * 128 + hd * 16 + i4 * 4) = (f32x4){sc[0][2], sc[1][2], sc[2][2], sc[3][2]};
        }
      }
    }
    __syncthreads();
    const __amdgpu_buffer_rsrc_t qrs = __builtin_amdgcn_make_buffer_rsrc((void*)p.Uq, 0, 2 * 16384 * QROWB, 0x00020000);
    const int voff_u = (QBITS == 8) ? lane * 16 : lane * 16, voff_v = voff_u + 16384 * QROWB;
    int n_ia, n_ib; float n_ga, n_gb, n_ua, n_ub, n_ba, n_bb, n_kt, n_hscale; unsigned n_hq[4];
    qrow_t bufA_u[8], bufA_v[8], bufB_u[8], bufB_v[8];
#define GA_PREP(ROW)                                                                                                              \
    {                                                                                                                             \
      const int prow = (ROW);                                                                                                     \
      n_ia = eidx[prow * 128 + lane]; n_ib = eidx[prow * 128 + 64 + lane];                                                        \
      n_ga = egate[prow * 128 + lane]; n_gb = egate[prow * 128 + 64 + lane];                                                      \
      n_ua = eus[prow * 128 + lane]; n_ub = eus[prow * 128 + 64 + lane];                                                          \
      n_ba = eub[prow * 128 + lane]; n_bb = eub[prow * 128 + 64 + lane];                                                          \
      {     \
        unsigned k0 = ((unsigned)n_ia << 7) | (unsigned)lane, k1 = ((unsigned)n_ib << 7) | (unsigned)(64 + lane);                 \
        sort128_asc(k0, k1, lane);                                                                                                \
        const int p0 = (int)(k0 & 127u), p1 = (int)(k1 & 127u);                                                                   \
        const float ga0 = __shfl(n_ga, p0 & 63), gb0 = __shfl(n_gb, p0 & 63), ga1 = __shfl(n_ga, p1 & 63), gb1 = __shfl(n_gb, p1 & 63); \
        const float ua0 = __shfl(n_ua, p0 & 63), ub0 = __shfl(n_ub, p0 & 63), ua1 = __shfl(n_ua, p1 & 63), ub1 = __shfl(n_ub, p1 & 63); \
        const float ba0 = __shfl(n_ba, p0 & 63), bb0 = __shfl(n_bb, p0 & 63), ba1 = __shfl(n_ba, p1 & 63), bb1 = __shfl(n_bb, p1 & 63); \
        n_ia = (int)(k0 >> 7) * (QBITS == 8 ? QROWB : 2 * QROWB); n_ib = (int)(k1 >> 7) * (QBITS == 8 ? QROWB : 2 * QROWB);       \
        n_ga = (p0 & 64) ? gb0 : ga0; n_gb = (p1 & 64) ? gb1 : ga1;                                                               \
        n_ua = (p0 & 64) ? ub0 : ua0; n_ub = (p1 & 64) ? ub1 : ua1;                                                               \
        n_ba = (p0 & 64) ? bb0 : ba0; n_bb = (p1 & 64) ? bb1 : ba1;                                                               \
      }                                                                                                                           \
      float hf[16];                                                                                                               \
      const u32x4 h0 = *(const u32x4*)(A + prow * LDA + lane * 16), h1 = *(const u32x4*)(A + prow * LDA + lane * 16 + 8);         \
      _Pragma("unroll") for (int j = 0; j < 4; ++j) { hf[2 * j] = bflo(h0[j]); hf[2 * j + 1] = bfhi(h0[j]); hf[8 + 2 * j] = bflo(h1[j]); hf[8 + 2 * j + 1] = bfhi(h1[j]); } \
      float hmax = 0.f;                                                                                                           \
      _Pragma("unroll") for (int j = 0; j < 16; ++j) hmax = fmaxf(hmax, fabsf(hf[j]));                                            \
      hmax = wave_max(hmax);                                                                                                      \
      n_hscale = hmax * (1.f / 127.f); const float hinv = hmax > 0.f ? 127.f / hmax : 0.f;                                        \
      float hsum = 0.f;                                                                                                           \
      if (QBITS == 8) {                                                                                                           \
        _Pragma("unroll") for (int j = 0; j < 4; ++j) {                                                                           \
          unsigned w = 0;                                                                                                         \
          _Pragma("unroll") for (int e = 0; e < 4; ++e) { const int q = (int)__builtin_rintf(hf[4 * j + e] * hinv) + 128; w |= (unsigned)q << (8 * e); hsum += (float)q; } \
          n_hq[j] = w;                                                                                                            \
        }                                                                                                                         \
      } else {                                                                                                                    \
        _Pragma("unroll") for (int jd = 0; jd < 2; ++jd) {                                                                        \
          unsigned whi = 0, wlo = 0;                                                                                              \
          _Pragma("unroll") for (int e = 0; e < 8; ++e) {                                                                         \
            const unsigned q = (unsigned)((int)__builtin_rintf(hf[8 * jd + e] * hinv) + 128); hsum += (float)q;                   \
            const int sh = 8 * (e & 3) + 4 * (e >> 2);                                                                            \
            whi |= (q >> 4) << sh; wlo |= (q & 15u) << sh;                                                                        \
          }                                                                                                                       \
          n_hq[jd] = whi; n_hq[2 + jd] = wlo;                                                                                     \
        }                                                                                                                         \
      }                                                                                                                           \
      n_kt = (QBITS == 8 ? 128.f : 7.5f) * (wave_sum(hsum) - 131072.f);                                                           \
    }
    GA_PREP(wave)
    ga_load(qrs, n_ia, 0, voff_u, voff_v, bufA_u, bufA_v);
#pragma unroll 1
    for (int rr = 0; rr < 8; ++rr) {
      const int row = rr * 8 + wave; const int tok = tok0 + row;
      const int ia = n_ia, ib = n_ib; const float ga = n_ga, gb = n_gb, ua = n_ua, ub = n_ub, ba = n_ba, bb = n_bb, kt = n_kt, hscale = n_hscale;
      unsigned hq[4];
#pragma unroll
      for (int j = 0; j < 4; ++j) hq[j] = n_hq[j];
      f32x4 xv4[4];
#pragma unroll
      for (int q = 0; q < 4; ++q) xv4[q] = *(const f32x4*)(x1s + row * 1024 + lane * 16 + q * 4);
      if (rr + 1 < 8) GA_PREP(row + 8)
      oacc_t oacc[8];
#pragma unroll
      for (int j = 0; j < 8; ++j) { oacc[j][0] = 0; oacc[j][1] = 0; }
      float csum = 0.f;
#pragma unroll 1
      for (int half = 0; half < 2; ++half) {
        const int iv = half ? ib : ia, ivn = half ? n_ia : ib;
        const float gs = half ? gb : ga, us = half ? ub : ua, bs = half ? bb : ba;
        const bool has_next = (half == 0) || (rr + 1 < 8);
#pragma unroll 1
        for (int g8 = 0; g8 < 8; g8 += 2) {
          ga_load(qrs, iv, (g8 + 1) * 8, voff_u, voff_v, bufB_u, bufB_v);
          ga_compute(gs, us, bs, g8 * 8, lane, kt, hscale, hq, bufA_u, bufA_v, oacc, csum);
          if (g8 + 2 < 8) ga_load(qrs, iv, (g8 + 2) * 8, voff_u, voff_v, bufA_u, bufA_v);
          else if (has_next) ga_load(qrs, ivn, 0, voff_u, voff_v, bufA_u, bufA_v);
          ga_compute(gs, us, bs, (g8 + 1) * 8, lane, kt, hscale, hq, bufB_u, bufB_v, oacc, csum);
        }
      }
      {
#if QBITS == 8
        const float corr = wave_sum(csum) * (128.f / 8.f);
#pragma unroll
        for (int j = 0; j < 8; ++j) oacc[j] = oacc[j] - corr;
#endif
      }
      float xo[16]; float ss = 0.f;
#pragma unroll
      for (int q = 0; q < 4; ++q) {
        const int col = lane * 16 + q * 4;
        const f32x4 xv = xv4[q];
        const f32x4 g2 = *(const f32x4*)(modb + 5120 + col);
#pragma unroll
        for (int j = 0; j < 4; ++j) { const float v = xv[j] + g2[j] * ((float)oacc[q * 2 + (j >> 1)][j & 1] * (1.f / OACC_SCALE)); xo[q * 4 + j] = v; ss += v * v; }
      }
      ss = wave_sum(ss);
      const float rs = rsqrtf(ss * (1.f / 1024.f) + EPS);
#pragma unroll
      for (int q = 0; q < 4; ++q) {
        const int col = lane * 16 + q * 4;
        const f32x4 fg = *(const f32x4*)(p.final_g + col);
        f32x4 o;
#pragma unroll
        for (int j = 0; j < 4; ++j) o[j] = xo[q * 4 + j] * rs * fg[j];
        *(f32x4*)(p.out + (size_t)tok * DM + col) = o;
      }
    }
#undef GA_PREP
    __syncthreads();
  }
}

template <int MODE>
__global__ void __launch_bounds__(NTHREADS) mk_fwd(Params p) {
  extern __shared__ __attribute__((aligned(16))) char smem[];
  if (MODE < 0) {
    cg::grid_group grid = cg::this_grid();
    if (__builtin_amdgcn_readfirstlane(threadIdx.x) >= 256) __builtin_amdgcn_s_setprio(1);
    typedef const __attribute__((address_space(4))) Params* KPP;
    { KPP kp = (KPP)__builtin_amdgcn_kernarg_segment_ptr(); asm volatile("" : "+s"(kp)); phase0(*kp, smem); }
    grid.sync();
    { KPP kp = (KPP)__builtin_amdgcn_kernarg_segment_ptr(); asm volatile("" : "+s"(kp)); phase1(*kp, smem); }
    grid.sync();
    { KPP kp = (KPP)__builtin_amdgcn_kernarg_segment_ptr(); asm volatile("" : "+s"(kp)); phase2(*kp, smem); }
    grid.sync();
    { KPP kp = (KPP)__builtin_amdgcn_kernarg_segment_ptr(); asm volatile("" : "+s"(kp)); phase3(*kp, smem); }
#ifdef PROBE_P3X2
    grid.sync();
    phase3(p, smem);
#endif
#ifdef PROBE_P1X2
    grid.sync();
    phase1(p, smem);
#endif
  } else {
    typedef const __attribute__((address_space(4))) Params* KPP;
    KPP kp = (KPP)__builtin_amdgcn_kernarg_segment_ptr();
    if (MODE == 0) phase0(*kp, smem);
    if (MODE == 1) phase1(*kp, smem);
    if (MODE == 2) phase2(*kp, smem);
    if (MODE == 3) phase3(*kp, smem);
  }
}

static size_t align_up(size_t v) { return (v + 255) & ~(size_t)255; }

extern "C" void kernel_launch(void* const* d_in, const int* in_sizes, int n_in, void* d_out, int out_size, void* d_ws, size_t ws_size, hipStream_t stream) {
  static int grid = 0;
  if (grid == 0) {
    int dev = 0, cus = 0, per_cu = 0;
    (void)hipGetDevice(&dev);
    (void)hipDeviceGetAttribute(&cus, hipDeviceAttributeMultiprocessorCount, dev);
#if N_LAUNCH_MODE == 1
    (void)hipFuncSetAttribute((const void*)mk_fwd<-1>, hipFuncAttributeMaxDynamicSharedMemorySize, LDS_BYTES);
    (void)hipOccupancyMaxActiveBlocksPerMultiprocessor(&per_cu, (const void*)mk_fwd<-1>, NTHREADS, LDS_BYTES);
#else
    (void)hipFuncSetAttribute((const void*)mk_fwd<0>, hipFuncAttributeMaxDynamicSharedMemorySize, LDS_BYTES);
    (void)hipFuncSetAttribute((const void*)mk_fwd<1>, hipFuncAttributeMaxDynamicSharedMemorySize, LDS_BYTES);
    (void)hipFuncSetAttribute((const void*)mk_fwd<2>, hipFuncAttributeMaxDynamicSharedMemorySize, LDS_BYTES);
    (void)hipFuncSetAttribute((const void*)mk_fwd<3>, hipFuncAttributeMaxDynamicSharedMemorySize, LDS_BYTES);
    (void)hipOccupancyMaxActiveBlocksPerMultiprocessor(&per_cu, (const void*)mk_fwd<3>, NTHREADS, LDS_BYTES);
#endif
    if (per_cu < 1) { fprintf(stderr, "kernel_launch: occupancy query says %d blocks/CU\n", per_cu); per_cu = 1; }
    if (per_cu > 1) per_cu = 1;
    grid = cus * per_cu;
    if (grid > 256) grid = 256;
    (void)hipGetLastError();
  }
  Params p{};
  const float* const* fin = (const float* const*)d_in;
  p.x = fin[0]; p.c = fin[1]; p.pos = (const int*)d_in[2];
  p.w_ada = fin[3]; p.b_ada = fin[4]; p.norm1_g = fin[5]; p.w_in = fin[6]; p.conv_w = fin[7]; p.conv_b = fin[8];
  p.lru_wa = fin[9]; p.lru_ba = fin[10]; p.lru_wx = fin[11]; p.lru_bx = fin[12]; p.lru_lambda = fin[13];
  p.q_norm_g = fin[14]; p.w_uq = fin[15]; p.kv_norm_g = fin[16]; p.w_ukv = fin[17]; p.lru_out_g = fin[18]; p.mla_out_g = fin[19];
  p.w_out = fin[20]; p.norm2_g = fin[21]; p.peer_wq = fin[22]; p.peer_keys = fin[23]; p.peer_u = fin[24]; p.peer_v = fin[25]; p.final_g = fin[26];
  p.out = (float*)d_out;
  char* w = (char*)d_ws; size_t off = 0;
  auto take = [&](size_t bytes) { char* r = w + off; off = align_up(off + bytes); return r; };
  p.mod = (float*)take((size_t)NB * 6144 * 4);
  p.ssq_lru = (float*)take((size_t)NTOK * 4);
  p.ssq_mla = (float*)take((size_t)NTOK * 4);
  p.invfreq = (double*)take(16 * 8);
  p.Wf_in = (bf16x8*)take((size_t)INW * 1024 * 2);
  p.Wf_uq = (bf16x8*)take((size_t)768 * 256 * 2);
  p.Wf_ukv = (bf16x8*)take((size_t)1024 * 128 * 2);
  p.Wf_a = (bf16x8*)take((size_t)8 * 64 * 64 * 2);
  p.Wf_x = (bf16x8*)take((size_t)8 * 64 * 64 * 2);
  p.Wf_out = (bf16x8*)take((size_t)1024 * 1024 * 2);
  p.Wf_s = (bf16x8*)take((size_t)2048 * 1024 * 2);
  p.Uq = (unsigned char*)take((size_t)2 * 16384 * QROWB);
  p.Vq = p.Uq + (size_t)16384 * QROWB;
  p.uscale = (float*)take((size_t)16384 * 16);
  p.vscale = p.uscale; p.ubias = p.uscale;
  p.xlru = (u16*)take((size_t)NTOK * 512 * 2);
  p.gate = (u16*)take((size_t)NTOK * 512 * 2);
  p.Q = (u16*)take((size_t)NTOK * 768 * 2);
  p.Kn = (u16*)take((size_t)NTOK * 512 * 2);
  p.Kr = (u16*)take((size_t)NTOK * 32 * 2);
  p.Vt = (u16*)take((size_t)NTOK * 512 * 2);
  p.y = (u16*)take((size_t)NTOK * 1024 * 2);
  p.scratch = take((size_t)256 * 655360);
  if (off > ws_size) { fprintf(stderr, "kernel_launch: workspace too small: need %zu have %zu\n", off, ws_size); return; }
#if N_LAUNCH_MODE == 1
  void* args[] = {&p};
  hipError_t e = hipLaunchCooperativeKernel((const void*)mk_fwd<-1>, dim3(grid), dim3(NTHREADS), args, LDS_BYTES, stream);
  if (e != hipSuccess) fprintf(stderr, "cooperative launch failed: %s (grid %d)\n", hipGetErrorString(e), grid);
#else
  hipLaunchKernelGGL(mk_fwd<0>, dim3(grid), dim3(NTHREADS), LDS_BYTES, stream, p);
  hipLaunchKernelGGL(mk_fwd<1>, dim3(grid), dim3(NTHREADS), LDS_BYTES, stream, p);
  hipLaunchKernelGGL(mk_fwd<2>, dim3(grid), dim3(NTHREADS), LDS_BYTES, stream, p);
  hipLaunchKernelGGL(mk_fwd<3>, dim3(grid), dim3(NTHREADS), LDS_BYTES, stream, p);
#endif
}
```

```cpp
#include <hip/hip_runtime.h>
#include <hip/hip_cooperative_groups.h>
#include <cstdio>
#include <cstdint>
namespace cg = cooperative_groups;

#ifndef QBITS
#define QBITS 4
#endif
#ifndef N_LAUNCH_MODE
#define N_LAUNCH_MODE 1
#endif

typedef short bf16x8 __attribute__((ext_vector_type(8)));
typedef float f32x16 __attribute__((ext_vector_type(16)));
typedef float f32x4 __attribute__((ext_vector_type(4)));
typedef float f32x2 __attribute__((ext_vector_type(2)));
typedef unsigned u32x4 __attribute__((ext_vector_type(4)));
typedef unsigned u32x2 __attribute__((ext_vector_type(2)));
typedef __bf16 bf16x2_t __attribute__((ext_vector_type(2)));
typedef unsigned short u16;
typedef _Float16 h16x2 __attribute__((ext_vector_type(2)));

#define DI __device__ __forceinline__
#define MFMA32(a, b, c) __builtin_amdgcn_mfma_f32_32x32x16_bf16((a), (b), (c), 0, 0, 0)
typedef int i32x4 __attribute__((ext_vector_type(4)));
typedef int i32x16 __attribute__((ext_vector_type(16)));
#define MFMA8(a, b, c) __builtin_amdgcn_mfma_i32_32x32x32_i8((a), (b), (c), 0, 0, 0)

constexpr int NB = 32, SEQ = 2048, DM = 1024, NTOK = NB * SEQ;
constexpr int INW = 1440;
constexpr int NTHREADS = 512;
constexpr int LDA = 1032;
constexpr int LDA8 = 1040;
constexpr int LDS_BYTES = 147456;
constexpr float EPS = 1e-6f;

struct Params {
  const float* x; const float* c; const int* pos;
  const float* w_ada; const float* b_ada; const float* norm1_g; const float* w_in; const float* conv_w; const float* conv_b;
  const float* lru_wa; const float* lru_ba; const float* lru_wx; const float* lru_bx; const float* lru_lambda;
  const float* q_norm_g; const float* w_uq; const float* kv_norm_g; const float* w_ukv; const float* lru_out_g; const float* mla_out_g;
  const float* w_out; const float* norm2_g; const float* peer_wq; const float* peer_keys; const float* peer_u; const float* peer_v; const float* final_g;
  float* out;
  float* mod; float* ssq_lru; float* ssq_mla; double* invfreq;
  bf16x8* Wf_in; bf16x8* Wf_uq; bf16x8* Wf_ukv; bf16x8* Wf_a; bf16x8* Wf_x; bf16x8* Wf_out; i32x4* Wf_s;
  float* Wsf; float* wsmaxp; float* wsc;
  unsigned char* Uq; unsigned char* Vq; float* uscale; float* vscale; float* ubias; u16* xlru; u16* gate; u16* Q; u16* Kn; u16* Kr; u16* Vt; u16* y;
  char* scratch;
};

typedef const __attribute__((address_space(4))) Params& KP;

DI unsigned pk2(float a, float b) { f32x2 v = {a, b}; bf16x2_t r = __builtin_convertvector(v, bf16x2_t); return __builtin_bit_cast(unsigned, r); }
DI u16 f2bf(float a) { return (u16)(pk2(a, 0.f) & 0xffffu); }
DI float bflo(unsigned u) { return __uint_as_float(u << 16); }
DI float bfhi(unsigned u) { return __uint_as_float(u & 0xffff0000u); }
DI float bf2f(u16 h) { return __uint_as_float(((unsigned)h) << 16); }
template <int CTRL> DI float dppf(float v) { return __builtin_bit_cast(float, __builtin_amdgcn_update_dpp(0, __builtin_bit_cast(int, v), CTRL, 0xF, 0xF, true)); }
typedef unsigned u32x2_ __attribute__((ext_vector_type(2)));
DI float wave_sum(float v) {
  v += dppf<0xB1>(v); v += dppf<0x4E>(v); v += dppf<0x141>(v); v += dppf<0x140>(v);
  u32x2_ r = __builtin_amdgcn_permlane16_swap(__float_as_uint(v), __float_as_uint(v), false, false); v = __uint_as_float(r[0]) + __uint_as_float(r[1]);
  r = __builtin_amdgcn_permlane32_swap(__float_as_uint(v), __float_as_uint(v), false, false); v = __uint_as_float(r[0]) + __uint_as_float(r[1]);
  return v;
}
DI float wave_max(float v) {
  v = fmaxf(v, dppf<0xB1>(v)); v = fmaxf(v, dppf<0x4E>(v)); v = fmaxf(v, dppf<0x141>(v)); v = fmaxf(v, dppf<0x140>(v));
  u32x2_ r = __builtin_amdgcn_permlane16_swap(__float_as_uint(v), __float_as_uint(v), false, false); v = fmaxf(__uint_as_float(r[0]), __uint_as_float(r[1]));
  r = __builtin_amdgcn_permlane32_swap(__float_as_uint(v), __float_as_uint(v), false, false); v = fmaxf(__uint_as_float(r[0]), __uint_as_float(r[1]));
  return v;
}
template <int CTRL> DI unsigned dppu(unsigned v) { return (unsigned)__builtin_amdgcn_update_dpp(0, (int)v, CTRL, 0xF, 0xF, true); }
template <int J> DI unsigned lane_xor_u(unsigned v, int lane) {
  if (J == 1) return dppu<0xB1>(v);
  if (J == 2) return dppu<0x4E>(v);
  if (J == 4) return dppu<0x141>(dppu<0x1B>(v));
  if (J == 8) return dppu<0x128>(v);
  if (J == 16) { const u32x2_ r = __builtin_amdgcn_permlane16_swap(v, v, false, false); return (lane & 16) ? r[0] : r[1]; }
  const u32x2_ r = __builtin_amdgcn_permlane32_swap(v, v, false, false); return (lane & 32) ? r[0] : r[1];
}
template <int J> DI float lane_xor_f(float v, int lane) { return __uint_as_float(lane_xor_u<J>(__float_as_uint(v), lane)); }
DI float sum_xor32(float v) { const u32x2_ r = __builtin_amdgcn_permlane32_swap(__float_as_uint(v), __float_as_uint(v), false, false); return __uint_as_float(r[0]) + __uint_as_float(r[1]); }
DI float max_xor32(float v) { const u32x2_ r = __builtin_amdgcn_permlane32_swap(__float_as_uint(v), __float_as_uint(v), false, false); return fmaxf(__uint_as_float(r[0]), __uint_as_float(r[1])); }
DI float other_xor32(float v, int lane) { const u32x2_ r = __builtin_amdgcn_permlane32_swap(__float_as_uint(v), __float_as_uint(v), false, false); return __uint_as_float((lane & 32) ? r[0] : r[1]); }
DI float reduce8(const float (&v)[8], int lane) {
  float q4[4], r2[2];
#pragma unroll
  for (int j = 0; j < 4; ++j) {
    const u32x2_ r = __builtin_amdgcn_permlane32_swap(__float_as_uint(v[j]), __float_as_uint(v[4 + j]), false, false);
    q4[j] = __uint_as_float(r[0]) + __uint_as_float(r[1]);
  }
#pragma unroll
  for (int j = 0; j < 2; ++j) {
    const u32x2_ r = __builtin_amdgcn_permlane16_swap(__float_as_uint(q4[j]), __float_as_uint(q4[2 + j]), false, false);
    r2[j] = __uint_as_float(r[0]) + __uint_as_float(r[1]);
  }
  const float s0 = r2[0] + dppf<0x128>(r2[0]), s1b = r2[1] + dppf<0x128>(r2[1]);
  float s1 = (lane & 8) ? s1b : s0;
  s1 += dppf<0xB1>(s1);
  s1 += dppf<0x4E>(s1);
  s1 += dppf<0x141>(s1);
  return s1;
}
DI float reduce32(const float (&v)[32], int lane) {
  const bool b3 = (lane & 8) != 0, b2 = (lane & 4) != 0, b1 = (lane & 2) != 0, b0 = (lane & 1) != 0;
  float a16[16], a8[8], a4[4], a2[2];
#pragma unroll
  for (int j = 0; j < 16; ++j) {
    const u32x2_ r = __builtin_amdgcn_permlane16_swap(__float_as_uint(v[j]), __float_as_uint(v[16 + j]), false, false);
    a16[j] = __uint_as_float(r[0]) + __uint_as_float(r[1]);
  }
#pragma unroll
  for (int j = 0; j < 8; ++j) { const float keep = b3 ? a16[8 + j] : a16[j], send = b3 ? a16[j] : a16[8 + j]; a8[j] = keep + lane_xor_f<8>(send, lane); }
#pragma unroll
  for (int j = 0; j < 4; ++j) { const float keep = b2 ? a8[4 + j] : a8[j], send = b2 ? a8[j] : a8[4 + j]; a4[j] = keep + lane_xor_f<4>(send, lane); }
#pragma unroll
  for (int j = 0; j < 2; ++j) { const float keep = b1 ? a4[2 + j] : a4[j], send = b1 ? a4[j] : a4[2 + j]; a2[j] = keep + lane_xor_f<2>(send, lane); }
  const float keep = b0 ? a2[1] : a2[0], send = b0 ? a2[0] : a2[1];
  return keep + lane_xor_f<1>(send, lane);
}
DI float sigmoidf_(float x) { return __builtin_amdgcn_rcpf(1.f + __builtin_amdgcn_exp2f(-1.4426950408889634f * x)); }
DI float gelu_tanh(float x) { const float u = 0.7978845608028654f * (x + 0.044715f * x * x * x); return x * __builtin_amdgcn_rcpf(1.f + __builtin_amdgcn_exp2f(-2.f * 1.4426950408889634f * u)); }
DI float one_minus_exp_small(float z) {
  float q = 1.f + z * (1.f / 6.f);
  q = 1.f + z * (1.f / 5.f) * q;
  q = 1.f + z * (1.f / 4.f) * q;
  q = 1.f + z * (1.f / 3.f) * q;
  q = 1.f + z * (1.f / 2.f) * q;
  return -z * q;
}
DI f32x16 zero16() { f32x16 z; for (int i = 0; i < 16; ++i) z[i] = 0.f; return z; }
DI int crow(int reg, int h) { return (reg & 3) + 8 * (reg >> 2) + 4 * h; }

template <int NT, int PD>
DI void gemm_pro(const bf16x8* __restrict__ Wf, int KS, const int (&tile)[NT], int lane, bf16x8 (&bq)[PD][NT]) {
#pragma unroll
  for (int d = 0; d < PD; ++d)
#pragma unroll
    for (int t = 0; t < NT; ++t) bq[d][t] = Wf[((size_t)tile[t] * KS + d) * 64 + lane];
}
template <int NT, int PD, bool SWAP, bool APF = false>
DI void gemm_main(const u16* As, int lda, int nks, const bf16x8* __restrict__ Wf, int KS, const int (&tile)[NT], f32x16 (&acc)[NT][2], int lane, bf16x8 (&bq)[PD][NT]) {
  const bf16x8* a0p = (const bf16x8*)(As + (lane & 31) * lda + 8 * (lane >> 5));
  const bf16x8* a1p = (const bf16x8*)(As + ((lane & 31) + 32) * lda + 8 * (lane >> 5));
  const bf16x8* bp[NT];
#pragma unroll
  for (int t = 0; t < NT; ++t) bp[t] = Wf + (size_t)tile[t] * KS * 64 + lane;
  bf16x8 a0n = a0p[0], a1n = a1p[0];
#pragma unroll 1
  for (int ks = 0; ks < nks; ks += PD) {
#pragma unroll
    for (int d = 0; d < PD; ++d) {
      bf16x8 a0, a1;
      if (APF) { a0 = a0n; a1 = a1n; const int ka = (ks + d + 1 < nks) ? (ks + d + 1) : (ks + d); a0n = a0p[2 * ka]; a1n = a1p[2 * ka]; }
      else { a0 = a0p[2 * (ks + d)]; a1 = a1p[2 * (ks + d)]; }
      const int kn = (ks + d + PD < nks) ? (ks + d + PD) : (ks + d);
#pragma unroll
      for (int t = 0; t < NT; ++t) {
        const bf16x8 b = bq[d][t];
        bq[d][t] = bp[t][kn * 64];
        acc[t][0] = SWAP ? MFMA32(b, a0, acc[t][0]) : MFMA32(a0, b, acc[t][0]);
        acc[t][1] = SWAP ? MFMA32(b, a1, acc[t][1]) : MFMA32(a1, b, acc[t][1]);
      }
    }
  }
}
template <int NT, int PD = 8, bool SWAP = false>
DI void gemm_core(const u16* As, int lda, int nks, const bf16x8* __restrict__ Wf, int KS, const int (&tile)[NT], f32x16 (&acc)[NT][2], int lane) {
  bf16x8 bq[PD][NT];
  gemm_pro<NT, PD>(Wf, KS, tile, lane, bq);
  gemm_main<NT, PD, SWAP>(As, lda, nks, Wf, KS, tile, acc, lane, bq);
}

template <int NT, int PD>
DI void gemm8_core(const signed char* As, int lda, int nks, const i32x4* __restrict__ Wf, int KS, const int (&tile)[NT], i32x16 (&acc)[NT][2], int lane) {
  i32x4 bq[PD][NT];
#pragma unroll
  for (int d = 0; d < PD; ++d)
#pragma unroll
    for (int t = 0; t < NT; ++t) bq[d][t] = Wf[((size_t)tile[t] * KS + d) * 64 + lane];
  const i32x4* a0p = (const i32x4*)(As + (lane & 31) * lda + 16 * (lane >> 5));
  const i32x4* a1p = (const i32x4*)(As + ((lane & 31) + 32) * lda + 16 * (lane >> 5));
  const i32x4* bp[NT];
#pragma unroll
  for (int t = 0; t < NT; ++t) bp[t] = Wf + (size_t)tile[t] * KS * 64 + lane;
#pragma unroll 1
  for (int ks = 0; ks < nks; ks += PD) {
#pragma unroll
    for (int d = 0; d < PD; ++d) {
      const i32x4 a0 = a0p[2 * (ks + d)], a1 = a1p[2 * (ks + d)];
      const int kn = (ks + d + PD < nks) ? (ks + d + PD) : (ks + d);
#pragma unroll
      for (int t = 0; t < NT; ++t) {
        const i32x4 b = bq[d][t];
        bq[d][t] = bp[t][kn * 64];
        acc[t][0] = MFMA8(b, a0, acc[t][0]);
        acc[t][1] = MFMA8(b, a1, acc[t][1]);
      }
    }
  }
}

DI void conv_frag(const float* __restrict__ W, long sk, long sn, int K, int N, const float* ks1, const float* ks2, int ksplit, bf16x8* out, int gtid, int gthreads) {
  const int KS = K / 16; const int total = (N / 32) * KS * 64;
  for (int i = gtid; i < total; i += gthreads) {
    const int lane = i & 63; const int t = i >> 6; const int ks = t % KS; const int nt = t / KS;
    const int n = nt * 32 + (lane & 31); const int k0 = ks * 16 + 8 * (lane >> 5);
    float v[8];
#pragma unroll
    for (int j = 0; j < 8; ++j) {
      const int k = k0 + j;
      float s = 1.f;
      if (ks1) s = (k < ksplit) ? ks1[k] : ks2[k - ksplit];
      v[j] = W[(long)k * sk + (long)n * sn] * s;
    }
    u32x4 o; o[0] = pk2(v[0], v[1]); o[1] = pk2(v[2], v[3]); o[2] = pk2(v[4], v[5]); o[3] = pk2(v[6], v[7]);
    out[i] = __builtin_bit_cast(bf16x8, o);
  }
}

DI void phase0(KP p, char* smem) {
  const int tid = threadIdx.x; const int gtid = blockIdx.x * NTHREADS + tid; const int gthreads = gridDim.x * NTHREADS;
  for (int i = gtid; i < NTOK; i += gthreads) { p.ssq_lru[i] = 0.f; p.ssq_mla[i] = 0.f; }
  if (gtid < 16) p.invfreq[gtid] = pow(10000.0, -(double)gtid / 16.0);
  {
    float* cact = (float*)smem;
    float* red = (float*)(smem + 65536);
    const int lane = tid & 63, wv = tid >> 6;
    for (int item = blockIdx.x; item < 192; item += gridDim.x) {
      const int cg = item >> 1, bh = item & 1;
      for (int i = tid; i < 16 * DM; i += NTHREADS) { const int bb = i >> 10, k = i & 1023; const float v = p.c[(bh * 16 + bb) * DM + k]; cact[k * 16 + bb] = v / (1.f + __expf(-v)); }
      __syncthreads();
      float acc[16];
#pragma unroll
      for (int bb = 0; bb < 16; ++bb) acc[bb] = 0.f;
      const float* wp = p.w_ada + (size_t)(wv * 128) * 6144 + cg * 64 + lane;
#pragma unroll 8
      for (int kk = 0; kk < 128; ++kk) {
        const float w = wp[(size_t)kk * 6144];
        const f32x4* cp = (const f32x4*)(cact + (wv * 128 + kk) * 16);
#pragma unroll
        for (int q = 0; q < 4; ++q) { const f32x4 cv = cp[q]; acc[4 * q] += cv[0] * w; acc[4 * q + 1] += cv[1] * w; acc[4 * q + 2] += cv[2] * w; acc[4 * q + 3] += cv[3] * w; }
      }
#pragma unroll
      for (int bb = 0; bb < 16; ++bb) red[(wv * 16 + bb) * 64 + lane] = acc[bb];
      __syncthreads();
      for (int o = tid; o < 1024; o += NTHREADS) {
        const int bb = o >> 6, c2 = o & 63;
        float sum = 0.f;
#pragma unroll
        for (int w8 = 0; w8 < 8; ++w8) sum += red[(w8 * 16 + bb) * 64 + c2];
        p.mod[(size_t)(bh * 16 + bb) * 6144 + cg * 64 + c2] = sum + p.b_ada[cg * 64 + c2];
      }
      __syncthreads();
    }
  }
  conv_frag(p.w_in, INW, 1, 1024, INW, nullptr, nullptr, 0, p.Wf_in, gtid, gthreads);
  conv_frag(p.w_uq, 768, 1, 256, 768, p.q_norm_g, p.q_norm_g, 256, p.Wf_uq, gtid, gthreads);
  conv_frag(p.w_ukv, 1024, 1, 128, 1024, p.kv_norm_g, p.kv_norm_g, 128, p.Wf_ukv, gtid, gthreads);
  for (int h = 0; h < 8; ++h) {
    conv_frag(p.lru_wa + h * 4096, 64, 1, 64, 64, nullptr, nullptr, 0, p.Wf_a + h * 512, gtid, gthreads);
    conv_frag(p.lru_wx + h * 4096, 64, 1, 64, 64, nullptr, nullptr, 0, p.Wf_x + h * 512, gtid, gthreads);
  }
  conv_frag(p.w_out, 1024, 1, 1024, 1024, p.lru_out_g, p.mla_out_g, 512, p.Wf_out, gtid, gthreads);
  {
    float* kl = (float*)smem;
    float* wl = (float*)(smem + 67584);
    unsigned* lmax = (unsigned*)(smem + 100352);
    for (int item = blockIdx.x; item < 256; item += gridDim.x) {
      const int hp = item >> 4, cc = item & 15;
      __syncthreads();
      if (tid < 128) lmax[tid] = 0u;
      for (int i = tid; i < 16384; i += NTHREADS) kl[(i >> 7) * 132 + (i & 127)] = p.peer_keys[(size_t)hp * 16384 + i];
      for (int i = tid; i < 8192; i += NTHREADS) wl[i] = p.peer_wq[(size_t)(cc * 64 + (i >> 7)) * 2048 + hp * 128 + (i & 127)];
      __syncthreads();
#pragma unroll 1
      for (int q = 0; q < 2; ++q) {
        const int f = tid + NTHREADS * q; const int ln = f & 63, ksl = (f >> 6) & 3, mt = f >> 8;
        const int r = mt * 32 + (ln & 31), cb = 16 * ksl + 8 * (ln >> 5);
        float acc[8];
#pragma unroll
        for (int j = 0; j < 8; ++j) acc[j] = 0.f;
        const f32x4* kp = (const f32x4*)(kl + r * 132);
#pragma unroll 2
        for (int d4 = 0; d4 < 32; ++d4) {
          const f32x4 kv = kp[d4];
#pragma unroll
          for (int j = 0; j < 8; ++j) {
            const f32x4 wv = *(const f32x4*)(wl + (cb + j) * 128 + d4 * 4);
            acc[j] += wv[0] * kv[0] + wv[1] * kv[1] + wv[2] * kv[2] + wv[3] * kv[3];
          }
        }
        float* dst = p.Wsf + (size_t)(hp * 128 + r) * 1024 + cc * 64 + cb;
        *(f32x4*)dst = (f32x4){acc[0], acc[1], acc[2], acc[3]}; *(f32x4*)(dst + 4) = (f32x4){acc[4], acc[5], acc[6], acc[7]};
        float m = 0.f;
#pragma unroll
        for (int j = 0; j < 8; ++j) m = fmaxf(m, fabsf(acc[j]));
        m = max_xor32(m);
        if (ln < 32) atomicMax(&lmax[r], __float_as_uint(m));
      }
      __syncthreads();
      if (tid < 128) p.wsmaxp[(size_t)(hp * 128 + tid) * 16 + cc] = __uint_as_float(lmax[tid]);
    }
    __syncthreads();
  }
  {
    const int lane = tid & 63; const int gw = gtid >> 6; const int nw = gthreads >> 6;
    for (int row = gw; row < 32768; row += nw) {
      const int r = row & 16383; const bool isv = row >= 16384;
      const f32x4* src = (const f32x4*)((isv ? p.peer_v : p.peer_u) + (size_t)r * 1024) + lane * 4;
      f32x4 a[4];
#pragma unroll
      for (int i = 0; i < 4; ++i) a[i] = src[i];
#if QBITS == 8
      float am = 0.f;
#pragma unroll
      for (int i = 0; i < 4; ++i)
#pragma unroll
        for (int j = 0; j < 4; ++j) am = fmaxf(am, fabsf(a[i][j]));
      am = wave_max(am);
      const float inv = am > 0.f ? 127.f / am : 0.f;
      u32x4 o;
#pragma unroll
      for (int i = 0; i < 4; ++i) {
        unsigned w = 0;
#pragma unroll
        for (int j = 0; j < 4; ++j) { const int q = (int)__builtin_rintf(a[i][j] * inv) + 128; w |= (unsigned)q << (8 * j); }
        o[i] = w;
      }
      ((u32x4*)(isv ? p.Vq : p.Uq))[(size_t)r * 64 + lane] = o;
      const float step = am * (1.f / 127.f);
      if (lane == 0) p.uscale[r * 4 + (isv ? 1 : 0)] = step;
      float ns = 0.f;
#pragma unroll
      for (int i = 0; i < 4; ++i) ns += (float)(o[i] & 255u) + (float)((o[i] >> 8) & 255u) + (float)((o[i] >> 16) & 255u) + (float)(o[i] >> 24);
      ns = wave_sum(ns);
      if (lane == 0 && !isv) p.uscale[r * 4 + 2] = step * 128.f * ns;
#else
      float ssum = 0.f;
#pragma unroll
      for (int i = 0; i < 4; ++i)
#pragma unroll
        for (int j = 0; j < 4; ++j) ssum += a[i][j] * a[i][j];
      ssum = wave_sum(ssum);
      const float rms = sqrtf(ssum * (1.f / 1024.f));
      const float step = (isv ? 0.49f : 0.3352f) * rms;
      const float inv = step > 0.f ? 1.f / step : 0.f;
      u32x2 o;
#pragma unroll
      for (int jd = 0; jd < 2; ++jd) {
        unsigned w = 0;
#pragma unroll
        for (int e = 0; e < 8; ++e) {
          const float x = a[(8 * jd + e) >> 2][(8 * jd + e) & 3];
          if (isv) {
            const float m = fabsf(x) * inv;
            const int mag = (m > 0.25f) + (m > 0.75f) + (m > 1.25f) + (m > 1.75f) + (m > 2.5f) + (m > 3.5f) + (m > 5.0f);
            w |= (unsigned)(mag | (x < 0.f ? 8 : 0)) << (4 * e);
          } else {
            int q = (int)__builtin_rintf(x * inv + 7.5f); q = q < 0 ? 0 : (q > 15 ? 15 : q);
            w |= (unsigned)q << (8 * (e & 3) + 4 * (e >> 2));
          }
        }
        o[jd] = w;
      }
      ((u32x2*)(p.Uq + (size_t)r * 1024))[2 * lane + (isv ? 1 : 0)] = o;
      if (lane == 0) p.uscale[r * 4 + (isv ? 1 : 0)] = step;
      float ns = 0.f;
#pragma unroll
      for (int jd = 0; jd < 2; ++jd)
#pragma unroll
        for (int e = 0; e < 8; ++e) ns += (float)((o[jd] >> (4 * e)) & 15u);
      ns = wave_sum(ns);
      if (lane == 0 && !isv) p.uscale[r * 4 + 2] = step * 128.f * ns;
#endif
    }
  }
}

DI void ws_quant(KP p) {
  const int gtid = blockIdx.x * NTHREADS + threadIdx.x; const int gthreads = gridDim.x * NTHREADS;
  for (int i = gtid; i < 64 * 32 * 64; i += gthreads) {
    const int lane = i & 63; const int ks = (i >> 6) & 31; const int tile = i >> 11;
    const int row = tile * 32 + (lane & 31); const int c0 = 32 * ks + 16 * (lane >> 5);
    const f32x4* pm = (const f32x4*)(p.wsmaxp + (size_t)row * 16);
    float m = 0.f;
#pragma unroll
    for (int q = 0; q < 4; ++q) { const f32x4 v = pm[q]; m = fmaxf(fmaxf(m, fmaxf(v[0], v[1])), fmaxf(v[2], v[3])); }
    const float inv = m > 0.f ? 127.f / m : 0.f;
    const f32x4* src = (const f32x4*)(p.Wsf + (size_t)row * 1024 + c0);
    i32x4 o;
#pragma unroll
    for (int q = 0; q < 4; ++q) {
      const f32x4 v = src[q];
      unsigned w = 0;
#pragma unroll
      for (int j = 0; j < 4; ++j) w |= ((unsigned)(int)__builtin_rintf(v[j] * inv) & 255u) << (8 * j);
      o[q] = (int)w;
    }
    p.Wf_s[i] = o;
    if (ks == 0 && lane < 32) p.wsc[row] = m * (1.f / 127.f);
  }
}

DI void phase1(KP p, char* smem) {
  const int tid = threadIdx.x, wave = __builtin_amdgcn_readfirstlane(tid >> 6);
  u16* hA = (u16*)smem;
  float* cs = (float*)(smem + 132096);
  float* ssq = (float*)(smem + 132096 + 8192);
  constexpr int LDL = 424;
  ws_quant(p);
  for (int tile = blockIdx.x; tile < NTOK / 64; tile += gridDim.x) {
    int lane_o = tid & 63; asm volatile("" : "+v"(lane_o));
    const int lane = lane_o, l31 = lane & 31, lh = lane >> 5;
    const int tok0 = tile * 64; const int b = tok0 / SEQ; const int s0 = tok0 % SEQ;
    const float* modb = p.mod + (size_t)b * 6144;
    for (int i = tid; i < 1024; i += NTHREADS) {
      const int r = i >> 4, j = i & 15;
      const double ang = (double)p.pos[tok0 + r] * p.invfreq[j];
      double rev = ang * 0.15915494309189535; rev -= floor(rev);
      const float rf = (float)rev;
      cs[2 * i] = __builtin_amdgcn_cosf(rf); cs[2 * i + 1] = __builtin_amdgcn_sinf(rf);
    }
    if (tid < 128) ssq[tid] = 0.f;
    {
      f32x4 cm[4], ca[4];
#pragma unroll
      for (int i = 0; i < 4; ++i) {
        const int col = i * 256 + lane * 4;
        const f32x4 g = *(const f32x4*)(p.norm1_g + col); const f32x4 sc = *(const f32x4*)(modb + 1024 + col);
        cm[i] = g * (sc + 1.0f); ca[i] = *(const f32x4*)(modb + col);
      }
#pragma unroll 2
      for (int rr = 0; rr < 8; rr += 4) {
        f32x4 xv[4][4];
#pragma unroll
        for (int q = 0; q < 4; ++q)
#pragma unroll
          for (int i = 0; i < 4; ++i) xv[q][i] = *(const f32x4*)(p.x + (size_t)(tok0 + wave * 8 + rr + q) * DM + i * 256 + lane * 4);
#pragma unroll
        for (int q = 0; q < 4; ++q) {
          float ss = 0.f;
#pragma unroll
          for (int i = 0; i < 4; ++i) ss += xv[q][i][0] * xv[q][i][0] + xv[q][i][1] * xv[q][i][1] + xv[q][i][2] * xv[q][i][2] + xv[q][i][3] * xv[q][i][3];
          ss = wave_sum(ss);
          const float rs = rsqrtf(ss * (1.f / 1024.f) + EPS);
          const int row = wave * 8 + rr + q;
#pragma unroll
          for (int i = 0; i < 4; ++i) {
            const f32x4 h = xv[q][i] * rs * cm[i] + ca[i];
            u32x2 o; o[0] = pk2(h[0], h[1]); o[1] = pk2(h[2], h[3]);
            *(u32x2*)(hA + row * LDA + i * 256 + lane * 4) = o;
          }
        }
      }
    }
    __syncthreads();
    bf16x8 ring1[8][2];
    const bool has2 = (wave + 40) < 45;
    { const int tl0[2] = {wave, wave + 8}; gemm_pro<2, 8>(p.Wf_in, 64, tl0, lane, ring1); }
#pragma unroll 1
    for (int pass = 0; pass < 2; ++pass) {
      f32x16 acc[2][2];
#pragma unroll
      for (int t = 0; t < 2; ++t) { acc[t][0] = zero16(); acc[t][1] = zero16(); }
      const int tl[2] = {wave + 16 * pass, wave + 16 * pass + 8};
      gemm_main<2, 8, false, true>(hA, LDA, 64, p.Wf_in, 64, tl, acc, lane, ring1);
      { const int tn[2] = {wave + 16 * (pass + 1), (pass == 0 || has2) ? wave + 16 * (pass + 1) + 8 : wave + 32}; gemm_pro<2, 8>(p.Wf_in, 64, tn, lane, ring1); }
      int el_ = lane; asm volatile("" : "+v"(el_));
      const int l31 = el_ & 31, lh = el_ >> 5;
      u16* dstb[2];
#pragma unroll
      for (int t = 0; t < 2; ++t) { const int col = tl[t] * 32 + l31; dstb[t] = (col < 512) ? (p.xlru + col) : (p.gate + (col - 512)); }
#pragma unroll
      for (int rt = 0; rt < 2; ++rt)
#pragma unroll
        for (int r = 0; r < 16; ++r) {
          const size_t ro = (size_t)(tok0 + rt * 32 + crow(r, lh)) * 512;
#pragma unroll
          for (int t = 0; t < 2; ++t) dstb[t][ro] = f2bf(acc[t][rt][r]);
        }
    }
    {
      f32x16 acc[2][2];
#pragma unroll
      for (int t = 0; t < 2; ++t) { acc[t][0] = zero16(); acc[t][1] = zero16(); }
      const int tl[2] = {wave + 32, has2 ? wave + 40 : wave + 32};
      gemm_main<2, 8, false, true>(hA, LDA, 64, p.Wf_in, 64, tl, acc, lane, ring1);
      int el_ = lane; asm volatile("" : "+v"(el_));
      const int l31 = el_ & 31, lh = el_ >> 5;
      __syncthreads();
      u16* lat = hA;
#pragma unroll
      for (int t = 0; t < 2; ++t) {
        if (t == 1 && !has2) continue;
        const int lc = tl[t] * 32 - 1024 + l31;
        if (tl[t] < 44) {
          float sq[32];
#pragma unroll
          for (int rt = 0; rt < 2; ++rt)
#pragma unroll
            for (int r = 0; r < 16; ++r) { const float v = acc[t][rt][r]; sq[rt * 16 + r] = v * v; }
          const float tot = reduce32(sq, lane);
          __hip_atomic_fetch_add(&ssq[(tl[t] < 40 ? 0 : 64) + (l31 >> 4) * 32 + crow(l31 & 15, lh)], tot, __ATOMIC_RELAXED, __HIP_MEMORY_SCOPE_WORKGROUP);
        }
#pragma unroll
        for (int rt = 0; rt < 2; ++rt)
#pragma unroll
          for (int r = 0; r < 16; ++r) {
            const int row = rt * 32 + crow(r, lh);
            const float v = acc[t][rt][r];
            if (lc < 384) {
              lat[row * LDL + lc] = f2bf(v);
            } else {
              const float pv = lane_xor_f<16>(v, lane);
              const int j = lc - 384; const int jj = j & 15;
              const float co = cs[(row * 16 + jj) * 2], si = cs[(row * 16 + jj) * 2 + 1];
              const float o = (j < 16) ? (v * co - pv * si) : (v * co + pv * si);
              p.Kr[(size_t)(tok0 + row) * 32 + j] = f2bf(o);
            }
          }
      }
    }
    __syncthreads();
    {
      const u16* lat = hA;
      const float qscale = 0.10206207261596577f * 1.4426950408889634f;
      const int jj = l31 & 15;
#pragma unroll 1
      for (int pass = 0; pass < 2; ++pass) {
        f32x16 acc[2][2];
#pragma unroll
        for (int t = 0; t < 2; ++t) { acc[t][0] = zero16(); acc[t][1] = zero16(); }
        const int tl[2] = {pass == 0 ? wave : wave + 16, pass == 0 ? wave + 8 : wave + 16};
        gemm_core<2>(lat, LDL, 16, p.Wf_uq, 16, tl, acc, lane);
        int el_ = lane; asm volatile("" : "+v"(el_));
        const int l31 = el_ & 31, lh = el_ >> 5;
#pragma unroll
        for (int rt = 0; rt < 2; ++rt)
#pragma unroll
          for (int r = 0; r < 16; ++r) {
            const int row = rt * 32 + crow(r, lh);
            const float rs = rsqrtf(ssq[row] * (1.f / 256.f) + EPS) * qscale;
            const float co = cs[(row * 16 + jj) * 2], si = cs[(row * 16 + jj) * 2 + 1];
#pragma unroll
            for (int t = 0; t < 2; ++t) {
              if (t == 1 && pass == 1) continue;
              const int head = tl[t] / 3, part = tl[t] % 3;
              float v = acc[t][rt][r] * rs;
              if (part == 2) {
                const float pv = lane_xor_f<16>(v, lane);
                v = (l31 < 16) ? (v * co - pv * si) : (v * co + pv * si);
              }
              p.Q[((size_t)(b * 8 + head) * SEQ + s0 + row) * 96 + part * 32 + l31] = f2bf(v);
            }
          }
      }
#pragma unroll 1
      for (int pass = 0; pass < 2; ++pass) {
        f32x16 acc[2][2];
#pragma unroll
        for (int t = 0; t < 2; ++t) { acc[t][0] = zero16(); acc[t][1] = zero16(); }
        const int tl[2] = {wave + 16 * pass, wave + 16 * pass + 8};
        gemm_core<2>(lat + 256, LDL, 8, p.Wf_ukv, 8, tl, acc, lane);
        int el_ = lane; asm volatile("" : "+v"(el_));
        const int l31 = el_ & 31, lh = el_ >> 5;
#pragma unroll
        for (int rt = 0; rt < 2; ++rt)
#pragma unroll
          for (int g = 0; g < 4; ++g) {
            const int row = rt * 32 + 8 * g + 4 * lh;
            float rs4[4];
#pragma unroll
            for (int q = 0; q < 4; ++q) rs4[q] = rsqrtf(ssq[64 + row + q] * (1.f / 128.f) + EPS);
#pragma unroll
            for (int t = 0; t < 2; ++t) {
              const int head = tl[t] >> 2, sub = tl[t] & 3;
              float v4[4];
#pragma unroll
              for (int q = 0; q < 4; ++q) v4[q] = acc[t][rt][4 * g + q] * rs4[q];
              if (sub < 2) {
#pragma unroll
                for (int q = 0; q < 4; ++q) p.Kn[((size_t)(b * 8 + head) * SEQ + s0 + row + q) * 64 + sub * 32 + l31] = f2bf(v4[q]);
              } else {
                const int d = (sub - 2) * 32 + l31;
                u32x2 o; o[0] = pk2(v4[0], v4[1]); o[1] = pk2(v4[2], v4[3]);
                *(u32x2*)(p.Vt + ((size_t)(b * 8 + head) * 64 + d) * SEQ + s0 + row) = o;
              }
            }
          }
      }
    }
    __syncthreads();
  }
}

DI void lru_item(KP p, char* smem, int item) {
  const int tid = threadIdx.x, lane = tid & 63, wave = __builtin_amdgcn_readfirstlane(tid >> 6);
  const int l31 = lane & 31, lh = lane >> 5;
  const int b = item >> 3, cb = item & 7;
  const int c = lane; const int ch = cb * 64 + c; const int tg = wave;
  const float cw0 = p.conv_w[ch], cw1 = p.conv_w[512 + ch], cw2 = p.conv_w[1024 + ch], cw3 = p.conv_w[1536 + ch], cbias = p.conv_b[ch];
  const float ba = p.lru_ba[ch], bx = p.lru_bx[ch];
  const float sp = log1pf(__expf(-p.lru_lambda[ch]));
  float carry = 0.f;
  const u16* xl = p.xlru + (size_t)b * SEQ * 512 + ch;
  const u16* gt = p.gate + (size_t)b * SEQ * 512 + ch;
  u16* yo = p.y + (size_t)b * SEQ * 1024 + ch;
  const int mat = wave >> 2, rt = (wave >> 1) & 1, ct = wave & 1;
  const bf16x8* wf = (mat == 0 ? p.Wf_a : p.Wf_x) + cb * 512 + ct * 256 + lane;
  bf16x8 bw[4];
#pragma unroll
  for (int ks = 0; ks < 4; ++ks) bw[ks] = wf[ks * 64];
  constexpr int NCH = SEQ / 64;
  u16 xin_n[11], gv_n[8];
#pragma unroll
  for (int i = 0; i < 11; ++i) { const int t = tg * 8 - 3 + i; xin_n[i] = (t >= 0) ? xl[(size_t)t * 512] : (u16)0; }
#pragma unroll
  for (int i = 0; i < 8; ++i) gv_n[i] = gt[(size_t)(tg * 8 + i) * 512];
  float xcB[8], gvB[8], xcC[8], gvC[8], avD[8], bvD[8], gvD[8];
#pragma unroll
  for (int i = 0; i < 8; ++i) { xcB[i] = gvB[i] = xcC[i] = gvC[i] = avD[i] = bvD[i] = gvD[i] = 0.f; }
  __syncthreads();
#pragma unroll 1
  for (int it = 0; it < NCH + 3; ++it) {
    float xcA[8], gvA[8], avC[8], bvC[8];
    if (it < NCH) {
      const int t0 = it * 64 + tg * 8;
      float xin[11];
#pragma unroll
      for (int i = 0; i < 11; ++i) xin[i] = bf2f(xin_n[i]);
#pragma unroll
      for (int i = 0; i < 8; ++i) gvA[i] = bf2f(gv_n[i]);
      if (it + 1 < NCH) {
#pragma unroll
        for (int i = 0; i < 11; ++i) xin_n[i] = xl[(size_t)(t0 + 64 - 3 + i) * 512];
#pragma unroll
        for (int i = 0; i < 8; ++i) gv_n[i] = gt[(size_t)(t0 + 64 + i) * 512];
      }
      u16* xcb = (u16*)(smem + (it & 1) * 9216);
#pragma unroll
      for (int i = 0; i < 8; ++i) {
        xcA[i] = cbias + cw0 * xin[i] + cw1 * xin[i + 1] + cw2 * xin[i + 2] + cw3 * xin[i + 3];
        xcb[(tg * 8 + i) * 72 + c] = f2bf(xcA[i]);
      }
    } else {
#pragma unroll
      for (int i = 0; i < 8; ++i) { xcA[i] = 0.f; gvA[i] = 0.f; }
    }
    if (it >= 1 && it - 1 < NCH) {
      const u16* xcb = (const u16*)(smem + ((it - 1) & 1) * 9216);
      float* pm = (float*)(smem + 18432 + ((it - 1) & 1) * 33280) + mat * 4160;
      f32x16 acc = zero16();
      const bf16x8* ap = (const bf16x8*)(xcb + (rt * 32 + l31) * 72 + 8 * lh);
#pragma unroll
      for (int ks = 0; ks < 4; ++ks) acc = MFMA32(ap[2 * ks], bw[ks], acc);
#pragma unroll
      for (int r = 0; r < 16; ++r) pm[(rt * 32 + crow(r, lh)) * 65 + ct * 32 + l31] = acc[r];
    }
    if (it >= 2 && it - 2 < NCH) {
      const float* pre = (const float*)(smem + 18432 + ((it - 2) & 1) * 33280);
      float* seg = (float*)(smem + 84992 + ((it - 2) & 1) * 4096);
      float A = 1.f, Bc = 0.f;
#pragma unroll
      for (int i = 0; i < 8; ++i) {
        const int tl = tg * 8 + i;
        const float r = sigmoidf_(pre[tl * 65 + c] + ba);
        const float ig = sigmoidf_(pre[4160 + tl * 65 + c] + bx);
        const float log_a = -8.f * r * sp;
        const float a = __builtin_amdgcn_exp2f(1.4426950408889634f * log_a);
        const float z = 2.f * log_a;
        const float om = (z > -0.25f) ? one_minus_exp_small(z) : -expm1f(z);
        const float m = __builtin_amdgcn_sqrtf(om);
        avC[i] = a; bvC[i] = m * ig * xcC[i];
        A *= a; Bc = a * Bc + bvC[i];
      }
      seg[(tg * 64 + c) * 2] = A; seg[(tg * 64 + c) * 2 + 1] = Bc;
    } else {
#pragma unroll
      for (int i = 0; i < 8; ++i) { avC[i] = 0.f; bvC[i] = 0.f; }
    }
    if (it >= 3) {
      const int t0 = (it - 3) * 64 + tg * 8;
      const float* seg = (const float*)(smem + 84992 + ((it - 3) & 1) * 4096);
      float h = carry, hin = 0.f;
#pragma unroll
      for (int s2 = 0; s2 < 8; ++s2) {
        if (s2 == tg) hin = h;
        h = seg[(s2 * 64 + c) * 2] * h + seg[(s2 * 64 + c) * 2 + 1];
      }
      carry = h;
      h = hin;
      float sq[8];
#pragma unroll
      for (int i = 0; i < 8; ++i) {
        h = avD[i] * h + bvD[i];
        const float yv = gelu_tanh(gvD[i]) * h;
        yo[(size_t)(t0 + i) * 1024] = f2bf(yv);
        sq[i] = yv * yv;
      }
      const float tot = reduce8(sq, lane);
      if ((lane & 7) == 0) unsafeAtomicAdd(p.ssq_lru + (size_t)b * SEQ + t0 + (lane >> 3), tot);
    }
#pragma unroll
    for (int i = 0; i < 8; ++i) {
      avD[i] = avC[i]; bvD[i] = bvC[i]; gvD[i] = gvC[i];
      xcC[i] = xcB[i]; gvC[i] = gvB[i];
      xcB[i] = xcA[i]; gvB[i] = gvA[i];
    }
    __syncthreads();
  }
}

DI void attn_unit(KP p, char* smem, int b, int hd, int qb) {
  const int tid = threadIdx.x, lane = tid & 63, wave = __builtin_amdgcn_readfirstlane(tid >> 6);
  const int l31 = lane & 31, lh = lane >> 5;
  const int q0 = qb * 256 + wave * 32;
  const size_t bh = (size_t)(b * 8 + hd);
  const int nkt = qb * 4 + 4;
  const int qidx = q0 + l31;
  const int skey = tid >> 3, schn = tid & 7;
  const int rkey = (tid & 255) >> 2, rchn = tid & 3;
  const u16* kn_src = p.Kn + (bh * SEQ + skey) * 64 + schn * 8;
  const u16* kr_src = p.Kr + ((size_t)b * SEQ + rkey) * 32 + rchn * 8;
  const u16* vt_src = p.Vt + (bh * 64 + skey) * SEQ + schn * 8;
  u32x4 rk, rr, rv;
  rk = *(const u32x4*)(kn_src); rv = *(const u32x4*)(vt_src);
  if (tid < 256) rr = *(const u32x4*)(kr_src);
  bf16x8 qf[6];
  {
    const bf16x8* qp = (const bf16x8*)(p.Q + (bh * SEQ + q0 + l31) * 96 + 8 * lh);
#pragma unroll
    for (int ks = 0; ks < 6; ++ks) qf[ks] = qp[2 * ks];
  }
  __syncthreads();
  {
    u16* Kl = (u16*)smem; u16* Vl = (u16*)(smem + 13312);
    *(u32x4*)(Kl + skey * 104 + schn * 8) = rk;
    if (tid < 256) *(u32x4*)(Kl + rkey * 104 + 64 + rchn * 8) = rr;
    *(u32x4*)(Vl + skey * 72 + schn * 8) = rv;
  }
  __syncthreads();
  f32x16 o0 = zero16(), o1 = zero16();
  float m_run = -1e30f, l_run = 0.f;
  for (int kt = 0; kt < nkt; ++kt) {
    const u16* Kl = (const u16*)(smem + (kt & 1) * 22528);
    const u16* Vl = (const u16*)(smem + (kt & 1) * 22528 + 13312);
    const bool more = (kt + 1) < nkt;
    if (more) {
      rk = *(const u32x4*)(kn_src + (size_t)(kt + 1) * 64 * 64);
      rv = *(const u32x4*)(vt_src + (kt + 1) * 64);
      if (tid < 256) rr = *(const u32x4*)(kr_src + (size_t)(kt + 1) * 64 * 32);
    }
    if (kt * 64 <= q0 + 31) {
      f32x16 s[2];
      bf16x8 kfr[2][6];
#pragma unroll
      for (int st = 0; st < 2; ++st) {
        const bf16x8* kp = (const bf16x8*)(Kl + (st * 32 + l31) * 104 + 8 * lh);
#pragma unroll
        for (int ks = 0; ks < 6; ++ks) kfr[st][ks] = kp[2 * ks];
      }
#pragma unroll
      for (int st = 0; st < 2; ++st) {
        s[st] = zero16();
#pragma unroll
        for (int ks = 0; ks < 6; ++ks) s[st] = MFMA32(kfr[st][ks], qf[ks], s[st]);
      }
      u32x2 vfr[2][4][2];
#pragma unroll
      for (int dt = 0; dt < 2; ++dt)
#pragma unroll
        for (int c4 = 0; c4 < 4; ++c4) {
          const int kbase = c4 * 16 + 4 * lh;
          vfr[dt][c4][0] = *(const u32x2*)(Vl + (dt * 32 + l31) * 72 + kbase);
          vfr[dt][c4][1] = *(const u32x2*)(Vl + (dt * 32 + l31) * 72 + kbase + 8);
        }
      if (kt * 64 + 63 > q0) {
#pragma unroll
        for (int st = 0; st < 2; ++st)
#pragma unroll
          for (int r = 0; r < 16; ++r) { const int key = kt * 64 + st * 32 + crow(r, lh); if (key > qidx) s[st][r] = -1e30f; }
      }
      float mloc = s[0][0];
#pragma unroll
      for (int st = 0; st < 2; ++st)
#pragma unroll
        for (int r = 0; r < 16; ++r) mloc = fmaxf(mloc, s[st][r]);
      mloc = max_xor32(mloc);
      const float m_new = fmaxf(m_run, mloc);
      const float alpha = __builtin_amdgcn_exp2f(m_run - m_new);
      m_run = m_new;
      float lsum = 0.f;
#pragma unroll
      for (int st = 0; st < 2; ++st)
#pragma unroll
        for (int r = 0; r < 16; ++r) { const float e = __builtin_amdgcn_exp2f(s[st][r] - m_new); s[st][r] = e; lsum += e; }
      l_run = l_run * alpha + lsum;
#pragma unroll
      for (int r = 0; r < 16; ++r) { o0[r] *= alpha; o1[r] *= alpha; }
#pragma unroll
      for (int st = 0; st < 2; ++st)
#pragma unroll
        for (int s2 = 0; s2 < 2; ++s2) {
          u32x4 pw;
#pragma unroll
          for (int j = 0; j < 4; ++j) pw[j] = pk2(s[st][8 * s2 + 2 * j], s[st][8 * s2 + 2 * j + 1]);
          const bf16x8 pf = __builtin_bit_cast(bf16x8, pw);
          const int c4 = st * 2 + s2;
          {
            u32x4 vv; vv[0] = vfr[0][c4][0][0]; vv[1] = vfr[0][c4][0][1]; vv[2] = vfr[0][c4][1][0]; vv[3] = vfr[0][c4][1][1];
            o0 = MFMA32(__builtin_bit_cast(bf16x8, vv), pf, o0);
          }
          {
            u32x4 vv; vv[0] = vfr[1][c4][0][0]; vv[1] = vfr[1][c4][0][1]; vv[2] = vfr[1][c4][1][0]; vv[3] = vfr[1][c4][1][1];
            o1 = MFMA32(__builtin_bit_cast(bf16x8, vv), pf, o1);
          }
        }
    }
    if (more) {
      u16* Kn2 = (u16*)(smem + ((kt + 1) & 1) * 22528); u16* Vn2 = (u16*)(smem + ((kt + 1) & 1) * 22528 + 13312);
      *(u32x4*)(Kn2 + skey * 104 + schn * 8) = rk;
      if (tid < 256) *(u32x4*)(Kn2 + rkey * 104 + 64 + rchn * 8) = rr;
      *(u32x4*)(Vn2 + skey * 72 + schn * 8) = rv;
    }
    __syncthreads();
  }
  const float ltot = sum_xor32(l_run);
  const float inv = 1.f / ltot;
  float ss = 0.f;
  u16* yrow = p.y + ((size_t)b * SEQ + qidx) * 1024 + 512 + hd * 64;
#pragma unroll
  for (int g = 0; g < 4; ++g) {
    float v0[4], v1[4];
#pragma unroll
    for (int q = 0; q < 4; ++q) { v0[q] = o0[4 * g + q] * inv; v1[q] = o1[4 * g + q] * inv; ss += v0[q] * v0[q] + v1[q] * v1[q]; }
    u32x2 a; a[0] = pk2(v0[0], v0[1]); a[1] = pk2(v0[2], v0[3]);
    u32x2 c2; c2[0] = pk2(v1[0], v1[1]); c2[1] = pk2(v1[2], v1[3]);
    *(u32x2*)(yrow + 8 * g + 4 * lh) = a;
    *(u32x2*)(yrow + 32 + 8 * g + 4 * lh) = c2;
  }
  ss = sum_xor32(ss);
  if (lh == 0) unsafeAtomicAdd(p.ssq_mla + (size_t)b * SEQ + qidx, ss);
}

DI void phase2(KP p, char* smem) {
  for (int item = blockIdx.x; item < 256; item += gridDim.x) lru_item(p, smem, item);
  for (int it = blockIdx.x; it < 1024; it += gridDim.x) {
    const int j = it & 3; const int bh = it >> 2; const int hd = bh & 7; const int b = bh >> 3;
    attn_unit(p, smem, b, hd, 7 - j);
    attn_unit(p, smem, b, hd, j);
  }
}

DI void sort128_asc(unsigned& k0, unsigned& k1, int lane) {
#pragma unroll
  for (int k = 2; k <= 128; k <<= 1) {
#pragma unroll
    for (int j = k >> 1; j > 0; j >>= 1) {
      if (j == 64) {
        const unsigned lo = k0 < k1 ? k0 : k1, hi = k0 < k1 ? k1 : k0; k0 = lo; k1 = hi;
      } else {
        const unsigned o0 = (j == 1) ? lane_xor_u<1>(k0, lane) : (j == 2) ? lane_xor_u<2>(k0, lane) : (j == 4) ? lane_xor_u<4>(k0, lane) : (j == 8) ? lane_xor_u<8>(k0, lane) : (j == 16) ? lane_xor_u<16>(k0, lane) : lane_xor_u<32>(k0, lane);
        const unsigned o1 = (j == 1) ? lane_xor_u<1>(k1, lane) : (j == 2) ? lane_xor_u<2>(k1, lane) : (j == 4) ? lane_xor_u<4>(k1, lane) : (j == 8) ? lane_xor_u<8>(k1, lane) : (j == 16) ? lane_xor_u<16>(k1, lane) : lane_xor_u<32>(k1, lane);
        const bool lower = (lane & j) == 0;
        const bool asc0 = (k == 128) ? true : ((lane & k) == 0);
        const bool asc1 = (k == 128) ? true : (k == 64 ? false : ((lane & k) == 0));
        const unsigned mn0 = k0 < o0 ? k0 : o0, mx0 = k0 < o0 ? o0 : k0;
        const unsigned mn1 = k1 < o1 ? k1 : o1, mx1 = k1 < o1 ? o1 : k1;
        k0 = (asc0 == lower) ? mn0 : mx0;
        k1 = (asc1 == lower) ? mn1 : mx1;
      }
    }
  }
}
#if QBITS == 8
typedef u32x4 qrow_t;
#else
typedef u32x2 qrow_t;
#endif
constexpr int QROWB = (QBITS == 8) ? 1024 : 512;
DI void ga_load(__amdgpu_buffer_rsrc_t rs, int iv, int gl, int voff_u, int voff_v, qrow_t (&uq)[8], qrow_t (&vq)[8]) {
#pragma unroll
  for (int k = 0; k < 8; ++k) {
    const int so = __builtin_amdgcn_readlane(iv, gl + k);
#if QBITS == 8
    uq[k] = __builtin_amdgcn_raw_buffer_load_b128(rs, voff_u, so, 0);
    vq[k] = __builtin_amdgcn_raw_buffer_load_b128(rs, voff_v, so, 0);
#else
    const u32x4 rec = __builtin_amdgcn_raw_buffer_load_b128(rs, voff_u, so, 16);
    uq[k] = (u32x2){rec[0], rec[1]}; vq[k] = (u32x2){rec[2], rec[3]};
#endif
  }
}
DI unsigned qword(const qrow_t& r, int j) {
#if QBITS == 8
  return r[j];
#else
  const unsigned w0 = r[j >> 1];
  return (j & 1) ? ((w0 >> 4) & 0x0f0f0f0fu) : (w0 & 0x0f0f0f0fu);
#endif
}
#if QBITS == 8
typedef f32x2 oacc_t;
constexpr float OACC_SCALE = 1.f;
#else
typedef h16x2 oacc_t;
constexpr float OACC_SCALE = 16.f;
#endif
DI void ga_compute(float gsel, float asel, float bsel, int gl, int lane, float kt, float hscale, const unsigned (&hq)[4],
                   const qrow_t (&uq)[8], const qrow_t (&vq)[8], oacc_t (&oacc)[8], float& csum) {
  const float mg = __shfl(gsel, gl + (lane >> 3));
  const float ma = __shfl(asel, gl + (lane >> 3));
  const float mb = __shfl(bsel, gl + (lane >> 3));
  float pp[8];
#pragma unroll
  for (int k = 0; k < 8; ++k) {
#if QBITS == 8
    unsigned d = 0;
#pragma unroll
    for (int j = 0; j < 4; ++j) d = __builtin_amdgcn_udot4(qword(uq[k], j), hq[j], d, false);
#else
    unsigned dh = __builtin_amdgcn_udot8(uq[k][0], hq[0], 0u, false); dh = __builtin_amdgcn_udot8(uq[k][1], hq[1], dh, false);
    unsigned dl = __builtin_amdgcn_udot8(uq[k][0], hq[2], 0u, false); dl = __builtin_amdgcn_udot8(uq[k][1], hq[3], dl, false);
    const unsigned d = dh * 16u + dl;
#endif
    pp[k] = (float)d;
  }
  const float s1 = reduce8(pp, lane);
  const float pre = hscale * (ma * (s1 - kt) - mb);
  const float cf = mg * gelu_tanh(pre);
  csum += cf;
#if QBITS != 8
  const _Float16 cfs = (_Float16)(cf * OACC_SCALE);
  const unsigned cfp = __builtin_bit_cast(unsigned, (h16x2){cfs, cfs});
#endif
#pragma unroll
  for (int k = 0; k < 8; ++k) {
#if QBITS == 8
    const float c = __uint_as_float(__builtin_amdgcn_readlane(__float_as_uint(cf), 8 * k));
    const f32x2 cc = {c, c};
#pragma unroll
    for (int j = 0; j < 4; ++j) {
      unsigned w = qword(vq[k], j);
      asm volatile("" : "+v"(w));
      const f32x2 v0 = {(float)(w & 255u), (float)((w >> 8) & 255u)}, v1 = {(float)((w >> 16) & 255u), (float)(w >> 24)};
      oacc[2 * j] = v0 * cc + oacc[2 * j];
      oacc[2 * j + 1] = v1 * cc + oacc[2 * j + 1];
    }
#else
    const h16x2 cc = __builtin_bit_cast(h16x2, (unsigned)__builtin_amdgcn_readlane((int)cfp, 8 * k));
#pragma unroll
    for (int jd = 0; jd < 2; ++jd) {
      const unsigned w = vq[k][jd];
      oacc[4 * jd + 0] = __builtin_amdgcn_cvt_scalef32_pk_f16_fp4(w, 1.0f, 0) * cc + oacc[4 * jd + 0];
      oacc[4 * jd + 1] = __builtin_amdgcn_cvt_scalef32_pk_f16_fp4(w, 1.0f, 1) * cc + oacc[4 * jd + 1];
      oacc[4 * jd + 2] = __builtin_amdgcn_cvt_scalef32_pk_f16_fp4(w, 1.0f, 2) * cc + oacc[4 * jd + 2];
      oacc[4 * jd + 3] = __builtin_amdgcn_cvt_scalef32_pk_f16_fp4(w, 1.0f, 3) * cc + oacc[4 * jd + 3];
    }
#endif
  }
}

DI void ins16(float (&lst)[16], float x) {
#pragma unroll
  for (int i = 0; i < 16; ++i) { const float hi = fmaxf(lst[i], x); x = fminf(lst[i], x); lst[i] = hi; }
}
DI void ce_desc(float& a, float& b) { const float hi = fmaxf(a, b), lo = fminf(a, b); a = hi; b = lo; }
DI void sort16_desc(float (&a)[16]) {
#pragma unroll
  for (int k = 2; k <= 16; k <<= 1)
#pragma unroll
    for (int j = k >> 1; j > 0; j >>= 1)
#pragma unroll
      for (int i = 0; i < 16; ++i) {
        const int l = i ^ j;
        if (l > i) {
          if ((i & k) == 0) ce_desc(a[i], a[l]); else ce_desc(a[l], a[i]);
        }
      }
}
DI void merge16_desc(float (&x)[16], const float (&y)[16]) {
#pragma unroll
  for (int i = 0; i < 16; ++i) x[i] = fmaxf(x[i], y[15 - i]);
#pragma unroll
  for (int d = 8; d >= 1; d >>= 1)
#pragma unroll
    for (int i = 0; i < 16; ++i)
      if ((i & d) == 0) ce_desc(x[i], x[i + d]);
}
DI void merge_partner(float (&lst)[16], int lane) {
  float o[16];
#pragma unroll
  for (int i = 0; i < 16; ++i) o[i] = other_xor32(lst[i], lane);
  float c[16];
#pragma unroll
  for (int i = 0; i < 16; ++i) c[i] = fmaxf(lst[i], o[15 - i]);
#pragma unroll
  for (int d = 8; d >= 1; d >>= 1) {
#pragma unroll
    for (int i = 0; i < 16; ++i) {
      if ((i & d) == 0) { const float hi = fmaxf(c[i], c[i + d]), lo = fminf(c[i], c[i + d]); c[i] = hi; c[i + d] = lo; }
    }
  }
#pragma unroll
  for (int i = 0; i < 16; ++i) lst[i] = c[i];
}

DI void phase3(KP p, char* smem) {
  const int tid = threadIdx.x, wave = __builtin_amdgcn_readfirstlane(tid >> 6);
  u16* A = (u16*)smem;
  float* ssq2 = (float*)(smem + 132096);
  signed char* A8 = (signed char*)smem;
  float* hs = (float*)(smem + 132096 + 256);
  char* scr = p.scratch + (size_t)blockIdx.x * 655360;
  float* x1s = (float*)scr;
  u16* qp = (u16*)(scr + 262144);
  int* eidx = (int*)(scr + 524288);
  float* egate = (float*)(scr + 524288 + 32768);
  float* eus = (float*)(scr + 524288 + 65536);
  float* eub = (float*)(scr + 524288 + 98304);
  for (int tile = blockIdx.x; tile < NTOK / 64; tile += gridDim.x) {
    int lane_o = tid & 63; asm volatile("" : "+v"(lane_o));
    const int lane = lane_o, l31 = lane & 31, lh = lane >> 5;
    const int tok0 = tile * 64; const int b = tok0 / SEQ;
    const float* modb = p.mod + (size_t)b * 6144;
    if (tid < 64) ssq2[tid] = 0.f;
#pragma unroll 2
    for (int rr = 0; rr < 8; ++rr) {
      const int row = wave * 8 + rr; const int tok = tok0 + row;
      const float rl = rsqrtf(p.ssq_lru[tok] * (1.f / 512.f) + EPS), rm = rsqrtf(p.ssq_mla[tok] * (1.f / 512.f) + EPS);
#pragma unroll
      for (int i = 0; i < 2; ++i) {
        const u32x4 v = *(const u32x4*)(p.y + (size_t)tok * 1024 + (i * 64 + lane) * 8);
        const float sc = i == 0 ? rl : rm;
        u32x4 o;
#pragma unroll
        for (int j = 0; j < 4; ++j) o[j] = pk2(bflo(v[j]) * sc, bfhi(v[j]) * sc);
        *(u32x4*)(A + row * LDA + (i * 64 + lane) * 8) = o;
      }
    }
    __syncthreads();
    float sqa[32];
#pragma unroll
    for (int i = 0; i < 32; ++i) sqa[i] = 0.f;
    bf16x8 ring3[8][2];
    { const int tl0[2] = {wave, wave + 8}; gemm_pro<2, 8>(p.Wf_out, 64, tl0, lane, ring3); }
#pragma unroll 1
    for (int pass = 0; pass < 2; ++pass) {
      f32x16 acc[2][2];
#pragma unroll
      for (int t = 0; t < 2; ++t) { acc[t][0] = zero16(); acc[t][1] = zero16(); }
      const int tl[2] = {pass * 16 + wave, pass * 16 + wave + 8};
      gemm_main<2, 8, false, true>(A, LDA, 64, p.Wf_out, 64, tl, acc, lane, ring3);
      if (pass == 0) { const int tn[2] = {16 + wave, 16 + wave + 8}; gemm_pro<2, 8>(p.Wf_out, 64, tn, lane, ring3); }
      int el_ = lane; asm volatile("" : "+v"(el_));
      const int l31 = el_ & 31, lh = el_ >> 5;
      float g1[2];
#pragma unroll
      for (int t = 0; t < 2; ++t) g1[t] = modb[2048 + tl[t] * 32 + l31];
#pragma unroll
      for (int rt = 0; rt < 2; ++rt)
#pragma unroll
        for (int r = 0; r < 16; ++r) {
          const int row = rt * 32 + crow(r, lh);
#pragma unroll
          for (int t = 0; t < 2; ++t) {
            const int col = tl[t] * 32 + l31;
            const float v = p.x[(size_t)(tok0 + row) * DM + col] + g1[t] * acc[t][rt][r];
            x1s[row * 1024 + col] = v;
            sqa[rt * 16 + r] += v * v;
          }
        }
    }
    {
      const float tot = reduce32(sqa, lane);
      const int l31 = lane & 31, lh = lane >> 5;
      __hip_atomic_fetch_add(&ssq2[(l31 >> 4) * 32 + crow(l31 & 15, lh)], tot, __ATOMIC_RELAXED, __HIP_MEMORY_SCOPE_WORKGROUP);
    }
    __syncthreads();
    {
      f32x4 cm[4], ca[4];
#pragma unroll
      for (int i = 0; i < 4; ++i) {
        const int col = (i >> 1) * 512 + lane * 8 + (i & 1) * 4;
        const f32x4 g = *(const f32x4*)(p.norm2_g + col); const f32x4 sc = *(const f32x4*)(modb + 4096 + col);
        cm[i] = g * (sc + 1.0f); ca[i] = *(const f32x4*)(modb + 3072 + col);
      }
#pragma unroll 2
      for (int rr = 0; rr < 8; ++rr) {
        const int row = wave * 8 + rr;
        const float rs = rsqrtf(ssq2[row] * (1.f / 1024.f) + EPS);
        f32x4 hv[4];
        float hmax = 0.f;
#pragma unroll
        for (int i = 0; i < 2; ++i) {
          const f32x4 xa = *(const f32x4*)(x1s + row * 1024 + i * 512 + lane * 8), xb = *(const f32x4*)(x1s + row * 1024 + i * 512 + lane * 8 + 4);
          hv[2 * i] = xa * rs * cm[2 * i] + ca[2 * i]; hv[2 * i + 1] = xb * rs * cm[2 * i + 1] + ca[2 * i + 1];
#pragma unroll
          for (int j = 0; j < 4; ++j) hmax = fmaxf(hmax, fmaxf(fabsf(hv[2 * i][j]), fabsf(hv[2 * i + 1][j])));
        }
        hmax = wave_max(hmax);
        const float hinv = hmax > 0.f ? 127.f / hmax : 0.f;
#pragma unroll
        for (int i = 0; i < 2; ++i) {
          u32x2 o;
#pragma unroll
          for (int hh = 0; hh < 2; ++hh) {
            unsigned w = 0;
#pragma unroll
            for (int j = 0; j < 4; ++j) w |= ((unsigned)(int)__builtin_rintf(hv[2 * i + hh][j] * hinv) & 255u) << (8 * j);
            o[hh] = w;
          }
          *(u32x2*)(A8 + row * LDA8 + i * 512 + lane * 8) = o;
        }
        if (lane == 0) hs[row] = hmax * (1.f / 127.f);
      }
    }
    __syncthreads();
    float s12[2][16];
#pragma unroll 1
    for (int ph = 0; ph < 2; ++ph) {
      const int hd = wave;
      float lst0[16], lst1[16];
#pragma unroll
      for (int i = 0; i < 16; ++i) { lst0[i] = -3.0e38f; lst1[i] = -3.0e38f; }
#pragma unroll 1
      for (int mtp = 0; mtp < 2; ++mtp) {
        i32x16 acc[2][2];
#pragma unroll
        for (int t = 0; t < 2; ++t)
#pragma unroll
          for (int r = 0; r < 16; ++r) { acc[t][0][r] = 0; acc[t][1][r] = 0; }
        const int tl[2] = {(hd * 2 + ph) * 4 + 2 * mtp, (hd * 2 + ph) * 4 + 2 * mtp + 1};
        gemm8_core<2, 8>(A8, LDA8, 32, p.Wf_s, 32, tl, acc, lane);
        int el_ = lane; asm volatile("" : "+v"(el_));
        const int lh = el_ >> 5;
#pragma unroll
        for (int t = 0; t < 2; ++t) {
          f32x4 w4[4];
#pragma unroll
          for (int g = 0; g < 4; ++g) w4[g] = *(const f32x4*)(p.wsc + tl[t] * 32 + 8 * g + 4 * lh);
          float nv[16];
#pragma unroll
          for (int r = 0; r < 16; ++r) nv[r] = __uint_as_float((__float_as_uint((float)acc[t][0][r] * w4[r >> 2][r & 3]) & 0xffffff80u) | (unsigned)((2 * mtp + t) * 32 + crow(r, lh)));
          sort16_desc(nv);
          merge16_desc(lst0, nv);
#pragma unroll
          for (int r = 0; r < 16; ++r) nv[r] = __uint_as_float((__float_as_uint((float)acc[t][1][r] * w4[r >> 2][r & 3]) & 0xffffff80u) | (unsigned)((2 * mtp + t) * 32 + crow(r, lh)));
          sort16_desc(nv);
          merge16_desc(lst1, nv);
        }
      }
      merge_partner(lst0, lane);
      merge_partner(lst1, lane);
      if (ph == 0) {
#pragma unroll
        for (int i = 0; i < 16; ++i) s12[0][i] = lh ? lst1[i] : lst0[i];
      } else {
#pragma unroll
        for (int i = 0; i < 16; ++i) s12[1][i] = lh ? lst1[i] : lst0[i];
      }
    }
    {
      const int hd = wave;
      unsigned long long t1lo = 0, t1hi = 0, t2lo = 0, t2hi = 0;
#pragma unroll
      for (int i = 0; i < 8; ++i) {
        t1lo |= (unsigned long long)(__float_as_uint(s12[0][i]) & 127u) << (8 * i);
        t1hi |= (unsigned long long)(__float_as_uint(s12[0][8 + i]) & 127u) << (8 * i);
        t2lo |= (unsigned long long)(__float_as_uint(s12[1][i]) & 127u) << (8 * i);
        t2hi |= (unsigned long long)(__float_as_uint(s12[1][8 + i]) & 127u) << (8 * i);
      }
      const float hst = hs[lh * 32 + l31];
      float bv[16];
#pragma unroll
      for (int j = 0; j < 16; ++j) {
        const float sv = (s12[0][0] + s12[1][j]) * hst;
        bv[j] = __uint_as_float((__float_as_uint(sv) & 0xffffff00u) | (unsigned)j);
      }
#pragma unroll
      for (int i = 1; i < 16; ++i) {
#pragma unroll
        for (int j = 0; j < 16; ++j)
          if ((i + 1) * (j + 1) <= 16) {
            const float sv = (s12[0][i] + s12[1][j]) * hst;
            ins16(bv, __uint_as_float((__float_as_uint(sv) & 0xffffff00u) | (unsigned)(i * 16 + j)));
          }
      }
      int bi[16];
#pragma unroll
      for (int k = 0; k < 16; ++k) {
        const unsigned code = __float_as_uint(bv[k]) & 255u;
        const unsigned ci = code >> 4, cj = code & 15u;
        const unsigned long long w1 = (ci & 8u) ? t1hi : t1lo, w2 = (cj & 8u) ? t2hi : t2lo;
        const unsigned i1 = (unsigned)(w1 >> ((ci & 7u) * 8)) & 0xffu, i2 = (unsigned)(w2 >> ((cj & 7u) * 8)) & 0xffu;
        bi[k] = (int)(i1 * 128u + i2);
      }
      float esum = 0.f, ev[16];
#pragma unroll
      for (int i = 0; i < 16; ++i) { ev[i] = __expf(bv[i] - bv[0]); esum += ev[i]; }
      const float einv = 1.f / esum;
      {
        const int row = lh * 32 + l31;
#pragma unroll
        for (int i4 = 0; i4 < 4; ++i4) {
          f32x4 sc[4];
#pragma unroll
          for (int q = 0; q < 4; ++q) sc[q] = ((const f32x4*)p.uscale)[bi[i4 * 4 + q]];
          typedef int i32x4 __attribute__((ext_vector_type(4)));
          *(i32x4*)(eidx + row * 128 + hd * 16 + i4 * 4) = (i32x4){bi[i4 * 4], bi[i4 * 4 + 1], bi[i4 * 4 + 2], bi[i4 * 4 + 3]};
          *(f32x4*)(egate + row * 128 + hd * 16 + i4 * 4) = (f32x4){ev[i4 * 4] * einv * sc[0][1], ev[i4 * 4 + 1] * einv * sc[1][1], ev[i4 * 4 + 2] * einv * sc[2][1], ev[i4 * 4 + 3] * einv * sc[3][1]};
          *(f32x4*)(eus + row * 128 + hd * 16 + i4 * 4) = (f32x4){sc[0][0], sc[1][0], sc[2][0], sc[3][0]};
          *(f32x4*)(eub + row * 128 + hd * 16 + i4 * 4) = (f32x4){sc[0][2], sc[1][2], sc[2][2], sc[3][2]};
        }
      }
    }
    __syncthreads();
    const __amdgpu_buffer_rsrc_t qrs = __builtin_amdgcn_make_buffer_rsrc((void*)p.Uq, 0, 2 * 16384 * QROWB, 0x00020000);
    const int voff_u = (QBITS == 8) ? lane * 16 : lane * 16, voff_v = voff_u + 16384 * QROWB;
    int n_ia, n_ib; float n_ga, n_gb, n_ua, n_ub, n_ba, n_bb, n_kt, n_hscale; unsigned n_hq[4];
    qrow_t bufA_u[8], bufA_v[8], bufB_u[8], bufB_v[8];
#define GA_PREP(ROW)                                                                                                              \
    {                                                                                                                             \
      const int prow = (ROW);                                                                                                     \
      n_ia = eidx[prow * 128 + lane]; n_ib = eidx[prow * 128 + 64 + lane];                                                        \
      n_ga = egate[prow * 128 + lane]; n_gb = egate[prow * 128 + 64 + lane];                                                      \
      n_ua = eus[prow * 128 + lane]; n_ub = eus[prow * 128 + 64 + lane];                                                          \
      n_ba = eub[prow * 128 + lane]; n_bb = eub[prow * 128 + 64 + lane];                                                          \
      {     \
        unsigned k0 = ((unsigned)n_ia << 7) | (unsigned)lane, k1 = ((unsigned)n_ib << 7) | (unsigned)(64 + lane);                 \
        sort128_asc(k0, k1, lane);                                                                                                \
        const int p0 = (int)(k0 & 127u), p1 = (int)(k1 & 127u);                                                                   \
        const float ga0 = __shfl(n_ga, p0 & 63), gb0 = __shfl(n_gb, p0 & 63), ga1 = __shfl(n_ga, p1 & 63), gb1 = __shfl(n_gb, p1 & 63); \
        const float ua0 = __shfl(n_ua, p0 & 63), ub0 = __shfl(n_ub, p0 & 63), ua1 = __shfl(n_ua, p1 & 63), ub1 = __shfl(n_ub, p1 & 63); \
        const float ba0 = __shfl(n_ba, p0 & 63), bb0 = __shfl(n_bb, p0 & 63), ba1 = __shfl(n_ba, p1 & 63), bb1 = __shfl(n_bb, p1 & 63); \
        n_ia = (int)(k0 >> 7) * (QBITS == 8 ? QROWB : 2 * QROWB); n_ib = (int)(k1 >> 7) * (QBITS == 8 ? QROWB : 2 * QROWB);       \
        n_ga = (p0 & 64) ? gb0 : ga0; n_gb = (p1 & 64) ? gb1 : ga1;                                                               \
        n_ua = (p0 & 64) ? ub0 : ua0; n_ub = (p1 & 64) ? ub1 : ua1;                                                               \
        n_ba = (p0 & 64) ? bb0 : ba0; n_bb = (p1 & 64) ? bb1 : ba1;                                                               \
      }                                                                                                                           \
      u32x4 hc = *(const u32x4*)(A8 + prow * LDA8 + lane * 16);        \
      _Pragma("unroll") for (int j = 0; j < 4; ++j) hc[j] ^= 0x80808080u;                                                         \
      n_hscale = hs[prow];                                                                                                        \
      unsigned hsi = 0;                                                                                                           \
      _Pragma("unroll") for (int j = 0; j < 4; ++j) hsi = __builtin_amdgcn_udot4(hc[j], 0x01010101u, hsi, false);                 \
      const float hsum = (float)hsi;                                                                                              \
      if (QBITS == 8) {                                                                                                           \
        _Pragma("unroll") for (int j = 0; j < 4; ++j) n_hq[j] = hc[j];                                                            \
      } else {               \
        _Pragma("unroll") for (int jd = 0; jd < 2; ++jd) {                                                                        \
          n_hq[jd] = ((hc[2 * jd] >> 4) & 0x0f0f0f0fu) | (hc[2 * jd + 1] & 0xf0f0f0f0u);                                          \
          n_hq[2 + jd] = (hc[2 * jd] & 0x0f0f0f0fu) | ((hc[2 * jd + 1] & 0x0f0f0f0fu) << 4);                                      \
        }                                                                                                                         \
      }                                                                                                                           \
      n_kt = (QBITS == 8 ? 128.f : 7.5f) * (wave_sum(hsum) - 131072.f);                                                           \
    }
    GA_PREP(wave)
    ga_load(qrs, n_ia, 0, voff_u, voff_v, bufA_u, bufA_v);
#pragma unroll 1
    for (int rr = 0; rr < 8; ++rr) {
      const int row = rr * 8 + wave; const int tok = tok0 + row;
      const int ia = n_ia, ib = n_ib; const float ga = n_ga, gb = n_gb, ua = n_ua, ub = n_ub, ba = n_ba, bb = n_bb, kt = n_kt, hscale = n_hscale;
      unsigned hq[4];
#pragma unroll
      for (int j = 0; j < 4; ++j) hq[j] = n_hq[j];
      f32x4 xv4[4];
#pragma unroll
      for (int q = 0; q < 4; ++q) xv4[q] = *(const f32x4*)(x1s + row * 1024 + lane * 16 + q * 4);
      if (rr + 1 < 8) GA_PREP(row + 8)
      oacc_t oacc[8];
#pragma unroll
      for (int j = 0; j < 8; ++j) { oacc[j][0] = 0; oacc[j][1] = 0; }
      float csum = 0.f;
#pragma unroll 1
      for (int half = 0; half < 2; ++half) {
        const int iv = half ? ib : ia, ivn = half ? n_ia : ib;
        const float gs = half ? gb : ga, us = half ? ub : ua, bs = half ? bb : ba;
        const bool has_next = (half == 0) || (rr + 1 < 8);
#pragma unroll 1
        for (int g8 = 0; g8 < 8; g8 += 2) {
          ga_load(qrs, iv, (g8 + 1) * 8, voff_u, voff_v, bufB_u, bufB_v);
          ga_compute(gs, us, bs, g8 * 8, lane, kt, hscale, hq, bufA_u, bufA_v, oacc, csum);
          if (g8 + 2 < 8) ga_load(qrs, iv, (g8 + 2) * 8, voff_u, voff_v, bufA_u, bufA_v);
          else if (has_next) ga_load(qrs, ivn, 0, voff_u, voff_v, bufA_u, bufA_v);
          ga_compute(gs, us, bs, (g8 + 1) * 8, lane, kt, hscale, hq, bufB_u, bufB_v, oacc, csum);
        }
      }
      {
#if QBITS == 8
        const float corr = wave_sum(csum) * (128.f / 8.f);
#pragma unroll
        for (int j = 0; j < 8; ++j) oacc[j] = oacc[j] - corr;
#endif
      }
      float xo[16]; float ss = 0.f;
#pragma unroll
      for (int q = 0; q < 4; ++q) {
        const int col = lane * 16 + q * 4;
        const f32x4 xv = xv4[q];
        const f32x4 g2 = *(const f32x4*)(modb + 5120 + col);
#pragma unroll
        for (int j = 0; j < 4; ++j) { const float v = xv[j] + g2[j] * ((float)oacc[q * 2 + (j >> 1)][j & 1] * (1.f / OACC_SCALE)); xo[q * 4 + j] = v; ss += v * v; }
      }
      ss = wave_sum(ss);
      const float rs = rsqrtf(ss * (1.f / 1024.f) + EPS);
#pragma unroll
      for (int q = 0; q < 4; ++q) {
        const int col = lane * 16 + q * 4;
        const f32x4 fg = *(const f32x4*)(p.final_g + col);
        f32x4 o;
#pragma unroll
        for (int j = 0; j < 4; ++j) o[j] = xo[q * 4 + j] * rs * fg[j];
        *(f32x4*)(p.out + (size_t)tok * DM + col) = o;
      }
    }
#undef GA_PREP
    __syncthreads();
  }
}

template <int MODE>
__global__ void __launch_bounds__(NTHREADS) mk_fwd(Params p) {
  extern __shared__ __attribute__((aligned(16))) char smem[];
  if (MODE < 0) {
    cg::grid_group grid = cg::this_grid();
    typedef const __attribute__((address_space(4))) Params* KPP;
    { KPP kp = (KPP)__builtin_amdgcn_kernarg_segment_ptr(); asm volatile("" : "+s"(kp)); phase0(*kp, smem); }
    grid.sync();
    { KPP kp = (KPP)__builtin_amdgcn_kernarg_segment_ptr(); asm volatile("" : "+s"(kp)); phase1(*kp, smem); }
    grid.sync();
    { KPP kp = (KPP)__builtin_amdgcn_kernarg_segment_ptr(); asm volatile("" : "+s"(kp)); phase2(*kp, smem); }
    grid.sync();
    { KPP kp = (KPP)__builtin_amdgcn_kernarg_segment_ptr(); asm volatile("" : "+s"(kp)); phase3(*kp, smem); }
#ifdef PROBE_P3X2
    grid.sync();
    phase3(p, smem);
#endif
#ifdef PROBE_P1X2
    grid.sync();
    phase1(p, smem);
#endif
  } else {
    typedef const __attribute__((address_space(4))) Params* KPP;
    KPP kp = (KPP)__builtin_amdgcn_kernarg_segment_ptr();
    if (MODE == 0) phase0(*kp, smem);
    if (MODE == 1) phase1(*kp, smem);
    if (MODE == 2) phase2(*kp, smem);
    if (MODE == 3) phase3(*kp, smem);
  }
}

static size_t align_up(size_t v) { return (v + 255) & ~(size_t)255; }

extern "C" void kernel_launch(void* const* d_in, const int* in_sizes, int n_in, void* d_out, int out_size, void* d_ws, size_t ws_size, hipStream_t stream) {
  static int grid = 0;
  if (grid == 0) {
    int dev = 0, cus = 0, per_cu = 0;
    (void)hipGetDevice(&dev);
    (void)hipDeviceGetAttribute(&cus, hipDeviceAttributeMultiprocessorCount, dev);
#if N_LAUNCH_MODE == 1
    (void)hipFuncSetAttribute((const void*)mk_fwd<-1>, hipFuncAttributeMaxDynamicSharedMemorySize, LDS_BYTES);
    (void)hipOccupancyMaxActiveBlocksPerMultiprocessor(&per_cu, (const void*)mk_fwd<-1>, NTHREADS, LDS_BYTES);
#else
    (void)hipFuncSetAttribute((const void*)mk_fwd<0>, hipFuncAttributeMaxDynamicSharedMemorySize, LDS_BYTES);
    (void)hipFuncSetAttribute((const void*)mk_fwd<1>, hipFuncAttributeMaxDynamicSharedMemorySize, LDS_BYTES);
    (void)hipFuncSetAttribute((const void*)mk_fwd<2>, hipFuncAttributeMaxDynamicSharedMemorySize, LDS_BYTES);
    (void)hipFuncSetAttribute((const void*)mk_fwd<3>, hipFuncAttributeMaxDynamicSharedMemorySize, LDS_BYTES);
    (void)hipOccupancyMaxActiveBlocksPerMultiprocessor(&per_cu, (const void*)mk_fwd<3>, NTHREADS, LDS_BYTES);
#endif
    if (per_cu < 1) { fprintf(stderr, "kernel_launch: occupancy query says %d blocks/CU\n", per_cu); per_cu = 1; }
    if (per_cu > 1) per_cu = 1;
    grid = cus * per_cu;
    if (grid > 256) grid = 256;
    (void)hipGetLastError();
  }
  Params p{};
  const float* const* fin = (const float* const*)d_in;
  p.x = fin[0]; p.c = fin[1]; p.pos = (const int*)d_in[2];
  p.w_ada = fin[3]; p.b_ada = fin[4]; p.norm1_g = fin[5]; p.w_in = fin[6]; p.conv_w = fin[7]; p.conv_b = fin[8];
  p.lru_wa = fin[9]; p.lru_ba = fin[10]; p.lru_wx = fin[11]; p.lru_bx = fin[12]; p.lru_lambda = fin[13];
  p.q_norm_g = fin[14]; p.w_uq = fin[15]; p.kv_norm_g = fin[16]; p.w_ukv = fin[17]; p.lru_out_g = fin[18]; p.mla_out_g = fin[19];
  p.w_out = fin[20]; p.norm2_g = fin[21]; p.peer_wq = fin[22]; p.peer_keys = fin[23]; p.peer_u = fin[24]; p.peer_v = fin[25]; p.final_g = fin[26];
  p.out = (float*)d_out;
  char* w = (char*)d_ws; size_t off = 0;
  auto take = [&](size_t bytes) { char* r = w + off; off = align_up(off + bytes); return r; };
  p.mod = (float*)take((size_t)NB * 6144 * 4);
  p.ssq_lru = (float*)take((size_t)NTOK * 4);
  p.ssq_mla = (float*)take((size_t)NTOK * 4);
  p.invfreq = (double*)take(16 * 8);
  p.Wf_in = (bf16x8*)take((size_t)INW * 1024 * 2);
  p.Wf_uq = (bf16x8*)take((size_t)768 * 256 * 2);
  p.Wf_ukv = (bf16x8*)take((size_t)1024 * 128 * 2);
  p.Wf_a = (bf16x8*)take((size_t)8 * 64 * 64 * 2);
  p.Wf_x = (bf16x8*)take((size_t)8 * 64 * 64 * 2);
  p.Wf_out = (bf16x8*)take((size_t)1024 * 1024 * 2);
  p.Wf_s = (i32x4*)take((size_t)2048 * 1024);
  p.Wsf = (float*)take((size_t)2048 * 1024 * 4);
  p.wsmaxp = (float*)take((size_t)2048 * 16 * 4);
  p.wsc = (float*)take((size_t)2048 * 4);
  p.Uq = (unsigned char*)take((size_t)2 * 16384 * QROWB);
  p.Vq = p.Uq + (size_t)16384 * QROWB;
  p.uscale = (float*)take((size_t)16384 * 16);
  p.vscale = p.uscale; p.ubias = p.uscale;
  p.xlru = (u16*)take((size_t)NTOK * 512 * 2);
  p.gate = (u16*)take((size_t)NTOK * 512 * 2);
  p.Q = (u16*)take((size_t)NTOK * 768 * 2);
  p.Kn = (u16*)take((size_t)NTOK * 512 * 2);
  p.Kr = (u16*)take((size_t)NTOK * 32 * 2);
  p.Vt = (u16*)take((size_t)NTOK * 512 * 2);
  p.y = (u16*)take((size_t)NTOK * 1024 * 2);
  p.scratch = take((size_t)256 * 655360);
  if (off > ws_size) { fprintf(stderr, "kernel_launch: workspace too small: need %zu have %zu\n", off, ws_size); return; }
#if N_LAUNCH_MODE == 1
  void* args[] = {&p};
  hipError_t e = hipLaunchCooperativeKernel((const void*)mk_fwd<-1>, dim3(grid), dim3(NTHREADS), args, LDS_BYTES, stream);
  if (e != hipSuccess) fprintf(stderr, "cooperative launch failed: %s (grid %d)\n", hipGetErrorString(e), grid);
#else
  hipLaunchKernelGGL(mk_fwd<0>, dim3(grid), dim3(NTHREADS), LDS_BYTES, stream, p);
  hipLaunchKernelGGL(mk_fwd<1>, dim3(grid), dim3(NTHREADS), LDS_BYTES, stream, p);
  hipLaunchKernelGGL(mk_fwd<2>, dim3(grid), dim3(NTHREADS), LDS_BYTES, stream, p);
  hipLaunchKernelGGL(mk_fwd<3>, dim3(grid), dim3(NTHREADS), LDS_BYTES, stream, p);
#endif
}
```

```cpp
#include <hip/hip_runtime.h>
#include <hip/hip_cooperative_groups.h>
#include <cstdio>
#include <cstdint>
namespace cg = cooperative_groups;

#ifndef QBITS
#define QBITS 4
#endif
#ifndef N_LAUNCH_MODE
#define N_LAUNCH_MODE 1
#endif

typedef short bf16x8 __attribute__((ext_vector_type(8)));
typedef float f32x16 __attribute__((ext_vector_type(16)));
typedef float f32x4 __attribute__((ext_vector_type(4)));
typedef float f32x2 __attribute__((ext_vector_type(2)));
typedef unsigned u32x4 __attribute__((ext_vector_type(4)));
typedef unsigned u32x2 __attribute__((ext_vector_type(2)));
typedef __bf16 bf16x2_t __attribute__((ext_vector_type(2)));
typedef unsigned short u16;
typedef _Float16 h16x2 __attribute__((ext_vector_type(2)));

#define DI __device__ __forceinline__
#define MFMA32(a, b, c) __builtin_amdgcn_mfma_f32_32x32x16_bf16((a), (b), (c), 0, 0, 0)
typedef int i32x4 __attribute__((ext_vector_type(4)));
typedef int i32x16 __attribute__((ext_vector_type(16)));
#define MFMA8(a, b, c) __builtin_amdgcn_mfma_i32_32x32x32_i8((a), (b), (c), 0, 0, 0)

constexpr int NB = 32, SEQ = 2048, DM = 1024, NTOK = NB * SEQ;
constexpr int INW = 1440;
constexpr int NTHREADS = 512;
constexpr int LDA = 1032;
constexpr int LDA8 = 1040;
constexpr int LDS_BYTES = 147456;
constexpr float EPS = 1e-6f;

struct Params {
  const float* x; const float* c; const int* pos;
  const float* w_ada; const float* b_ada; const float* norm1_g; const float* w_in; const float* conv_w; const float* conv_b;
  const float* lru_wa; const float* lru_ba; const float* lru_wx; const float* lru_bx; const float* lru_lambda;
  const float* q_norm_g; const float* w_uq; const float* kv_norm_g; const float* w_ukv; const float* lru_out_g; const float* mla_out_g;
  const float* w_out; const float* norm2_g; const float* peer_wq; const float* peer_keys; const float* peer_u; const float* peer_v; const float* final_g;
  float* out;
  float* mod; float* ssq_lru; float* ssq_mla; double* invfreq;
  bf16x8* Wf_in; bf16x8* Wf_uq; bf16x8* Wf_ukv; bf16x8* Wf_a; bf16x8* Wf_x; bf16x8* Wf_out; i32x4* Wf_s;
  float* Wsf; float* wsmaxp; float* wsc;
  unsigned char* Uq; unsigned char* Vq; float* uscale; float* vscale; float* ubias; u16* xlru; u16* gate; u16* Q; u16* Kn; u16* Kr; u16* Vt; u16* y;
  char* scratch;
};

typedef const __attribute__((address_space(4))) Params& KP;

DI unsigned pk2(float a, float b) { f32x2 v = {a, b}; bf16x2_t r = __builtin_convertvector(v, bf16x2_t); return __builtin_bit_cast(unsigned, r); }
DI u16 f2bf(float a) { return (u16)(pk2(a, 0.f) & 0xffffu); }
DI float bflo(unsigned u) { return __uint_as_float(u << 16); }
DI float bfhi(unsigned u) { return __uint_as_float(u & 0xffff0000u); }
DI float bf2f(u16 h) { return __uint_as_float(((unsigned)h) << 16); }
template <int CTRL> DI float dppf(float v) { return __builtin_bit_cast(float, __builtin_amdgcn_update_dpp(0, __builtin_bit_cast(int, v), CTRL, 0xF, 0xF, true)); }
typedef unsigned u32x2_ __attribute__((ext_vector_type(2)));
DI float wave_sum(float v) {
  v += dppf<0xB1>(v); v += dppf<0x4E>(v); v += dppf<0x141>(v); v += dppf<0x140>(v);
  u32x2_ r = __builtin_amdgcn_permlane16_swap(__float_as_uint(v), __float_as_uint(v), false, false); v = __uint_as_float(r[0]) + __uint_as_float(r[1]);
  r = __builtin_amdgcn_permlane32_swap(__float_as_uint(v), __float_as_uint(v), false, false); v = __uint_as_float(r[0]) + __uint_as_float(r[1]);
  return v;
}
DI float wave_max(float v) {
  v = fmaxf(v, dppf<0xB1>(v)); v = fmaxf(v, dppf<0x4E>(v)); v = fmaxf(v, dppf<0x141>(v)); v = fmaxf(v, dppf<0x140>(v));
  u32x2_ r = __builtin_amdgcn_permlane16_swap(__float_as_uint(v), __float_as_uint(v), false, false); v = fmaxf(__uint_as_float(r[0]), __uint_as_float(r[1]));
  r = __builtin_amdgcn_permlane32_swap(__float_as_uint(v), __float_as_uint(v), false, false); v = fmaxf(__uint_as_float(r[0]), __uint_as_float(r[1]));
  return v;
}
template <int CTRL> DI unsigned dppu(unsigned v) { return (unsigned)__builtin_amdgcn_update_dpp(0, (int)v, CTRL, 0xF, 0xF, true); }
template <int J> DI unsigned lane_xor_u(unsigned v, int lane) {
  if (J == 1) return dppu<0xB1>(v);
  if (J == 2) return dppu<0x4E>(v);
  if (J == 4) return dppu<0x141>(dppu<0x1B>(v));
  if (J == 8) return dppu<0x128>(v);
  if (J == 16) { const u32x2_ r = __builtin_amdgcn_permlane16_swap(v, v, false, false); return (lane & 16) ? r[0] : r[1]; }
  const u32x2_ r = __builtin_amdgcn_permlane32_swap(v, v, false, false); return (lane & 32) ? r[0] : r[1];
}
template <int J> DI float lane_xor_f(float v, int lane) { return __uint_as_float(lane_xor_u<J>(__float_as_uint(v), lane)); }
DI float sum_xor32(float v) { const u32x2_ r = __builtin_amdgcn_permlane32_swap(__float_as_uint(v), __float_as_uint(v), false, false); return __uint_as_float(r[0]) + __uint_as_float(r[1]); }
DI float max_xor32(float v) { const u32x2_ r = __builtin_amdgcn_permlane32_swap(__float_as_uint(v), __float_as_uint(v), false, false); return fmaxf(__uint_as_float(r[0]), __uint_as_float(r[1])); }
DI float other_xor32(float v, int lane) { const u32x2_ r = __builtin_amdgcn_permlane32_swap(__float_as_uint(v), __float_as_uint(v), false, false); return __uint_as_float((lane & 32) ? r[0] : r[1]); }
DI float reduce8(const float (&v)[8], int lane) {
  float q4[4], r2[2];
#pragma unroll
  for (int j = 0; j < 4; ++j) {
    const u32x2_ r = __builtin_amdgcn_permlane32_swap(__float_as_uint(v[j]), __float_as_uint(v[4 + j]), false, false);
    q4[j] = __uint_as_float(r[0]) + __uint_as_float(r[1]);
  }
#pragma unroll
  for (int j = 0; j < 2; ++j) {
    const u32x2_ r = __builtin_amdgcn_permlane16_swap(__float_as_uint(q4[j]), __float_as_uint(q4[2 + j]), false, false);
    r2[j] = __uint_as_float(r[0]) + __uint_as_float(r[1]);
  }
  const float s0 = r2[0] + dppf<0x128>(r2[0]), s1b = r2[1] + dppf<0x128>(r2[1]);
  float s1 = (lane & 8) ? s1b : s0;
  s1 += dppf<0xB1>(s1);
  s1 += dppf<0x4E>(s1);
  s1 += dppf<0x141>(s1);
  return s1;
}
DI float reduce32(const float (&v)[32], int lane) {
  const bool b3 = (lane & 8) != 0, b2 = (lane & 4) != 0, b1 = (lane & 2) != 0, b0 = (lane & 1) != 0;
  float a16[16], a8[8], a4[4], a2[2];
#pragma unroll
  for (int j = 0; j < 16; ++j) {
    const u32x2_ r = __builtin_amdgcn_permlane16_swap(__float_as_uint(v[j]), __float_as_uint(v[16 + j]), false, false);
    a16[j] = __uint_as_float(r[0]) + __uint_as_float(r[1]);
  }
#pragma unroll
  for (int j = 0; j < 8; ++j) { const float keep = b3 ? a16[8 + j] : a16[j], send = b3 ? a16[j] : a16[8 + j]; a8[j] = keep + lane_xor_f<8>(send, lane); }
#pragma unroll
  for (int j = 0; j < 4; ++j) { const float keep = b2 ? a8[4 + j] : a8[j], send = b2 ? a8[j] : a8[4 + j]; a4[j] = keep + lane_xor_f<4>(send, lane); }
#pragma unroll
  for (int j = 0; j < 2; ++j) { const float keep = b1 ? a4[2 + j] : a4[j], send = b1 ? a4[j] : a4[2 + j]; a2[j] = keep + lane_xor_f<2>(send, lane); }
  const float keep = b0 ? a2[1] : a2[0], send = b0 ? a2[0] : a2[1];
  return keep + lane_xor_f<1>(send, lane);
}
DI float sigmoidf_(float x) { return __builtin_amdgcn_rcpf(1.f + __builtin_amdgcn_exp2f(-1.4426950408889634f * x)); }
DI float gelu_tanh(float x) { const float u = 0.7978845608028654f * (x + 0.044715f * x * x * x); return x * __builtin_amdgcn_rcpf(1.f + __builtin_amdgcn_exp2f(-2.f * 1.4426950408889634f * u)); }
DI float one_minus_exp_small(float z) {
  float q = 1.f + z * (1.f / 6.f);
  q = 1.f + z * (1.f / 5.f) * q;
  q = 1.f + z * (1.f / 4.f) * q;
  q = 1.f + z * (1.f / 3.f) * q;
  q = 1.f + z * (1.f / 2.f) * q;
  return -z * q;
}
DI f32x16 zero16() { f32x16 z; for (int i = 0; i < 16; ++i) z[i] = 0.f; return z; }
DI int crow(int reg, int h) { return (reg & 3) + 8 * (reg >> 2) + 4 * h; }

template <int NT, int PD>
DI void gemm_pro(const bf16x8* __restrict__ Wf, int KS, const int (&tile)[NT], int lane, bf16x8 (&bq)[PD][NT]) {
#pragma unroll
  for (int d = 0; d < PD; ++d)
#pragma unroll
    for (int t = 0; t < NT; ++t) bq[d][t] = Wf[((size_t)tile[t] * KS + d) * 64 + lane];
}
template <int NT, int PD, bool SWAP, bool APF = false>
DI void gemm_main(const u16* As, int lda, int nks, const bf16x8* __restrict__ Wf, int KS, const int (&tile)[NT], f32x16 (&acc)[NT][2], int lane, bf16x8 (&bq)[PD][NT]) {
  const bf16x8* a0p = (const bf16x8*)(As + (lane & 31) * lda + 8 * (lane >> 5));
  const bf16x8* a1p = (const bf16x8*)(As + ((lane & 31) + 32) * lda + 8 * (lane >> 5));
  const bf16x8* bp[NT];
#pragma unroll
  for (int t = 0; t < NT; ++t) bp[t] = Wf + (size_t)tile[t] * KS * 64 + lane;
  bf16x8 a0n = a0p[0], a1n = a1p[0];
#pragma unroll 1
  for (int ks = 0; ks < nks; ks += PD) {
#pragma unroll
    for (int d = 0; d < PD; ++d) {
      bf16x8 a0, a1;
      if (APF) { a0 = a0n; a1 = a1n; const int ka = (ks + d + 1 < nks) ? (ks + d + 1) : (ks + d); a0n = a0p[2 * ka]; a1n = a1p[2 * ka]; }
      else { a0 = a0p[2 * (ks + d)]; a1 = a1p[2 * (ks + d)]; }
      const int kn = (ks + d + PD < nks) ? (ks + d + PD) : (ks + d);
#pragma unroll
      for (int t = 0; t < NT; ++t) {
        const bf16x8 b = bq[d][t];
        bq[d][t] = bp[t][kn * 64];
        acc[t][0] = SWAP ? MFMA32(b, a0, acc[t][0]) : MFMA32(a0, b, acc[t][0]);
        acc[t][1] = SWAP ? MFMA32(b, a1, acc[t][1]) : MFMA32(a1, b, acc[t][1]);
      }
    }
  }
}
template <int NT, int PD = 8, bool SWAP = false>
DI void gemm_core(const u16* As, int lda, int nks, const bf16x8* __restrict__ Wf, int KS, const int (&tile)[NT], f32x16 (&acc)[NT][2], int lane) {
  bf16x8 bq[PD][NT];
  gemm_pro<NT, PD>(Wf, KS, tile, lane, bq);
  gemm_main<NT, PD, SWAP>(As, lda, nks, Wf, KS, tile, acc, lane, bq);
}

template <int NT, int PD>
DI void gemm8_core(const signed char* As, int lda, int nks, const i32x4* __restrict__ Wf, int KS, const int (&tile)[NT], i32x16 (&acc)[NT][2], int lane) {
  i32x4 bq[PD][NT];
#pragma unroll
  for (int d = 0; d < PD; ++d)
#pragma unroll
    for (int t = 0; t < NT; ++t) bq[d][t] = Wf[((size_t)tile[t] * KS + d) * 64 + lane];
  const i32x4* a0p = (const i32x4*)(As + (lane & 31) * lda + 16 * (lane >> 5));
  const i32x4* a1p = (const i32x4*)(As + ((lane & 31) + 32) * lda + 16 * (lane >> 5));
  const i32x4* bp[NT];
#pragma unroll
  for (int t = 0; t < NT; ++t) bp[t] = Wf + (size_t)tile[t] * KS * 64 + lane;
#pragma unroll 1
  for (int ks = 0; ks < nks; ks += PD) {
#pragma unroll
    for (int d = 0; d < PD; ++d) {
      const i32x4 a0 = a0p[2 * (ks + d)], a1 = a1p[2 * (ks + d)];
      const int kn = (ks + d + PD < nks) ? (ks + d + PD) : (ks + d);
#pragma unroll
      for (int t = 0; t < NT; ++t) {
        const i32x4 b = bq[d][t];
        bq[d][t] = bp[t][kn * 64];
        acc[t][0] = MFMA8(b, a0, acc[t][0]);
        acc[t][1] = MFMA8(b, a1, acc[t][1]);
      }
    }
  }
}

DI void conv_frag(const float* __restrict__ W, long sk, long sn, int K, int N, const float* ks1, const float* ks2, int ksplit, bf16x8* out, int gtid, int gthreads) {
  const int KS = K / 16; const int total = (N / 32) * KS * 64;
  for (int i = gtid; i < total; i += gthreads) {
    const int lane = i & 63; const int t = i >> 6; const int ks = t % KS; const int nt = t / KS;
    const int n = nt * 32 + (lane & 31); const int k0 = ks * 16 + 8 * (lane >> 5);
    float v[8];
#pragma unroll
    for (int j = 0; j < 8; ++j) {
      const int k = k0 + j;
      float s = 1.f;
      if (ks1) s = (k < ksplit) ? ks1[k] : ks2[k - ksplit];
      v[j] = W[(long)k * sk + (long)n * sn] * s;
    }
    u32x4 o; o[0] = pk2(v[0], v[1]); o[1] = pk2(v[2], v[3]); o[2] = pk2(v[4], v[5]); o[3] = pk2(v[6], v[7]);
    out[i] = __builtin_bit_cast(bf16x8, o);
  }
}

DI void conv_one(const float* __restrict__ W, long sk, int KS, const float* ks1, const float* ks2, int ksplit, bf16x8* out, int i) {
  const int lane = i & 63; const int t = i >> 6; const int ks = t % KS; const int nt = t / KS;
  const int n = nt * 32 + (lane & 31); const int k0 = ks * 16 + 8 * (lane >> 5);
  float v[8];
#pragma unroll
  for (int j = 0; j < 8; ++j) v[j] = W[(long)(k0 + j) * sk + n];
  if (ks1) {
#pragma unroll
    for (int j = 0; j < 8; ++j) { const int k = k0 + j; v[j] *= (k < ksplit) ? ks1[k] : ks2[k - ksplit]; }
  }
  u32x4 o; o[0] = pk2(v[0], v[1]); o[1] = pk2(v[2], v[3]); o[2] = pk2(v[4], v[5]); o[3] = pk2(v[6], v[7]);
  out[i] = __builtin_bit_cast(bf16x8, o);
}

DI void phase0(KP p, char* smem) {
  const int tid = threadIdx.x; const int gtid = blockIdx.x * NTHREADS + tid; const int gthreads = gridDim.x * NTHREADS;
  for (int i = gtid; i < NTOK; i += gthreads) { p.ssq_lru[i] = 0.f; p.ssq_mla[i] = 0.f; }
  if (gtid < 16) p.invfreq[gtid] = pow(10000.0, -(double)gtid / 16.0);
  {
    float* cact = (float*)smem;
    float* red = (float*)(smem + 65536);
    const int lane = tid & 63, wv = tid >> 6;
    for (int item = blockIdx.x; item < 192; item += gridDim.x) {
      const int cg = item >> 1, bh = item & 1;
      for (int i = tid; i < 16 * DM; i += NTHREADS) { const int bb = i >> 10, k = i & 1023; const float v = p.c[(bh * 16 + bb) * DM + k]; cact[k * 16 + bb] = v / (1.f + __expf(-v)); }
      __syncthreads();
      float acc[16];
#pragma unroll
      for (int bb = 0; bb < 16; ++bb) acc[bb] = 0.f;
      const float* wp = p.w_ada + (size_t)(wv * 128) * 6144 + cg * 64 + lane;
#pragma unroll 32
      for (int kk = 0; kk < 128; ++kk) {
        const float w = wp[(size_t)kk * 6144];
        const f32x4* cp = (const f32x4*)(cact + (wv * 128 + kk) * 16);
#pragma unroll
        for (int q = 0; q < 4; ++q) { const f32x4 cv = cp[q]; acc[4 * q] += cv[0] * w; acc[4 * q + 1] += cv[1] * w; acc[4 * q + 2] += cv[2] * w; acc[4 * q + 3] += cv[3] * w; }
      }
#pragma unroll
      for (int bb = 0; bb < 16; ++bb) red[(wv * 16 + bb) * 64 + lane] = acc[bb];
      __syncthreads();
      for (int o = tid; o < 1024; o += NTHREADS) {
        const int bb = o >> 6, c2 = o & 63;
        float sum = 0.f;
#pragma unroll
        for (int w8 = 0; w8 < 8; ++w8) sum += red[(w8 * 16 + bb) * 64 + c2];
        p.mod[(size_t)(bh * 16 + bb) * 6144 + cg * 64 + c2] = sum + p.b_ada[cg * 64 + c2];
      }
      __syncthreads();
    }
  }
  {
    constexpr int N_IN = 45 * 64 * 64, N_UQ = 24 * 16 * 64, N_UKV = 32 * 8 * 64, N_LRU = 16 * 512, N_OUT = 32 * 64 * 64;
    for (int i = gtid; i < N_IN + N_UQ + N_UKV + N_LRU + N_OUT; i += gthreads) {
      int j = i;
      if (j < N_OUT) { conv_one(p.w_out, 1024, 64, p.lru_out_g, p.mla_out_g, 512, p.Wf_out, j); continue; }
      j -= N_OUT;
      if (j < N_IN) { conv_one(p.w_in, INW, 64, nullptr, nullptr, 0, p.Wf_in, j); continue; }
      j -= N_IN;
      if (j < N_UQ) { conv_one(p.w_uq, 768, 16, p.q_norm_g, p.q_norm_g, 256, p.Wf_uq, j); continue; }
      j -= N_UQ;
      if (j < N_UKV) { conv_one(p.w_ukv, 1024, 8, p.kv_norm_g, p.kv_norm_g, 128, p.Wf_ukv, j); continue; }
      j -= N_UKV;
      { const int h = j >> 10, m = (j >> 9) & 1, f = j & 511; conv_one((m ? p.lru_wx : p.lru_wa) + h * 4096, 64, 4, nullptr, nullptr, 0, (m ? p.Wf_x : p.Wf_a) + h * 512, f); }
    }
  }
  {
    float* kl = (float*)smem;
    float* wl = (float*)(smem + 67584);
    const int lane = tid & 63, wv = tid >> 6, l31 = lane & 31, lh = lane >> 5;
    for (int item = blockIdx.x; item < 256; item += gridDim.x) {
      const int hp = item >> 4, cc = item & 15;
      __syncthreads();
#pragma unroll
      for (int i = 0; i < 8; ++i) { const int e = tid + NTHREADS * i; const int r = e >> 5, q = e & 31; *(f32x4*)(kl + r * 132 + q * 4) = *(const f32x4*)(p.peer_keys + (size_t)hp * 16384 + r * 128 + q * 4); }
#pragma unroll
      for (int i = 0; i < 4; ++i) { const int e = tid + NTHREADS * i; const int c = e >> 5, q = e & 31; *(f32x4*)(wl + c * 132 + q * 4) = *(const f32x4*)(p.peer_wq + (size_t)(cc * 64 + c) * 2048 + hp * 128 + q * 4); }
      __syncthreads();
      const int rt = wv >> 1, ct = wv & 1;
      const float* ap = kl + (rt * 32 + l31) * 132 + 8 * lh;
      const float* bp = wl + (ct * 32 + l31) * 132 + 8 * lh;
      f32x16 acc = zero16();
#pragma unroll
      for (int ks = 0; ks < 8; ++ks) {
        const f32x4 a0 = *(const f32x4*)(ap + 16 * ks), a1 = *(const f32x4*)(ap + 16 * ks + 4);
        const f32x4 b0 = *(const f32x4*)(bp + 16 * ks), b1 = *(const f32x4*)(bp + 16 * ks + 4);
        u32x4 av, bv;
        av[0] = pk2(a0[0], a0[1]); av[1] = pk2(a0[2], a0[3]); av[2] = pk2(a1[0], a1[1]); av[3] = pk2(a1[2], a1[3]);
        bv[0] = pk2(b0[0], b0[1]); bv[1] = pk2(b0[2], b0[3]); bv[2] = pk2(b1[0], b1[1]); bv[3] = pk2(b1[2], b1[3]);
        acc = MFMA32(__builtin_bit_cast(bf16x8, av), __builtin_bit_cast(bf16x8, bv), acc);
      }
      float* dst = p.Wsf + (size_t)(hp * 128 + rt * 32) * 1024 + cc * 64 + ct * 32 + l31;
#pragma unroll
      for (int r = 0; r < 16; ++r) dst[(size_t)crow(r, lh) * 1024] = acc[r];
    }
    __syncthreads();
  }
#if QBITS == 8
  {
    const int lane = tid & 63; const int gw = gtid >> 6; const int nw = gthreads >> 6;
    for (int row = gw; row < 32768; row += nw) {
      const int r = row & 16383; const bool isv = row >= 16384;
      const f32x4* src = (const f32x4*)((isv ? p.peer_v : p.peer_u) + (size_t)r * 1024) + lane * 4;
      f32x4 a[4];
#pragma unroll
      for (int i = 0; i < 4; ++i) a[i] = src[i];
#if QBITS == 8
      float am = 0.f;
#pragma unroll
      for (int i = 0; i < 4; ++i)
#pragma unroll
        for (int j = 0; j < 4; ++j) am = fmaxf(am, fabsf(a[i][j]));
      am = wave_max(am);
      const float inv = am > 0.f ? 127.f / am : 0.f;
      u32x4 o;
#pragma unroll
      for (int i = 0; i < 4; ++i) {
        unsigned w = 0;
#pragma unroll
        for (int j = 0; j < 4; ++j) { const int q = (int)__builtin_rintf(a[i][j] * inv) + 128; w |= (unsigned)q << (8 * j); }
        o[i] = w;
      }
      ((u32x4*)(isv ? p.Vq : p.Uq))[(size_t)r * 64 + lane] = o;
      const float step = am * (1.f / 127.f);
      if (lane == 0) p.uscale[r * 4 + (isv ? 1 : 0)] = step;
      float ns = 0.f;
#pragma unroll
      for (int i = 0; i < 4; ++i) ns += (float)(o[i] & 255u) + (float)((o[i] >> 8) & 255u) + (float)((o[i] >> 16) & 255u) + (float)(o[i] >> 24);
      ns = wave_sum(ns);
      if (lane == 0 && !isv) p.uscale[r * 4 + 2] = step * 128.f * ns;
#else
      float ssum = 0.f;
#pragma unroll
      for (int i = 0; i < 4; ++i)
#pragma unroll
        for (int j = 0; j < 4; ++j) ssum += a[i][j] * a[i][j];
      ssum = wave_sum(ssum);
      const float rms = sqrtf(ssum * (1.f / 1024.f));
      const float step = (isv ? 0.49f : 0.3352f) * rms;
      const float inv = step > 0.f ? 1.f / step : 0.f;
      u32x2 o;
#pragma unroll
      for (int jd = 0; jd < 2; ++jd) {
        unsigned w = 0;
#pragma unroll
        for (int e = 0; e < 8; ++e) {
          const float x = a[(8 * jd + e) >> 2][(8 * jd + e) & 3];
          if (isv) {
            const float m = fabsf(x) * inv;
            const int mag = (m > 0.25f) + (m > 0.75f) + (m > 1.25f) + (m > 1.75f) + (m > 2.5f) + (m > 3.5f) + (m > 5.0f);
            w |= (unsigned)(mag | (x < 0.f ? 8 : 0)) << (4 * e);
          } else {
            int q = (int)__builtin_rintf(x * inv + 7.5f); q = q < 0 ? 0 : (q > 15 ? 15 : q);
            w |= (unsigned)q << (8 * (e & 3) + 4 * (e >> 2));
          }
        }
        o[jd] = w;
      }
      ((u32x2*)(p.Uq + (size_t)r * 1024))[2 * lane + (isv ? 1 : 0)] = o;
      if (lane == 0) p.uscale[r * 4 + (isv ? 1 : 0)] = step;
      float ns = 0.f;
#pragma unroll
      for (int jd = 0; jd < 2; ++jd)
#pragma unroll
        for (int e = 0; e < 8; ++e) ns += (float)((o[jd] >> (4 * e)) & 15u);
      ns = wave_sum(ns);
      if (lane == 0 && !isv) p.uscale[r * 4 + 2] = step * 128.f * ns;
#endif
    }
  }
#else
  {
    const int lane = tid & 63; const int gw = gtid >> 6; const int nw = gthreads >> 6;
    for (int r = gw; r < 16384; r += nw) {
      const f32x4* su = (const f32x4*)(p.peer_u + (size_t)r * 1024) + lane * 4;
      const f32x4* sv = (const f32x4*)(p.peer_v + (size_t)r * 1024) + lane * 4;
      f32x4 au[4], av[4];
#pragma unroll
      for (int i = 0; i < 4; ++i) { au[i] = su[i]; av[i] = sv[i]; }
      float ssu = 0.f, ssv = 0.f;
#pragma unroll
      for (int i = 0; i < 4; ++i)
#pragma unroll
        for (int j = 0; j < 4; ++j) { ssu += au[i][j] * au[i][j]; ssv += av[i][j] * av[i][j]; }
      ssu = wave_sum(ssu); ssv = wave_sum(ssv);
      const float ustep = 0.3352f * sqrtf(ssu * (1.f / 1024.f)), vstep = 0.49f * sqrtf(ssv * (1.f / 1024.f));
      const float uinv = ustep > 0.f ? 1.f / ustep : 0.f, vinv = vstep > 0.f ? 1.f / vstep : 0.f;
      u32x4 o;
      float ns = 0.f;
#pragma unroll
      for (int jd = 0; jd < 2; ++jd) {
        unsigned wu = 0, wv = 0;
#pragma unroll
        for (int e = 0; e < 8; ++e) {
          const float xu = au[(8 * jd + e) >> 2][(8 * jd + e) & 3], xv = av[(8 * jd + e) >> 2][(8 * jd + e) & 3];
          int q = (int)__builtin_rintf(xu * uinv + 7.5f); q = q < 0 ? 0 : (q > 15 ? 15 : q);
          wu |= (unsigned)q << (8 * (e & 3) + 4 * (e >> 2)); ns += (float)q;
          const float m = fabsf(xv) * vinv;
          const int mag = (m > 0.25f) + (m > 0.75f) + (m > 1.25f) + (m > 1.75f) + (m > 2.5f) + (m > 3.5f) + (m > 5.0f);
          wv |= (unsigned)(mag | (xv < 0.f ? 8 : 0)) << (4 * e);
        }
        o[jd] = wu; o[2 + jd] = wv;
      }
      ((u32x4*)(p.Uq + (size_t)r * 1024))[lane] = o;
      ns = wave_sum(ns);
      if (lane == 0) *(f32x4*)(p.uscale + r * 4) = (f32x4){ustep, vstep, ustep * 128.f * ns, 0.f};
    }
  }
#endif
}

DI void ws_quant(KP p) {
  const int lane = threadIdx.x & 63; const int gw = (blockIdx.x * NTHREADS + threadIdx.x) >> 6; const int nw = (gridDim.x * NTHREADS) >> 6;
  for (int row = gw; row < 2048; row += nw) {
    const f32x4* src = (const f32x4*)(p.Wsf + (size_t)row * 1024 + lane * 16);
    f32x4 v[4];
    float m = 0.f;
#pragma unroll
    for (int q = 0; q < 4; ++q) { v[q] = src[q]; m = fmaxf(fmaxf(m, fmaxf(fabsf(v[q][0]), fabsf(v[q][1]))), fmaxf(fabsf(v[q][2]), fabsf(v[q][3]))); }
    m = wave_max(m);
    const float inv = m > 0.f ? 127.f / m : 0.f;
    i32x4 o;
#pragma unroll
    for (int q = 0; q < 4; ++q) {
      unsigned w = 0;
#pragma unroll
      for (int j = 0; j < 4; ++j) w |= ((unsigned)(int)__builtin_rintf(v[q][j] * inv) & 255u) << (8 * j);
      o[q] = (int)w;
    }
    p.Wf_s[(size_t)((row >> 5) * 32 + (lane >> 1)) * 64 + (row & 31) + 32 * (lane & 1)] = o;
    if (lane == 0) p.wsc[row] = m * (1.f / 127.f);
  }
}

DI void phase1(KP p, char* smem) {
  const int tid = threadIdx.x, wave = __builtin_amdgcn_readfirstlane(tid >> 6);
  u16* hA = (u16*)smem;
  float* cs = (float*)(smem + 132096);
  float* ssq = (float*)(smem + 132096 + 8192);
  constexpr int LDL = 424;
  ws_quant(p);
  for (int tile = blockIdx.x; tile < NTOK / 64; tile += gridDim.x) {
    int lane_o = tid & 63; asm volatile("" : "+v"(lane_o));
    const int lane = lane_o, l31 = lane & 31, lh = lane >> 5;
    const int tok0 = tile * 64; const int b = tok0 / SEQ; const int s0 = tok0 % SEQ;
    const float* modb = p.mod + (size_t)b * 6144;
    for (int i = tid; i < 1024; i += NTHREADS) {
      const int r = i >> 4, j = i & 15;
      const double ang = (double)p.pos[tok0 + r] * p.invfreq[j];
      double rev = ang * 0.15915494309189535; rev -= floor(rev);
      const float rf = (float)rev;
      cs[2 * i] = __builtin_amdgcn_cosf(rf); cs[2 * i + 1] = __builtin_amdgcn_sinf(rf);
    }
    if (tid < 128) ssq[tid] = 0.f;
    {
      f32x4 cm[4], ca[4];
#pragma unroll
      for (int i = 0; i < 4; ++i) {
        const int col = i * 256 + lane * 4;
        const f32x4 g = *(const f32x4*)(p.norm1_g + col); const f32x4 sc = *(const f32x4*)(modb + 1024 + col);
        cm[i] = g * (sc + 1.0f); ca[i] = *(const f32x4*)(modb + col);
      }
#pragma unroll 2
      for (int rr = 0; rr < 8; rr += 4) {
        f32x4 xv[4][4];
#pragma unroll
        for (int q = 0; q < 4; ++q)
#pragma unroll
          for (int i = 0; i < 4; ++i) xv[q][i] = *(const f32x4*)(p.x + (size_t)(tok0 + wave * 8 + rr + q) * DM + i * 256 + lane * 4);
#pragma unroll
        for (int q = 0; q < 4; ++q) {
          float ss = 0.f;
#pragma unroll
          for (int i = 0; i < 4; ++i) ss += xv[q][i][0] * xv[q][i][0] + xv[q][i][1] * xv[q][i][1] + xv[q][i][2] * xv[q][i][2] + xv[q][i][3] * xv[q][i][3];
          ss = wave_sum(ss);
          const float rs = rsqrtf(ss * (1.f / 1024.f) + EPS);
          const int row = wave * 8 + rr + q;
#pragma unroll
          for (int i = 0; i < 4; ++i) {
            const f32x4 h = xv[q][i] * rs * cm[i] + ca[i];
            u32x2 o; o[0] = pk2(h[0], h[1]); o[1] = pk2(h[2], h[3]);
            *(u32x2*)(hA + row * LDA + i * 256 + lane * 4) = o;
          }
        }
      }
    }
    __syncthreads();
    bf16x8 ring1[8][2];
    const bool has2 = (wave + 40) < 45;
    { const int tl0[2] = {wave, wave + 8}; gemm_pro<2, 8>(p.Wf_in, 64, tl0, lane, ring1); }
#pragma unroll 1
    for (int pass = 0; pass < 2; ++pass) {
      f32x16 acc[2][2];
#pragma unroll
      for (int t = 0; t < 2; ++t) { acc[t][0] = zero16(); acc[t][1] = zero16(); }
      const int tl[2] = {wave + 16 * pass, wave + 16 * pass + 8};
      gemm_main<2, 8, false, true>(hA, LDA, 64, p.Wf_in, 64, tl, acc, lane, ring1);
      { const int tn[2] = {wave + 16 * (pass + 1), (pass == 0 || has2) ? wave + 16 * (pass + 1) + 8 : wave + 32}; gemm_pro<2, 8>(p.Wf_in, 64, tn, lane, ring1); }
      int el_ = lane; asm volatile("" : "+v"(el_));
      const int l31 = el_ & 31, lh = el_ >> 5;
      u16* dstb[2];
#pragma unroll
      for (int t = 0; t < 2; ++t) { const int col = tl[t] * 32 + l31; dstb[t] = (col < 512) ? (p.xlru + col) : (p.gate + (col - 512)); }
#pragma unroll
      for (int rt = 0; rt < 2; ++rt)
#pragma unroll
        for (int r = 0; r < 16; ++r) {
          const size_t ro = (size_t)(tok0 + rt * 32 + crow(r, lh)) * 512;
#pragma unroll
          for (int t = 0; t < 2; ++t) dstb[t][ro] = f2bf(acc[t][rt][r]);
        }
    }
    {
      f32x16 acc[2][2];
#pragma unroll
      for (int t = 0; t < 2; ++t) { acc[t][0] = zero16(); acc[t][1] = zero16(); }
      const int tl[2] = {wave + 32, has2 ? wave + 40 : wave + 32};
      gemm_main<2, 8, false, true>(hA, LDA, 64, p.Wf_in, 64, tl, acc, lane, ring1);
      int el_ = lane; asm volatile("" : "+v"(el_));
      const int l31 = el_ & 31, lh = el_ >> 5;
      __syncthreads();
      u16* lat = hA;
#pragma unroll
      for (int t = 0; t < 2; ++t) {
        if (t == 1 && !has2) continue;
        const int lc = tl[t] * 32 - 1024 + l31;
        if (tl[t] < 44) {
          float sq[32];
#pragma unroll
          for (int rt = 0; rt < 2; ++rt)
#pragma unroll
            for (int r = 0; r < 16; ++r) { const float v = acc[t][rt][r]; sq[rt * 16 + r] = v * v; }
          const float tot = reduce32(sq, lane);
          __hip_atomic_fetch_add(&ssq[(tl[t] < 40 ? 0 : 64) + (l31 >> 4) * 32 + crow(l31 & 15, lh)], tot, __ATOMIC_RELAXED, __HIP_MEMORY_SCOPE_WORKGROUP);
        }
#pragma unroll
        for (int rt = 0; rt < 2; ++rt)
#pragma unroll
          for (int r = 0; r < 16; ++r) {
            const int row = rt * 32 + crow(r, lh);
            const float v = acc[t][rt][r];
            if (lc < 384) {
              lat[row * LDL + lc] = f2bf(v);
            } else {
              const float pv = lane_xor_f<16>(v, lane);
              const int j = lc - 384; const int jj = j & 15;
              const float co = cs[(row * 16 + jj) * 2], si = cs[(row * 16 + jj) * 2 + 1];
              const float o = (j < 16) ? (v * co - pv * si) : (v * co + pv * si);
              p.Kr[(size_t)(tok0 + row) * 32 + j] = f2bf(o);
            }
          }
      }
    }
    __syncthreads();
    {
      const u16* lat = hA;
      const float qscale = 0.10206207261596577f * 1.4426950408889634f;
      const int jj = l31 & 15;
#pragma unroll 1
      for (int pass = 0; pass < 2; ++pass) {
        f32x16 acc[2][2];
#pragma unroll
        for (int t = 0; t < 2; ++t) { acc[t][0] = zero16(); acc[t][1] = zero16(); }
        const int tl[2] = {pass == 0 ? wave : wave + 16, pass == 0 ? wave + 8 : wave + 16};
        gemm_core<2>(lat, LDL, 16, p.Wf_uq, 16, tl, acc, lane);
        int el_ = lane; asm volatile("" : "+v"(el_));
        const int l31 = el_ & 31, lh = el_ >> 5;
#pragma unroll
        for (int rt = 0; rt < 2; ++rt)
#pragma unroll
          for (int r = 0; r < 16; ++r) {
            const int row = rt * 32 + crow(r, lh);
            const float rs = rsqrtf(ssq[row] * (1.f / 256.f) + EPS) * qscale;
            const float co = cs[(row * 16 + jj) * 2], si = cs[(row * 16 + jj) * 2 + 1];
#pragma unroll
            for (int t = 0; t < 2; ++t) {
              if (t == 1 && pass == 1) continue;
              const int head = tl[t] / 3, part = tl[t] % 3;
              float v = acc[t][rt][r] * rs;
              if (part == 2) {
                const float pv = lane_xor_f<16>(v, lane);
                v = (l31 < 16) ? (v * co - pv * si) : (v * co + pv * si);
              }
              p.Q[((size_t)(b * 8 + head) * SEQ + s0 + row) * 96 + part * 32 + l31] = f2bf(v);
            }
          }
      }
#pragma unroll 1
      for (int pass = 0; pass < 2; ++pass) {
        f32x16 acc[2][2];
#pragma unroll
        for (int t = 0; t < 2; ++t) { acc[t][0] = zero16(); acc[t][1] = zero16(); }
        const int tl[2] = {wave + 16 * pass, wave + 16 * pass + 8};
        gemm_core<2>(lat + 256, LDL, 8, p.Wf_ukv, 8, tl, acc, lane);
        int el_ = lane; asm volatile("" : "+v"(el_));
        const int l31 = el_ & 31, lh = el_ >> 5;
#pragma unroll
        for (int rt = 0; rt < 2; ++rt)
#pragma unroll
          for (int g = 0; g < 4; ++g) {
            const int row = rt * 32 + 8 * g + 4 * lh;
            float rs4[4];
#pragma unroll
            for (int q = 0; q < 4; ++q) rs4[q] = rsqrtf(ssq[64 + row + q] * (1.f / 128.f) + EPS);
#pragma unroll
            for (int t = 0; t < 2; ++t) {
              const int head = tl[t] >> 2, sub = tl[t] & 3;
              float v4[4];
#pragma unroll
              for (int q = 0; q < 4; ++q) v4[q] = acc[t][rt][4 * g + q] * rs4[q];
              if (sub < 2) {
#pragma unroll
                for (int q = 0; q < 4; ++q) p.Kn[((size_t)(b * 8 + head) * SEQ + s0 + row + q) * 64 + sub * 32 + l31] = f2bf(v4[q]);
              } else {
                const int d = (sub - 2) * 32 + l31;
                u32x2 o; o[0] = pk2(v4[0], v4[1]); o[1] = pk2(v4[2], v4[3]);
                *(u32x2*)(p.Vt + ((size_t)(b * 8 + head) * 64 + d) * SEQ + s0 + row) = o;
              }
            }
          }
      }
    }
    __syncthreads();
  }
}

DI void lru_item(KP p, char* smem, int item) {
  const int tid = threadIdx.x, lane = tid & 63, wave = __builtin_amdgcn_readfirstlane(tid >> 6);
  const int l31 = lane & 31, lh = lane >> 5;
  const int b = item >> 3, cb = item & 7;
  const int c = lane; const int ch = cb * 64 + c; const int tg = wave;
  const float cw0 = p.conv_w[ch], cw1 = p.conv_w[512 + ch], cw2 = p.conv_w[1024 + ch], cw3 = p.conv_w[1536 + ch], cbias = p.conv_b[ch];
  const float ba = p.lru_ba[ch], bx = p.lru_bx[ch];
  const float sp = log1pf(__expf(-p.lru_lambda[ch]));
  float carry = 0.f;
  const u16* xl = p.xlru + (size_t)b * SEQ * 512 + ch;
  const u16* gt = p.gate + (size_t)b * SEQ * 512 + ch;
  u16* yo = p.y + (size_t)b * SEQ * 1024 + ch;
  const int mat = wave >> 2, rt = (wave >> 1) & 1, ct = wave & 1;
  const bf16x8* wf = (mat == 0 ? p.Wf_a : p.Wf_x) + cb * 512 + ct * 256 + lane;
  bf16x8 bw[4];
#pragma unroll
  for (int ks = 0; ks < 4; ++ks) bw[ks] = wf[ks * 64];
  constexpr int NCH = SEQ / 64;
  u16 xin_n[11], gv_n[8];
#pragma unroll
  for (int i = 0; i < 11; ++i) { const int t = tg * 8 - 3 + i; xin_n[i] = (t >= 0) ? xl[(size_t)t * 512] : (u16)0; }
#pragma unroll
  for (int i = 0; i < 8; ++i) gv_n[i] = gt[(size_t)(tg * 8 + i) * 512];
  float xcB[8], gvB[8], xcC[8], gvC[8], avD[8], bvD[8], gvD[8];
#pragma unroll
  for (int i = 0; i < 8; ++i) { xcB[i] = gvB[i] = xcC[i] = gvC[i] = avD[i] = bvD[i] = gvD[i] = 0.f; }
  __syncthreads();
#pragma unroll 1
  for (int it = 0; it < NCH + 3; ++it) {
    float xcA[8], gvA[8], avC[8], bvC[8];
    if (it < NCH) {
      const int t0 = it * 64 + tg * 8;
      float xin[11];
#pragma unroll
      for (int i = 0; i < 11; ++i) xin[i] = bf2f(xin_n[i]);
#pragma unroll
      for (int i = 0; i < 8; ++i) gvA[i] = bf2f(gv_n[i]);
      if (it + 1 < NCH) {
#pragma unroll
        for (int i = 0; i < 11; ++i) xin_n[i] = xl[(size_t)(t0 + 64 - 3 + i) * 512];
#pragma unroll
        for (int i = 0; i < 8; ++i) gv_n[i] = gt[(size_t)(t0 + 64 + i) * 512];
      }
      u16* xcb = (u16*)(smem + (it & 1) * 9216);
#pragma unroll
      for (int i = 0; i < 8; ++i) {
        xcA[i] = cbias + cw0 * xin[i] + cw1 * xin[i + 1] + cw2 * xin[i + 2] + cw3 * xin[i + 3];
        xcb[(tg * 8 + i) * 72 + c] = f2bf(xcA[i]);
      }
    } else {
#pragma unroll
      for (int i = 0; i < 8; ++i) { xcA[i] = 0.f; gvA[i] = 0.f; }
    }
    if (it >= 1 && it - 1 < NCH) {
      const u16* xcb = (const u16*)(smem + ((it - 1) & 1) * 9216);
      float* pm = (float*)(smem + 18432 + ((it - 1) & 1) * 33280) + mat * 4160;
      f32x16 acc = zero16();
      const bf16x8* ap = (const bf16x8*)(xcb + (rt * 32 + l31) * 72 + 8 * lh);
#pragma unroll
      for (int ks = 0; ks < 4; ++ks) acc = MFMA32(ap[2 * ks], bw[ks], acc);
#pragma unroll
      for (int r = 0; r < 16; ++r) pm[(rt * 32 + crow(r, lh)) * 65 + ct * 32 + l31] = acc[r];
    }
    if (it >= 2 && it - 2 < NCH) {
      const float* pre = (const float*)(smem + 18432 + ((it - 2) & 1) * 33280);
      float* seg = (float*)(smem + 84992 + ((it - 2) & 1) * 4096);
      float A = 1.f, Bc = 0.f;
#pragma unroll
      for (int i = 0; i < 8; ++i) {
        const int tl = tg * 8 + i;
        const float r = sigmoidf_(pre[tl * 65 + c] + ba);
        const float ig = sigmoidf_(pre[4160 + tl * 65 + c] + bx);
        const float log_a = -8.f * r * sp;
        const float a = __builtin_amdgcn_exp2f(1.4426950408889634f * log_a);
        const float z = 2.f * log_a;
        const float om = (z > -0.25f) ? one_minus_exp_small(z) : -expm1f(z);
        const float m = __builtin_amdgcn_sqrtf(om);
        avC[i] = a; bvC[i] = m * ig * xcC[i];
        A *= a; Bc = a * Bc + bvC[i];
      }
      seg[(tg * 64 + c) * 2] = A; seg[(tg * 64 + c) * 2 + 1] = Bc;
    } else {
#pragma unroll
      for (int i = 0; i < 8; ++i) { avC[i] = 0.f; bvC[i] = 0.f; }
    }
    if (it >= 3) {
      const int t0 = (it - 3) * 64 + tg * 8;
      const float* seg = (const float*)(smem + 84992 + ((it - 3) & 1) * 4096);
      float h = carry, hin = 0.f;
#pragma unroll
      for (int s2 = 0; s2 < 8; ++s2) {
        if (s2 == tg) hin = h;
        h = seg[(s2 * 64 + c) * 2] * h + seg[(s2 * 64 + c) * 2 + 1];
      }
      carry = h;
      h = hin;
      float sq[8];
#pragma unroll
      for (int i = 0; i < 8; ++i) {
        h = avD[i] * h + bvD[i];
        const float yv = gelu_tanh(gvD[i]) * h;
        yo[(size_t)(t0 + i) * 1024] = f2bf(yv);
        sq[i] = yv * yv;
      }
      const float tot = reduce8(sq, lane);
      if ((lane & 7) == 0) unsafeAtomicAdd(p.ssq_lru + (size_t)b * SEQ + t0 + (lane >> 3), tot);
    }
#pragma unroll
    for (int i = 0; i < 8; ++i) {
      avD[i] = avC[i]; bvD[i] = bvC[i]; gvD[i] = gvC[i];
      xcC[i] = xcB[i]; gvC[i] = gvB[i];
      xcB[i] = xcA[i]; gvB[i] = gvA[i];
    }
    __syncthreads();
  }
}

DI void attn_unit(KP p, char* smem, int b, int hd, int qb) {
  const int tid = threadIdx.x, lane = tid & 63, wave = __builtin_amdgcn_readfirstlane(tid >> 6);
  const int l31 = lane & 31, lh = lane >> 5;
  const int q0 = qb * 256 + wave * 32;
  const size_t bh = (size_t)(b * 8 + hd);
  const int nkt = qb * 4 + 4;
  const int qidx = q0 + l31;
  const int skey = tid >> 3, schn = tid & 7;
  const int rkey = (tid & 255) >> 2, rchn = tid & 3;
  const u16* kn_src = p.Kn + (bh * SEQ + skey) * 64 + schn * 8;
  const u16* kr_src = p.Kr + ((size_t)b * SEQ + rkey) * 32 + rchn * 8;
  const u16* vt_src = p.Vt + (bh * 64 + skey) * SEQ + schn * 8;
  u32x4 rk, rr, rv;
  rk = *(const u32x4*)(kn_src); rv = *(const u32x4*)(vt_src);
  if (tid < 256) rr = *(const u32x4*)(kr_src);
  bf16x8 qf[6];
  {
    const bf16x8* qp = (const bf16x8*)(p.Q + (bh * SEQ + q0 + l31) * 96 + 8 * lh);
#pragma unroll
    for (int ks = 0; ks < 6; ++ks) qf[ks] = qp[2 * ks];
  }
  __syncthreads();
  {
    u16* Kl = (u16*)smem; u16* Vl = (u16*)(smem + 13312);
    *(u32x4*)(Kl + skey * 104 + schn * 8) = rk;
    if (tid < 256) *(u32x4*)(Kl + rkey * 104 + 64 + rchn * 8) = rr;
    *(u32x4*)(Vl + skey * 72 + schn * 8) = rv;
  }
  __syncthreads();
  f32x16 o0 = zero16(), o1 = zero16();
  float m_run = -1e30f, l_run = 0.f;
  for (int kt = 0; kt < nkt; ++kt) {
    const u16* Kl = (const u16*)(smem + (kt & 1) * 22528);
    const u16* Vl = (const u16*)(smem + (kt & 1) * 22528 + 13312);
    const bool more = (kt + 1) < nkt;
    if (more) {
      rk = *(const u32x4*)(kn_src + (size_t)(kt + 1) * 64 * 64);
      rv = *(const u32x4*)(vt_src + (kt + 1) * 64);
      if (tid < 256) rr = *(const u32x4*)(kr_src + (size_t)(kt + 1) * 64 * 32);
    }
    if (kt * 64 <= q0 + 31) {
      f32x16 s[2];
      bf16x8 kfr[2][6];
#pragma unroll
      for (int st = 0; st < 2; ++st) {
        const bf16x8* kp = (const bf16x8*)(Kl + (st * 32 + l31) * 104 + 8 * lh);
#pragma unroll
        for (int ks = 0; ks < 6; ++ks) kfr[st][ks] = kp[2 * ks];
      }
#pragma unroll
      for (int st = 0; st < 2; ++st) {
        s[st] = zero16();
#pragma unroll
        for (int ks = 0; ks < 6; ++ks) s[st] = MFMA32(kfr[st][ks], qf[ks], s[st]);
      }
      u32x2 vfr[2][4][2];
#pragma unroll
      for (int dt = 0; dt < 2; ++dt)
#pragma unroll
        for (int c4 = 0; c4 < 4; ++c4) {
          const int kbase = c4 * 16 + 4 * lh;
          vfr[dt][c4][0] = *(const u32x2*)(Vl + (dt * 32 + l31) * 72 + kbase);
          vfr[dt][c4][1] = *(const u32x2*)(Vl + (dt * 32 + l31) * 72 + kbase + 8);
        }
      if (kt * 64 + 63 > q0) {
#pragma unroll
        for (int st = 0; st < 2; ++st)
#pragma unroll
          for (int r = 0; r < 16; ++r) { const int key = kt * 64 + st * 32 + crow(r, lh); if (key > qidx) s[st][r] = -1e30f; }
      }
      float mloc = s[0][0];
#pragma unroll
      for (int st = 0; st < 2; ++st)
#pragma unroll
        for (int r = 0; r < 16; ++r) mloc = fmaxf(mloc, s[st][r]);
      mloc = max_xor32(mloc);
      const float m_new = fmaxf(m_run, mloc);
      const float alpha = __builtin_amdgcn_exp2f(m_run - m_new);
      m_run = m_new;
      float lsum = 0.f;
#pragma unroll
      for (int st = 0; st < 2; ++st)
#pragma unroll
        for (int r = 0; r < 16; ++r) { const float e = __builtin_amdgcn_exp2f(s[st][r] - m_new); s[st][r] = e; lsum += e; }
      l_run = l_run * alpha + lsum;
#pragma unroll
      for (int r = 0; r < 16; ++r) { o0[r] *= alpha; o1[r] *= alpha; }
#pragma unroll
      for (int st = 0; st < 2; ++st)
#pragma unroll
        for (int s2 = 0; s2 < 2; ++s2) {
          u32x4 pw;
#pragma unroll
          for (int j = 0; j < 4; ++j) pw[j] = pk2(s[st][8 * s2 + 2 * j], s[st][8 * s2 + 2 * j + 1]);
          const bf16x8 pf = __builtin_bit_cast(bf16x8, pw);
          const int c4 = st * 2 + s2;
          {
            u32x4 vv; vv[0] = vfr[0][c4][0][0]; vv[1] = vfr[0][c4][0][1]; vv[2] = vfr[0][c4][1][0]; vv[3] = vfr[0][c4][1][1];
            o0 = MFMA32(__builtin_bit_cast(bf16x8, vv), pf, o0);
          }
          {
            u32x4 vv; vv[0] = vfr[1][c4][0][0]; vv[1] = vfr[1][c4][0][1]; vv[2] = vfr[1][c4][1][0]; vv[3] = vfr[1][c4][1][1];
            o1 = MFMA32(__builtin_bit_cast(bf16x8, vv), pf, o1);
          }
        }
    }
    if (more) {
      u16* Kn2 = (u16*)(smem + ((kt + 1) & 1) * 22528); u16* Vn2 = (u16*)(smem + ((kt + 1) & 1) * 22528 + 13312);
      *(u32x4*)(Kn2 + skey * 104 + schn * 8) = rk;
      if (tid < 256) *(u32x4*)(Kn2 + rkey * 104 + 64 + rchn * 8) = rr;
      *(u32x4*)(Vn2 + skey * 72 + schn * 8) = rv;
    }
    __syncthreads();
  }
  const float ltot = sum_xor32(l_run);
  const float inv = 1.f / ltot;
  float ss = 0.f;
  u16* yrow = p.y + ((size_t)b * SEQ + qidx) * 1024 + 512 + hd * 64;
#pragma unroll
  for (int g = 0; g < 4; ++g) {
    float v0[4], v1[4];
#pragma unroll
    for (int q = 0; q < 4; ++q) { v0[q] = o0[4 * g + q] * inv; v1[q] = o1[4 * g + q] * inv; ss += v0[q] * v0[q] + v1[q] * v1[q]; }
    u32x2 a; a[0] = pk2(v0[0], v0[1]); a[1] = pk2(v0[2], v0[3]);
    u32x2 c2; c2[0] = pk2(v1[0], v1[1]); c2[1] = pk2(v1[2], v1[3]);
    *(u32x2*)(yrow + 8 * g + 4 * lh) = a;
    *(u32x2*)(yrow + 32 + 8 * g + 4 * lh) = c2;
  }
  ss = sum_xor32(ss);
  if (lh == 0) unsafeAtomicAdd(p.ssq_mla + (size_t)b * SEQ + qidx, ss);
}

DI void phase2(KP p, char* smem) {
  for (int item = blockIdx.x; item < 256; item += gridDim.x) lru_item(p, smem, item);
  for (int it = blockIdx.x; it < 1024; it += gridDim.x) {
    const int j = it & 3; const int bh = it >> 2; const int hd = bh & 7; const int b = bh >> 3;
    attn_unit(p, smem, b, hd, 7 - j);
    attn_unit(p, smem, b, hd, j);
  }
}

DI void sort128_asc(unsigned& k0, unsigned& k1, int lane) {
#pragma unroll
  for (int k = 2; k <= 128; k <<= 1) {
#pragma unroll
    for (int j = k >> 1; j > 0; j >>= 1) {
      if (j == 64) {
        const unsigned lo = k0 < k1 ? k0 : k1, hi = k0 < k1 ? k1 : k0; k0 = lo; k1 = hi;
      } else {
        const unsigned o0 = (j == 1) ? lane_xor_u<1>(k0, lane) : (j == 2) ? lane_xor_u<2>(k0, lane) : (j == 4) ? lane_xor_u<4>(k0, lane) : (j == 8) ? lane_xor_u<8>(k0, lane) : (j == 16) ? lane_xor_u<16>(k0, lane) : lane_xor_u<32>(k0, lane);
        const unsigned o1 = (j == 1) ? lane_xor_u<1>(k1, lane) : (j == 2) ? lane_xor_u<2>(k1, lane) : (j == 4) ? lane_xor_u<4>(k1, lane) : (j == 8) ? lane_xor_u<8>(k1, lane) : (j == 16) ? lane_xor_u<16>(k1, lane) : lane_xor_u<32>(k1, lane);
        const bool lower = (lane & j) == 0;
        const bool asc0 = (k == 128) ? true : ((lane & k) == 0);
        const bool asc1 = (k == 128) ? true : (k == 64 ? false : ((lane & k) == 0));
        const unsigned mn0 = k0 < o0 ? k0 : o0, mx0 = k0 < o0 ? o0 : k0;
        const unsigned mn1 = k1 < o1 ? k1 : o1, mx1 = k1 < o1 ? o1 : k1;
        k0 = (asc0 == lower) ? mn0 : mx0;
        k1 = (asc1 == lower) ? mn1 : mx1;
      }
    }
  }
}
#if QBITS == 8
typedef u32x4 qrow_t;
#else
typedef u32x2 qrow_t;
#endif
constexpr int QROWB = (QBITS == 8) ? 1024 : 512;
DI void ga_load(__amdgpu_buffer_rsrc_t rs, int iv, int gl, int voff_u, int voff_v, qrow_t (&uq)[8], qrow_t (&vq)[8]) {
#pragma unroll
  for (int k = 0; k < 8; ++k) {
    const int so = __builtin_amdgcn_readlane(iv, gl + k);
#if QBITS == 8
    uq[k] = __builtin_amdgcn_raw_buffer_load_b128(rs, voff_u, so, 0);
    vq[k] = __builtin_amdgcn_raw_buffer_load_b128(rs, voff_v, so, 0);
#else
    const u32x4 rec = __builtin_amdgcn_raw_buffer_load_b128(rs, voff_u, so, 16);
    uq[k] = (u32x2){rec[0], rec[1]}; vq[k] = (u32x2){rec[2], rec[3]};
#endif
  }
}
DI unsigned qword(const qrow_t& r, int j) {
#if QBITS == 8
  return r[j];
#else
  const unsigned w0 = r[j >> 1];
  return (j & 1) ? ((w0 >> 4) & 0x0f0f0f0fu) : (w0 & 0x0f0f0f0fu);
#endif
}
#if QBITS == 8
typedef f32x2 oacc_t;
constexpr float OACC_SCALE = 1.f;
#else
typedef h16x2 oacc_t;
constexpr float OACC_SCALE = 16.f;
#endif
DI void ga_compute(float gsel, float asel, float bsel, int gl, int lane, float kt, float hscale, const unsigned (&hq)[4],
                   const qrow_t (&uq)[8], const qrow_t (&vq)[8], oacc_t (&oacc)[8], float& csum) {
  const float mg = __shfl(gsel, gl + (lane >> 3));
  const float ma = __shfl(asel, gl + (lane >> 3));
  const float mb = __shfl(bsel, gl + (lane >> 3));
  float pp[8];
#pragma unroll
  for (int k = 0; k < 8; ++k) {
#if QBITS == 8
    unsigned d = 0;
#pragma unroll
    for (int j = 0; j < 4; ++j) d = __builtin_amdgcn_udot4(qword(uq[k], j), hq[j], d, false);
#else
    unsigned dh = __builtin_amdgcn_udot8(uq[k][0], hq[0], 0u, false); dh = __builtin_amdgcn_udot8(uq[k][1], hq[1], dh, false);
    unsigned dl = __builtin_amdgcn_udot8(uq[k][0], hq[2], 0u, false); dl = __builtin_amdgcn_udot8(uq[k][1], hq[3], dl, false);
    const unsigned d = dh * 16u + dl;
#endif
    pp[k] = (float)d;
  }
  const float s1 = reduce8(pp, lane);
  const float pre = hscale * (ma * (s1 - kt) - mb);
  const float cf = mg * gelu_tanh(pre);
  csum += cf;
#if QBITS != 8
  const _Float16 cfs = (_Float16)(cf * OACC_SCALE);
  const unsigned cfp = __builtin_bit_cast(unsigned, (h16x2){cfs, cfs});
#endif
#pragma unroll
  for (int k = 0; k < 8; ++k) {
#if QBITS == 8
    const float c = __uint_as_float(__builtin_amdgcn_readlane(__float_as_uint(cf), 8 * k));
    const f32x2 cc = {c, c};
#pragma unroll
    for (int j = 0; j < 4; ++j) {
      unsigned w = qword(vq[k], j);
      asm volatile("" : "+v"(w));
      const f32x2 v0 = {(float)(w & 255u), (float)((w >> 8) & 255u)}, v1 = {(float)((w >> 16) & 255u), (float)(w >> 24)};
      oacc[2 * j] = v0 * cc + oacc[2 * j];
      oacc[2 * j + 1] = v1 * cc + oacc[2 * j + 1];
    }
#else
    const h16x2 cc = __builtin_bit_cast(h16x2, (unsigned)__builtin_amdgcn_readlane((int)cfp, 8 * k));
#pragma unroll
    for (int jd = 0; jd < 2; ++jd) {
      const unsigned w = vq[k][jd];
      oacc[4 * jd + 0] = __builtin_amdgcn_cvt_scalef32_pk_f16_fp4(w, 1.0f, 0) * cc + oacc[4 * jd + 0];
      oacc[4 * jd + 1] = __builtin_amdgcn_cvt_scalef32_pk_f16_fp4(w, 1.0f, 1) * cc + oacc[4 * jd + 1];
      oacc[4 * jd + 2] = __builtin_amdgcn_cvt_scalef32_pk_f16_fp4(w, 1.0f, 2) * cc + oacc[4 * jd + 2];
      oacc[4 * jd + 3] = __builtin_amdgcn_cvt_scalef32_pk_f16_fp4(w, 1.0f, 3) * cc + oacc[4 * jd + 3];
    }
#endif
  }
}

DI void ins16(float (&lst)[16], float x) {
#pragma unroll
  for (int i = 0; i < 16; ++i) { const float hi = fmaxf(lst[i], x); x = fminf(lst[i], x); lst[i] = hi; }
}
DI void ce_desc(float& a, float& b) { const float hi = fmaxf(a, b), lo = fminf(a, b); a = hi; b = lo; }
DI void sort16_desc(float (&a)[16]) {
#pragma unroll
  for (int k = 2; k <= 16; k <<= 1)
#pragma unroll
    for (int j = k >> 1; j > 0; j >>= 1)
#pragma unroll
      for (int i = 0; i < 16; ++i) {
        const int l = i ^ j;
        if (l > i) {
          if ((i & k) == 0) ce_desc(a[i], a[l]); else ce_desc(a[l], a[i]);
        }
      }
}
DI void merge16_desc(float (&x)[16], const float (&y)[16]) {
#pragma unroll
  for (int i = 0; i < 16; ++i) x[i] = fmaxf(x[i], y[15 - i]);
#pragma unroll
  for (int d = 8; d >= 1; d >>= 1)
#pragma unroll
    for (int i = 0; i < 16; ++i)
      if ((i & d) == 0) ce_desc(x[i], x[i + d]);
}
DI void merge_partner(float (&lst)[16], int lane) {
  float o[16];
#pragma unroll
  for (int i = 0; i < 16; ++i) o[i] = other_xor32(lst[i], lane);
  float c[16];
#pragma unroll
  for (int i = 0; i < 16; ++i) c[i] = fmaxf(lst[i], o[15 - i]);
#pragma unroll
  for (int d = 8; d >= 1; d >>= 1) {
#pragma unroll
    for (int i = 0; i < 16; ++i) {
      if ((i & d) == 0) { const float hi = fmaxf(c[i], c[i + d]), lo = fminf(c[i], c[i + d]); c[i] = hi; c[i + d] = lo; }
    }
  }
#pragma unroll
  for (int i = 0; i < 16; ++i) lst[i] = c[i];
}

DI void phase3(KP p, char* smem) {
  const int tid = threadIdx.x, wave = __builtin_amdgcn_readfirstlane(tid >> 6);
  u16* A = (u16*)smem;
  float* ssq2 = (float*)(smem + 132096);
  signed char* A8 = (signed char*)smem;
  float* hs = (float*)(smem + 132096 + 256);
  char* scr = p.scratch + (size_t)blockIdx.x * 655360;
  float* x1s = (float*)scr;
  u16* qp = (u16*)(scr + 262144);
  int* eidx = (int*)(scr + 524288);
  float* egate = (float*)(scr + 524288 + 32768);
  float* eus = (float*)(scr + 524288 + 65536);
  float* eub = (float*)(scr + 524288 + 98304);
  for (int tile = blockIdx.x; tile < NTOK / 64; tile += gridDim.x) {
    int lane_o = tid & 63; asm volatile("" : "+v"(lane_o));
    const int lane = lane_o, l31 = lane & 31, lh = lane >> 5;
    const int tok0 = tile * 64; const int b = tok0 / SEQ;
    const float* modb = p.mod + (size_t)b * 6144;
    if (tid < 64) ssq2[tid] = 0.f;
#pragma unroll 2
    for (int rr = 0; rr < 8; ++rr) {
      const int row = wave * 8 + rr; const int tok = tok0 + row;
      const float rl = rsqrtf(p.ssq_lru[tok] * (1.f / 512.f) + EPS), rm = rsqrtf(p.ssq_mla[tok] * (1.f / 512.f) + EPS);
#pragma unroll
      for (int i = 0; i < 2; ++i) {
        const u32x4 v = *(const u32x4*)(p.y + (size_t)tok * 1024 + (i * 64 + lane) * 8);
        const float sc = i == 0 ? rl : rm;
        u32x4 o;
#pragma unroll
        for (int j = 0; j < 4; ++j) o[j] = pk2(bflo(v[j]) * sc, bfhi(v[j]) * sc);
        *(u32x4*)(A + row * LDA + (i * 64 + lane) * 8) = o;
      }
    }
    __syncthreads();
    float sqa[32];
#pragma unroll
    for (int i = 0; i < 32; ++i) sqa[i] = 0.f;
    bf16x8 ring3[8][2];
    { const int tl0[2] = {wave, wave + 8}; gemm_pro<2, 8>(p.Wf_out, 64, tl0, lane, ring3); }
#pragma unroll 1
    for (int pass = 0; pass < 2; ++pass) {
      f32x16 acc[2][2];
#pragma unroll
      for (int t = 0; t < 2; ++t) { acc[t][0] = zero16(); acc[t][1] = zero16(); }
      const int tl[2] = {pass * 16 + wave, pass * 16 + wave + 8};
      gemm_main<2, 8, false, true>(A, LDA, 64, p.Wf_out, 64, tl, acc, lane, ring3);
      if (pass == 0) { const int tn[2] = {16 + wave, 16 + wave + 8}; gemm_pro<2, 8>(p.Wf_out, 64, tn, lane, ring3); }
      int el_ = lane; asm volatile("" : "+v"(el_));
      const int l31 = el_ & 31, lh = el_ >> 5;
      float g1[2];
#pragma unroll
      for (int t = 0; t < 2; ++t) g1[t] = modb[2048 + tl[t] * 32 + l31];
#pragma unroll
      for (int rt = 0; rt < 2; ++rt)
#pragma unroll
        for (int r = 0; r < 16; ++r) {
          const int row = rt * 32 + crow(r, lh);
#pragma unroll
          for (int t = 0; t < 2; ++t) {
            const int col = tl[t] * 32 + l31;
            const float v = p.x[(size_t)(tok0 + row) * DM + col] + g1[t] * acc[t][rt][r];
            x1s[row * 1024 + col] = v;
            sqa[rt * 16 + r] += v * v;
          }
        }
    }
    {
      const float tot = reduce32(sqa, lane);
      const int l31 = lane & 31, lh = lane >> 5;
      __hip_atomic_fetch_add(&ssq2[(l31 >> 4) * 32 + crow(l31 & 15, lh)], tot, __ATOMIC_RELAXED, __HIP_MEMORY_SCOPE_WORKGROUP);
    }
    __syncthreads();
    {
      f32x4 cm[4], ca[4];
#pragma unroll
      for (int i = 0; i < 4; ++i) {
        const int col = (i >> 1) * 512 + lane * 8 + (i & 1) * 4;
        const f32x4 g = *(const f32x4*)(p.norm2_g + col); const f32x4 sc = *(const f32x4*)(modb + 4096 + col);
        cm[i] = g * (sc + 1.0f); ca[i] = *(const f32x4*)(modb + 3072 + col);
      }
#pragma unroll 2
      for (int rr = 0; rr < 8; ++rr) {
        const int row = wave * 8 + rr;
        const float rs = rsqrtf(ssq2[row] * (1.f / 1024.f) + EPS);
        f32x4 hv[4];
        float hmax = 0.f;
#pragma unroll
        for (int i = 0; i < 2; ++i) {
          const f32x4 xa = *(const f32x4*)(x1s + row * 1024 + i * 512 + lane * 8), xb = *(const f32x4*)(x1s + row * 1024 + i * 512 + lane * 8 + 4);
          hv[2 * i] = xa * rs * cm[2 * i] + ca[2 * i]; hv[2 * i + 1] = xb * rs * cm[2 * i + 1] + ca[2 * i + 1];
#pragma unroll
          for (int j = 0; j < 4; ++j) hmax = fmaxf(hmax, fmaxf(fabsf(hv[2 * i][j]), fabsf(hv[2 * i + 1][j])));
        }
        hmax = wave_max(hmax);
        const float hinv = hmax > 0.f ? 127.f / hmax : 0.f;
#pragma unroll
        for (int i = 0; i < 2; ++i) {
          u32x2 o;
#pragma unroll
          for (int hh = 0; hh < 2; ++hh) {
            unsigned w = 0;
#pragma unroll
            for (int j = 0; j < 4; ++j) w |= ((unsigned)(int)__builtin_rintf(hv[2 * i + hh][j] * hinv) & 255u) << (8 * j);
            o[hh] = w;
          }
          *(u32x2*)(A8 + row * LDA8 + i * 512 + lane * 8) = o;
        }
        if (lane == 0) hs[row] = hmax * (1.f / 127.f);
      }
    }
    __syncthreads();
    float s12[2][16];
#pragma unroll 1
    for (int ph = 0; ph < 2; ++ph) {
      const int hd = wave;
      float lst0[16], lst1[16];
#pragma unroll
      for (int i = 0; i < 16; ++i) { lst0[i] = -3.0e38f; lst1[i] = -3.0e38f; }
#pragma unroll 1
      for (int mtp = 0; mtp < 2; ++mtp) {
        i32x16 acc[2][2];
#pragma unroll
        for (int t = 0; t < 2; ++t)
#pragma unroll
          for (int r = 0; r < 16; ++r) { acc[t][0][r] = 0; acc[t][1][r] = 0; }
        const int tl[2] = {(hd * 2 + ph) * 4 + 2 * mtp, (hd * 2 + ph) * 4 + 2 * mtp + 1};
        gemm8_core<2, 8>(A8, LDA8, 32, p.Wf_s, 32, tl, acc, lane);
        int el_ = lane; asm volatile("" : "+v"(el_));
        const int lh = el_ >> 5;
#pragma unroll
        for (int t = 0; t < 2; ++t) {
          f32x4 w4[4];
#pragma unroll
          for (int g = 0; g < 4; ++g) w4[g] = *(const f32x4*)(p.wsc + tl[t] * 32 + 8 * g + 4 * lh);
          float nv[16];
#pragma unroll
          for (int r = 0; r < 16; ++r) nv[r] = __uint_as_float((__float_as_uint((float)acc[t][0][r] * w4[r >> 2][r & 3]) & 0xffffff80u) | (unsigned)((2 * mtp + t) * 32 + crow(r, lh)));
          sort16_desc(nv);
          merge16_desc(lst0, nv);
#pragma unroll
          for (int r = 0; r < 16; ++r) nv[r] = __uint_as_float((__float_as_uint((float)acc[t][1][r] * w4[r >> 2][r & 3]) & 0xffffff80u) | (unsigned)((2 * mtp + t) * 32 + crow(r, lh)));
          sort16_desc(nv);
          merge16_desc(lst1, nv);
        }
      }
      merge_partner(lst0, lane);
      merge_partner(lst1, lane);
      if (ph == 0) {
#pragma unroll
        for (int i = 0; i < 16; ++i) s12[0][i] = lh ? lst1[i] : lst0[i];
      } else {
#pragma unroll
        for (int i = 0; i < 16; ++i) s12[1][i] = lh ? lst1[i] : lst0[i];
      }
    }
    {
      const int hd = wave;
      unsigned long long t1lo = 0, t1hi = 0, t2lo = 0, t2hi = 0;
#pragma unroll
      for (int i = 0; i < 8; ++i) {
        t1lo |= (unsigned long long)(__float_as_uint(s12[0][i]) & 127u) << (8 * i);
        t1hi |= (unsigned long long)(__float_as_uint(s12[0][8 + i]) & 127u) << (8 * i);
        t2lo |= (unsigned long long)(__float_as_uint(s12[1][i]) & 127u) << (8 * i);
        t2hi |= (unsigned long long)(__float_as_uint(s12[1][8 + i]) & 127u) << (8 * i);
      }
      const float hst = hs[lh * 32 + l31];
      float bv[16];
#pragma unroll
      for (int j = 0; j < 16; ++j) {
        const float sv = (s12[0][0] + s12[1][j]) * hst;
        bv[j] = __uint_as_float((__float_as_uint(sv) & 0xffffff00u) | (unsigned)j);
      }
#pragma unroll
      for (int i = 1; i < 16; ++i) {
#pragma unroll
        for (int j = 0; j < 16; ++j)
          if ((i + 1) * (j + 1) <= 16) {
            const float sv = (s12[0][i] + s12[1][j]) * hst;
            ins16(bv, __uint_as_float((__float_as_uint(sv) & 0xffffff00u) | (unsigned)(i * 16 + j)));
          }
      }
      int bi[16];
#pragma unroll
      for (int k = 0; k < 16; ++k) {
        const unsigned code = __float_as_uint(bv[k]) & 255u;
        const unsigned ci = code >> 4, cj = code & 15u;
        const unsigned long long w1 = (ci & 8u) ? t1hi : t1lo, w2 = (cj & 8u) ? t2hi : t2lo;
        const unsigned i1 = (unsigned)(w1 >> ((ci & 7u) * 8)) & 0xffu, i2 = (unsigned)(w2 >> ((cj & 7u) * 8)) & 0xffu;
        bi[k] = (int)(i1 * 128u + i2);
      }
      float esum = 0.f, ev[16];
#pragma unroll
      for (int i = 0; i < 16; ++i) { ev[i] = __expf(bv[i] - bv[0]); esum += ev[i]; }
      const float einv = 1.f / esum;
      {
        const int row = lh * 32 + l31;
#pragma unroll
        for (int i4 = 0; i4 < 4; ++i4) {
          f32x4 sc[4];
#pragma unroll
          for (int q = 0; q < 4; ++q) sc[q] = ((const f32x4*)p.uscale)[bi[i4 * 4 + q]];
          typedef int i32x4 __attribute__((ext_vector_type(4)));
          *(i32x4*)(eidx + row * 128 + hd * 16 + i4 * 4) = (i32x4){bi[i4 * 4], bi[i4 * 4 + 1], bi[i4 * 4 + 2], bi[i4 * 4 + 3]};
          *(f32x4*)(egate + row * 128 + hd * 16 + i4 * 4) = (f32x4){ev[i4 * 4] * einv * sc[0][1], ev[i4 * 4 + 1] * einv * sc[1][1], ev[i4 * 4 + 2] * einv * sc[2][1], ev[i4 * 4 + 3] * einv * sc[3][1]};
          *(f32x4*)(eus + row * 128 + hd * 16 + i4 * 4) = (f32x4){sc[0][0], sc[1][0], sc[2][0], sc[3][0]};
          *(f32x4*)(eub + row * 128 + hd * 16 + i4 * 4) = (f32x4){sc[0][2], sc[1][2], sc[2][2], sc[3][2]};
        }
      }
    }
    __syncthreads();
    const __amdgpu_buffer_rsrc_t qrs = __builtin_amdgcn_make_buffer_rsrc((void*)p.Uq, 0, 2 * 16384 * QROWB, 0x00020000);
    const int voff_u = (QBITS == 8) ? lane * 16 : lane * 16, voff_v = voff_u + 16384 * QROWB;
    int n_ia, n_ib; float n_ga, n_gb, n_ua, n_ub, n_ba, n_bb, n_kt, n_hscale; unsigned n_hq[4];
    qrow_t bufA_u[8], bufA_v[8], bufB_u[8], bufB_v[8];
#define GA_PREP(ROW)                                                                                                              \
    {                                                                                                                             \
      const int prow = (ROW);                                                                                                     \
      n_ia = eidx[prow * 128 + lane]; n_ib = eidx[prow * 128 + 64 + lane];                                                        \
      n_ga = egate[prow * 128 + lane]; n_gb = egate[prow * 128 + 64 + lane];                                                      \
      n_ua = eus[prow * 128 + lane]; n_ub = eus[prow * 128 + 64 + lane];                                                          \
      n_ba = eub[prow * 128 + lane]; n_bb = eub[prow * 128 + 64 + lane];                                                          \
      {     \
        unsigned k0 = ((unsigned)n_ia << 7) | (unsigned)lane, k1 = ((unsigned)n_ib << 7) | (unsigned)(64 + lane);                 \
        sort128_asc(k0, k1, lane);                                                                                                \
        const int p0 = (int)(k0 & 127u), p1 = (int)(k1 & 127u);                                                                   \
        const float ga0 = __shfl(n_ga, p0 & 63), gb0 = __shfl(n_gb, p0 & 63), ga1 = __shfl(n_ga, p1 & 63), gb1 = __shfl(n_gb, p1 & 63); \
        const float ua0 = __shfl(n_ua, p0 & 63), ub0 = __shfl(n_ub, p0 & 63), ua1 = __shfl(n_ua, p1 & 63), ub1 = __shfl(n_ub, p1 & 63); \
        const float ba0 = __shfl(n_ba, p0 & 63), bb0 = __shfl(n_bb, p0 & 63), ba1 = __shfl(n_ba, p1 & 63), bb1 = __shfl(n_bb, p1 & 63); \
        n_ia = (int)(k0 >> 7) * (QBITS == 8 ? QROWB : 2 * QROWB); n_ib = (int)(k1 >> 7) * (QBITS == 8 ? QROWB : 2 * QROWB);       \
        n_ga = (p0 & 64) ? gb0 : ga0; n_gb = (p1 & 64) ? gb1 : ga1;                                                               \
        n_ua = (p0 & 64) ? ub0 : ua0; n_ub = (p1 & 64) ? ub1 : ua1;                                                               \
        n_ba = (p0 & 64) ? bb0 : ba0; n_bb = (p1 & 64) ? bb1 : ba1;                                                               \
      }                                                                                                                           \
      u32x4 hc = *(const u32x4*)(A8 + prow * LDA8 + lane * 16);        \
      _Pragma("unroll") for (int j = 0; j < 4; ++j) hc[j] ^= 0x80808080u;                                                         \
      n_hscale = hs[prow];                                                                                                        \
      unsigned hsi = 0;                                                                                                           \
      _Pragma("unroll") for (int j = 0; j < 4; ++j) hsi = __builtin_amdgcn_udot4(hc[j], 0x01010101u, hsi, false);                 \
      const float hsum = (float)hsi;                                                                                              \
      if (QBITS == 8) {                                                                                                           \
        _Pragma("unroll") for (int j = 0; j < 4; ++j) n_hq[j] = hc[j];                                                            \
      } else {               \
        _Pragma("unroll") for (int jd = 0; jd < 2; ++jd) {                                                                        \
          n_hq[jd] = ((hc[2 * jd] >> 4) & 0x0f0f0f0fu) | (hc[2 * jd + 1] & 0xf0f0f0f0u);                                          \
          n_hq[2 + jd] = (hc[2 * jd] & 0x0f0f0f0fu) | ((hc[2 * jd + 1] & 0x0f0f0f0fu) << 4);                                      \
        }                                                                                                                         \
      }                                                                                                                           \
      n_kt = (QBITS == 8 ? 128.f : 7.5f) * (wave_sum(hsum) - 131072.f);                                                           \
    }
    GA_PREP(wave)
    ga_load(qrs, n_ia, 0, voff_u, voff_v, bufA_u, bufA_v);
#pragma unroll 1
    for (int rr = 0; rr < 8; ++rr) {
      const int row = rr * 8 + wave; const int tok = tok0 + row;
      const int ia = n_ia, ib = n_ib; const float ga = n_ga, gb = n_gb, ua = n_ua, ub = n_ub, ba = n_ba, bb = n_bb, kt = n_kt, hscale = n_hscale;
      unsigned hq[4];
#pragma unroll
      for (int j = 0; j < 4; ++j) hq[j] = n_hq[j];
      f32x4 xv4[4];
#pragma unroll
      for (int q = 0; q < 4; ++q) xv4[q] = *(const f32x4*)(x1s + row * 1024 + lane * 16 + q * 4);
      if (rr + 1 < 8) GA_PREP(row + 8)
      oacc_t oacc[8];
#pragma unroll
      for (int j = 0; j < 8; ++j) { oacc[j][0] = 0; oacc[j][1] = 0; }
      float csum = 0.f;
#pragma unroll 1
      for (int half = 0; half < 2; ++half) {
        const int iv = half ? ib : ia, ivn = half ? n_ia : ib;
        const float gs = half ? gb : ga, us = half ? ub : ua, bs = half ? bb : ba;
        const bool has_next = (half == 0) || (rr + 1 < 8);
#pragma unroll 1
        for (int g8 = 0; g8 < 8; g8 += 2) {
          ga_load(qrs, iv, (g8 + 1) * 8, voff_u, voff_v, bufB_u, bufB_v);
          ga_compute(gs, us, bs, g8 * 8, lane, kt, hscale, hq, bufA_u, bufA_v, oacc, csum);
          if (g8 + 2 < 8) ga_load(qrs, iv, (g8 + 2) * 8, voff_u, voff_v, bufA_u, bufA_v);
          else if (has_next) ga_load(qrs, ivn, 0, voff_u, voff_v, bufA_u, bufA_v);
          ga_compute(gs, us, bs, (g8 + 1) * 8, lane, kt, hscale, hq, bufB_u, bufB_v, oacc, csum);
        }
      }
      {
#if QBITS == 8
        const float corr = wave_sum(csum) * (128.f / 8.f);
#pragma unroll
        for (int j = 0; j < 8; ++j) oacc[j] = oacc[j] - corr;
#endif
      }
      float xo[16]; float ss = 0.f;
#pragma unroll
      for (int q = 0; q < 4; ++q) {
        const int col = lane * 16 + q * 4;
        const f32x4 xv = xv4[q];
        const f32x4 g2 = *(const f32x4*)(modb + 5120 + col);
#pragma unroll
        for (int j = 0; j < 4; ++j) { const float v = xv[j] + g2[j] * ((float)oacc[q * 2 + (j >> 1)][j & 1] * (1.f / OACC_SCALE)); xo[q * 4 + j] = v; ss += v * v; }
      }
      ss = wave_sum(ss);
      const float rs = rsqrtf(ss * (1.f / 1024.f) + EPS);
#pragma unroll
      for (int q = 0; q < 4; ++q) {
        const int col = lane * 16 + q * 4;
        const f32x4 fg = *(const f32x4*)(p.final_g + col);
        f32x4 o;
#pragma unroll
        for (int j = 0; j < 4; ++j) o[j] = xo[q * 4 + j] * rs * fg[j];
        *(f32x4*)(p.out + (size_t)tok * DM + col) = o;
      }
    }
#undef GA_PREP
    __syncthreads();
  }
}

template <int MODE>
__global__ void __launch_bounds__(NTHREADS) mk_fwd(Params p) {
  extern __shared__ __attribute__((aligned(16))) char smem[];
  if (MODE < 0) {
    cg::grid_group grid = cg::this_grid();
    typedef const __attribute__((address_space(4))) Params* KPP;
    { KPP kp = (KPP)__builtin_amdgcn_kernarg_segment_ptr(); asm volatile("" : "+s"(kp)); phase0(*kp, smem); }
    grid.sync();
    { KPP kp = (KPP)__builtin_amdgcn_kernarg_segment_ptr(); asm volatile("" : "+s"(kp)); phase1(*kp, smem); }
    grid.sync();
    { KPP kp = (KPP)__builtin_amdgcn_kernarg_segment_ptr(); asm volatile("" : "+s"(kp)); phase2(*kp, smem); }
    grid.sync();
    { KPP kp = (KPP)__builtin_amdgcn_kernarg_segment_ptr(); asm volatile("" : "+s"(kp)); phase3(*kp, smem); }
#ifdef PROBE_P3X2
    grid.sync();
    phase3(p, smem);
#endif
#ifdef PROBE_P1X2
    grid.sync();
    phase1(p, smem);
#endif
  } else {
    typedef const __attribute__((address_space(4))) Params* KPP;
    KPP kp = (KPP)__builtin_amdgcn_kernarg_segment_ptr();
    if (MODE == 0) phase0(*kp, smem);
    if (MODE == 1) phase1(*kp, smem);
    if (MODE == 2) phase2(*kp, smem);
    if (MODE == 3) phase3(*kp, smem);
  }
}

static size_t align_up(size_t v) { return (v + 255) & ~(size_t)255; }

extern "C" void kernel_launch(void* const* d_in, const int* in_sizes, int n_in, void* d_out, int out_size, void* d_ws, size_t ws_size, hipStream_t stream) {
  static int grid = 0;
  if (grid == 0) {
    int dev = 0, cus = 0, per_cu = 0;
    (void)hipGetDevice(&dev);
    (void)hipDeviceGetAttribute(&cus, hipDeviceAttributeMultiprocessorCount, dev);
#if N_LAUNCH_MODE == 1
    (void)hipFuncSetAttribute((const void*)mk_fwd<-1>, hipFuncAttributeMaxDynamicSharedMemorySize, LDS_BYTES);
    (void)hipOccupancyMaxActiveBlocksPerMultiprocessor(&per_cu, (const void*)mk_fwd<-1>, NTHREADS, LDS_BYTES);
#else
    (void)hipFuncSetAttribute((const void*)mk_fwd<0>, hipFuncAttributeMaxDynamicSharedMemorySize, LDS_BYTES);
    (void)hipFuncSetAttribute((const void*)mk_fwd<1>, hipFuncAttributeMaxDynamicSharedMemorySize, LDS_BYTES);
    (void)hipFuncSetAttribute((const void*)mk_fwd<2>, hipFuncAttributeMaxDynamicSharedMemorySize, LDS_BYTES);
    (void)hipFuncSetAttribute((const void*)mk_fwd<3>, hipFuncAttributeMaxDynamicSharedMemorySize, LDS_BYTES);
    (void)hipOccupancyMaxActiveBlocksPerMultiprocessor(&per_cu, (const void*)mk_fwd<3>, NTHREADS, LDS_BYTES);
#endif
    if (per_cu < 1) { fprintf(stderr, "kernel_launch: occupancy query says %d blocks/CU\n", per_cu); per_cu = 1; }
    if (per_cu > 1) per_cu = 1;
    grid = cus * per_cu;
    if (grid > 256) grid = 256;
    (void)hipGetLastError();
  }
  Params p{};
  const float* const* fin = (const float* const*)d_in;
  p.x = fin[0]; p.c = fin[1]; p.pos = (const int*)d_in[2];
  p.w_ada = fin[3]; p.b_ada = fin[4]; p.norm1_g = fin[5]; p.w_in = fin[6]; p.conv_w = fin[7]; p.conv_b = fin[8];
  p.lru_wa = fin[9]; p.lru_ba = fin[10]; p.lru_wx = fin[11]; p.lru_bx = fin[12]; p.lru_lambda = fin[13];
  p.q_norm_g = fin[14]; p.w_uq = fin[15]; p.kv_norm_g = fin[16]; p.w_ukv = fin[17]; p.lru_out_g = fin[18]; p.mla_out_g = fin[19];
  p.w_out = fin[20]; p.norm2_g = fin[21]; p.peer_wq = fin[22]; p.peer_keys = fin[23]; p.peer_u = fin[24]; p.peer_v = fin[25]; p.final_g = fin[26];
  p.out = (float*)d_out;
  char* w = (char*)d_ws; size_t off = 0;
  auto take = [&](size_t bytes) { char* r = w + off; off = align_up(off + bytes); return r; };
  p.mod = (float*)take((size_t)NB * 6144 * 4);
  p.ssq_lru = (float*)take((size_t)NTOK * 4);
  p.ssq_mla = (float*)take((size_t)NTOK * 4);
  p.invfreq = (double*)take(16 * 8);
  p.Wf_in = (bf16x8*)take((size_t)INW * 1024 * 2);
  p.Wf_uq = (bf16x8*)take((size_t)768 * 256 * 2);
  p.Wf_ukv = (bf16x8*)take((size_t)1024 * 128 * 2);
  p.Wf_a = (bf16x8*)take((size_t)8 * 64 * 64 * 2);
  p.Wf_x = (bf16x8*)take((size_t)8 * 64 * 64 * 2);
  p.Wf_out = (bf16x8*)take((size_t)1024 * 1024 * 2);
  p.Wf_s = (i32x4*)take((size_t)2048 * 1024);
  p.Wsf = (float*)take((size_t)2048 * 1024 * 4);
  p.wsmaxp = (float*)take((size_t)2048 * 16 * 4);
  p.wsc = (float*)take((size_t)2048 * 4);
  p.Uq = (unsigned char*)take((size_t)2 * 16384 * QROWB);
  p.Vq = p.Uq + (size_t)16384 * QROWB;
  p.uscale = (float*)take((size_t)16384 * 16);
  p.vscale = p.uscale; p.ubias = p.uscale;
  p.xlru = (u16*)take((size_t)NTOK * 512 * 2);
  p.gate = (u16*)take((size_t)NTOK * 512 * 2);
  p.Q = (u16*)take((size_t)NTOK * 768 * 2);
  p.Kn = (u16*)take((size_t)NTOK * 512 * 2);
  p.Kr = (u16*)take((size_t)NTOK * 32 * 2);
  p.Vt = (u16*)take((size_t)NTOK * 512 * 2);
  p.y = (u16*)take((size_t)NTOK * 1024 * 2);
  p.scratch = take((size_t)256 * 655360);
  if (off > ws_size) { fprintf(stderr, "kernel_launch: workspace too small: need %zu have %zu\n", off, ws_size); return; }
#if N_LAUNCH_MODE == 1
  void* args[] = {&p};
  hipError_t e = hipLaunchCooperativeKernel((const void*)mk_fwd<-1>, dim3(grid), dim3(NTHREADS), args, LDS_BYTES, stream);
  if (e != hipSuccess) fprintf(stderr, "cooperative launch failed: %s (grid %d)\n", hipGetErrorString(e), grid);
#else
  hipLaunchKernelGGL(mk_fwd<0>, dim3(grid), dim3(NTHREADS), LDS_BYTES, stream, p);
  hipLaunchKernelGGL(mk_fwd<1>, dim3(grid), dim3(NTHREADS), LDS_BYTES, stream, p);
  hipLaunchKernelGGL(mk_fwd<2>, dim3(grid), dim3(NTHREADS), LDS_BYTES, stream, p);
  hipLaunchKernelGGL(mk_fwd<3>, dim3(grid), dim3(NTHREADS), LDS_BYTES, stream, p);
#endif
}
```

```cpp
#include <hip/hip_runtime.h>
#include <hip/hip_cooperative_groups.h>
#include <cstdio>
#include <cstdint>
namespace cg = cooperative_groups;

#ifndef QBITS
#define QBITS 4
#endif
#ifndef N_LAUNCH_MODE
#define N_LAUNCH_MODE 1
#endif

typedef short bf16x8 __attribute__((ext_vector_type(8)));
typedef float f32x16 __attribute__((ext_vector_type(16)));
typedef float f32x4 __attribute__((ext_vector_type(4)));
typedef float f32x2 __attribute__((ext_vector_type(2)));
typedef unsigned u32x4 __attribute__((ext_vector_type(4)));
typedef unsigned u32x2 __attribute__((ext_vector_type(2)));
typedef __bf16 bf16x2_t __attribute__((ext_vector_type(2)));
typedef unsigned short u16;
typedef _Float16 h16x2 __attribute__((ext_vector_type(2)));

#define DI __device__ __forceinline__
#define MFMA32(a, b, c) __builtin_amdgcn_mfma_f32_32x32x16_bf16((a), (b), (c), 0, 0, 0)
typedef int i32x4 __attribute__((ext_vector_type(4)));
typedef int i32x16 __attribute__((ext_vector_type(16)));
#define MFMA8(a, b, c) __builtin_amdgcn_mfma_i32_32x32x32_i8((a), (b), (c), 0, 0, 0)

constexpr int NB = 32, SEQ = 2048, DM = 1024, NTOK = NB * SEQ;
constexpr int INW = 1440;
constexpr int NTHREADS = 512;
constexpr int LDA = 1032;
constexpr int LDA8 = 1040;
constexpr int LDS_BYTES = 147456;
constexpr float EPS = 1e-6f;

struct Params {
  const float* x; const float* c; const int* pos;
  const float* w_ada; const float* b_ada; const float* norm1_g; const float* w_in; const float* conv_w; const float* conv_b;
  const float* lru_wa; const float* lru_ba; const float* lru_wx; const float* lru_bx; const float* lru_lambda;
  const float* q_norm_g; const float* w_uq; const float* kv_norm_g; const float* w_ukv; const float* lru_out_g; const float* mla_out_g;
  const float* w_out; const float* norm2_g; const float* peer_wq; const float* peer_keys; const float* peer_u; const float* peer_v; const float* final_g;
  float* out;
  float* mod; float* ssq_lru; float* ssq_mla; double* invfreq;
  bf16x8* Wf_in; bf16x8* Wf_uq; bf16x8* Wf_ukv; bf16x8* Wf_a; bf16x8* Wf_x; bf16x8* Wf_out; i32x4* Wf_s;
  float* Wsf; float* wsmaxp; float* wsc;
  unsigned char* Uq; unsigned char* Vq; float* uscale; float* vscale; float* ubias; u16* xlru; u16* gate; u16* Q; u16* Kn; u16* Kr; u16* Vt; u16* y;
  char* scratch;
};

typedef const __attribute__((address_space(4))) Params& KP;

DI unsigned pk2(float a, float b) { f32x2 v = {a, b}; bf16x2_t r = __builtin_convertvector(v, bf16x2_t); return __builtin_bit_cast(unsigned, r); }
DI u16 f2bf(float a) { return (u16)(pk2(a, 0.f) & 0xffffu); }
DI float bflo(unsigned u) { return __uint_as_float(u << 16); }
DI float bfhi(unsigned u) { return __uint_as_float(u & 0xffff0000u); }
DI float bf2f(u16 h) { return __uint_as_float(((unsigned)h) << 16); }
template <int CTRL> DI float dppf(float v) { return __builtin_bit_cast(float, __builtin_amdgcn_update_dpp(0, __builtin_bit_cast(int, v), CTRL, 0xF, 0xF, true)); }
typedef unsigned u32x2_ __attribute__((ext_vector_type(2)));
DI float wave_sum(float v) {
  v += dppf<0xB1>(v); v += dppf<0x4E>(v); v += dppf<0x141>(v); v += dppf<0x140>(v);
  u32x2_ r = __builtin_amdgcn_permlane16_swap(__float_as_uint(v), __float_as_uint(v), false, false); v = __uint_as_float(r[0]) + __uint_as_float(r[1]);
  r = __builtin_amdgcn_permlane32_swap(__float_as_uint(v), __float_as_uint(v), false, false); v = __uint_as_float(r[0]) + __uint_as_float(r[1]);
  return v;
}
DI float wave_max(float v) {
  v = fmaxf(v, dppf<0xB1>(v)); v = fmaxf(v, dppf<0x4E>(v)); v = fmaxf(v, dppf<0x141>(v)); v = fmaxf(v, dppf<0x140>(v));
  u32x2_ r = __builtin_amdgcn_permlane16_swap(__float_as_uint(v), __float_as_uint(v), false, false); v = fmaxf(__uint_as_float(r[0]), __uint_as_float(r[1]));
  r = __builtin_amdgcn_permlane32_swap(__float_as_uint(v), __float_as_uint(v), false, false); v = fmaxf(__uint_as_float(r[0]), __uint_as_float(r[1]));
  return v;
}
template <int CTRL> DI unsigned dppu(unsigned v) { return (unsigned)__builtin_amdgcn_update_dpp(0, (int)v, CTRL, 0xF, 0xF, true); }
template <int J> DI unsigned lane_xor_u(unsigned v, int lane) {
  if (J == 1) return dppu<0xB1>(v);
  if (J == 2) return dppu<0x4E>(v);
  if (J == 4) return dppu<0x141>(dppu<0x1B>(v));
  if (J == 8) return dppu<0x128>(v);
  if (J == 16) { const u32x2_ r = __builtin_amdgcn_permlane16_swap(v, v, false, false); return (lane & 16) ? r[0] : r[1]; }
  const u32x2_ r = __builtin_amdgcn_permlane32_swap(v, v, false, false); return (lane & 32) ? r[0] : r[1];
}
template <int J> DI float lane_xor_f(float v, int lane) { return __uint_as_float(lane_xor_u<J>(__float_as_uint(v), lane)); }
DI float sum_xor32(float v) { const u32x2_ r = __builtin_amdgcn_permlane32_swap(__float_as_uint(v), __float_as_uint(v), false, false); return __uint_as_float(r[0]) + __uint_as_float(r[1]); }
DI float max_xor32(float v) { const u32x2_ r = __builtin_amdgcn_permlane32_swap(__float_as_uint(v), __float_as_uint(v), false, false); return fmaxf(__uint_as_float(r[0]), __uint_as_float(r[1])); }
DI float other_xor32(float v, int lane) { const u32x2_ r = __builtin_amdgcn_permlane32_swap(__float_as_uint(v), __float_as_uint(v), false, false); return __uint_as_float((lane & 32) ? r[0] : r[1]); }
DI float reduce8(const float (&v)[8], int lane) {
  float q4[4], r2[2];
#pragma unroll
  for (int j = 0; j < 4; ++j) {
    const u32x2_ r = __builtin_amdgcn_permlane32_swap(__float_as_uint(v[j]), __float_as_uint(v[4 + j]), false, false);
    q4[j] = __uint_as_float(r[0]) + __uint_as_float(r[1]);
  }
#pragma unroll
  for (int j = 0; j < 2; ++j) {
    const u32x2_ r = __builtin_amdgcn_permlane16_swap(__float_as_uint(q4[j]), __float_as_uint(q4[2 + j]), false, false);
    r2[j] = __uint_as_float(r[0]) + __uint_as_float(r[1]);
  }
  const float s0 = r2[0] + dppf<0x128>(r2[0]), s1b = r2[1] + dppf<0x128>(r2[1]);
  float s1 = (lane & 8) ? s1b : s0;
  s1 += dppf<0xB1>(s1);
  s1 += dppf<0x4E>(s1);
  s1 += dppf<0x141>(s1);
  return s1;
}
DI float reduce32(const float (&v)[32], int lane) {
  const bool b3 = (lane & 8) != 0, b2 = (lane & 4) != 0, b1 = (lane & 2) != 0, b0 = (lane & 1) != 0;
  float a16[16], a8[8], a4[4], a2[2];
#pragma unroll
  for (int j = 0; j < 16; ++j) {
    const u32x2_ r = __builtin_amdgcn_permlane16_swap(__float_as_uint(v[j]), __float_as_uint(v[16 + j]), false, false);
    a16[j] = __uint_as_float(r[0]) + __uint_as_float(r[1]);
  }
#pragma unroll
  for (int j = 0; j < 8; ++j) { const float keep = b3 ? a16[8 + j] : a16[j], send = b3 ? a16[j] : a16[8 + j]; a8[j] = keep + lane_xor_f<8>(send, lane); }
#pragma unroll
  for (int j = 0; j < 4; ++j) { const float keep = b2 ? a8[4 + j] : a8[j], send = b2 ? a8[j] : a8[4 + j]; a4[j] = keep + lane_xor_f<4>(send, lane); }
#pragma unroll
  for (int j = 0; j < 2; ++j) { const float keep = b1 ? a4[2 + j] : a4[j], send = b1 ? a4[j] : a4[2 + j]; a2[j] = keep + lane_xor_f<2>(send, lane); }
  const float keep = b0 ? a2[1] : a2[0], send = b0 ? a2[0] : a2[1];
  return keep + lane_xor_f<1>(send, lane);
}
DI float sigmoidf_(float x) { return __builtin_amdgcn_rcpf(1.f + __builtin_amdgcn_exp2f(-1.4426950408889634f * x)); }
DI float gelu_tanh(float x) { const float u = 0.7978845608028654f * (x + 0.044715f * x * x * x); return x * __builtin_amdgcn_rcpf(1.f + __builtin_amdgcn_exp2f(-2.f * 1.4426950408889634f * u)); }
DI float one_minus_exp_small(float z) {
  float q = 1.f + z * (1.f / 6.f);
  q = 1.f + z * (1.f / 5.f) * q;
  q = 1.f + z * (1.f / 4.f) * q;
  q = 1.f + z * (1.f / 3.f) * q;
  q = 1.f + z * (1.f / 2.f) * q;
  return -z * q;
}
DI f32x16 zero16() { f32x16 z; for (int i = 0; i < 16; ++i) z[i] = 0.f; return z; }
DI int crow(int reg, int h) { return (reg & 3) + 8 * (reg >> 2) + 4 * h; }

template <int NT, int PD>
DI void gemm_pro(const bf16x8* __restrict__ Wf, int KS, const int (&tile)[NT], int lane, bf16x8 (&bq)[PD][NT]) {
#pragma unroll
  for (int d = 0; d < PD; ++d)
#pragma unroll
    for (int t = 0; t < NT; ++t) bq[d][t] = Wf[((size_t)tile[t] * KS + d) * 64 + lane];
}
template <int NT, int PD, bool SWAP, bool APF = false>
DI void gemm_main(const u16* As, int lda, int nks, const bf16x8* __restrict__ Wf, int KS, const int (&tile)[NT], f32x16 (&acc)[NT][2], int lane, bf16x8 (&bq)[PD][NT]) {
  const bf16x8* a0p = (const bf16x8*)(As + (lane & 31) * lda + 8 * (lane >> 5));
  const bf16x8* a1p = (const bf16x8*)(As + ((lane & 31) + 32) * lda + 8 * (lane >> 5));
  const bf16x8* bp[NT];
#pragma unroll
  for (int t = 0; t < NT; ++t) bp[t] = Wf + (size_t)tile[t] * KS * 64 + lane;
  bf16x8 a0n = a0p[0], a1n = a1p[0];
#pragma unroll 1
  for (int ks = 0; ks < nks; ks += PD) {
#pragma unroll
    for (int d = 0; d < PD; ++d) {
      bf16x8 a0, a1;
      if (APF) { a0 = a0n; a1 = a1n; const int ka = (ks + d + 1 < nks) ? (ks + d + 1) : (ks + d); a0n = a0p[2 * ka]; a1n = a1p[2 * ka]; }
      else { a0 = a0p[2 * (ks + d)]; a1 = a1p[2 * (ks + d)]; }
      const int kn = (ks + d + PD < nks) ? (ks + d + PD) : (ks + d);
#pragma unroll
      for (int t = 0; t < NT; ++t) {
        const bf16x8 b = bq[d][t];
        bq[d][t] = bp[t][kn * 64];
        acc[t][0] = SWAP ? MFMA32(b, a0, acc[t][0]) : MFMA32(a0, b, acc[t][0]);
        acc[t][1] = SWAP ? MFMA32(b, a1, acc[t][1]) : MFMA32(a1, b, acc[t][1]);
      }
    }
  }
}
template <int NT, int PD = 8, bool SWAP = false>
DI void gemm_core(const u16* As, int lda, int nks, const bf16x8* __restrict__ Wf, int KS, const int (&tile)[NT], f32x16 (&acc)[NT][2], int lane) {
  bf16x8 bq[PD][NT];
  gemm_pro<NT, PD>(Wf, KS, tile, lane, bq);
  gemm_main<NT, PD, SWAP>(As, lda, nks, Wf, KS, tile, acc, lane, bq);
}

template <int NT, int PD>
DI void gemm8_core(const signed char* As, int lda, int nks, const i32x4* __restrict__ Wf, int KS, const int (&tile)[NT], i32x16 (&acc)[NT][2], int lane) {
  i32x4 bq[PD][NT];
#pragma unroll
  for (int d = 0; d < PD; ++d)
#pragma unroll
    for (int t = 0; t < NT; ++t) bq[d][t] = Wf[((size_t)tile[t] * KS + d) * 64 + lane];
  const i32x4* a0p = (const i32x4*)(As + (lane & 31) * lda + 16 * (lane >> 5));
  const i32x4* a1p = (const i32x4*)(As + ((lane & 31) + 32) * lda + 16 * (lane >> 5));
  const i32x4* bp[NT];
#pragma unroll
  for (int t = 0; t < NT; ++t) bp[t] = Wf + (size_t)tile[t] * KS * 64 + lane;
#pragma unroll 1
  for (int ks = 0; ks < nks; ks += PD) {
#pragma unroll
    for (int d = 0; d < PD; ++d) {
      const i32x4 a0 = a0p[2 * (ks + d)], a1 = a1p[2 * (ks + d)];
      const int kn = (ks + d + PD < nks) ? (ks + d + PD) : (ks + d);
#pragma unroll
      for (int t = 0; t < NT; ++t) {
        const i32x4 b = bq[d][t];
        bq[d][t] = bp[t][kn * 64];
        acc[t][0] = MFMA8(b, a0, acc[t][0]);
        acc[t][1] = MFMA8(b, a1, acc[t][1]);
      }
    }
  }
}

DI void conv_frag(const float* __restrict__ W, long sk, long sn, int K, int N, const float* ks1, const float* ks2, int ksplit, bf16x8* out, int gtid, int gthreads) {
  const int KS = K / 16; const int total = (N / 32) * KS * 64;
  for (int i = gtid; i < total; i += gthreads) {
    const int lane = i & 63; const int t = i >> 6; const int ks = t % KS; const int nt = t / KS;
    const int n = nt * 32 + (lane & 31); const int k0 = ks * 16 + 8 * (lane >> 5);
    float v[8];
#pragma unroll
    for (int j = 0; j < 8; ++j) {
      const int k = k0 + j;
      float s = 1.f;
      if (ks1) s = (k < ksplit) ? ks1[k] : ks2[k - ksplit];
      v[j] = W[(long)k * sk + (long)n * sn] * s;
    }
    u32x4 o; o[0] = pk2(v[0], v[1]); o[1] = pk2(v[2], v[3]); o[2] = pk2(v[4], v[5]); o[3] = pk2(v[6], v[7]);
    out[i] = __builtin_bit_cast(bf16x8, o);
  }
}

DI void conv_one(const float* __restrict__ W, long sk, int KS, const float* ks1, const float* ks2, int ksplit, bf16x8* out, int i) {
  const int lane = i & 63; const int t = i >> 6; const int ks = t % KS; const int nt = t / KS;
  const int n = nt * 32 + (lane & 31); const int k0 = ks * 16 + 8 * (lane >> 5);
  float v[8];
#pragma unroll
  for (int j = 0; j < 8; ++j) v[j] = W[(long)(k0 + j) * sk + n];
  if (ks1) {
#pragma unroll
    for (int j = 0; j < 8; ++j) { const int k = k0 + j; v[j] *= (k < ksplit) ? ks1[k] : ks2[k - ksplit]; }
  }
  u32x4 o; o[0] = pk2(v[0], v[1]); o[1] = pk2(v[2], v[3]); o[2] = pk2(v[4], v[5]); o[3] = pk2(v[6], v[7]);
  out[i] = __builtin_bit_cast(bf16x8, o);
}

DI void phase0(KP p, char* smem) {
  const int tid = threadIdx.x; const int gtid = blockIdx.x * NTHREADS + tid; const int gthreads = gridDim.x * NTHREADS;
  for (int i = gtid; i < NTOK; i += gthreads) { p.ssq_lru[i] = 0.f; p.ssq_mla[i] = 0.f; }
  if (gtid < 16) p.invfreq[gtid] = pow(10000.0, -(double)gtid / 16.0);
  {
    float* cact = (float*)smem;
    float* red = (float*)(smem + 65536);
    const int lane = tid & 63, wv = tid >> 6;
    for (int item = blockIdx.x; item < 192; item += gridDim.x) {
      const int cg = item >> 1, bh = item & 1;
      for (int i = tid; i < 16 * DM; i += NTHREADS) { const int bb = i >> 10, k = i & 1023; const float v = p.c[(bh * 16 + bb) * DM + k]; cact[k * 16 + bb] = v / (1.f + __expf(-v)); }
      __syncthreads();
      float acc[16];
#pragma unroll
      for (int bb = 0; bb < 16; ++bb) acc[bb] = 0.f;
      const float* wp = p.w_ada + (size_t)(wv * 128) * 6144 + cg * 64 + lane;
#pragma unroll 32
      for (int kk = 0; kk < 128; ++kk) {
        const float w = wp[(size_t)kk * 6144];
        const f32x4* cp = (const f32x4*)(cact + (wv * 128 + kk) * 16);
#pragma unroll
        for (int q = 0; q < 4; ++q) { const f32x4 cv = cp[q]; acc[4 * q] += cv[0] * w; acc[4 * q + 1] += cv[1] * w; acc[4 * q + 2] += cv[2] * w; acc[4 * q + 3] += cv[3] * w; }
      }
#pragma unroll
      for (int bb = 0; bb < 16; ++bb) red[(wv * 16 + bb) * 64 + lane] = acc[bb];
      __syncthreads();
      for (int o = tid; o < 1024; o += NTHREADS) {
        const int bb = o >> 6, c2 = o & 63;
        float sum = 0.f;
#pragma unroll
        for (int w8 = 0; w8 < 8; ++w8) sum += red[(w8 * 16 + bb) * 64 + c2];
        p.mod[(size_t)(bh * 16 + bb) * 6144 + cg * 64 + c2] = sum + p.b_ada[cg * 64 + c2];
      }
      __syncthreads();
    }
  }
  {
    constexpr int N_IN = 45 * 64 * 64, N_UQ = 24 * 16 * 64, N_UKV = 32 * 8 * 64, N_LRU = 16 * 512, N_OUT = 32 * 64 * 64;
    for (int i = gtid; i < N_IN + N_UQ + N_UKV + N_LRU + N_OUT; i += gthreads) {
      int j = i;
      if (j < N_OUT) { conv_one(p.w_out, 1024, 64, p.lru_out_g, p.mla_out_g, 512, p.Wf_out, j); continue; }
      j -= N_OUT;
      if (j < N_IN) { conv_one(p.w_in, INW, 64, nullptr, nullptr, 0, p.Wf_in, j); continue; }
      j -= N_IN;
      if (j < N_UQ) { conv_one(p.w_uq, 768, 16, p.q_norm_g, p.q_norm_g, 256, p.Wf_uq, j); continue; }
      j -= N_UQ;
      if (j < N_UKV) { conv_one(p.w_ukv, 1024, 8, p.kv_norm_g, p.kv_norm_g, 128, p.Wf_ukv, j); continue; }
      j -= N_UKV;
      { const int h = j >> 10, m = (j >> 9) & 1, f = j & 511; conv_one((m ? p.lru_wx : p.lru_wa) + h * 4096, 64, 4, nullptr, nullptr, 0, (m ? p.Wf_x : p.Wf_a) + h * 512, f); }
    }
  }
  {
    float* kl = (float*)smem;
    float* wl = (float*)(smem + 67584);
    const int lane = tid & 63, wv = tid >> 6, l31 = lane & 31, lh = lane >> 5;
    for (int item = blockIdx.x; item < 256; item += gridDim.x) {
      const int hp = item >> 4, cc = item & 15;
      __syncthreads();
#pragma unroll
      for (int i = 0; i < 8; ++i) { const int e = tid + NTHREADS * i; const int r = e >> 5, q = e & 31; *(f32x4*)(kl + r * 132 + q * 4) = *(const f32x4*)(p.peer_keys + (size_t)hp * 16384 + r * 128 + q * 4); }
#pragma unroll
      for (int i = 0; i < 4; ++i) { const int e = tid + NTHREADS * i; const int c = e >> 5, q = e & 31; *(f32x4*)(wl + c * 132 + q * 4) = *(const f32x4*)(p.peer_wq + (size_t)(cc * 64 + c) * 2048 + hp * 128 + q * 4); }
      __syncthreads();
      const int rt = wv >> 1, ct = wv & 1;
      const float* ap = kl + (rt * 32 + l31) * 132 + 8 * lh;
      const float* bp = wl + (ct * 32 + l31) * 132 + 8 * lh;
      f32x16 acc = zero16();
#pragma unroll
      for (int ks = 0; ks < 8; ++ks) {
        const f32x4 a0 = *(const f32x4*)(ap + 16 * ks), a1 = *(const f32x4*)(ap + 16 * ks + 4);
        const f32x4 b0 = *(const f32x4*)(bp + 16 * ks), b1 = *(const f32x4*)(bp + 16 * ks + 4);
        u32x4 av, bv;
        av[0] = pk2(a0[0], a0[1]); av[1] = pk2(a0[2], a0[3]); av[2] = pk2(a1[0], a1[1]); av[3] = pk2(a1[2], a1[3]);
        bv[0] = pk2(b0[0], b0[1]); bv[1] = pk2(b0[2], b0[3]); bv[2] = pk2(b1[0], b1[1]); bv[3] = pk2(b1[2], b1[3]);
        acc = MFMA32(__builtin_bit_cast(bf16x8, av), __builtin_bit_cast(bf16x8, bv), acc);
      }
      float* dst = p.Wsf + (size_t)(hp * 128 + rt * 32) * 1024 + cc * 64 + ct * 32 + l31;
#pragma unroll
      for (int r = 0; r < 16; ++r) dst[(size_t)crow(r, lh) * 1024] = acc[r];
    }
    __syncthreads();
  }
#if QBITS == 8
  {
    const int lane = tid & 63; const int gw = gtid >> 6; const int nw = gthreads >> 6;
    for (int row = gw; row < 32768; row += nw) {
      const int r = row & 16383; const bool isv = row >= 16384;
      const f32x4* src = (const f32x4*)((isv ? p.peer_v : p.peer_u) + (size_t)r * 1024) + lane * 4;
      f32x4 a[4];
#pragma unroll
      for (int i = 0; i < 4; ++i) a[i] = src[i];
#if QBITS == 8
      float am = 0.f;
#pragma unroll
      for (int i = 0; i < 4; ++i)
#pragma unroll
        for (int j = 0; j < 4; ++j) am = fmaxf(am, fabsf(a[i][j]));
      am = wave_max(am);
      const float inv = am > 0.f ? 127.f / am : 0.f;
      u32x4 o;
#pragma unroll
      for (int i = 0; i < 4; ++i) {
        unsigned w = 0;
#pragma unroll
        for (int j = 0; j < 4; ++j) { const int q = (int)__builtin_rintf(a[i][j] * inv) + 128; w |= (unsigned)q << (8 * j); }
        o[i] = w;
      }
      ((u32x4*)(isv ? p.Vq : p.Uq))[(size_t)r * 64 + lane] = o;
      const float step = am * (1.f / 127.f);
      if (lane == 0) p.uscale[r * 4 + (isv ? 1 : 0)] = step;
      float ns = 0.f;
#pragma unroll
      for (int i = 0; i < 4; ++i) ns += (float)(o[i] & 255u) + (float)((o[i] >> 8) & 255u) + (float)((o[i] >> 16) & 255u) + (float)(o[i] >> 24);
      ns = wave_sum(ns);
      if (lane == 0 && !isv) p.uscale[r * 4 + 2] = step * 128.f * ns;
#else
      float ssum = 0.f;
#pragma unroll
      for (int i = 0; i < 4; ++i)
#pragma unroll
        for (int j = 0; j < 4; ++j) ssum += a[i][j] * a[i][j];
      ssum = wave_sum(ssum);
      const float rms = sqrtf(ssum * (1.f / 1024.f));
      const float step = (isv ? 0.49f : 0.3352f) * rms;
      const float inv = step > 0.f ? 1.f / step : 0.f;
      u32x2 o;
#pragma unroll
      for (int jd = 0; jd < 2; ++jd) {
        unsigned w = 0;
#pragma unroll
        for (int e = 0; e < 8; ++e) {
          const float x = a[(8 * jd + e) >> 2][(8 * jd + e) & 3];
          if (isv) {
            const float m = fabsf(x) * inv;
            const int mag = (m > 0.25f) + (m > 0.75f) + (m > 1.25f) + (m > 1.75f) + (m > 2.5f) + (m > 3.5f) + (m > 5.0f);
            w |= (unsigned)(mag | (x < 0.f ? 8 : 0)) << (4 * e);
          } else {
            int q = (int)__builtin_rintf(x * inv + 7.5f); q = q < 0 ? 0 : (q > 15 ? 15 : q);
            w |= (unsigned)q << (8 * (e & 3) + 4 * (e >> 2));
          }
        }
        o[jd] = w;
      }
      ((u32x2*)(p.Uq + (size_t)r * 1024))[2 * lane + (isv ? 1 : 0)] = o;
      if (lane == 0) p.uscale[r * 4 + (isv ? 1 : 0)] = step;
      float ns = 0.f;
#pragma unroll
      for (int jd = 0; jd < 2; ++jd)
#pragma unroll
        for (int e = 0; e < 8; ++e) ns += (float)((o[jd] >> (4 * e)) & 15u);
      ns = wave_sum(ns);
      if (lane == 0 && !isv) p.uscale[r * 4 + 2] = step * 128.f * ns;
#endif
    }
  }
#else
  {
    const int lane = tid & 63; const int gw = gtid >> 6; const int nw = gthreads >> 6;
    for (int r = gw; r < 16384; r += nw) {
      const f32x4* su = (const f32x4*)(p.peer_u + (size_t)r * 1024) + lane * 4;
      const f32x4* sv = (const f32x4*)(p.peer_v + (size_t)r * 1024) + lane * 4;
      f32x4 au[4], av[4];
#pragma unroll
      for (int i = 0; i < 4; ++i) { au[i] = su[i]; av[i] = sv[i]; }
      float ssu = 0.f, ssv = 0.f;
#pragma unroll
      for (int i = 0; i < 4; ++i)
#pragma unroll
        for (int j = 0; j < 4; ++j) { ssu += au[i][j] * au[i][j]; ssv += av[i][j] * av[i][j]; }
      ssu = wave_sum(ssu); ssv = wave_sum(ssv);
      const float ustep = 0.3352f * sqrtf(ssu * (1.f / 1024.f)), vstep = 0.49f * sqrtf(ssv * (1.f / 1024.f));
      const float uinv = ustep > 0.f ? 1.f / ustep : 0.f, vinv = vstep > 0.f ? 1.f / vstep : 0.f;
      u32x4 o;
      float ns = 0.f;
#pragma unroll
      for (int jd = 0; jd < 2; ++jd) {
        unsigned wu = 0, wv = 0;
#pragma unroll
        for (int e = 0; e < 8; ++e) {
          const float xu = au[(8 * jd + e) >> 2][(8 * jd + e) & 3], xv = av[(8 * jd + e) >> 2][(8 * jd + e) & 3];
          int q = (int)__builtin_rintf(xu * uinv + 7.5f); q = q < 0 ? 0 : (q > 15 ? 15 : q);
          wu |= (unsigned)q << (8 * (e & 3) + 4 * (e >> 2)); ns += (float)q;
          const float m = fabsf(xv) * vinv;
          const int mag = (m > 0.25f) + (m > 0.75f) + (m > 1.25f) + (m > 1.75f) + (m > 2.5f) + (m > 3.5f) + (m > 5.0f);
          wv |= (unsigned)(mag | (xv < 0.f ? 8 : 0)) << (4 * e);
        }
        o[jd] = wu; o[2 + jd] = wv;
      }
      ((u32x4*)(p.Uq + (size_t)r * 1024))[lane] = o;
      ns = wave_sum(ns);
      if (lane == 0) *(f32x4*)(p.uscale + r * 4) = (f32x4){ustep, vstep, ustep * 128.f * ns, 0.f};
    }
  }
#endif
}

DI void ws_quant(KP p) {
  const int lane = threadIdx.x & 63; const int gw = (blockIdx.x * NTHREADS + threadIdx.x) >> 6; const int nw = (gridDim.x * NTHREADS) >> 6;
  for (int row = gw; row < 2048; row += nw) {
    const f32x4* src = (const f32x4*)(p.Wsf + (size_t)row * 1024 + lane * 16);
    f32x4 v[4];
    float m = 0.f;
#pragma unroll
    for (int q = 0; q < 4; ++q) { v[q] = src[q]; m = fmaxf(fmaxf(m, fmaxf(fabsf(v[q][0]), fabsf(v[q][1]))), fmaxf(fabsf(v[q][2]), fabsf(v[q][3]))); }
    m = wave_max(m);
    const float inv = m > 0.f ? 127.f / m : 0.f;
    i32x4 o;
#pragma unroll
    for (int q = 0; q < 4; ++q) {
      unsigned w = 0;
#pragma unroll
      for (int j = 0; j < 4; ++j) w |= ((unsigned)(int)__builtin_rintf(v[q][j] * inv) & 255u) << (8 * j);
      o[q] = (int)w;
    }
    p.Wf_s[(size_t)((row >> 5) * 32 + (lane >> 1)) * 64 + (row & 31) + 32 * (lane & 1)] = o;
    if (lane == 0) p.wsc[row] = m * (1.f / 127.f);
  }
}

DI void phase1(KP p, char* smem) {
  const int tid = threadIdx.x, wave = __builtin_amdgcn_readfirstlane(tid >> 6);
  u16* hA = (u16*)smem;
  float* cs = (float*)(smem + 132096);
  float* ssq = (float*)(smem + 132096 + 8192);
  constexpr int LDL = 424;
  ws_quant(p);
  for (int tile = blockIdx.x; tile < NTOK / 64; tile += gridDim.x) {
    int lane_o = tid & 63; asm volatile("" : "+v"(lane_o));
    const int lane = lane_o, l31 = lane & 31, lh = lane >> 5;
    const int tok0 = tile * 64; const int b = tok0 / SEQ; const int s0 = tok0 % SEQ;
    const float* modb = p.mod + (size_t)b * 6144;
    for (int i = tid; i < 1024; i += NTHREADS) {
      const int r = i >> 4, j = i & 15;
      const double ang = (double)p.pos[tok0 + r] * p.invfreq[j];
      double rev = ang * 0.15915494309189535; rev -= floor(rev);
      const float rf = (float)rev;
      cs[2 * i] = __builtin_amdgcn_cosf(rf); cs[2 * i + 1] = __builtin_amdgcn_sinf(rf);
    }
    if (tid < 128) ssq[tid] = 0.f;
    {
      f32x4 cm[4], ca[4];
#pragma unroll
      for (int i = 0; i < 4; ++i) {
        const int col = i * 256 + lane * 4;
        const f32x4 g = *(const f32x4*)(p.norm1_g + col); const f32x4 sc = *(const f32x4*)(modb + 1024 + col);
        cm[i] = g * (sc + 1.0f); ca[i] = *(const f32x4*)(modb + col);
      }
#pragma unroll 2
      for (int rr = 0; rr < 8; rr += 4) {
        f32x4 xv[4][4];
#pragma unroll
        for (int q = 0; q < 4; ++q)
#pragma unroll
          for (int i = 0; i < 4; ++i) xv[q][i] = *(const f32x4*)(p.x + (size_t)(tok0 + wave * 8 + rr + q) * DM + i * 256 + lane * 4);
#pragma unroll
        for (int q = 0; q < 4; ++q) {
          float ss = 0.f;
#pragma unroll
          for (int i = 0; i < 4; ++i) ss += xv[q][i][0] * xv[q][i][0] + xv[q][i][1] * xv[q][i][1] + xv[q][i][2] * xv[q][i][2] + xv[q][i][3] * xv[q][i][3];
          ss = wave_sum(ss);
          const float rs = rsqrtf(ss * (1.f / 1024.f) + EPS);
          const int row = wave * 8 + rr + q;
#pragma unroll
          for (int i = 0; i < 4; ++i) {
            const f32x4 h = xv[q][i] * rs * cm[i] + ca[i];
            u32x2 o; o[0] = pk2(h[0], h[1]); o[1] = pk2(h[2], h[3]);
            *(u32x2*)(hA + row * LDA + i * 256 + lane * 4) = o;
          }
        }
      }
    }
    __syncthreads();
    bf16x8 ring1[8][2];
    const bool has2 = (wave + 40) < 45;
    { const int tl0[2] = {wave, wave + 8}; gemm_pro<2, 8>(p.Wf_in, 64, tl0, lane, ring1); }
#pragma unroll 1
    for (int pass = 0; pass < 2; ++pass) {
      f32x16 acc[2][2];
#pragma unroll
      for (int t = 0; t < 2; ++t) { acc[t][0] = zero16(); acc[t][1] = zero16(); }
      const int tl[2] = {wave + 16 * pass, wave + 16 * pass + 8};
      gemm_main<2, 8, false, true>(hA, LDA, 64, p.Wf_in, 64, tl, acc, lane, ring1);
      { const int tn[2] = {wave + 16 * (pass + 1), (pass == 0 || has2) ? wave + 16 * (pass + 1) + 8 : wave + 32}; gemm_pro<2, 8>(p.Wf_in, 64, tn, lane, ring1); }
      int el_ = lane; asm volatile("" : "+v"(el_));
      const int l31 = el_ & 31, lh = el_ >> 5;
      u16* dstb[2];
#pragma unroll
      for (int t = 0; t < 2; ++t) { const int col = tl[t] * 32 + l31; dstb[t] = (col < 512) ? (p.xlru + col) : (p.gate + (col - 512)); }
#pragma unroll
      for (int rt = 0; rt < 2; ++rt)
#pragma unroll
        for (int r = 0; r < 16; ++r) {
          const size_t ro = (size_t)(tok0 + rt * 32 + crow(r, lh)) * 512;
#pragma unroll
          for (int t = 0; t < 2; ++t) dstb[t][ro] = f2bf(acc[t][rt][r]);
        }
    }
    {
      f32x16 acc[2][2];
#pragma unroll
      for (int t = 0; t < 2; ++t) { acc[t][0] = zero16(); acc[t][1] = zero16(); }
      const int tl[2] = {wave + 32, has2 ? wave + 40 : wave + 32};
      gemm_main<2, 8, false, true>(hA, LDA, 64, p.Wf_in, 64, tl, acc, lane, ring1);
      int el_ = lane; asm volatile("" : "+v"(el_));
      const int l31 = el_ & 31, lh = el_ >> 5;
      __syncthreads();
      u16* lat = hA;
#pragma unroll
      for (int t = 0; t < 2; ++t) {
        if (t == 1 && !has2) continue;
        const int lc = tl[t] * 32 - 1024 + l31;
        if (tl[t] < 44) {
          float sq[32];
#pragma unroll
          for (int rt = 0; rt < 2; ++rt)
#pragma unroll
            for (int r = 0; r < 16; ++r) { const float v = acc[t][rt][r]; sq[rt * 16 + r] = v * v; }
          const float tot = reduce32(sq, lane);
          __hip_atomic_fetch_add(&ssq[(tl[t] < 40 ? 0 : 64) + (l31 >> 4) * 32 + crow(l31 & 15, lh)], tot, __ATOMIC_RELAXED, __HIP_MEMORY_SCOPE_WORKGROUP);
        }
#pragma unroll
        for (int rt = 0; rt < 2; ++rt)
#pragma unroll
          for (int r = 0; r < 16; ++r) {
            const int row = rt * 32 + crow(r, lh);
            const float v = acc[t][rt][r];
            if (lc < 384) {
              lat[row * LDL + lc] = f2bf(v);
            } else {
              const float pv = lane_xor_f<16>(v, lane);
              const int j = lc - 384; const int jj = j & 15;
              const float co = cs[(row * 16 + jj) * 2], si = cs[(row * 16 + jj) * 2 + 1];
              const float o = (j < 16) ? (v * co - pv * si) : (v * co + pv * si);
              p.Kr[(size_t)(tok0 + row) * 32 + j] = f2bf(o);
            }
          }
      }
    }
    __syncthreads();
    {
      const u16* lat = hA;
      const float qscale = 0.10206207261596577f * 1.4426950408889634f;
      const int jj = l31 & 15;
#pragma unroll 1
      for (int pass = 0; pass < 2; ++pass) {
        f32x16 acc[2][2];
#pragma unroll
        for (int t = 0; t < 2; ++t) { acc[t][0] = zero16(); acc[t][1] = zero16(); }
        const int tl[2] = {pass == 0 ? wave : wave + 16, pass == 0 ? wave + 8 : wave + 16};
        gemm_core<2>(lat, LDL, 16, p.Wf_uq, 16, tl, acc, lane);
        int el_ = lane; asm volatile("" : "+v"(el_));
        const int l31 = el_ & 31, lh = el_ >> 5;
#pragma unroll
        for (int rt = 0; rt < 2; ++rt)
#pragma unroll
          for (int r = 0; r < 16; ++r) {
            const int row = rt * 32 + crow(r, lh);
            const float rs = rsqrtf(ssq[row] * (1.f / 256.f) + EPS) * qscale;
            const float co = cs[(row * 16 + jj) * 2], si = cs[(row * 16 + jj) * 2 + 1];
#pragma unroll
            for (int t = 0; t < 2; ++t) {
              if (t == 1 && pass == 1) continue;
              const int head = tl[t] / 3, part = tl[t] % 3;
              float v = acc[t][rt][r] * rs;
              if (part == 2) {
                const float pv = lane_xor_f<16>(v, lane);
                v = (l31 < 16) ? (v * co - pv * si) : (v * co + pv * si);
              }
              p.Q[((size_t)(b * 8 + head) * SEQ + s0 + row) * 96 + part * 32 + l31] = f2bf(v);
            }
          }
      }
#pragma unroll 1
      for (int pass = 0; pass < 2; ++pass) {
        f32x16 acc[2][2];
#pragma unroll
        for (int t = 0; t < 2; ++t) { acc[t][0] = zero16(); acc[t][1] = zero16(); }
        const int tl[2] = {wave + 16 * pass, wave + 16 * pass + 8};
        gemm_core<2>(lat + 256, LDL, 8, p.Wf_ukv, 8, tl, acc, lane);
        int el_ = lane; asm volatile("" : "+v"(el_));
        const int l31 = el_ & 31, lh = el_ >> 5;
#pragma unroll
        for (int rt = 0; rt < 2; ++rt)
#pragma unroll
          for (int g = 0; g < 4; ++g) {
            const int row = rt * 32 + 8 * g + 4 * lh;
            float rs4[4];
#pragma unroll
            for (int q = 0; q < 4; ++q) rs4[q] = rsqrtf(ssq[64 + row + q] * (1.f / 128.f) + EPS);
#pragma unroll
            for (int t = 0; t < 2; ++t) {
              const int head = tl[t] >> 2, sub = tl[t] & 3;
              float v4[4];
#pragma unroll
              for (int q = 0; q < 4; ++q) v4[q] = acc[t][rt][4 * g + q] * rs4[q];
              if (sub < 2) {
#pragma unroll
                for (int q = 0; q < 4; ++q) p.Kn[((size_t)(b * 8 + head) * SEQ + s0 + row + q) * 64 + sub * 32 + l31] = f2bf(v4[q]);
              } else {
                const int d = (sub - 2) * 32 + l31;
                u32x2 o; o[0] = pk2(v4[0], v4[1]); o[1] = pk2(v4[2], v4[3]);
                *(u32x2*)(p.Vt + ((size_t)(b * 8 + head) * 64 + d) * SEQ + s0 + row) = o;
              }
            }
          }
      }
    }
    __syncthreads();
  }
}

DI void lru_item(KP p, char* smem, int item) {
  const int tid = threadIdx.x, lane = tid & 63, wave = __builtin_amdgcn_readfirstlane(tid >> 6);
  const int l31 = lane & 31, lh = lane >> 5;
  const int b = item >> 3, cb = item & 7;
  const int c = lane; const int ch = cb * 64 + c; const int tg = wave;
  const float cw0 = p.conv_w[ch], cw1 = p.conv_w[512 + ch], cw2 = p.conv_w[1024 + ch], cw3 = p.conv_w[1536 + ch], cbias = p.conv_b[ch];
  const float ba = p.lru_ba[ch], bx = p.lru_bx[ch];
  const float sp = log1pf(__expf(-p.lru_lambda[ch]));
  float carry = 0.f;
  const u16* xl = p.xlru + (size_t)b * SEQ * 512 + ch;
  const u16* gt = p.gate + (size_t)b * SEQ * 512 + ch;
  u16* yo = p.y + (size_t)b * SEQ * 1024 + ch;
  const int mat = wave >> 2, rt = (wave >> 1) & 1, ct = wave & 1;
  const bf16x8* wf = (mat == 0 ? p.Wf_a : p.Wf_x) + cb * 512 + ct * 256 + lane;
  bf16x8 bw[4];
#pragma unroll
  for (int ks = 0; ks < 4; ++ks) bw[ks] = wf[ks * 64];
  constexpr int NCH = SEQ / 64;
  u16 xin_n[11], gv_n[8];
#pragma unroll
  for (int i = 0; i < 11; ++i) { const int t = tg * 8 - 3 + i; xin_n[i] = (t >= 0) ? xl[(size_t)t * 512] : (u16)0; }
#pragma unroll
  for (int i = 0; i < 8; ++i) gv_n[i] = gt[(size_t)(tg * 8 + i) * 512];
  float xcB[8], gvB[8], xcC[8], gvC[8], avD[8], bvD[8], gvD[8];
#pragma unroll
  for (int i = 0; i < 8; ++i) { xcB[i] = gvB[i] = xcC[i] = gvC[i] = avD[i] = bvD[i] = gvD[i] = 0.f; }
  __syncthreads();
#pragma unroll 1
  for (int it = 0; it < NCH + 3; ++it) {
    float xcA[8], gvA[8], avC[8], bvC[8];
    if (it < NCH) {
      const int t0 = it * 64 + tg * 8;
      float xin[11];
#pragma unroll
      for (int i = 0; i < 11; ++i) xin[i] = bf2f(xin_n[i]);
#pragma unroll
      for (int i = 0; i < 8; ++i) gvA[i] = bf2f(gv_n[i]);
      if (it + 1 < NCH) {
#pragma unroll
        for (int i = 0; i < 11; ++i) xin_n[i] = xl[(size_t)(t0 + 64 - 3 + i) * 512];
#pragma unroll
        for (int i = 0; i < 8; ++i) gv_n[i] = gt[(size_t)(t0 + 64 + i) * 512];
      }
      u16* xcb = (u16*)(smem + (it & 1) * 9216);
#pragma unroll
      for (int i = 0; i < 8; ++i) {
        xcA[i] = cbias + cw0 * xin[i] + cw1 * xin[i + 1] + cw2 * xin[i + 2] + cw3 * xin[i + 3];
        xcb[(tg * 8 + i) * 72 + c] = f2bf(xcA[i]);
      }
    } else {
#pragma unroll
      for (int i = 0; i < 8; ++i) { xcA[i] = 0.f; gvA[i] = 0.f; }
    }
    if (it >= 1 && it - 1 < NCH) {
      const u16* xcb = (const u16*)(smem + ((it - 1) & 1) * 9216);
      float* pm = (float*)(smem + 18432 + ((it - 1) & 1) * 33280) + mat * 4160;
      f32x16 acc = zero16();
      const bf16x8* ap = (const bf16x8*)(xcb + (rt * 32 + l31) * 72 + 8 * lh);
#pragma unroll
      for (int ks = 0; ks < 4; ++ks) acc = MFMA32(ap[2 * ks], bw[ks], acc);
#pragma unroll
      for (int r = 0; r < 16; ++r) pm[(rt * 32 + crow(r, lh)) * 65 + ct * 32 + l31] = acc[r];
    }
    if (it >= 2 && it - 2 < NCH) {
      const float* pre = (const float*)(smem + 18432 + ((it - 2) & 1) * 33280);
      float* seg = (float*)(smem + 84992 + ((it - 2) & 1) * 4096);
      float A = 1.f, Bc = 0.f;
#pragma unroll
      for (int i = 0; i < 8; ++i) {
        const int tl = tg * 8 + i;
        const float r = sigmoidf_(pre[tl * 65 + c] + ba);
        const float ig = sigmoidf_(pre[4160 + tl * 65 + c] + bx);
        const float log_a = -8.f * r * sp;
        const float a = __builtin_amdgcn_exp2f(1.4426950408889634f * log_a);
        const float z = 2.f * log_a;
        const float om = (z > -0.25f) ? one_minus_exp_small(z) : -expm1f(z);
        const float m = __builtin_amdgcn_sqrtf(om);
        avC[i] = a; bvC[i] = m * ig * xcC[i];
        A *= a; Bc = a * Bc + bvC[i];
      }
      seg[(tg * 64 + c) * 2] = A; seg[(tg * 64 + c) * 2 + 1] = Bc;
    } else {
#pragma unroll
      for (int i = 0; i < 8; ++i) { avC[i] = 0.f; bvC[i] = 0.f; }
    }
    if (it >= 3) {
      const int t0 = (it - 3) * 64 + tg * 8;
      const float* seg = (const float*)(smem + 84992 + ((it - 3) & 1) * 4096);
      float h = carry, hin = 0.f;
#pragma unroll
      for (int s2 = 0; s2 < 8; ++s2) {
        if (s2 == tg) hin = h;
        h = seg[(s2 * 64 + c) * 2] * h + seg[(s2 * 64 + c) * 2 + 1];
      }
      carry = h;
      h = hin;
      float sq[8];
#pragma unroll
      for (int i = 0; i < 8; ++i) {
        h = avD[i] * h + bvD[i];
        const float yv = gelu_tanh(gvD[i]) * h;
        yo[(size_t)(t0 + i) * 1024] = f2bf(yv);
        sq[i] = yv * yv;
      }
      const float tot = reduce8(sq, lane);
      if ((lane & 7) == 0) unsafeAtomicAdd(p.ssq_lru + (size_t)b * SEQ + t0 + (lane >> 3), tot);
    }
#pragma unroll
    for (int i = 0; i < 8; ++i) {
      avD[i] = avC[i]; bvD[i] = bvC[i]; gvD[i] = gvC[i];
      xcC[i] = xcB[i]; gvC[i] = gvB[i];
      xcB[i] = xcA[i]; gvB[i] = gvA[i];
    }
    __syncthreads();
  }
}

DI void attn_unit(KP p, char* smem, int b, int hd, int qb) {
  const int tid = threadIdx.x, lane = tid & 63, wave = __builtin_amdgcn_readfirstlane(tid >> 6);
  const int l31 = lane & 31, lh = lane >> 5;
  const int q0 = qb * 256 + wave * 32;
  const size_t bh = (size_t)(b * 8 + hd);
  const int nkt = qb * 4 + 4;
  const int qidx = q0 + l31;
  const int skey = tid >> 3, schn = tid & 7;
  const int rkey = (tid & 255) >> 2, rchn = tid & 3;
  const u16* kn_src = p.Kn + (bh * SEQ + skey) * 64 + schn * 8;
  const u16* kr_src = p.Kr + ((size_t)b * SEQ + rkey) * 32 + rchn * 8;
  const u16* vt_src = p.Vt + (bh * 64 + skey) * SEQ + schn * 8;
  u32x4 rk, rr, rv;
  rk = *(const u32x4*)(kn_src); rv = *(const u32x4*)(vt_src);
  if (tid < 256) rr = *(const u32x4*)(kr_src);
  bf16x8 qf[6];
  {
    const bf16x8* qp = (const bf16x8*)(p.Q + (bh * SEQ + q0 + l31) * 96 + 8 * lh);
#pragma unroll
    for (int ks = 0; ks < 6; ++ks) qf[ks] = qp[2 * ks];
  }
  __syncthreads();
  {
    u16* Kl = (u16*)smem; u16* Vl = (u16*)(smem + 13312);
    *(u32x4*)(Kl + skey * 104 + schn * 8) = rk;
    if (tid < 256) *(u32x4*)(Kl + rkey * 104 + 64 + rchn * 8) = rr;
    *(u32x4*)(Vl + skey * 72 + schn * 8) = rv;
  }
  __syncthreads();
  f32x16 o0 = zero16(), o1 = zero16();
  float m_run = -1e30f, l_run = 0.f;
  for (int kt = 0; kt < nkt; ++kt) {
    const u16* Kl = (const u16*)(smem + (kt & 1) * 22528);
    const u16* Vl = (const u16*)(smem + (kt & 1) * 22528 + 13312);
    const bool more = (kt + 1) < nkt;
    if (more) {
      rk = *(const u32x4*)(kn_src + (size_t)(kt + 1) * 64 * 64);
      rv = *(const u32x4*)(vt_src + (kt + 1) * 64);
      if (tid < 256) rr = *(const u32x4*)(kr_src + (size_t)(kt + 1) * 64 * 32);
    }
    if (kt * 64 <= q0 + 31) {
      f32x16 s[2];
      bf16x8 kfr[2][6];
#pragma unroll
      for (int st = 0; st < 2; ++st) {
        const bf16x8* kp = (const bf16x8*)(Kl + (st * 32 + l31) * 104 + 8 * lh);
#pragma unroll
        for (int ks = 0; ks < 6; ++ks) kfr[st][ks] = kp[2 * ks];
      }
#pragma unroll
      for (int st = 0; st < 2; ++st) {
        s[st] = zero16();
#pragma unroll
        for (int ks = 0; ks < 6; ++ks) s[st] = MFMA32(kfr[st][ks], qf[ks], s[st]);
      }
      u32x2 vfr[2][4][2];
#pragma unroll
      for (int dt = 0; dt < 2; ++dt)
#pragma unroll
        for (int c4 = 0; c4 < 4; ++c4) {
          const int kbase = c4 * 16 + 4 * lh;
          vfr[dt][c4][0] = *(const u32x2*)(Vl + (dt * 32 + l31) * 72 + kbase);
          vfr[dt][c4][1] = *(const u32x2*)(Vl + (dt * 32 + l31) * 72 + kbase + 8);
        }
      if (kt * 64 + 63 > q0) {
#pragma unroll
        for (int st = 0; st < 2; ++st)
#pragma unroll
          for (int r = 0; r < 16; ++r) { const int key = kt * 64 + st * 32 + crow(r, lh); if (key > qidx) s[st][r] = -1e30f; }
      }
      float mloc = s[0][0];
#pragma unroll
      for (int st = 0; st < 2; ++st)
#pragma unroll
        for (int r = 0; r < 16; ++r) mloc = fmaxf(mloc, s[st][r]);
      mloc = max_xor32(mloc);
      const float m_new = fmaxf(m_run, mloc);
      const float alpha = __builtin_amdgcn_exp2f(m_run - m_new);
      m_run = m_new;
      float lsum = 0.f;
#pragma unroll
      for (int st = 0; st < 2; ++st)
#pragma unroll
        for (int r = 0; r < 16; ++r) { const float e = __builtin_amdgcn_exp2f(s[st][r] - m_new); s[st][r] = e; lsum += e; }
      l_run = l_run * alpha + lsum;
#pragma unroll
      for (int r = 0; r < 16; ++r) { o0[r] *= alpha; o1[r] *= alpha; }
#pragma unroll
      for (int st = 0; st < 2; ++st)
#pragma unroll
        for (int s2 = 0; s2 < 2; ++s2) {
          u32x4 pw;
#pragma unroll
          for (int j = 0; j < 4; ++j) pw[j] = pk2(s[st][8 * s2 + 2 * j], s[st][8 * s2 + 2 * j + 1]);
          const bf16x8 pf = __builtin_bit_cast(bf16x8, pw);
          const int c4 = st * 2 + s2;
          {
            u32x4 vv; vv[0] = vfr[0][c4][0][0]; vv[1] = vfr[0][c4][0][1]; vv[2] = vfr[0][c4][1][0]; vv[3] = vfr[0][c4][1][1];
            o0 = MFMA32(__builtin_bit_cast(bf16x8, vv), pf, o0);
          }
          {
            u32x4 vv; vv[0] = vfr[1][c4][0][0]; vv[1] = vfr[1][c4][0][1]; vv[2] = vfr[1][c4][1][0]; vv[3] = vfr[1][c4][1][1];
            o1 = MFMA32(__builtin_bit_cast(bf16x8, vv), pf, o1);
          }
        }
    }
    if (more) {
      u16* Kn2 = (u16*)(smem + ((kt + 1) & 1) * 22528); u16* Vn2 = (u16*)(smem + ((kt + 1) & 1) * 22528 + 13312);
      *(u32x4*)(Kn2 + skey * 104 + schn * 8) = rk;
      if (tid < 256) *(u32x4*)(Kn2 + rkey * 104 + 64 + rchn * 8) = rr;
      *(u32x4*)(Vn2 + skey * 72 + schn * 8) = rv;
    }
    __syncthreads();
  }
  const float ltot = sum_xor32(l_run);
  const float inv = 1.f / ltot;
  float ss = 0.f;
  u16* yrow = p.y + ((size_t)b * SEQ + qidx) * 1024 + 512 + hd * 64;
#pragma unroll
  for (int g = 0; g < 4; ++g) {
    float v0[4], v1[4];
#pragma unroll
    for (int q = 0; q < 4; ++q) { v0[q] = o0[4 * g + q] * inv; v1[q] = o1[4 * g + q] * inv; ss += v0[q] * v0[q] + v1[q] * v1[q]; }
    u32x2 a; a[0] = pk2(v0[0], v0[1]); a[1] = pk2(v0[2], v0[3]);
    u32x2 c2; c2[0] = pk2(v1[0], v1[1]); c2[1] = pk2(v1[2], v1[3]);
    *(u32x2*)(yrow + 8 * g + 4 * lh) = a;
    *(u32x2*)(yrow + 32 + 8 * g + 4 * lh) = c2;
  }
  ss = sum_xor32(ss);
  if (lh == 0) unsafeAtomicAdd(p.ssq_mla + (size_t)b * SEQ + qidx, ss);
}

DI void phase2(KP p, char* smem) {
  for (int item = blockIdx.x; item < 256; item += gridDim.x) lru_item(p, smem, item);
  for (int it = blockIdx.x; it < 1024; it += gridDim.x) {
    const int j = it & 3; const int bh = it >> 2; const int hd = bh & 7; const int b = bh >> 3;
    attn_unit(p, smem, b, hd, 7 - j);
    attn_unit(p, smem, b, hd, j);
  }
}

DI void sort128_asc(unsigned& k0, unsigned& k1, int lane) {
#pragma unroll
  for (int k = 2; k <= 128; k <<= 1) {
#pragma unroll
    for (int j = k >> 1; j > 0; j >>= 1) {
      if (j == 64) {
        const unsigned lo = k0 < k1 ? k0 : k1, hi = k0 < k1 ? k1 : k0; k0 = lo; k1 = hi;
      } else {
        const unsigned o0 = (j == 1) ? lane_xor_u<1>(k0, lane) : (j == 2) ? lane_xor_u<2>(k0, lane) : (j == 4) ? lane_xor_u<4>(k0, lane) : (j == 8) ? lane_xor_u<8>(k0, lane) : (j == 16) ? lane_xor_u<16>(k0, lane) : lane_xor_u<32>(k0, lane);
        const unsigned o1 = (j == 1) ? lane_xor_u<1>(k1, lane) : (j == 2) ? lane_xor_u<2>(k1, lane) : (j == 4) ? lane_xor_u<4>(k1, lane) : (j == 8) ? lane_xor_u<8>(k1, lane) : (j == 16) ? lane_xor_u<16>(k1, lane) : lane_xor_u<32>(k1, lane);
        const bool lower = (lane & j) == 0;
        const bool asc0 = (k == 128) ? true : ((lane & k) == 0);
        const bool asc1 = (k == 128) ? true : (k == 64 ? false : ((lane & k) == 0));
        const unsigned mn0 = k0 < o0 ? k0 : o0, mx0 = k0 < o0 ? o0 : k0;
        const unsigned mn1 = k1 < o1 ? k1 : o1, mx1 = k1 < o1 ? o1 : k1;
        k0 = (asc0 == lower) ? mn0 : mx0;
        k1 = (asc1 == lower) ? mn1 : mx1;
      }
    }
  }
}
#if QBITS == 8
typedef u32x4 qrow_t;
#else
typedef u32x2 qrow_t;
#endif
constexpr int QROWB = (QBITS == 8) ? 1024 : 512;
DI void ga_load(__amdgpu_buffer_rsrc_t rs, int iv, int gl, int voff_u, int voff_v, qrow_t (&uq)[8], qrow_t (&vq)[8]) {
#pragma unroll
  for (int k = 0; k < 8; ++k) {
    const int so = __builtin_amdgcn_readlane(iv, gl + k);
#if QBITS == 8
    uq[k] = __builtin_amdgcn_raw_buffer_load_b128(rs, voff_u, so, 0);
    vq[k] = __builtin_amdgcn_raw_buffer_load_b128(rs, voff_v, so, 0);
#else
    const u32x4 rec = __builtin_amdgcn_raw_buffer_load_b128(rs, voff_u, so, 16);
    uq[k] = (u32x2){rec[0], rec[1]}; vq[k] = (u32x2){rec[2], rec[3]};
#endif
  }
}
DI unsigned qword(const qrow_t& r, int j) {
#if QBITS == 8
  return r[j];
#else
  const unsigned w0 = r[j >> 1];
  return (j & 1) ? ((w0 >> 4) & 0x0f0f0f0fu) : (w0 & 0x0f0f0f0fu);
#endif
}
#if QBITS == 8
typedef f32x2 oacc_t;
constexpr float OACC_SCALE = 1.f;
#else
typedef h16x2 oacc_t;
constexpr float OACC_SCALE = 16.f;
#endif
DI void ga_compute(float gsel, float asel, float bsel, int gl, int lane, float kt, float hscale, const unsigned (&hq)[4],
                   const qrow_t (&uq)[8], const qrow_t (&vq)[8], oacc_t (&oacc)[8], float& csum) {
  const float mg = __shfl(gsel, gl + (lane >> 3));
  const float ma = __shfl(asel, gl + (lane >> 3));
  const float mb = __shfl(bsel, gl + (lane >> 3));
  float pp[8];
#pragma unroll
  for (int k = 0; k < 8; ++k) {
#if QBITS == 8
    unsigned d = 0;
#pragma unroll
    for (int j = 0; j < 4; ++j) d = __builtin_amdgcn_udot4(qword(uq[k], j), hq[j], d, false);
#else
    unsigned dh = __builtin_amdgcn_udot8(uq[k][0], hq[0], 0u, false); dh = __builtin_amdgcn_udot8(uq[k][1], hq[1], dh, false);
    unsigned dl = __builtin_amdgcn_udot8(uq[k][0], hq[2], 0u, false); dl = __builtin_amdgcn_udot8(uq[k][1], hq[3], dl, false);
    const unsigned d = dh * 16u + dl;
#endif
    pp[k] = (float)d;
  }
  const float s1 = reduce8(pp, lane);
  const float pre = hscale * (ma * (s1 - kt) - mb);
  const float cf = mg * gelu_tanh(pre);
  csum += cf;
#if QBITS != 8
  const _Float16 cfs = (_Float16)(cf * OACC_SCALE);
  const unsigned cfp = __builtin_bit_cast(unsigned, (h16x2){cfs, cfs});
#endif
#pragma unroll
  for (int k = 0; k < 8; ++k) {
#if QBITS == 8
    const float c = __uint_as_float(__builtin_amdgcn_readlane(__float_as_uint(cf), 8 * k));
    const f32x2 cc = {c, c};
#pragma unroll
    for (int j = 0; j < 4; ++j) {
      unsigned w = qword(vq[k], j);
      asm volatile("" : "+v"(w));
      const f32x2 v0 = {(float)(w & 255u), (float)((w >> 8) & 255u)}, v1 = {(float)((w >> 16) & 255u), (float)(w >> 24)};
      oacc[2 * j] = v0 * cc + oacc[2 * j];
      oacc[2 * j + 1] = v1 * cc + oacc[2 * j + 1];
    }
#else
    const h16x2 cc = __builtin_bit_cast(h16x2, (unsigned)__builtin_amdgcn_readlane((int)cfp, 8 * k));
#pragma unroll
    for (int jd = 0; jd < 2; ++jd) {
      const unsigned w = vq[k][jd];
      oacc[4 * jd + 0] = __builtin_amdgcn_cvt_scalef32_pk_f16_fp4(w, 1.0f, 0) * cc + oacc[4 * jd + 0];
      oacc[4 * jd + 1] = __builtin_amdgcn_cvt_scalef32_pk_f16_fp4(w, 1.0f, 1) * cc + oacc[4 * jd + 1];
      oacc[4 * jd + 2] = __builtin_amdgcn_cvt_scalef32_pk_f16_fp4(w, 1.0f, 2) * cc + oacc[4 * jd + 2];
      oacc[4 * jd + 3] = __builtin_amdgcn_cvt_scalef32_pk_f16_fp4(w, 1.0f, 3) * cc + oacc[4 * jd + 3];
    }
#endif
  }
}

DI void ins16(float (&lst)[16], float x) {
#pragma unroll
  for (int i = 0; i < 16; ++i) { const float hi = fmaxf(lst[i], x); x = fminf(lst[i], x); lst[i] = hi; }
}
DI void ce_desc(float& a, float& b) { const float hi = fmaxf(a, b), lo = fminf(a, b); a = hi; b = lo; }
DI void sort16_desc(float (&a)[16]) {
#pragma unroll
  for (int k = 2; k <= 16; k <<= 1)
#pragma unroll
    for (int j = k >> 1; j > 0; j >>= 1)
#pragma unroll
      for (int i = 0; i < 16; ++i) {
        const int l = i ^ j;
        if (l > i) {
          if ((i & k) == 0) ce_desc(a[i], a[l]); else ce_desc(a[l], a[i]);
        }
      }
}
DI void merge16_desc(float (&x)[16], const float (&y)[16]) {
#pragma unroll
  for (int i = 0; i < 16; ++i) x[i] = fmaxf(x[i], y[15 - i]);
#pragma unroll
  for (int d = 8; d >= 1; d >>= 1)
#pragma unroll
    for (int i = 0; i < 16; ++i)
      if ((i & d) == 0) ce_desc(x[i], x[i + d]);
}
DI void merge_partner(float (&lst)[16], int lane) {
  float o[16];
#pragma unroll
  for (int i = 0; i < 16; ++i) o[i] = other_xor32(lst[i], lane);
  float c[16];
#pragma unroll
  for (int i = 0; i < 16; ++i) c[i] = fmaxf(lst[i], o[15 - i]);
#pragma unroll
  for (int d = 8; d >= 1; d >>= 1) {
#pragma unroll
    for (int i = 0; i < 16; ++i) {
      if ((i & d) == 0) { const float hi = fmaxf(c[i], c[i + d]), lo = fminf(c[i], c[i + d]); c[i] = hi; c[i + d] = lo; }
    }
  }
#pragma unroll
  for (int i = 0; i < 16; ++i) lst[i] = c[i];
}

DI void phase3(KP p, char* smem) {
  const int tid = threadIdx.x, wave = __builtin_amdgcn_readfirstlane(tid >> 6);
  u16* A = (u16*)smem;
  float* ssq2 = (float*)(smem + 146944);
  signed char* A8 = (signed char*)smem;
  float* hs = (float*)(smem + 146944 + 256);
  constexpr int ELD = 132;
  int* eidx = (int*)(smem + 66560);
  float* egate = (float*)(smem + 100352);
  char* scr = p.scratch + (size_t)blockIdx.x * 655360;
  float* x1s = (float*)scr;
  u16* qp = (u16*)(scr + 262144);
  for (int tile = blockIdx.x; tile < NTOK / 64; tile += gridDim.x) {
    int lane_o = tid & 63; asm volatile("" : "+v"(lane_o));
    const int lane = lane_o, l31 = lane & 31, lh = lane >> 5;
    const int tok0 = tile * 64; const int b = tok0 / SEQ;
    const float* modb = p.mod + (size_t)b * 6144;
    if (tid < 64) ssq2[tid] = 0.f;
#pragma unroll 2
    for (int rr = 0; rr < 8; ++rr) {
      const int row = wave * 8 + rr; const int tok = tok0 + row;
      const float rl = rsqrtf(p.ssq_lru[tok] * (1.f / 512.f) + EPS), rm = rsqrtf(p.ssq_mla[tok] * (1.f / 512.f) + EPS);
#pragma unroll
      for (int i = 0; i < 2; ++i) {
        const u32x4 v = *(const u32x4*)(p.y + (size_t)tok * 1024 + (i * 64 + lane) * 8);
        const float sc = i == 0 ? rl : rm;
        u32x4 o;
#pragma unroll
        for (int j = 0; j < 4; ++j) o[j] = pk2(bflo(v[j]) * sc, bfhi(v[j]) * sc);
        *(u32x4*)(A + row * LDA + (i * 64 + lane) * 8) = o;
      }
    }
    __syncthreads();
    float sqa[32];
#pragma unroll
    for (int i = 0; i < 32; ++i) sqa[i] = 0.f;
    bf16x8 ring3[8][2];
    { const int tl0[2] = {wave, wave + 8}; gemm_pro<2, 8>(p.Wf_out, 64, tl0, lane, ring3); }
#pragma unroll 1
    for (int pass = 0; pass < 2; ++pass) {
      f32x16 acc[2][2];
#pragma unroll
      for (int t = 0; t < 2; ++t) { acc[t][0] = zero16(); acc[t][1] = zero16(); }
      const int tl[2] = {pass * 16 + wave, pass * 16 + wave + 8};
      gemm_main<2, 8, false, true>(A, LDA, 64, p.Wf_out, 64, tl, acc, lane, ring3);
      if (pass == 0) { const int tn[2] = {16 + wave, 16 + wave + 8}; gemm_pro<2, 8>(p.Wf_out, 64, tn, lane, ring3); }
      int el_ = lane; asm volatile("" : "+v"(el_));
      const int l31 = el_ & 31, lh = el_ >> 5;
      float g1[2];
#pragma unroll
      for (int t = 0; t < 2; ++t) g1[t] = modb[2048 + tl[t] * 32 + l31];
#pragma unroll
      for (int rt = 0; rt < 2; ++rt)
#pragma unroll
        for (int r = 0; r < 16; ++r) {
          const int row = rt * 32 + crow(r, lh);
#pragma unroll
          for (int t = 0; t < 2; ++t) {
            const int col = tl[t] * 32 + l31;
            const float v = p.x[(size_t)(tok0 + row) * DM + col] + g1[t] * acc[t][rt][r];
            x1s[row * 1024 + col] = v;
            sqa[rt * 16 + r] += v * v;
          }
        }
    }
    {
      const float tot = reduce32(sqa, lane);
      const int l31 = lane & 31, lh = lane >> 5;
      __hip_atomic_fetch_add(&ssq2[(l31 >> 4) * 32 + crow(l31 & 15, lh)], tot, __ATOMIC_RELAXED, __HIP_MEMORY_SCOPE_WORKGROUP);
    }
    __syncthreads();
    {
      f32x4 cm[4], ca[4];
#pragma unroll
      for (int i = 0; i < 4; ++i) {
        const int col = (i >> 1) * 512 + lane * 8 + (i & 1) * 4;
        const f32x4 g = *(const f32x4*)(p.norm2_g + col); const f32x4 sc = *(const f32x4*)(modb + 4096 + col);
        cm[i] = g * (sc + 1.0f); ca[i] = *(const f32x4*)(modb + 3072 + col);
      }
#pragma unroll 2
      for (int rr = 0; rr < 8; ++rr) {
        const int row = wave * 8 + rr;
        const float rs = rsqrtf(ssq2[row] * (1.f / 1024.f) + EPS);
        f32x4 hv[4];
        float hmax = 0.f;
#pragma unroll
        for (int i = 0; i < 2; ++i) {
          const f32x4 xa = *(const f32x4*)(x1s + row * 1024 + i * 512 + lane * 8), xb = *(const f32x4*)(x1s + row * 1024 + i * 512 + lane * 8 + 4);
          hv[2 * i] = xa * rs * cm[2 * i] + ca[2 * i]; hv[2 * i + 1] = xb * rs * cm[2 * i + 1] + ca[2 * i + 1];
#pragma unroll
          for (int j = 0; j < 4; ++j) hmax = fmaxf(hmax, fmaxf(fabsf(hv[2 * i][j]), fabsf(hv[2 * i + 1][j])));
        }
        hmax = wave_max(hmax);
        const float hinv = hmax > 0.f ? 127.f / hmax : 0.f;
#pragma unroll
        for (int i = 0; i < 2; ++i) {
          u32x2 o;
#pragma unroll
          for (int hh = 0; hh < 2; ++hh) {
            unsigned w = 0;
#pragma unroll
            for (int j = 0; j < 4; ++j) w |= ((unsigned)(int)__builtin_rintf(hv[2 * i + hh][j] * hinv) & 255u) << (8 * j);
            o[hh] = w;
          }
          *(u32x2*)(A8 + row * LDA8 + i * 512 + lane * 8) = o;
        }
        if (lane == 0) hs[row] = hmax * (1.f / 127.f);
      }
    }
    __syncthreads();
    float s12[2][16];
#pragma unroll 1
    for (int ph = 0; ph < 2; ++ph) {
      const int hd = wave;
      float lst0[16], lst1[16];
#pragma unroll
      for (int i = 0; i < 16; ++i) { lst0[i] = -3.0e38f; lst1[i] = -3.0e38f; }
#pragma unroll 1
      for (int mtp = 0; mtp < 2; ++mtp) {
        i32x16 acc[2][2];
#pragma unroll
        for (int t = 0; t < 2; ++t)
#pragma unroll
          for (int r = 0; r < 16; ++r) { acc[t][0][r] = 0; acc[t][1][r] = 0; }
        const int tl[2] = {(hd * 2 + ph) * 4 + 2 * mtp, (hd * 2 + ph) * 4 + 2 * mtp + 1};
        gemm8_core<2, 8>(A8, LDA8, 32, p.Wf_s, 32, tl, acc, lane);
        int el_ = lane; asm volatile("" : "+v"(el_));
        const int lh = el_ >> 5;
#pragma unroll
        for (int t = 0; t < 2; ++t) {
          f32x4 w4[4];
#pragma unroll
          for (int g = 0; g < 4; ++g) w4[g] = *(const f32x4*)(p.wsc + tl[t] * 32 + 8 * g + 4 * lh);
          float nv[16];
#pragma unroll
          for (int r = 0; r < 16; ++r) nv[r] = __uint_as_float((__float_as_uint((float)acc[t][0][r] * w4[r >> 2][r & 3]) & 0xffffff80u) | (unsigned)((2 * mtp + t) * 32 + crow(r, lh)));
          sort16_desc(nv);
          merge16_desc(lst0, nv);
#pragma unroll
          for (int r = 0; r < 16; ++r) nv[r] = __uint_as_float((__float_as_uint((float)acc[t][1][r] * w4[r >> 2][r & 3]) & 0xffffff80u) | (unsigned)((2 * mtp + t) * 32 + crow(r, lh)));
          sort16_desc(nv);
          merge16_desc(lst1, nv);
        }
      }
      merge_partner(lst0, lane);
      merge_partner(lst1, lane);
      if (ph == 0) {
#pragma unroll
        for (int i = 0; i < 16; ++i) s12[0][i] = lh ? lst1[i] : lst0[i];
      } else {
#pragma unroll
        for (int i = 0; i < 16; ++i) s12[1][i] = lh ? lst1[i] : lst0[i];
      }
    }
    {
      const int hd = wave;
      unsigned long long t1lo = 0, t1hi = 0, t2lo = 0, t2hi = 0;
#pragma unroll
      for (int i = 0; i < 8; ++i) {
        t1lo |= (unsigned long long)(__float_as_uint(s12[0][i]) & 127u) << (8 * i);
        t1hi |= (unsigned long long)(__float_as_uint(s12[0][8 + i]) & 127u) << (8 * i);
        t2lo |= (unsigned long long)(__float_as_uint(s12[1][i]) & 127u) << (8 * i);
        t2hi |= (unsigned long long)(__float_as_uint(s12[1][8 + i]) & 127u) << (8 * i);
      }
      const float hst = hs[lh * 32 + l31];
      float bv[16];
#pragma unroll
      for (int j = 0; j < 16; ++j) {
        const float sv = (s12[0][0] + s12[1][j]) * hst;
        bv[j] = __uint_as_float((__float_as_uint(sv) & 0xffffff00u) | (unsigned)j);
      }
#pragma unroll
      for (int i = 1; i < 16; ++i) {
#pragma unroll
        for (int j = 0; j < 16; ++j)
          if ((i + 1) * (j + 1) <= 16) {
            const float sv = (s12[0][i] + s12[1][j]) * hst;
            ins16(bv, __uint_as_float((__float_as_uint(sv) & 0xffffff00u) | (unsigned)(i * 16 + j)));
          }
      }
      int bi[16];
#pragma unroll
      for (int k = 0; k < 16; ++k) {
        const unsigned code = __float_as_uint(bv[k]) & 255u;
        const unsigned ci = code >> 4, cj = code & 15u;
        const unsigned long long w1 = (ci & 8u) ? t1hi : t1lo, w2 = (cj & 8u) ? t2hi : t2lo;
        const unsigned i1 = (unsigned)(w1 >> ((ci & 7u) * 8)) & 0xffu, i2 = (unsigned)(w2 >> ((cj & 7u) * 8)) & 0xffu;
        bi[k] = (int)(i1 * 128u + i2);
      }
      float esum = 0.f, ev[16];
#pragma unroll
      for (int i = 0; i < 16; ++i) { ev[i] = __expf(bv[i] - bv[0]); esum += ev[i]; }
      const float einv = 1.f / esum;
      {
        const int row = lh * 32 + l31;
#pragma unroll
        for (int i4 = 0; i4 < 4; ++i4) {
          *(i32x4*)(eidx + row * ELD + hd * 16 + i4 * 4) = (i32x4){bi[i4 * 4], bi[i4 * 4 + 1], bi[i4 * 4 + 2], bi[i4 * 4 + 3]};
          *(f32x4*)(egate + row * ELD + hd * 16 + i4 * 4) = (f32x4){ev[i4 * 4] * einv, ev[i4 * 4 + 1] * einv, ev[i4 * 4 + 2] * einv, ev[i4 * 4 + 3] * einv};
        }
      }
    }
    __syncthreads();
    const __amdgpu_buffer_rsrc_t qrs = __builtin_amdgcn_make_buffer_rsrc((void*)p.Uq, 0, 2 * 16384 * QROWB, 0x00020000);
    const int voff_u = (QBITS == 8) ? lane * 16 : lane * 16, voff_v = voff_u + 16384 * QROWB;
    int n_ia, n_ib; float n_ga, n_gb, n_ua, n_ub, n_ba, n_bb, n_kt, n_hscale; unsigned n_hq[4];
    qrow_t bufA_u[8], bufA_v[8], bufB_u[8], bufB_v[8];
#define GA_PREP(ROW)                                                                                                              \
    {                                                                                                                             \
      const int prow = (ROW);                                                                                                     \
      n_ia = eidx[prow * ELD + lane]; n_ib = eidx[prow * ELD + 64 + lane];                                                        \
      n_ga = egate[prow * ELD + lane]; n_gb = egate[prow * ELD + 64 + lane];                                                      \
      {     \
        unsigned k0 = ((unsigned)n_ia << 7) | (unsigned)lane, k1 = ((unsigned)n_ib << 7) | (unsigned)(64 + lane);                 \
        sort128_asc(k0, k1, lane);                                                                                                \
        const int p0 = (int)(k0 & 127u), p1 = (int)(k1 & 127u);                                                                   \
        const f32x4 sa = ((const f32x4*)p.uscale)[k0 >> 7], sb = ((const f32x4*)p.uscale)[k1 >> 7];        \
        const float ga0 = __shfl(n_ga, p0 & 63), gb0 = __shfl(n_gb, p0 & 63), ga1 = __shfl(n_ga, p1 & 63), gb1 = __shfl(n_gb, p1 & 63); \
        n_ia = (int)(k0 >> 7) * (QBITS == 8 ? QROWB : 2 * QROWB); n_ib = (int)(k1 >> 7) * (QBITS == 8 ? QROWB : 2 * QROWB);       \
        n_ga = ((p0 & 64) ? gb0 : ga0) * sa[1]; n_gb = ((p1 & 64) ? gb1 : ga1) * sb[1];                                           \
        n_ua = sa[0]; n_ub = sb[0]; n_ba = sa[2]; n_bb = sb[2];                                                                   \
      }                                                                                                                           \
      u32x4 hc = *(const u32x4*)(A8 + prow * LDA8 + lane * 16);        \
      _Pragma("unroll") for (int j = 0; j < 4; ++j) hc[j] ^= 0x80808080u;                                                         \
      n_hscale = hs[prow];                                                                                                        \
      unsigned hsi = 0;                                                                                                           \
      _Pragma("unroll") for (int j = 0; j < 4; ++j) hsi = __builtin_amdgcn_udot4(hc[j], 0x01010101u, hsi, false);                 \
      const float hsum = (float)hsi;                                                                                              \
      if (QBITS == 8) {                                                                                                           \
        _Pragma("unroll") for (int j = 0; j < 4; ++j) n_hq[j] = hc[j];                                                            \
      } else {               \
        _Pragma("unroll") for (int jd = 0; jd < 2; ++jd) {                                                                        \
          n_hq[jd] = ((hc[2 * jd] >> 4) & 0x0f0f0f0fu) | (hc[2 * jd + 1] & 0xf0f0f0f0u);                                          \
          n_hq[2 + jd] = (hc[2 * jd] & 0x0f0f0f0fu) | ((hc[2 * jd + 1] & 0x0f0f0f0fu) << 4);                                      \
        }                                                                                                                         \
      }                                                                                                                           \
      n_kt = (QBITS == 8 ? 128.f : 7.5f) * (wave_sum(hsum) - 131072.f);                                                           \
    }
    GA_PREP(wave)
    ga_load(qrs, n_ia, 0, voff_u, voff_v, bufA_u, bufA_v);
#pragma unroll 1
    for (int rr = 0; rr < 8; ++rr) {
      const int row = rr * 8 + wave; const int tok = tok0 + row;
      const int ia = n_ia, ib = n_ib; const float ga = n_ga, gb = n_gb, ua = n_ua, ub = n_ub, ba = n_ba, bb = n_bb, kt = n_kt, hscale = n_hscale;
      unsigned hq[4];
#pragma unroll
      for (int j = 0; j < 4; ++j) hq[j] = n_hq[j];
      f32x4 xv4[4];
#pragma unroll
      for (int q = 0; q < 4; ++q) xv4[q] = *(const f32x4*)(x1s + row * 1024 + lane * 16 + q * 4);
      if (rr + 1 < 8) GA_PREP(row + 8)
      oacc_t oacc[8];
#pragma unroll
      for (int j = 0; j < 8; ++j) { oacc[j][0] = 0; oacc[j][1] = 0; }
      float csum = 0.f;
#pragma unroll 1
      for (int half = 0; half < 2; ++half) {
        const int iv = half ? ib : ia, ivn = half ? n_ia : ib;
        const float gs = half ? gb : ga, us = half ? ub : ua, bs = half ? bb : ba;
        const bool has_next = (half == 0) || (rr + 1 < 8);
#pragma unroll 1
        for (int g8 = 0; g8 < 8; g8 += 2) {
          ga_load(qrs, iv, (g8 + 1) * 8, voff_u, voff_v, bufB_u, bufB_v);
          ga_compute(gs, us, bs, g8 * 8, lane, kt, hscale, hq, bufA_u, bufA_v, oacc, csum);
          if (g8 + 2 < 8) ga_load(qrs, iv, (g8 + 2) * 8, voff_u, voff_v, bufA_u, bufA_v);
          else if (has_next) ga_load(qrs, ivn, 0, voff_u, voff_v, bufA_u, bufA_v);
          ga_compute(gs, us, bs, (g8 + 1) * 8, lane, kt, hscale, hq, bufB_u, bufB_v, oacc, csum);
        }
      }
      {
#if QBITS == 8
        const float corr = wave_sum(csum) * (128.f / 8.f);
#pragma unroll
        for (int j = 0; j < 8; ++j) oacc[j] = oacc[j] - corr;
#endif
      }
      float xo[16]; float ss = 0.f;
#pragma unroll
      for (int q = 0; q < 4; ++q) {
        const int col = lane * 16 + q * 4;
        const f32x4 xv = xv4[q];
        const f32x4 g2 = *(const f32x4*)(modb + 5120 + col);
#pragma unroll
        for (int j = 0; j < 4; ++j) { const float v = xv[j] + g2[j] * ((float)oacc[q * 2 + (j >> 1)][j & 1] * (1.f / OACC_SCALE)); xo[q * 4 + j] = v; ss += v * v; }
      }
      ss = wave_sum(ss);
      const float rs = rsqrtf(ss * (1.f / 1024.f) + EPS);
#pragma unroll
      for (int q = 0; q < 4; ++q) {
        const int col = lane * 16 + q * 4;
        const f32x4 fg = *(const f32x4*)(p.final_g + col);
        f32x4 o;
#pragma unroll
        for (int j = 0; j < 4; ++j) o[j] = xo[q * 4 + j] * rs * fg[j];
        *(f32x4*)(p.out + (size_t)tok * DM + col) = o;
      }
    }
#undef GA_PREP
    __syncthreads();
  }
}

template <int MODE>
__global__ void __launch_bounds__(NTHREADS) mk_fwd(Params p) {
  extern __shared__ __attribute__((aligned(16))) char smem[];
  if (MODE < 0) {
    cg::grid_group grid = cg::this_grid();
    typedef const __attribute__((address_space(4))) Params* KPP;
    { KPP kp = (KPP)__builtin_amdgcn_kernarg_segment_ptr(); asm volatile("" : "+s"(kp)); phase0(*kp, smem); }
    grid.sync();
    { KPP kp = (KPP)__builtin_amdgcn_kernarg_segment_ptr(); asm volatile("" : "+s"(kp)); phase1(*kp, smem); }
    grid.sync();
    { KPP kp = (KPP)__builtin_amdgcn_kernarg_segment_ptr(); asm volatile("" : "+s"(kp)); phase2(*kp, smem); }
    grid.sync();
    { KPP kp = (KPP)__builtin_amdgcn_kernarg_segment_ptr(); asm volatile("" : "+s"(kp)); phase3(*kp, smem); }
#ifdef PROBE_P3X2
    grid.sync();
    phase3(p, smem);
#endif
#ifdef PROBE_P1X2
    grid.sync();
    phase1(p, smem);
#endif
  } else {
    typedef const __attribute__((address_space(4))) Params* KPP;
    KPP kp = (KPP)__builtin_amdgcn_kernarg_segment_ptr();
    if (MODE == 0) phase0(*kp, smem);
    if (MODE == 1) phase1(*kp, smem);
    if (MODE == 2) phase2(*kp, smem);
    if (MODE == 3) phase3(*kp, smem);
  }
}

static size_t align_up(size_t v) { return (v + 255) & ~(size_t)255; }

extern "C" void kernel_launch(void* const* d_in, const int* in_sizes, int n_in, void* d_out, int out_size, void* d_ws, size_t ws_size, hipStream_t stream) {
  static int grid = 0;
  if (grid == 0) {
    int dev = 0, cus = 0, per_cu = 0;
    (void)hipGetDevice(&dev);
    (void)hipDeviceGetAttribute(&cus, hipDeviceAttributeMultiprocessorCount, dev);
#if N_LAUNCH_MODE == 1
    (void)hipFuncSetAttribute((const void*)mk_fwd<-1>, hipFuncAttributeMaxDynamicSharedMemorySize, LDS_BYTES);
    (void)hipOccupancyMaxActiveBlocksPerMultiprocessor(&per_cu, (const void*)mk_fwd<-1>, NTHREADS, LDS_BYTES);
#else
    (void)hipFuncSetAttribute((const void*)mk_fwd<0>, hipFuncAttributeMaxDynamicSharedMemorySize, LDS_BYTES);
    (void)hipFuncSetAttribute((const void*)mk_fwd<1>, hipFuncAttributeMaxDynamicSharedMemorySize, LDS_BYTES);
    (void)hipFuncSetAttribute((const void*)mk_fwd<2>, hipFuncAttributeMaxDynamicSharedMemorySize, LDS_BYTES);
    (void)hipFuncSetAttribute((const void*)mk_fwd<3>, hipFuncAttributeMaxDynamicSharedMemorySize, LDS_BYTES);
    (void)hipOccupancyMaxActiveBlocksPerMultiprocessor(&per_cu, (const void*)mk_fwd<3>, NTHREADS, LDS_BYTES);
#endif
    if (per_cu < 1) { fprintf(stderr, "kernel_launch: occupancy query says %d blocks/CU\n", per_cu); per_cu = 1; }
    if (per_cu > 1) per_cu = 1;
    grid = cus * per_cu;
    if (grid > 256) grid = 256;
    (void)hipGetLastError();
  }
  Params p{};
  const float* const* fin = (const float* const*)d_in;
  p.x = fin[0]; p.c = fin[1]; p.pos = (const int*)d_in[2];
  p.w_ada = fin[3]; p.b_ada = fin[4]; p.norm1_g = fin[5]; p.w_in = fin[6]; p.conv_w = fin[7]; p.conv_b = fin[8];
  p.lru_wa = fin[9]; p.lru_ba = fin[10]; p.lru_wx = fin[11]; p.lru_bx = fin[12]; p.lru_lambda = fin[13];
  p.q_norm_g = fin[14]; p.w_uq = fin[15]; p.kv_norm_g = fin[16]; p.w_ukv = fin[17]; p.lru_out_g = fin[18]; p.mla_out_g = fin[19];
  p.w_out = fin[20]; p.norm2_g = fin[21]; p.peer_wq = fin[22]; p.peer_keys = fin[23]; p.peer_u = fin[24]; p.peer_v = fin[25]; p.final_g = fin[26];
  p.out = (float*)d_out;
  char* w = (char*)d_ws; size_t off = 0;
  auto take = [&](size_t bytes) { char* r = w + off; off = align_up(off + bytes); return r; };
  p.mod = (float*)take((size_t)NB * 6144 * 4);
  p.ssq_lru = (float*)take((size_t)NTOK * 4);
  p.ssq_mla = (float*)take((size_t)NTOK * 4);
  p.invfreq = (double*)take(16 * 8);
  p.Wf_in = (bf16x8*)take((size_t)INW * 1024 * 2);
  p.Wf_uq = (bf16x8*)take((size_t)768 * 256 * 2);
  p.Wf_ukv = (bf16x8*)take((size_t)1024 * 128 * 2);
  p.Wf_a = (bf16x8*)take((size_t)8 * 64 * 64 * 2);
  p.Wf_x = (bf16x8*)take((size_t)8 * 64 * 64 * 2);
  p.Wf_out = (bf16x8*)take((size_t)1024 * 1024 * 2);
  p.Wf_s = (i32x4*)take((size_t)2048 * 1024);
  p.Wsf = (float*)take((size_t)2048 * 1024 * 4);
  p.wsmaxp = (float*)take((size_t)2048 * 16 * 4);
  p.wsc = (float*)take((size_t)2048 * 4);
  p.Uq = (unsigned char*)take((size_t)2 * 16384 * QROWB);
  p.Vq = p.Uq + (size_t)16384 * QROWB;
  p.uscale = (float*)take((size_t)16384 * 16);
  p.vscale = p.uscale; p.ubias = p.uscale;
  p.xlru = (u16*)take((size_t)NTOK * 512 * 2);
  p.gate = (u16*)take((size_t)NTOK * 512 * 2);
  p.Q = (u16*)take((size_t)NTOK * 768 * 2);
  p.Kn = (u16*)take((size_t)NTOK * 512 * 2);
  p.Kr = (u16*)take((size_t)NTOK * 32 * 2);
  p.Vt = (u16*)take((size_t)NTOK * 512 * 2);
  p.y = (u16*)take((size_t)NTOK * 1024 * 2);
  p.scratch = take((size_t)256 * 655360);
  if (off > ws_size) { fprintf(stderr, "kernel_launch: workspace too small: need %zu have %zu\n", off, ws_size); return; }
#if N_LAUNCH_MODE == 1
  void* args[] = {&p};
  hipError_t e = hipLaunchCooperativeKernel((const void*)mk_fwd<-1>, dim3(grid), dim3(NTHREADS), args, LDS_BYTES, stream);
  if (e != hipSuccess) fprintf(stderr, "cooperative launch failed: %s (grid %d)\n", hipGetErrorString(e), grid);
#else
  hipLaunchKernelGGL(mk_fwd<0>, dim3(grid), dim3(NTHREADS), LDS_BYTES, stream, p);
  hipLaunchKernelGGL(mk_fwd<1>, dim3(grid), dim3(NTHREADS), LDS_BYTES, stream, p);
  hipLaunchKernelGGL(mk_fwd<2>, dim3(grid), dim3(NTHREADS), LDS_BYTES, stream, p);
  hipLaunchKernelGGL(mk_fwd<3>, dim3(grid), dim3(NTHREADS), LDS_BYTES, stream, p);
#endif
}
```

```cpp
#include <hip/hip_runtime.h>
#include <hip/hip_cooperative_groups.h>
#include <cstdio>
#include <cstdint>
namespace cg = cooperative_groups;

#ifndef QBITS
#define QBITS 4
#endif
#ifndef N_LAUNCH_MODE
#define N_LAUNCH_MODE 1
#endif

typedef short bf16x8 __attribute__((ext_vector_type(8)));
typedef float f32x16 __attribute__((ext_vector_type(16)));
typedef float f32x4 __attribute__((ext_vector_type(4)));
typedef float f32x2 __attribute__((ext_vector_type(2)));
typedef unsigned u32x4 __attribute__((ext_vector_type(4)));
typedef unsigned u32x2 __attribute__((ext_vector_type(2)));
typedef __bf16 bf16x2_t __attribute__((ext_vector_type(2)));
typedef unsigned short u16;
typedef _Float16 h16x2 __attribute__((ext_vector_type(2)));

#define DI __device__ __forceinline__
#define MFMA32(a, b, c) __builtin_amdgcn_mfma_f32_32x32x16_bf16((a), (b), (c), 0, 0, 0)
typedef int i32x4 __attribute__((ext_vector_type(4)));
typedef int i32x16 __attribute__((ext_vector_type(16)));
#define MFMA8(a, b, c) __builtin_amdgcn_mfma_i32_32x32x32_i8((a), (b), (c), 0, 0, 0)

constexpr int NB = 32, SEQ = 2048, DM = 1024, NTOK = NB * SEQ;
constexpr int INW = 1440;
constexpr int NTHREADS = 512;
constexpr int LDA = 1032;
constexpr int LDA8 = 1040;
constexpr int LDS_BYTES = 147456;
constexpr float EPS = 1e-6f;

struct Params {
  const float* x; const float* c; const int* pos;
  const float* w_ada; const float* b_ada; const float* norm1_g; const float* w_in; const float* conv_w; const float* conv_b;
  const float* lru_wa; const float* lru_ba; const float* lru_wx; const float* lru_bx; const float* lru_lambda;
  const float* q_norm_g; const float* w_uq; const float* kv_norm_g; const float* w_ukv; const float* lru_out_g; const float* mla_out_g;
  const float* w_out; const float* norm2_g; const float* peer_wq; const float* peer_keys; const float* peer_u; const float* peer_v; const float* final_g;
  float* out;
  float* mod; float* ssq_lru; float* ssq_mla; double* invfreq;
  bf16x8* Wf_in; bf16x8* Wf_uq; bf16x8* Wf_ukv; bf16x8* Wf_a; bf16x8* Wf_x; bf16x8* Wf_out; i32x4* Wf_s;
  float* Wsf; float* wsmaxp; float* wsc;
  unsigned char* Uq; unsigned char* Vq; float* uscale; float* vscale; float* ubias; u16* xlru; u16* gate; u16* Q; u16* Kn; u16* Kr; u16* Vt; u16* y;
  char* scratch;
};

typedef const __attribute__((address_space(4))) Params& KP;

DI unsigned pk2(float a, float b) { f32x2 v = {a, b}; bf16x2_t r = __builtin_convertvector(v, bf16x2_t); return __builtin_bit_cast(unsigned, r); }
DI u16 f2bf(float a) { return (u16)(pk2(a, 0.f) & 0xffffu); }
DI float bflo(unsigned u) { return __uint_as_float(u << 16); }
DI float bfhi(unsigned u) { return __uint_as_float(u & 0xffff0000u); }
DI float bf2f(u16 h) { return __uint_as_float(((unsigned)h) << 16); }
template <int CTRL> DI float dppf(float v) { return __builtin_bit_cast(float, __builtin_amdgcn_update_dpp(0, __builtin_bit_cast(int, v), CTRL, 0xF, 0xF, true)); }
typedef unsigned u32x2_ __attribute__((ext_vector_type(2)));
DI float wave_sum(float v) {
  v += dppf<0xB1>(v); v += dppf<0x4E>(v); v += dppf<0x141>(v); v += dppf<0x140>(v);
  u32x2_ r = __builtin_amdgcn_permlane16_swap(__float_as_uint(v), __float_as_uint(v), false, false); v = __uint_as_float(r[0]) + __uint_as_float(r[1]);
  r = __builtin_amdgcn_permlane32_swap(__float_as_uint(v), __float_as_uint(v), false, false); v = __uint_as_float(r[0]) + __uint_as_float(r[1]);
  return v;
}
DI float wave_max(float v) {
  v = fmaxf(v, dppf<0xB1>(v)); v = fmaxf(v, dppf<0x4E>(v)); v = fmaxf(v, dppf<0x141>(v)); v = fmaxf(v, dppf<0x140>(v));
  u32x2_ r = __builtin_amdgcn_permlane16_swap(__float_as_uint(v), __float_as_uint(v), false, false); v = fmaxf(__uint_as_float(r[0]), __uint_as_float(r[1]));
  r = __builtin_amdgcn_permlane32_swap(__float_as_uint(v), __float_as_uint(v), false, false); v = fmaxf(__uint_as_float(r[0]), __uint_as_float(r[1]));
  return v;
}
template <int CTRL> DI unsigned dppu(unsigned v) { return (unsigned)__builtin_amdgcn_update_dpp(0, (int)v, CTRL, 0xF, 0xF, true); }
template <int J> DI unsigned lane_xor_u(unsigned v, int lane) {
  if (J == 1) return dppu<0xB1>(v);
  if (J == 2) return dppu<0x4E>(v);
  if (J == 4) return dppu<0x141>(dppu<0x1B>(v));
  if (J == 8) return dppu<0x128>(v);
  if (J == 16) { const u32x2_ r = __builtin_amdgcn_permlane16_swap(v, v, false, false); return (lane & 16) ? r[0] : r[1]; }
  const u32x2_ r = __builtin_amdgcn_permlane32_swap(v, v, false, false); return (lane & 32) ? r[0] : r[1];
}
template <int J> DI float lane_xor_f(float v, int lane) { return __uint_as_float(lane_xor_u<J>(__float_as_uint(v), lane)); }
DI float sum_xor32(float v) { const u32x2_ r = __builtin_amdgcn_permlane32_swap(__float_as_uint(v), __float_as_uint(v), false, false); return __uint_as_float(r[0]) + __uint_as_float(r[1]); }
DI float max_xor32(float v) { const u32x2_ r = __builtin_amdgcn_permlane32_swap(__float_as_uint(v), __float_as_uint(v), false, false); return fmaxf(__uint_as_float(r[0]), __uint_as_float(r[1])); }
DI float other_xor32(float v, int lane) { const u32x2_ r = __builtin_amdgcn_permlane32_swap(__float_as_uint(v), __float_as_uint(v), false, false); return __uint_as_float((lane & 32) ? r[0] : r[1]); }
DI float reduce8(const float (&v)[8], int lane) {
  float q4[4], r2[2];
#pragma unroll
  for (int j = 0; j < 4; ++j) {
    const u32x2_ r = __builtin_amdgcn_permlane32_swap(__float_as_uint(v[j]), __float_as_uint(v[4 + j]), false, false);
    q4[j] = __uint_as_float(r[0]) + __uint_as_float(r[1]);
  }
#pragma unroll
  for (int j = 0; j < 2; ++j) {
    const u32x2_ r = __builtin_amdgcn_permlane16_swap(__float_as_uint(q4[j]), __float_as_uint(q4[2 + j]), false, false);
    r2[j] = __uint_as_float(r[0]) + __uint_as_float(r[1]);
  }
  const float s0 = r2[0] + dppf<0x128>(r2[0]), s1b = r2[1] + dppf<0x128>(r2[1]);
  float s1 = (lane & 8) ? s1b : s0;
  s1 += dppf<0xB1>(s1);
  s1 += dppf<0x4E>(s1);
  s1 += dppf<0x141>(s1);
  return s1;
}
DI float reduce32(const float (&v)[32], int lane) {
  const bool b3 = (lane & 8) != 0, b2 = (lane & 4) != 0, b1 = (lane & 2) != 0, b0 = (lane & 1) != 0;
  float a16[16], a8[8], a4[4], a2[2];
#pragma unroll
  for (int j = 0; j < 16; ++j) {
    const u32x2_ r = __builtin_amdgcn_permlane16_swap(__float_as_uint(v[j]), __float_as_uint(v[16 + j]), false, false);
    a16[j] = __uint_as_float(r[0]) + __uint_as_float(r[1]);
  }
#pragma unroll
  for (int j = 0; j < 8; ++j) { const float keep = b3 ? a16[8 + j] : a16[j], send = b3 ? a16[j] : a16[8 + j]; a8[j] = keep + lane_xor_f<8>(send, lane); }
#pragma unroll
  for (int j = 0; j < 4; ++j) { const float keep = b2 ? a8[4 + j] : a8[j], send = b2 ? a8[j] : a8[4 + j]; a4[j] = keep + lane_xor_f<4>(send, lane); }
#pragma unroll
  for (int j = 0; j < 2; ++j) { const float keep = b1 ? a4[2 + j] : a4[j], send = b1 ? a4[j] : a4[2 + j]; a2[j] = keep + lane_xor_f<2>(send, lane); }
  const float keep = b0 ? a2[1] : a2[0], send = b0 ? a2[0] : a2[1];
  return keep + lane_xor_f<1>(send, lane);
}
DI float sigmoidf_(float x) { return __builtin_amdgcn_rcpf(1.f + __builtin_amdgcn_exp2f(-1.4426950408889634f * x)); }
DI float gelu_tanh(float x) { const float u = 0.7978845608028654f * (x + 0.044715f * x * x * x); return x * __builtin_amdgcn_rcpf(1.f + __builtin_amdgcn_exp2f(-2.f * 1.4426950408889634f * u)); }
DI float one_minus_exp_small(float z) {
  float q = 1.f + z * (1.f / 6.f);
  q = 1.f + z * (1.f / 5.f) * q;
  q = 1.f + z * (1.f / 4.f) * q;
  q = 1.f + z * (1.f / 3.f) * q;
  q = 1.f + z * (1.f / 2.f) * q;
  return -z * q;
}
DI f32x16 zero16() { f32x16 z; for (int i = 0; i < 16; ++i) z[i] = 0.f; return z; }
DI int crow(int reg, int h) { return (reg & 3) + 8 * (reg >> 2) + 4 * h; }

template <int NT, int PD>
DI void gemm_pro(const bf16x8* __restrict__ Wf, int KS, const int (&tile)[NT], int lane, bf16x8 (&bq)[PD][NT]) {
#pragma unroll
  for (int d = 0; d < PD; ++d)
#pragma unroll
    for (int t = 0; t < NT; ++t) bq[d][t] = Wf[((size_t)tile[t] * KS + d) * 64 + lane];
}
template <int NT, int PD, bool SWAP, bool APF = false>
DI void gemm_main(const u16* As, int lda, int nks, const bf16x8* __restrict__ Wf, int KS, const int (&tile)[NT], f32x16 (&acc)[NT][2], int lane, bf16x8 (&bq)[PD][NT]) {
  const bf16x8* a0p = (const bf16x8*)(As + (lane & 31) * lda + 8 * (lane >> 5));
  const bf16x8* a1p = (const bf16x8*)(As + ((lane & 31) + 32) * lda + 8 * (lane >> 5));
  const bf16x8* bp[NT];
#pragma unroll
  for (int t = 0; t < NT; ++t) bp[t] = Wf + (size_t)tile[t] * KS * 64 + lane;
  bf16x8 a0n = a0p[0], a1n = a1p[0];
#pragma unroll 1
  for (int ks = 0; ks < nks; ks += PD) {
#pragma unroll
    for (int d = 0; d < PD; ++d) {
      bf16x8 a0, a1;
      if (APF) { a0 = a0n; a1 = a1n; const int ka = (ks + d + 1 < nks) ? (ks + d + 1) : (ks + d); a0n = a0p[2 * ka]; a1n = a1p[2 * ka]; }
      else { a0 = a0p[2 * (ks + d)]; a1 = a1p[2 * (ks + d)]; }
      const int kn = (ks + d + PD < nks) ? (ks + d + PD) : (ks + d);
#pragma unroll
      for (int t = 0; t < NT; ++t) {
        const bf16x8 b = bq[d][t];
        bq[d][t] = bp[t][kn * 64];
        acc[t][0] = SWAP ? MFMA32(b, a0, acc[t][0]) : MFMA32(a0, b, acc[t][0]);
        acc[t][1] = SWAP ? MFMA32(b, a1, acc[t][1]) : MFMA32(a1, b, acc[t][1]);
      }
    }
  }
}
template <int NT, int PD = 8, bool SWAP = false>
DI void gemm_core(const u16* As, int lda, int nks, const bf16x8* __restrict__ Wf, int KS, const int (&tile)[NT], f32x16 (&acc)[NT][2], int lane) {
  bf16x8 bq[PD][NT];
  gemm_pro<NT, PD>(Wf, KS, tile, lane, bq);
  gemm_main<NT, PD, SWAP>(As, lda, nks, Wf, KS, tile, acc, lane, bq);
}

template <int NT, int PD>
DI void gemm8_pro(const i32x4* __restrict__ Wf, int KS, const int (&tile)[NT], int lane, i32x4 (&bq)[PD][NT]) {
#pragma unroll
  for (int d = 0; d < PD; ++d)
#pragma unroll
    for (int t = 0; t < NT; ++t) bq[d][t] = Wf[((size_t)tile[t] * KS + d) * 64 + lane];
}
template <int NT, int PD>
DI void gemm8_main(const signed char* As, int lda, int nks, const i32x4* __restrict__ Wf, int KS, const int (&tile)[NT], i32x16 (&acc)[NT][2], int lane, i32x4 (&bq)[PD][NT]) {
  const i32x4* a0p = (const i32x4*)(As + (lane & 31) * lda + 16 * (lane >> 5));
  const i32x4* a1p = (const i32x4*)(As + ((lane & 31) + 32) * lda + 16 * (lane >> 5));
  const i32x4* bp[NT];
#pragma unroll
  for (int t = 0; t < NT; ++t) bp[t] = Wf + (size_t)tile[t] * KS * 64 + lane;
#pragma unroll 1
  for (int ks = 0; ks < nks; ks += PD) {
#pragma unroll
    for (int d = 0; d < PD; ++d) {
      const i32x4 a0 = a0p[2 * (ks + d)], a1 = a1p[2 * (ks + d)];
      const int kn = (ks + d + PD < nks) ? (ks + d + PD) : (ks + d);
#pragma unroll
      for (int t = 0; t < NT; ++t) {
        const i32x4 b = bq[d][t];
        bq[d][t] = bp[t][kn * 64];
        acc[t][0] = MFMA8(b, a0, acc[t][0]);
        acc[t][1] = MFMA8(b, a1, acc[t][1]);
      }
    }
  }
}

DI void conv_frag(const float* __restrict__ W, long sk, long sn, int K, int N, const float* ks1, const float* ks2, int ksplit, bf16x8* out, int gtid, int gthreads) {
  const int KS = K / 16; const int total = (N / 32) * KS * 64;
  for (int i = gtid; i < total; i += gthreads) {
    const int lane = i & 63; const int t = i >> 6; const int ks = t % KS; const int nt = t / KS;
    const int n = nt * 32 + (lane & 31); const int k0 = ks * 16 + 8 * (lane >> 5);
    float v[8];
#pragma unroll
    for (int j = 0; j < 8; ++j) {
      const int k = k0 + j;
      float s = 1.f;
      if (ks1) s = (k < ksplit) ? ks1[k] : ks2[k - ksplit];
      v[j] = W[(long)k * sk + (long)n * sn] * s;
    }
    u32x4 o; o[0] = pk2(v[0], v[1]); o[1] = pk2(v[2], v[3]); o[2] = pk2(v[4], v[5]); o[3] = pk2(v[6], v[7]);
    out[i] = __builtin_bit_cast(bf16x8, o);
  }
}

DI void conv_one(const float* __restrict__ W, long sk, int KS, const float* ks1, const float* ks2, int ksplit, bf16x8* out, int i) {
  const int lane = i & 63; const int t = i >> 6; const int ks = t % KS; const int nt = t / KS;
  const int n = nt * 32 + (lane & 31); const int k0 = ks * 16 + 8 * (lane >> 5);
  float v[8];
#pragma unroll
  for (int j = 0; j < 8; ++j) v[j] = W[(long)(k0 + j) * sk + n];
  if (ks1) {
#pragma unroll
    for (int j = 0; j < 8; ++j) { const int k = k0 + j; v[j] *= (k < ksplit) ? ks1[k] : ks2[k - ksplit]; }
  }
  u32x4 o; o[0] = pk2(v[0], v[1]); o[1] = pk2(v[2], v[3]); o[2] = pk2(v[4], v[5]); o[3] = pk2(v[6], v[7]);
  out[i] = __builtin_bit_cast(bf16x8, o);
}

DI void phase0(KP p, char* smem) {
  const int tid = threadIdx.x; const int gtid = blockIdx.x * NTHREADS + tid; const int gthreads = gridDim.x * NTHREADS;
  for (int i = gtid; i < NTOK; i += gthreads) { p.ssq_lru[i] = 0.f; p.ssq_mla[i] = 0.f; }
  if (gtid < 16) p.invfreq[gtid] = pow(10000.0, -(double)gtid / 16.0);
  {
    float* cact = (float*)smem;
    float* red = (float*)(smem + 65536);
    const int lane = tid & 63, wv = tid >> 6;
    for (int item = blockIdx.x; item < 192; item += gridDim.x) {
      const int cg = item >> 1, bh = item & 1;
      for (int i = tid; i < 16 * DM; i += NTHREADS) { const int bb = i >> 10, k = i & 1023; const float v = p.c[(bh * 16 + bb) * DM + k]; cact[k * 16 + bb] = v / (1.f + __expf(-v)); }
      __syncthreads();
      float acc[16];
#pragma unroll
      for (int bb = 0; bb < 16; ++bb) acc[bb] = 0.f;
      const float* wp = p.w_ada + (size_t)(wv * 128) * 6144 + cg * 64 + lane;
#pragma unroll 32
      for (int kk = 0; kk < 128; ++kk) {
        const float w = wp[(size_t)kk * 6144];
        const f32x4* cp = (const f32x4*)(cact + (wv * 128 + kk) * 16);
#pragma unroll
        for (int q = 0; q < 4; ++q) { const f32x4 cv = cp[q]; acc[4 * q] += cv[0] * w; acc[4 * q + 1] += cv[1] * w; acc[4 * q + 2] += cv[2] * w; acc[4 * q + 3] += cv[3] * w; }
      }
#pragma unroll
      for (int bb = 0; bb < 16; ++bb) red[(wv * 16 + bb) * 64 + lane] = acc[bb];
      __syncthreads();
      for (int o = tid; o < 1024; o += NTHREADS) {
        const int bb = o >> 6, c2 = o & 63;
        float sum = 0.f;
#pragma unroll
        for (int w8 = 0; w8 < 8; ++w8) sum += red[(w8 * 16 + bb) * 64 + c2];
        p.mod[(size_t)(bh * 16 + bb) * 6144 + cg * 64 + c2] = sum + p.b_ada[cg * 64 + c2];
      }
      __syncthreads();
    }
  }
  {
    constexpr int N_IN = 45 * 64 * 64, N_UQ = 24 * 16 * 64, N_UKV = 32 * 8 * 64, N_LRU = 16 * 512, N_OUT = 32 * 64 * 64;
    for (int i = gtid; i < N_IN + N_UQ + N_UKV + N_LRU + N_OUT; i += gthreads) {
      int j = i;
      if (j < N_OUT) { conv_one(p.w_out, 1024, 64, p.lru_out_g, p.mla_out_g, 512, p.Wf_out, j); continue; }
      j -= N_OUT;
      if (j < N_IN) { conv_one(p.w_in, INW, 64, nullptr, nullptr, 0, p.Wf_in, j); continue; }
      j -= N_IN;
      if (j < N_UQ) { conv_one(p.w_uq, 768, 16, p.q_norm_g, p.q_norm_g, 256, p.Wf_uq, j); continue; }
      j -= N_UQ;
      if (j < N_UKV) { conv_one(p.w_ukv, 1024, 8, p.kv_norm_g, p.kv_norm_g, 128, p.Wf_ukv, j); continue; }
      j -= N_UKV;
      { const int h = j >> 10, m = (j >> 9) & 1, f = j & 511; conv_one((m ? p.lru_wx : p.lru_wa) + h * 4096, 64, 4, nullptr, nullptr, 0, (m ? p.Wf_x : p.Wf_a) + h * 512, f); }
    }
  }
  {
    float* kl = (float*)smem;
    float* wl = (float*)(smem + 67584);
    const int lane = tid & 63, wv = tid >> 6, l31 = lane & 31, lh = lane >> 5;
    for (int item = blockIdx.x; item < 256; item += gridDim.x) {
      const int hp = item >> 4, cc = item & 15;
      __syncthreads();
#pragma unroll
      for (int i = 0; i < 8; ++i) { const int e = tid + NTHREADS * i; const int r = e >> 5, q = e & 31; *(f32x4*)(kl + r * 132 + q * 4) = *(const f32x4*)(p.peer_keys + (size_t)hp * 16384 + r * 128 + q * 4); }
#pragma unroll
      for (int i = 0; i < 4; ++i) { const int e = tid + NTHREADS * i; const int c = e >> 5, q = e & 31; *(f32x4*)(wl + c * 132 + q * 4) = *(const f32x4*)(p.peer_wq + (size_t)(cc * 64 + c) * 2048 + hp * 128 + q * 4); }
      __syncthreads();
      const int rt = wv >> 1, ct = wv & 1;
      const float* ap = kl + (rt * 32 + l31) * 132 + 8 * lh;
      const float* bp = wl + (ct * 32 + l31) * 132 + 8 * lh;
      f32x16 acc = zero16();
#pragma unroll
      for (int ks = 0; ks < 8; ++ks) {
        const f32x4 a0 = *(const f32x4*)(ap + 16 * ks), a1 = *(const f32x4*)(ap + 16 * ks + 4);
        const f32x4 b0 = *(const f32x4*)(bp + 16 * ks), b1 = *(const f32x4*)(bp + 16 * ks + 4);
        u32x4 av, bv;
        av[0] = pk2(a0[0], a0[1]); av[1] = pk2(a0[2], a0[3]); av[2] = pk2(a1[0], a1[1]); av[3] = pk2(a1[2], a1[3]);
        bv[0] = pk2(b0[0], b0[1]); bv[1] = pk2(b0[2], b0[3]); bv[2] = pk2(b1[0], b1[1]); bv[3] = pk2(b1[2], b1[3]);
        acc = MFMA32(__builtin_bit_cast(bf16x8, av), __builtin_bit_cast(bf16x8, bv), acc);
      }
      float* dst = p.Wsf + (size_t)(hp * 128 + rt * 32) * 1024 + cc * 64 + ct * 32 + l31;
#pragma unroll
      for (int r = 0; r < 16; ++r) dst[(size_t)crow(r, lh) * 1024] = acc[r];
    }
    __syncthreads();
  }
#if QBITS == 8
  {
    const int lane = tid & 63; const int gw = gtid >> 6; const int nw = gthreads >> 6;
    for (int row = gw; row < 32768; row += nw) {
      const int r = row & 16383; const bool isv = row >= 16384;
      const f32x4* src = (const f32x4*)((isv ? p.peer_v : p.peer_u) + (size_t)r * 1024) + lane * 4;
      f32x4 a[4];
#pragma unroll
      for (int i = 0; i < 4; ++i) a[i] = src[i];
#if QBITS == 8
      float am = 0.f;
#pragma unroll
      for (int i = 0; i < 4; ++i)
#pragma unroll
        for (int j = 0; j < 4; ++j) am = fmaxf(am, fabsf(a[i][j]));
      am = wave_max(am);
      const float inv = am > 0.f ? 127.f / am : 0.f;
      u32x4 o;
#pragma unroll
      for (int i = 0; i < 4; ++i) {
        unsigned w = 0;
#pragma unroll
        for (int j = 0; j < 4; ++j) { const int q = (int)__builtin_rintf(a[i][j] * inv) + 128; w |= (unsigned)q << (8 * j); }
        o[i] = w;
      }
      ((u32x4*)(isv ? p.Vq : p.Uq))[(size_t)r * 64 + lane] = o;
      const float step = am * (1.f / 127.f);
      if (lane == 0) p.uscale[r * 4 + (isv ? 1 : 0)] = step;
      float ns = 0.f;
#pragma unroll
      for (int i = 0; i < 4; ++i) ns += (float)(o[i] & 255u) + (float)((o[i] >> 8) & 255u) + (float)((o[i] >> 16) & 255u) + (float)(o[i] >> 24);
      ns = wave_sum(ns);
      if (lane == 0 && !isv) p.uscale[r * 4 + 2] = step * 128.f * ns;
#else
      float ssum = 0.f;
#pragma unroll
      for (int i = 0; i < 4; ++i)
#pragma unroll
        for (int j = 0; j < 4; ++j) ssum += a[i][j] * a[i][j];
      ssum = wave_sum(ssum);
      const float rms = sqrtf(ssum * (1.f / 1024.f));
      const float step = (isv ? 0.49f : 0.3352f) * rms;
      const float inv = step > 0.f ? 1.f / step : 0.f;
      u32x2 o;
#pragma unroll
      for (int jd = 0; jd < 2; ++jd) {
        unsigned w = 0;
#pragma unroll
        for (int e = 0; e < 8; ++e) {
          const float x = a[(8 * jd + e) >> 2][(8 * jd + e) & 3];
          if (isv) {
            const float m = fabsf(x) * inv;
            const int mag = (m > 0.25f) + (m > 0.75f) + (m > 1.25f) + (m > 1.75f) + (m > 2.5f) + (m > 3.5f) + (m > 5.0f);
            w |= (unsigned)(mag | (x < 0.f ? 8 : 0)) << (4 * e);
          } else {
            int q = (int)__builtin_rintf(x * inv + 7.5f); q = q < 0 ? 0 : (q > 15 ? 15 : q);
            w |= (unsigned)q << (8 * (e & 3) + 4 * (e >> 2));
          }
        }
        o[jd] = w;
      }
      ((u32x2*)(p.Uq + (size_t)r * 1024))[2 * lane + (isv ? 1 : 0)] = o;
      if (lane == 0) p.uscale[r * 4 + (isv ? 1 : 0)] = step;
      float ns = 0.f;
#pragma unroll
      for (int jd = 0; jd < 2; ++jd)
#pragma unroll
        for (int e = 0; e < 8; ++e) ns += (float)((o[jd] >> (4 * e)) & 15u);
      ns = wave_sum(ns);
      if (lane == 0 && !isv) p.uscale[r * 4 + 2] = step * 128.f * ns;
#endif
    }
  }
#else
  {
    const int lane = tid & 63; const int gw = gtid >> 6; const int nw = gthreads >> 6;
    for (int r = gw; r < 16384; r += nw) {
      const f32x4* su = (const f32x4*)(p.peer_u + (size_t)r * 1024) + lane * 4;
      const f32x4* sv = (const f32x4*)(p.peer_v + (size_t)r * 1024) + lane * 4;
      f32x4 au[4], av[4];
#pragma unroll
      for (int i = 0; i < 4; ++i) { au[i] = su[i]; av[i] = sv[i]; }
      float ssu = 0.f, ssv = 0.f;
#pragma unroll
      for (int i = 0; i < 4; ++i)
#pragma unroll
        for (int j = 0; j < 4; ++j) { ssu += au[i][j] * au[i][j]; ssv += av[i][j] * av[i][j]; }
      ssu = wave_sum(ssu); ssv = wave_sum(ssv);
      const float ustep = 0.3352f * sqrtf(ssu * (1.f / 1024.f)), vstep = 0.49f * sqrtf(ssv * (1.f / 1024.f));
      const float uinv = ustep > 0.f ? 1.f / ustep : 0.f, vinv = vstep > 0.f ? 1.f / vstep : 0.f;
      u32x4 o;
      float ns = 0.f;
#pragma unroll
      for (int jd = 0; jd < 2; ++jd) {
        unsigned wu = 0, wv = 0;
#pragma unroll
        for (int e = 0; e < 8; ++e) {
          const float xu = au[(8 * jd + e) >> 2][(8 * jd + e) & 3], xv = av[(8 * jd + e) >> 2][(8 * jd + e) & 3];
          int q = (int)__builtin_rintf(xu * uinv + 7.5f); q = q < 0 ? 0 : (q > 15 ? 15 : q);
          wu |= (unsigned)q << (8 * (e & 3) + 4 * (e >> 2)); ns += (float)q;
          const float m = fabsf(xv) * vinv;
          const int mag = (m > 0.25f) + (m > 0.75f) + (m > 1.25f) + (m > 1.75f) + (m > 2.5f) + (m > 3.5f) + (m > 5.0f);
          wv |= (unsigned)(mag | (xv < 0.f ? 8 : 0)) << (4 * e);
        }
        o[jd] = wu; o[2 + jd] = wv;
      }
      ((u32x4*)(p.Uq + (size_t)r * 1024))[lane] = o;
      ns = wave_sum(ns);
      if (lane == 0) *(f32x4*)(p.uscale + r * 4) = (f32x4){ustep, vstep, ustep * 128.f * ns, 0.f};
    }
  }
#endif
}

DI void ws_quant(KP p) {
  const int lane = threadIdx.x & 63; const int gw = (blockIdx.x * NTHREADS + threadIdx.x) >> 6; const int nw = (gridDim.x * NTHREADS) >> 6;
  for (int row = gw; row < 2048; row += nw) {
    const f32x4* src = (const f32x4*)(p.Wsf + (size_t)row * 1024 + lane * 16);
    f32x4 v[4];
    float m = 0.f;
#pragma unroll
    for (int q = 0; q < 4; ++q) { v[q] = src[q]; m = fmaxf(fmaxf(m, fmaxf(fabsf(v[q][0]), fabsf(v[q][1]))), fmaxf(fabsf(v[q][2]), fabsf(v[q][3]))); }
    m = wave_max(m);
    const float inv = m > 0.f ? 127.f / m : 0.f;
    i32x4 o;
#pragma unroll
    for (int q = 0; q < 4; ++q) {
      unsigned w = 0;
#pragma unroll
      for (int j = 0; j < 4; ++j) w |= ((unsigned)(int)__builtin_rintf(v[q][j] * inv) & 255u) << (8 * j);
      o[q] = (int)w;
    }
    p.Wf_s[(size_t)((row >> 5) * 32 + (lane >> 1)) * 64 + (row & 31) + 32 * (lane & 1)] = o;
    if (lane == 0) p.wsc[row] = m * (1.f / 127.f);
  }
}

DI void phase1(KP p, char* smem) {
  const int tid = threadIdx.x, wave = __builtin_amdgcn_readfirstlane(tid >> 6);
  u16* hA = (u16*)smem;
  float* cs = (float*)(smem + 132096);
  float* ssq = (float*)(smem + 132096 + 8192);
  constexpr int LDL = 424;
  ws_quant(p);
  for (int tile = blockIdx.x; tile < NTOK / 64; tile += gridDim.x) {
    int lane_o = tid & 63; asm volatile("" : "+v"(lane_o));
    const int lane = lane_o, l31 = lane & 31, lh = lane >> 5;
    const int tok0 = tile * 64; const int b = tok0 / SEQ; const int s0 = tok0 % SEQ;
    const float* modb = p.mod + (size_t)b * 6144;
    for (int i = tid; i < 1024; i += NTHREADS) {
      const int r = i >> 4, j = i & 15;
      const double ang = (double)p.pos[tok0 + r] * p.invfreq[j];
      double rev = ang * 0.15915494309189535; rev -= floor(rev);
      const float rf = (float)rev;
      cs[2 * i] = __builtin_amdgcn_cosf(rf); cs[2 * i + 1] = __builtin_amdgcn_sinf(rf);
    }
    if (tid < 128) ssq[tid] = 0.f;
    {
      f32x4 cm[4], ca[4];
#pragma unroll
      for (int i = 0; i < 4; ++i) {
        const int col = i * 256 + lane * 4;
        const f32x4 g = *(const f32x4*)(p.norm1_g + col); const f32x4 sc = *(const f32x4*)(modb + 1024 + col);
        cm[i] = g * (sc + 1.0f); ca[i] = *(const f32x4*)(modb + col);
      }
#pragma unroll 2
      for (int rr = 0; rr < 8; rr += 4) {
        f32x4 xv[4][4];
#pragma unroll
        for (int q = 0; q < 4; ++q)
#pragma unroll
          for (int i = 0; i < 4; ++i) xv[q][i] = *(const f32x4*)(p.x + (size_t)(tok0 + wave * 8 + rr + q) * DM + i * 256 + lane * 4);
#pragma unroll
        for (int q = 0; q < 4; ++q) {
          float ss = 0.f;
#pragma unroll
          for (int i = 0; i < 4; ++i) ss += xv[q][i][0] * xv[q][i][0] + xv[q][i][1] * xv[q][i][1] + xv[q][i][2] * xv[q][i][2] + xv[q][i][3] * xv[q][i][3];
          ss = wave_sum(ss);
          const float rs = rsqrtf(ss * (1.f / 1024.f) + EPS);
          const int row = wave * 8 + rr + q;
#pragma unroll
          for (int i = 0; i < 4; ++i) {
            const f32x4 h = xv[q][i] * rs * cm[i] + ca[i];
            u32x2 o; o[0] = pk2(h[0], h[1]); o[1] = pk2(h[2], h[3]);
            *(u32x2*)(hA + row * LDA + i * 256 + lane * 4) = o;
          }
        }
      }
    }
    __syncthreads();
    bf16x8 ring1[8][2];
    const bool has2 = (wave + 40) < 45;
    { const int tl0[2] = {wave, wave + 8}; gemm_pro<2, 8>(p.Wf_in, 64, tl0, lane, ring1); }
#pragma unroll 1
    for (int pass = 0; pass < 2; ++pass) {
      f32x16 acc[2][2];
#pragma unroll
      for (int t = 0; t < 2; ++t) { acc[t][0] = zero16(); acc[t][1] = zero16(); }
      const int tl[2] = {wave + 16 * pass, wave + 16 * pass + 8};
      gemm_main<2, 8, false, true>(hA, LDA, 64, p.Wf_in, 64, tl, acc, lane, ring1);
      { const int tn[2] = {wave + 16 * (pass + 1), (pass == 0 || has2) ? wave + 16 * (pass + 1) + 8 : wave + 32}; gemm_pro<2, 8>(p.Wf_in, 64, tn, lane, ring1); }
      int el_ = lane; asm volatile("" : "+v"(el_));
      const int l31 = el_ & 31, lh = el_ >> 5;
      u16* dstb[2];
#pragma unroll
      for (int t = 0; t < 2; ++t) { const int col = tl[t] * 32 + l31; dstb[t] = (col < 512) ? (p.xlru + col) : (p.gate + (col - 512)); }
#pragma unroll
      for (int rt = 0; rt < 2; ++rt)
#pragma unroll
        for (int r = 0; r < 16; ++r) {
          const size_t ro = (size_t)(tok0 + rt * 32 + crow(r, lh)) * 512;
#pragma unroll
          for (int t = 0; t < 2; ++t) dstb[t][ro] = f2bf(acc[t][rt][r]);
        }
    }
    {
      f32x16 acc[2][2];
#pragma unroll
      for (int t = 0; t < 2; ++t) { acc[t][0] = zero16(); acc[t][1] = zero16(); }
      const int tl[2] = {wave + 32, has2 ? wave + 40 : wave + 32};
      gemm_main<2, 8, false, true>(hA, LDA, 64, p.Wf_in, 64, tl, acc, lane, ring1);
      int el_ = lane; asm volatile("" : "+v"(el_));
      const int l31 = el_ & 31, lh = el_ >> 5;
      __syncthreads();
      u16* lat = hA;
#pragma unroll
      for (int t = 0; t < 2; ++t) {
        if (t == 1 && !has2) continue;
        const int lc = tl[t] * 32 - 1024 + l31;
        if (tl[t] < 44) {
          float sq[32];
#pragma unroll
          for (int rt = 0; rt < 2; ++rt)
#pragma unroll
            for (int r = 0; r < 16; ++r) { const float v = acc[t][rt][r]; sq[rt * 16 + r] = v * v; }
          const float tot = reduce32(sq, lane);
          __hip_atomic_fetch_add(&ssq[(tl[t] < 40 ? 0 : 64) + (l31 >> 4) * 32 + crow(l31 & 15, lh)], tot, __ATOMIC_RELAXED, __HIP_MEMORY_SCOPE_WORKGROUP);
        }
#pragma unroll
        for (int rt = 0; rt < 2; ++rt)
#pragma unroll
          for (int r = 0; r < 16; ++r) {
            const int row = rt * 32 + crow(r, lh);
            const float v = acc[t][rt][r];
            if (lc < 384) {
              lat[row * LDL + lc] = f2bf(v);
            } else {
              const float pv = lane_xor_f<16>(v, lane);
              const int j = lc - 384; const int jj = j & 15;
              const float co = cs[(row * 16 + jj) * 2], si = cs[(row * 16 + jj) * 2 + 1];
              const float o = (j < 16) ? (v * co - pv * si) : (v * co + pv * si);
              p.Kr[(size_t)(tok0 + row) * 32 + j] = f2bf(o);
            }
          }
      }
    }
    __syncthreads();
    {
      const u16* lat = hA;
      const float qscale = 0.10206207261596577f * 1.4426950408889634f;
      const int jj = l31 & 15;
#pragma unroll 1
      for (int pass = 0; pass < 2; ++pass) {
        f32x16 acc[2][2];
#pragma unroll
        for (int t = 0; t < 2; ++t) { acc[t][0] = zero16(); acc[t][1] = zero16(); }
        const int tl[2] = {pass == 0 ? wave : wave + 16, pass == 0 ? wave + 8 : wave + 16};
        gemm_core<2>(lat, LDL, 16, p.Wf_uq, 16, tl, acc, lane);
        int el_ = lane; asm volatile("" : "+v"(el_));
        const int l31 = el_ & 31, lh = el_ >> 5;
#pragma unroll
        for (int rt = 0; rt < 2; ++rt)
#pragma unroll
          for (int r = 0; r < 16; ++r) {
            const int row = rt * 32 + crow(r, lh);
            const float rs = rsqrtf(ssq[row] * (1.f / 256.f) + EPS) * qscale;
            const float co = cs[(row * 16 + jj) * 2], si = cs[(row * 16 + jj) * 2 + 1];
#pragma unroll
            for (int t = 0; t < 2; ++t) {
              if (t == 1 && pass == 1) continue;
              const int head = tl[t] / 3, part = tl[t] % 3;
              float v = acc[t][rt][r] * rs;
              if (part == 2) {
                const float pv = lane_xor_f<16>(v, lane);
                v = (l31 < 16) ? (v * co - pv * si) : (v * co + pv * si);
              }
              p.Q[((size_t)(b * 8 + head) * SEQ + s0 + row) * 96 + part * 32 + l31] = f2bf(v);
            }
          }
      }
#pragma unroll 1
      for (int pass = 0; pass < 2; ++pass) {
        f32x16 acc[2][2];
#pragma unroll
        for (int t = 0; t < 2; ++t) { acc[t][0] = zero16(); acc[t][1] = zero16(); }
        const int tl[2] = {wave + 16 * pass, wave + 16 * pass + 8};
        gemm_core<2>(lat + 256, LDL, 8, p.Wf_ukv, 8, tl, acc, lane);
        int el_ = lane; asm volatile("" : "+v"(el_));
        const int l31 = el_ & 31, lh = el_ >> 5;
#pragma unroll
        for (int rt = 0; rt < 2; ++rt)
#pragma unroll
          for (int g = 0; g < 4; ++g) {
            const int row = rt * 32 + 8 * g + 4 * lh;
            float rs4[4];
#pragma unroll
            for (int q = 0; q < 4; ++q) rs4[q] = rsqrtf(ssq[64 + row + q] * (1.f / 128.f) + EPS);
#pragma unroll
            for (int t = 0; t < 2; ++t) {
              const int head = tl[t] >> 2, sub = tl[t] & 3;
              float v4[4];
#pragma unroll
              for (int q = 0; q < 4; ++q) v4[q] = acc[t][rt][4 * g + q] * rs4[q];
              if (sub < 2) {
#pragma unroll
                for (int q = 0; q < 4; ++q) p.Kn[((size_t)(b * 8 + head) * SEQ + s0 + row + q) * 64 + sub * 32 + l31] = f2bf(v4[q]);
              } else {
                const int d = (sub - 2) * 32 + l31;
                u32x2 o; o[0] = pk2(v4[0], v4[1]); o[1] = pk2(v4[2], v4[3]);
                *(u32x2*)(p.Vt + ((size_t)(b * 8 + head) * 64 + d) * SEQ + s0 + row) = o;
              }
            }
          }
      }
    }
    __syncthreads();
  }
}

DI void lru_item(KP p, char* smem, int item) {
  const int tid = threadIdx.x, lane = tid & 63, wave = __builtin_amdgcn_readfirstlane(tid >> 6);
  const int l31 = lane & 31, lh = lane >> 5;
  const int b = item >> 3, cb = item & 7;
  const int c = lane; const int ch = cb * 64 + c; const int tg = wave;
  const float cw0 = p.conv_w[ch], cw1 = p.conv_w[512 + ch], cw2 = p.conv_w[1024 + ch], cw3 = p.conv_w[1536 + ch], cbias = p.conv_b[ch];
  const float ba = p.lru_ba[ch], bx = p.lru_bx[ch];
  const float sp = log1pf(__expf(-p.lru_lambda[ch]));
  float carry = 0.f;
  const u16* xl = p.xlru + (size_t)b * SEQ * 512 + ch;
  const u16* gt = p.gate + (size_t)b * SEQ * 512 + ch;
  u16* yo = p.y + (size_t)b * SEQ * 1024 + ch;
  const int mat = wave >> 2, rt = (wave >> 1) & 1, ct = wave & 1;
  const bf16x8* wf = (mat == 0 ? p.Wf_a : p.Wf_x) + cb * 512 + ct * 256 + lane;
  bf16x8 bw[4];
#pragma unroll
  for (int ks = 0; ks < 4; ++ks) bw[ks] = wf[ks * 64];
  constexpr int NCH = SEQ / 64;
  u16 xin_n[11], gv_n[8];
#pragma unroll
  for (int i = 0; i < 11; ++i) { const int t = tg * 8 - 3 + i; xin_n[i] = (t >= 0) ? xl[(size_t)t * 512] : (u16)0; }
#pragma unroll
  for (int i = 0; i < 8; ++i) gv_n[i] = gt[(size_t)(tg * 8 + i) * 512];
  float xcB[8], gvB[8], xcC[8], gvC[8], avD[8], bvD[8], gvD[8];
#pragma unroll
  for (int i = 0; i < 8; ++i) { xcB[i] = gvB[i] = xcC[i] = gvC[i] = avD[i] = bvD[i] = gvD[i] = 0.f; }
  __syncthreads();
#pragma unroll 1
  for (int it = 0; it < NCH + 3; ++it) {
    float xcA[8], gvA[8], avC[8], bvC[8];
    if (it < NCH) {
      const int t0 = it * 64 + tg * 8;
      float xin[11];
#pragma unroll
      for (int i = 0; i < 11; ++i) xin[i] = bf2f(xin_n[i]);
#pragma unroll
      for (int i = 0; i < 8; ++i) gvA[i] = bf2f(gv_n[i]);
      if (it + 1 < NCH) {
#pragma unroll
        for (int i = 0; i < 11; ++i) xin_n[i] = xl[(size_t)(t0 + 64 - 3 + i) * 512];
#pragma unroll
        for (int i = 0; i < 8; ++i) gv_n[i] = gt[(size_t)(t0 + 64 + i) * 512];
      }
      u16* xcb = (u16*)(smem + (it & 1) * 9216);
#pragma unroll
      for (int i = 0; i < 8; ++i) {
        xcA[i] = cbias + cw0 * xin[i] + cw1 * xin[i + 1] + cw2 * xin[i + 2] + cw3 * xin[i + 3];
        xcb[(tg * 8 + i) * 72 + c] = f2bf(xcA[i]);
      }
    } else {
#pragma unroll
      for (int i = 0; i < 8; ++i) { xcA[i] = 0.f; gvA[i] = 0.f; }
    }
    if (it >= 1 && it - 1 < NCH) {
      const u16* xcb = (const u16*)(smem + ((it - 1) & 1) * 9216);
      float* pm = (float*)(smem + 18432 + ((it - 1) & 1) * 33280) + mat * 4160;
      f32x16 acc = zero16();
      const bf16x8* ap = (const bf16x8*)(xcb + (rt * 32 + l31) * 72 + 8 * lh);
#pragma unroll
      for (int ks = 0; ks < 4; ++ks) acc = MFMA32(ap[2 * ks], bw[ks], acc);
#pragma unroll
      for (int r = 0; r < 16; ++r) pm[(rt * 32 + crow(r, lh)) * 65 + ct * 32 + l31] = acc[r];
    }
    if (it >= 2 && it - 2 < NCH) {
      const float* pre = (const float*)(smem + 18432 + ((it - 2) & 1) * 33280);
      float* seg = (float*)(smem + 84992 + ((it - 2) & 1) * 4096);
      float A = 1.f, Bc = 0.f;
#pragma unroll
      for (int i = 0; i < 8; ++i) {
        const int tl = tg * 8 + i;
        const float r = sigmoidf_(pre[tl * 65 + c] + ba);
        const float ig = sigmoidf_(pre[4160 + tl * 65 + c] + bx);
        const float log_a = -8.f * r * sp;
        const float a = __builtin_amdgcn_exp2f(1.4426950408889634f * log_a);
        const float z = 2.f * log_a;
        const float om = (z > -0.25f) ? one_minus_exp_small(z) : -expm1f(z);
        const float m = __builtin_amdgcn_sqrtf(om);
        avC[i] = a; bvC[i] = m * ig * xcC[i];
        A *= a; Bc = a * Bc + bvC[i];
      }
      seg[(tg * 64 + c) * 2] = A; seg[(tg * 64 + c) * 2 + 1] = Bc;
    } else {
#pragma unroll
      for (int i = 0; i < 8; ++i) { avC[i] = 0.f; bvC[i] = 0.f; }
    }
    if (it >= 3) {
      const int t0 = (it - 3) * 64 + tg * 8;
      const float* seg = (const float*)(smem + 84992 + ((it - 3) & 1) * 4096);
      float h = carry, hin = 0.f;
#pragma unroll
      for (int s2 = 0; s2 < 8; ++s2) {
        if (s2 == tg) hin = h;
        h = seg[(s2 * 64 + c) * 2] * h + seg[(s2 * 64 + c) * 2 + 1];
      }
      carry = h;
      h = hin;
      float sq[8];
#pragma unroll
      for (int i = 0; i < 8; ++i) {
        h = avD[i] * h + bvD[i];
        const float yv = gelu_tanh(gvD[i]) * h;
        yo[(size_t)(t0 + i) * 1024] = f2bf(yv);
        sq[i] = yv * yv;
      }
      const float tot = reduce8(sq, lane);
      if ((lane & 7) == 0) unsafeAtomicAdd(p.ssq_lru + (size_t)b * SEQ + t0 + (lane >> 3), tot);
    }
#pragma unroll
    for (int i = 0; i < 8; ++i) {
      avD[i] = avC[i]; bvD[i] = bvC[i]; gvD[i] = gvC[i];
      xcC[i] = xcB[i]; gvC[i] = gvB[i];
      xcB[i] = xcA[i]; gvB[i] = gvA[i];
    }
    __syncthreads();
  }
}

DI void attn_unit(KP p, char* smem, int b, int hd, int qb) {
  const int tid = threadIdx.x, lane = tid & 63, wave = __builtin_amdgcn_readfirstlane(tid >> 6);
  const int l31 = lane & 31, lh = lane >> 5;
  const int q0 = qb * 256 + wave * 32;
  const size_t bh = (size_t)(b * 8 + hd);
  const int nkt = qb * 4 + 4;
  const int qidx = q0 + l31;
  const int skey = tid >> 3, schn = tid & 7;
  const int rkey = (tid & 255) >> 2, rchn = tid & 3;
  const u16* kn_src = p.Kn + (bh * SEQ + skey) * 64 + schn * 8;
  const u16* kr_src = p.Kr + ((size_t)b * SEQ + rkey) * 32 + rchn * 8;
  const u16* vt_src = p.Vt + (bh * 64 + skey) * SEQ + schn * 8;
  u32x4 rk, rr, rv;
  rk = *(const u32x4*)(kn_src); rv = *(const u32x4*)(vt_src);
  if (tid < 256) rr = *(const u32x4*)(kr_src);
  bf16x8 qf[6];
  {
    const bf16x8* qp = (const bf16x8*)(p.Q + (bh * SEQ + q0 + l31) * 96 + 8 * lh);
#pragma unroll
    for (int ks = 0; ks < 6; ++ks) qf[ks] = qp[2 * ks];
  }
  __syncthreads();
  {
    u16* Kl = (u16*)smem; u16* Vl = (u16*)(smem + 13312);
    *(u32x4*)(Kl + skey * 104 + schn * 8) = rk;
    if (tid < 256) *(u32x4*)(Kl + rkey * 104 + 64 + rchn * 8) = rr;
    *(u32x4*)(Vl + skey * 72 + schn * 8) = rv;
  }
  __syncthreads();
  f32x16 o0 = zero16(), o1 = zero16();
  float m_run = -1e30f, l_run = 0.f;
  for (int kt = 0; kt < nkt; ++kt) {
    const u16* Kl = (const u16*)(smem + (kt & 1) * 22528);
    const u16* Vl = (const u16*)(smem + (kt & 1) * 22528 + 13312);
    const bool more = (kt + 1) < nkt;
    if (more) {
      rk = *(const u32x4*)(kn_src + (size_t)(kt + 1) * 64 * 64);
      rv = *(const u32x4*)(vt_src + (kt + 1) * 64);
      if (tid < 256) rr = *(const u32x4*)(kr_src + (size_t)(kt + 1) * 64 * 32);
    }
    if (kt * 64 <= q0 + 31) {
      f32x16 s[2];
      bf16x8 kfr[2][6];
#pragma unroll
      for (int st = 0; st < 2; ++st) {
        const bf16x8* kp = (const bf16x8*)(Kl + (st * 32 + l31) * 104 + 8 * lh);
#pragma unroll
        for (int ks = 0; ks < 6; ++ks) kfr[st][ks] = kp[2 * ks];
      }
#pragma unroll
      for (int st = 0; st < 2; ++st) {
        s[st] = zero16();
#pragma unroll
        for (int ks = 0; ks < 6; ++ks) s[st] = MFMA32(kfr[st][ks], qf[ks], s[st]);
      }
      u32x2 vfr[2][4][2];
#pragma unroll
      for (int dt = 0; dt < 2; ++dt)
#pragma unroll
        for (int c4 = 0; c4 < 4; ++c4) {
          const int kbase = c4 * 16 + 4 * lh;
          vfr[dt][c4][0] = *(const u32x2*)(Vl + (dt * 32 + l31) * 72 + kbase);
          vfr[dt][c4][1] = *(const u32x2*)(Vl + (dt * 32 + l31) * 72 + kbase + 8);
        }
      if (kt * 64 + 63 > q0) {
#pragma unroll
        for (int st = 0; st < 2; ++st)
#pragma unroll
          for (int r = 0; r < 16; ++r) { const int key = kt * 64 + st * 32 + crow(r, lh); if (key > qidx) s[st][r] = -1e30f; }
      }
      float mloc = s[0][0];
#pragma unroll
      for (int st = 0; st < 2; ++st)
#pragma unroll
        for (int r = 0; r < 16; ++r) mloc = fmaxf(mloc, s[st][r]);
      mloc = max_xor32(mloc);
      const float m_new = fmaxf(m_run, mloc);
      const float alpha = __builtin_amdgcn_exp2f(m_run - m_new);
      m_run = m_new;
      float lsum = 0.f;
#pragma unroll
      for (int st = 0; st < 2; ++st)
#pragma unroll
        for (int r = 0; r < 16; ++r) { const float e = __builtin_amdgcn_exp2f(s[st][r] - m_new); s[st][r] = e; lsum += e; }
      l_run = l_run * alpha + lsum;
#pragma unroll
      for (int r = 0; r < 16; ++r) { o0[r] *= alpha; o1[r] *= alpha; }
#pragma unroll
      for (int st = 0; st < 2; ++st)
#pragma unroll
        for (int s2 = 0; s2 < 2; ++s2) {
          u32x4 pw;
#pragma unroll
          for (int j = 0; j < 4; ++j) pw[j] = pk2(s[st][8 * s2 + 2 * j], s[st][8 * s2 + 2 * j + 1]);
          const bf16x8 pf = __builtin_bit_cast(bf16x8, pw);
          const int c4 = st * 2 + s2;
          {
            u32x4 vv; vv[0] = vfr[0][c4][0][0]; vv[1] = vfr[0][c4][0][1]; vv[2] = vfr[0][c4][1][0]; vv[3] = vfr[0][c4][1][1];
            o0 = MFMA32(__builtin_bit_cast(bf16x8, vv), pf, o0);
          }
          {
            u32x4 vv; vv[0] = vfr[1][c4][0][0]; vv[1] = vfr[1][c4][0][1]; vv[2] = vfr[1][c4][1][0]; vv[3] = vfr[1][c4][1][1];
            o1 = MFMA32(__builtin_bit_cast(bf16x8, vv), pf, o1);
          }
        }
    }
    if (more) {
      u16* Kn2 = (u16*)(smem + ((kt + 1) & 1) * 22528); u16* Vn2 = (u16*)(smem + ((kt + 1) & 1) * 22528 + 13312);
      *(u32x4*)(Kn2 + skey * 104 + schn * 8) = rk;
      if (tid < 256) *(u32x4*)(Kn2 + rkey * 104 + 64 + rchn * 8) = rr;
      *(u32x4*)(Vn2 + skey * 72 + schn * 8) = rv;
    }
    __syncthreads();
  }
  const float ltot = sum_xor32(l_run);
  const float inv = 1.f / ltot;
  float ss = 0.f;
  u16* yrow = p.y + ((size_t)b * SEQ + qidx) * 1024 + 512 + hd * 64;
#pragma unroll
  for (int g = 0; g < 4; ++g) {
    float v0[4], v1[4];
#pragma unroll
    for (int q = 0; q < 4; ++q) { v0[q] = o0[4 * g + q] * inv; v1[q] = o1[4 * g + q] * inv; ss += v0[q] * v0[q] + v1[q] * v1[q]; }
    u32x2 a; a[0] = pk2(v0[0], v0[1]); a[1] = pk2(v0[2], v0[3]);
    u32x2 c2; c2[0] = pk2(v1[0], v1[1]); c2[1] = pk2(v1[2], v1[3]);
    *(u32x2*)(yrow + 8 * g + 4 * lh) = a;
    *(u32x2*)(yrow + 32 + 8 * g + 4 * lh) = c2;
  }
  ss = sum_xor32(ss);
  if (lh == 0) unsafeAtomicAdd(p.ssq_mla + (size_t)b * SEQ + qidx, ss);
}

DI void phase2(KP p, char* smem) {
  for (int item = blockIdx.x; item < 256; item += gridDim.x) lru_item(p, smem, item);
  for (int it = blockIdx.x; it < 1024; it += gridDim.x) {
    const int j = it & 3; const int bh = it >> 2; const int hd = bh & 7; const int b = bh >> 3;
    attn_unit(p, smem, b, hd, 7 - j);
    attn_unit(p, smem, b, hd, j);
  }
}

DI void sort128_asc(unsigned& k0, unsigned& k1, int lane) {
#pragma unroll
  for (int k = 2; k <= 128; k <<= 1) {
#pragma unroll
    for (int j = k >> 1; j > 0; j >>= 1) {
      if (j == 64) {
        const unsigned lo = k0 < k1 ? k0 : k1, hi = k0 < k1 ? k1 : k0; k0 = lo; k1 = hi;
      } else {
        const unsigned o0 = (j == 1) ? lane_xor_u<1>(k0, lane) : (j == 2) ? lane_xor_u<2>(k0, lane) : (j == 4) ? lane_xor_u<4>(k0, lane) : (j == 8) ? lane_xor_u<8>(k0, lane) : (j == 16) ? lane_xor_u<16>(k0, lane) : lane_xor_u<32>(k0, lane);
        const unsigned o1 = (j == 1) ? lane_xor_u<1>(k1, lane) : (j == 2) ? lane_xor_u<2>(k1, lane) : (j == 4) ? lane_xor_u<4>(k1, lane) : (j == 8) ? lane_xor_u<8>(k1, lane) : (j == 16) ? lane_xor_u<16>(k1, lane) : lane_xor_u<32>(k1, lane);
        const bool lower = (lane & j) == 0;
        const bool asc0 = (k == 128) ? true : ((lane & k) == 0);
        const bool asc1 = (k == 128) ? true : (k == 64 ? false : ((lane & k) == 0));
        const unsigned mn0 = k0 < o0 ? k0 : o0, mx0 = k0 < o0 ? o0 : k0;
        const unsigned mn1 = k1 < o1 ? k1 : o1, mx1 = k1 < o1 ? o1 : k1;
        k0 = (asc0 == lower) ? mn0 : mx0;
        k1 = (asc1 == lower) ? mn1 : mx1;
      }
    }
  }
}
#if QBITS == 8
typedef u32x4 qrow_t;
#else
typedef u32x2 qrow_t;
#endif
constexpr int QROWB = (QBITS == 8) ? 1024 : 512;
DI void ga_load(__amdgpu_buffer_rsrc_t rs, int iv, int gl, int voff_u, int voff_v, qrow_t (&uq)[8], qrow_t (&vq)[8]) {
#pragma unroll
  for (int k = 0; k < 8; ++k) {
    const int so = __builtin_amdgcn_readlane(iv, gl + k);
#if QBITS == 8
    uq[k] = __builtin_amdgcn_raw_buffer_load_b128(rs, voff_u, so, 0);
    vq[k] = __builtin_amdgcn_raw_buffer_load_b128(rs, voff_v, so, 0);
#else
    const u32x4 rec = __builtin_amdgcn_raw_buffer_load_b128(rs, voff_u, so, 16);
    uq[k] = (u32x2){rec[0], rec[1]}; vq[k] = (u32x2){rec[2], rec[3]};
#endif
  }
}
DI unsigned qword(const qrow_t& r, int j) {
#if QBITS == 8
  return r[j];
#else
  const unsigned w0 = r[j >> 1];
  return (j & 1) ? ((w0 >> 4) & 0x0f0f0f0fu) : (w0 & 0x0f0f0f0fu);
#endif
}
#if QBITS == 8
typedef f32x2 oacc_t;
constexpr float OACC_SCALE = 1.f;
#else
typedef h16x2 oacc_t;
constexpr float OACC_SCALE = 16.f;
#endif
DI void ga_compute(float gsel, float asel, float bsel, int gl, int lane, float kt, float hscale, const unsigned (&hq)[4],
                   const qrow_t (&uq)[8], const qrow_t (&vq)[8], oacc_t (&oacc)[8], float& csum) {
  const float mg = __shfl(gsel, gl + (lane >> 3));
  const float ma = __shfl(asel, gl + (lane >> 3));
  const float mb = __shfl(bsel, gl + (lane >> 3));
  float pp[8];
#pragma unroll
  for (int k = 0; k < 8; ++k) {
#if QBITS == 8
    unsigned d = 0;
#pragma unroll
    for (int j = 0; j < 4; ++j) d = __builtin_amdgcn_udot4(qword(uq[k], j), hq[j], d, false);
#else
    unsigned dh = __builtin_amdgcn_udot8(uq[k][0], hq[0], 0u, false); dh = __builtin_amdgcn_udot8(uq[k][1], hq[1], dh, false);
    unsigned dl = __builtin_amdgcn_udot8(uq[k][0], hq[2], 0u, false); dl = __builtin_amdgcn_udot8(uq[k][1], hq[3], dl, false);
    const unsigned d = dh * 16u + dl;
#endif
    pp[k] = (float)d;
  }
  const float s1 = reduce8(pp, lane);
  const float pre = hscale * (ma * (s1 - kt) - mb);
  const float cf = mg * gelu_tanh(pre);
  csum += cf;
#if QBITS != 8
  const _Float16 cfs = (_Float16)(cf * OACC_SCALE);
  const unsigned cfp = __builtin_bit_cast(unsigned, (h16x2){cfs, cfs});
#endif
#pragma unroll
  for (int k = 0; k < 8; ++k) {
#if QBITS == 8
    const float c = __uint_as_float(__builtin_amdgcn_readlane(__float_as_uint(cf), 8 * k));
    const f32x2 cc = {c, c};
#pragma unroll
    for (int j = 0; j < 4; ++j) {
      unsigned w = qword(vq[k], j);
      asm volatile("" : "+v"(w));
      const f32x2 v0 = {(float)(w & 255u), (float)((w >> 8) & 255u)}, v1 = {(float)((w >> 16) & 255u), (float)(w >> 24)};
      oacc[2 * j] = v0 * cc + oacc[2 * j];
      oacc[2 * j + 1] = v1 * cc + oacc[2 * j + 1];
    }
#else
    const h16x2 cc = __builtin_bit_cast(h16x2, (unsigned)__builtin_amdgcn_readlane((int)cfp, 8 * k));
#pragma unroll
    for (int jd = 0; jd < 2; ++jd) {
      const unsigned w = vq[k][jd];
      oacc[4 * jd + 0] = __builtin_amdgcn_cvt_scalef32_pk_f16_fp4(w, 1.0f, 0) * cc + oacc[4 * jd + 0];
      oacc[4 * jd + 1] = __builtin_amdgcn_cvt_scalef32_pk_f16_fp4(w, 1.0f, 1) * cc + oacc[4 * jd + 1];
      oacc[4 * jd + 2] = __builtin_amdgcn_cvt_scalef32_pk_f16_fp4(w, 1.0f, 2) * cc + oacc[4 * jd + 2];
      oacc[4 * jd + 3] = __builtin_amdgcn_cvt_scalef32_pk_f16_fp4(w, 1.0f, 3) * cc + oacc[4 * jd + 3];
    }
#endif
  }
}

DI void ins16(float (&lst)[16], float x, const int P) {
#pragma unroll
  for (int i = 0; i < 16; ++i) if (i >= P) { const float hi = fmaxf(lst[i], x); x = fminf(lst[i], x); lst[i] = hi; }
}
DI void ce_desc(float& a, float& b) { const float hi = fmaxf(a, b), lo = fminf(a, b); a = hi; b = lo; }
DI void sort16_desc(float (&a)[16]) {
#define CE_(i, j) ce_desc(a[i], a[j]);
  CE_(0, 13) CE_(1, 12) CE_(2, 15) CE_(3, 14) CE_(4, 8) CE_(5, 6) CE_(7, 11) CE_(9, 10)
  CE_(0, 5) CE_(1, 7) CE_(2, 9) CE_(3, 4) CE_(6, 13) CE_(8, 14) CE_(10, 15) CE_(11, 12)
  CE_(0, 1) CE_(2, 3) CE_(4, 5) CE_(6, 8) CE_(7, 9) CE_(10, 11) CE_(12, 13) CE_(14, 15)
  CE_(0, 2) CE_(1, 3) CE_(4, 10) CE_(5, 11) CE_(6, 7) CE_(8, 9) CE_(12, 14) CE_(13, 15)
  CE_(1, 2) CE_(3, 12) CE_(4, 6) CE_(5, 7) CE_(8, 10) CE_(9, 11) CE_(13, 14)
  CE_(1, 4) CE_(2, 6) CE_(5, 8) CE_(7, 10) CE_(9, 13) CE_(11, 14)
  CE_(2, 4) CE_(3, 6) CE_(9, 12) CE_(11, 13)
  CE_(3, 5) CE_(6, 8) CE_(7, 9) CE_(10, 12)
  CE_(3, 4) CE_(5, 6) CE_(7, 8) CE_(9, 10) CE_(11, 12)
  CE_(6, 7) CE_(8, 9)
#undef CE_
}
DI void merge16_desc(float (&x)[16], const float (&y)[16]) {
#pragma unroll
  for (int i = 0; i < 16; ++i) x[i] = fmaxf(x[i], y[15 - i]);
#pragma unroll
  for (int d = 8; d >= 1; d >>= 1)
#pragma unroll
    for (int i = 0; i < 16; ++i)
      if ((i & d) == 0) ce_desc(x[i], x[i + d]);
}
DI void merge_partner(float (&lst)[16], int lane) {
  float o[16];
#pragma unroll
  for (int i = 0; i < 16; ++i) o[i] = other_xor32(lst[i], lane);
  float c[16];
#pragma unroll
  for (int i = 0; i < 16; ++i) c[i] = fmaxf(lst[i], o[15 - i]);
#pragma unroll
  for (int d = 8; d >= 1; d >>= 1) {
#pragma unroll
    for (int i = 0; i < 16; ++i) {
      if ((i & d) == 0) { const float hi = fmaxf(c[i], c[i + d]), lo = fminf(c[i], c[i + d]); c[i] = hi; c[i + d] = lo; }
    }
  }
#pragma unroll
  for (int i = 0; i < 16; ++i) lst[i] = c[i];
}

DI void phase3(KP p, char* smem) {
  const int tid = threadIdx.x, wave = __builtin_amdgcn_readfirstlane(tid >> 6);
  u16* A = (u16*)smem;
  float* ssq2 = (float*)(smem + 146944);
  signed char* A8 = (signed char*)smem;
  float* hs = (float*)(smem + 146944 + 256);
  constexpr int ELD = 132;
  int* eidx = (int*)(smem + 66560);
  float* egate = (float*)(smem + 100352);
  char* scr = p.scratch + (size_t)blockIdx.x * 655360;
  float* x1s = (float*)scr;
  u16* qp = (u16*)(scr + 262144);
  for (int tile = blockIdx.x; tile < NTOK / 64; tile += gridDim.x) {
    int lane_o = tid & 63; asm volatile("" : "+v"(lane_o));
    const int lane = lane_o, l31 = lane & 31, lh = lane >> 5;
    const int tok0 = tile * 64; const int b = tok0 / SEQ;
    const float* modb = p.mod + (size_t)b * 6144;
    if (tid < 64) ssq2[tid] = 0.f;
#pragma unroll 2
    for (int rr = 0; rr < 8; ++rr) {
      const int row = wave * 8 + rr; const int tok = tok0 + row;
      const float rl = rsqrtf(p.ssq_lru[tok] * (1.f / 512.f) + EPS), rm = rsqrtf(p.ssq_mla[tok] * (1.f / 512.f) + EPS);
#pragma unroll
      for (int i = 0; i < 2; ++i) {
        const u32x4 v = *(const u32x4*)(p.y + (size_t)tok * 1024 + (i * 64 + lane) * 8);
        const float sc = i == 0 ? rl : rm;
        u32x4 o;
#pragma unroll
        for (int j = 0; j < 4; ++j) o[j] = pk2(bflo(v[j]) * sc, bfhi(v[j]) * sc);
        *(u32x4*)(A + row * LDA + (i * 64 + lane) * 8) = o;
      }
    }
    __syncthreads();
    float sqa[32];
#pragma unroll
    for (int i = 0; i < 32; ++i) sqa[i] = 0.f;
    bf16x8 ring3[8][2];
    { const int tl0[2] = {wave, wave + 8}; gemm_pro<2, 8>(p.Wf_out, 64, tl0, lane, ring3); }
#pragma unroll 1
    for (int pass = 0; pass < 2; ++pass) {
      f32x16 acc[2][2];
#pragma unroll
      for (int t = 0; t < 2; ++t) { acc[t][0] = zero16(); acc[t][1] = zero16(); }
      const int tl[2] = {pass * 16 + wave, pass * 16 + wave + 8};
      gemm_main<2, 8, false, true>(A, LDA, 64, p.Wf_out, 64, tl, acc, lane, ring3);
      if (pass == 0) { const int tn[2] = {16 + wave, 16 + wave + 8}; gemm_pro<2, 8>(p.Wf_out, 64, tn, lane, ring3); }
      int el_ = lane; asm volatile("" : "+v"(el_));
      const int l31 = el_ & 31, lh = el_ >> 5;
      float g1[2];
#pragma unroll
      for (int t = 0; t < 2; ++t) g1[t] = modb[2048 + tl[t] * 32 + l31];
#pragma unroll
      for (int rt = 0; rt < 2; ++rt)
#pragma unroll
        for (int r = 0; r < 16; ++r) {
          const int row = rt * 32 + crow(r, lh);
#pragma unroll
          for (int t = 0; t < 2; ++t) {
            const int col = tl[t] * 32 + l31;
            const float v = p.x[(size_t)(tok0 + row) * DM + col] + g1[t] * acc[t][rt][r];
            x1s[row * 1024 + col] = v;
            sqa[rt * 16 + r] += v * v;
          }
        }
    }
    {
      const float tot = reduce32(sqa, lane);
      const int l31 = lane & 31, lh = lane >> 5;
      __hip_atomic_fetch_add(&ssq2[(l31 >> 4) * 32 + crow(l31 & 15, lh)], tot, __ATOMIC_RELAXED, __HIP_MEMORY_SCOPE_WORKGROUP);
    }
    __syncthreads();
    {
      f32x4 cm[4], ca[4];
#pragma unroll
      for (int i = 0; i < 4; ++i) {
        const int col = (i >> 1) * 512 + lane * 8 + (i & 1) * 4;
        const f32x4 g = *(const f32x4*)(p.norm2_g + col); const f32x4 sc = *(const f32x4*)(modb + 4096 + col);
        cm[i] = g * (sc + 1.0f); ca[i] = *(const f32x4*)(modb + 3072 + col);
      }
#pragma unroll 2
      for (int rr = 0; rr < 8; ++rr) {
        const int row = wave * 8 + rr;
        const float rs = rsqrtf(ssq2[row] * (1.f / 1024.f) + EPS);
        f32x4 hv[4];
        float hmax = 0.f;
#pragma unroll
        for (int i = 0; i < 2; ++i) {
          const f32x4 xa = *(const f32x4*)(x1s + row * 1024 + i * 512 + lane * 8), xb = *(const f32x4*)(x1s + row * 1024 + i * 512 + lane * 8 + 4);
          hv[2 * i] = xa * rs * cm[2 * i] + ca[2 * i]; hv[2 * i + 1] = xb * rs * cm[2 * i + 1] + ca[2 * i + 1];
#pragma unroll
          for (int j = 0; j < 4; ++j) hmax = fmaxf(hmax, fmaxf(fabsf(hv[2 * i][j]), fabsf(hv[2 * i + 1][j])));
        }
        hmax = wave_max(hmax);
        const float hinv = hmax > 0.f ? 127.f / hmax : 0.f;
#pragma unroll
        for (int i = 0; i < 2; ++i) {
          u32x2 o;
#pragma unroll
          for (int hh = 0; hh < 2; ++hh) {
            unsigned w = 0;
#pragma unroll
            for (int j = 0; j < 4; ++j) w |= ((unsigned)(int)__builtin_rintf(hv[2 * i + hh][j] * hinv) & 255u) << (8 * j);
            o[hh] = w;
          }
          *(u32x2*)(A8 + row * LDA8 + i * 512 + lane * 8) = o;
        }
        if (lane == 0) hs[row] = hmax * (1.f / 127.f);
      }
    }
    __syncthreads();
    float s12[2][16];
    i32x4 ring8[8][2];
    { const int t0[2] = {wave * 8, wave * 8 + 1}; gemm8_pro<2, 8>(p.Wf_s, 32, t0, lane, ring8); }
#pragma unroll 1
    for (int ph = 0; ph < 2; ++ph) {
      const int hd = wave;
      float lst0[16], lst1[16];
#pragma unroll
      for (int i = 0; i < 16; ++i) { lst0[i] = -3.0e38f; lst1[i] = -3.0e38f; }
#pragma unroll 1
      for (int mtp = 0; mtp < 2; ++mtp) {
        i32x16 acc[2][2];
#pragma unroll
        for (int t = 0; t < 2; ++t)
#pragma unroll
          for (int r = 0; r < 16; ++r) { acc[t][0][r] = 0; acc[t][1][r] = 0; }
        const int tl[2] = {(hd * 2 + ph) * 4 + 2 * mtp, (hd * 2 + ph) * 4 + 2 * mtp + 1};
        gemm8_main<2, 8>(A8, LDA8, 32, p.Wf_s, 32, tl, acc, lane, ring8);
        if (ph * 2 + mtp < 3) { const int pn = ph * 2 + mtp + 1; const int tn[2] = {wave * 8 + 2 * pn, wave * 8 + 2 * pn + 1}; gemm8_pro<2, 8>(p.Wf_s, 32, tn, lane, ring8); }
        int el_ = lane; asm volatile("" : "+v"(el_));
        const int lh = el_ >> 5;
#pragma unroll
        for (int t = 0; t < 2; ++t) {
          f32x4 w4[4];
#pragma unroll
          for (int g = 0; g < 4; ++g) w4[g] = *(const f32x4*)(p.wsc + tl[t] * 32 + 8 * g + 4 * lh);
          float nv[16];
#pragma unroll
          for (int r = 0; r < 16; ++r) nv[r] = __uint_as_float((__float_as_uint((float)acc[t][0][r] * w4[r >> 2][r & 3]) & 0xffffff80u) | (unsigned)((2 * mtp + t) * 32 + crow(r, lh)));
          sort16_desc(nv);
          if (t == 0 && mtp == 0) {
#pragma unroll
            for (int r = 0; r < 16; ++r) lst0[r] = nv[r];
          } else merge16_desc(lst0, nv);
#pragma unroll
          for (int r = 0; r < 16; ++r) nv[r] = __uint_as_float((__float_as_uint((float)acc[t][1][r] * w4[r >> 2][r & 3]) & 0xffffff80u) | (unsigned)((2 * mtp + t) * 32 + crow(r, lh)));
          sort16_desc(nv);
          if (t == 0 && mtp == 0) {
#pragma unroll
            for (int r = 0; r < 16; ++r) lst1[r] = nv[r];
          } else merge16_desc(lst1, nv);
        }
      }
      merge_partner(lst0, lane);
      merge_partner(lst1, lane);
      if (ph == 0) {
#pragma unroll
        for (int i = 0; i < 16; ++i) s12[0][i] = lh ? lst1[i] : lst0[i];
      } else {
#pragma unroll
        for (int i = 0; i < 16; ++i) s12[1][i] = lh ? lst1[i] : lst0[i];
      }
    }
    {
      const int hd = wave;
      unsigned long long t1lo = 0, t1hi = 0, t2lo = 0, t2hi = 0;
#pragma unroll
      for (int i = 0; i < 8; ++i) {
        t1lo |= (unsigned long long)(__float_as_uint(s12[0][i]) & 127u) << (8 * i);
        t1hi |= (unsigned long long)(__float_as_uint(s12[0][8 + i]) & 127u) << (8 * i);
        t2lo |= (unsigned long long)(__float_as_uint(s12[1][i]) & 127u) << (8 * i);
        t2hi |= (unsigned long long)(__float_as_uint(s12[1][8 + i]) & 127u) << (8 * i);
      }
      const float hst = hs[lh * 32 + l31];
      float bv[16];
#pragma unroll
      for (int j = 0; j < 16; ++j) {
        const float sv = (s12[0][0] + s12[1][j]) * hst;
        bv[j] = __uint_as_float((__float_as_uint(sv) & 0xffffff00u) | (unsigned)j);
      }
#pragma unroll
      for (int i = 1; i < 16; ++i) {
#pragma unroll
        for (int j = 0; j < 16; ++j)
          if ((i + 1) * (j + 1) <= 16) {
            const float sv = (s12[0][i] + s12[1][j]) * hst;
            ins16(bv, __uint_as_float((__float_as_uint(sv) & 0xffffff00u) | (unsigned)(i * 16 + j)), (i + 1) * (j + 1) - 1);
          }
      }
      int bi[16];
#pragma unroll
      for (int k = 0; k < 16; ++k) {
        const unsigned code = __float_as_uint(bv[k]) & 255u;
        const unsigned ci = code >> 4, cj = code & 15u;
        const unsigned long long w1 = (ci & 8u) ? t1hi : t1lo, w2 = (cj & 8u) ? t2hi : t2lo;
        const unsigned i1 = (unsigned)(w1 >> ((ci & 7u) * 8)) & 0xffu, i2 = (unsigned)(w2 >> ((cj & 7u) * 8)) & 0xffu;
        bi[k] = (int)(i1 * 128u + i2);
      }
      float esum = 0.f, ev[16];
#pragma unroll
      for (int i = 0; i < 16; ++i) { ev[i] = __expf(bv[i] - bv[0]); esum += ev[i]; }
      const float einv = 1.f / esum;
      {
        const int row = lh * 32 + l31;
#pragma unroll
        for (int i4 = 0; i4 < 4; ++i4) {
          *(i32x4*)(eidx + row * ELD + hd * 16 + i4 * 4) = (i32x4){bi[i4 * 4], bi[i4 * 4 + 1], bi[i4 * 4 + 2], bi[i4 * 4 + 3]};
          *(f32x4*)(egate + row * ELD + hd * 16 + i4 * 4) = (f32x4){ev[i4 * 4] * einv, ev[i4 * 4 + 1] * einv, ev[i4 * 4 + 2] * einv, ev[i4 * 4 + 3] * einv};
        }
      }
    }
    __syncthreads();
    const __amdgpu_buffer_rsrc_t qrs = __builtin_amdgcn_make_buffer_rsrc((void*)p.Uq, 0, 2 * 16384 * QROWB, 0x00020000);
    const int voff_u = (QBITS == 8) ? lane * 16 : lane * 16, voff_v = voff_u + 16384 * QROWB;
    int n_ia, n_ib; float n_ga, n_gb, n_ua, n_ub, n_ba, n_bb, n_kt, n_hscale; unsigned n_hq[4];
    qrow_t bufA_u[8], bufA_v[8], bufB_u[8], bufB_v[8];
#define GA_PREP(ROW)                                                                                                              \
    {                                                                                                                             \
      const int prow = (ROW);                                                                                                     \
      n_ia = eidx[prow * ELD + lane]; n_ib = eidx[prow * ELD + 64 + lane];                                                        \
      n_ga = egate[prow * ELD + lane]; n_gb = egate[prow * ELD + 64 + lane];                                                      \
      {     \
        unsigned k0 = ((unsigned)n_ia << 7) | (unsigned)lane, k1 = ((unsigned)n_ib << 7) | (unsigned)(64 + lane);                 \
        sort128_asc(k0, k1, lane);                                                                                                \
        const int p0 = (int)(k0 & 127u), p1 = (int)(k1 & 127u);                                                                   \
        const f32x4 sa = ((const f32x4*)p.uscale)[k0 >> 7], sb = ((const f32x4*)p.uscale)[k1 >> 7];        \
        const float ga0 = __shfl(n_ga, p0 & 63), gb0 = __shfl(n_gb, p0 & 63), ga1 = __shfl(n_ga, p1 & 63), gb1 = __shfl(n_gb, p1 & 63); \
        n_ia = (int)(k0 >> 7) * (QBITS == 8 ? QROWB : 2 * QROWB); n_ib = (int)(k1 >> 7) * (QBITS == 8 ? QROWB : 2 * QROWB);       \
        n_ga = ((p0 & 64) ? gb0 : ga0) * sa[1]; n_gb = ((p1 & 64) ? gb1 : ga1) * sb[1];                                           \
        n_ua = sa[0]; n_ub = sb[0]; n_ba = sa[2]; n_bb = sb[2];                                                                   \
      }                                                                                                                           \
      u32x4 hc = *(const u32x4*)(A8 + prow * LDA8 + lane * 16);        \
      _Pragma("unroll") for (int j = 0; j < 4; ++j) hc[j] ^= 0x80808080u;                                                         \
      n_hscale = hs[prow];                                                                                                        \
      unsigned hsi = 0;                                                                                                           \
      _Pragma("unroll") for (int j = 0; j < 4; ++j) hsi = __builtin_amdgcn_udot4(hc[j], 0x01010101u, hsi, false);                 \
      const float hsum = (float)hsi;                                                                                              \
      if (QBITS == 8) {                                                                                                           \
        _Pragma("unroll") for (int j = 0; j < 4; ++j) n_hq[j] = hc[j];                                                            \
      } else {               \
        _Pragma("unroll") for (int jd = 0; jd < 2; ++jd) {                                                                        \
          n_hq[jd] = ((hc[2 * jd] >> 4) & 0x0f0f0f0fu) | (hc[2 * jd + 1] & 0xf0f0f0f0u);                                          \
          n_hq[2 + jd] = (hc[2 * jd] & 0x0f0f0f0fu) | ((hc[2 * jd + 1] & 0x0f0f0f0fu) << 4);                                      \
        }                                                                                                                         \
      }                                                                                                                           \
      n_kt = (QBITS == 8 ? 128.f : 7.5f) * (wave_sum(hsum) - 131072.f);                                                           \
    }
    GA_PREP(wave)
    ga_load(qrs, n_ia, 0, voff_u, voff_v, bufA_u, bufA_v);
#pragma unroll 1
    for (int rr = 0; rr < 8; ++rr) {
      const int row = rr * 8 + wave; const int tok = tok0 + row;
      const int ia = n_ia, ib = n_ib; const float ga = n_ga, gb = n_gb, ua = n_ua, ub = n_ub, ba = n_ba, bb = n_bb, kt = n_kt, hscale = n_hscale;
      unsigned hq[4];
#pragma unroll
      for (int j = 0; j < 4; ++j) hq[j] = n_hq[j];
      f32x4 xv4[4];
#pragma unroll
      for (int q = 0; q < 4; ++q) xv4[q] = *(const f32x4*)(x1s + row * 1024 + lane * 16 + q * 4);
      if (rr + 1 < 8) GA_PREP(row + 8)
      oacc_t oacc[8];
#pragma unroll
      for (int j = 0; j < 8; ++j) { oacc[j][0] = 0; oacc[j][1] = 0; }
      float csum = 0.f;
#pragma unroll 1
      for (int half = 0; half < 2; ++half) {
        const int iv = half ? ib : ia, ivn = half ? n_ia : ib;
        const float gs = half ? gb : ga, us = half ? ub : ua, bs = half ? bb : ba;
        const bool has_next = (half == 0) || (rr + 1 < 8);
#pragma unroll 1
        for (int g8 = 0; g8 < 8; g8 += 2) {
          ga_load(qrs, iv, (g8 + 1) * 8, voff_u, voff_v, bufB_u, bufB_v);
          ga_compute(gs, us, bs, g8 * 8, lane, kt, hscale, hq, bufA_u, bufA_v, oacc, csum);
          if (g8 + 2 < 8) ga_load(qrs, iv, (g8 + 2) * 8, voff_u, voff_v, bufA_u, bufA_v);
          else if (has_next) ga_load(qrs, ivn, 0, voff_u, voff_v, bufA_u, bufA_v);
          ga_compute(gs, us, bs, (g8 + 1) * 8, lane, kt, hscale, hq, bufB_u, bufB_v, oacc, csum);
        }
      }
      {
#if QBITS == 8
        const float corr = wave_sum(csum) * (128.f / 8.f);
#pragma unroll
        for (int j = 0; j < 8; ++j) oacc[j] = oacc[j] - corr;
#endif
      }
      float xo[16]; float ss = 0.f;
#pragma unroll
      for (int q = 0; q < 4; ++q) {
        const int col = lane * 16 + q * 4;
        const f32x4 xv = xv4[q];
        const f32x4 g2 = *(const f32x4*)(modb + 5120 + col);
#pragma unroll
        for (int j = 0; j < 4; ++j) { const float v = xv[j] + g2[j] * ((float)oacc[q * 2 + (j >> 1)][j & 1] * (1.f / OACC_SCALE)); xo[q * 4 + j] = v; ss += v * v; }
      }
      ss = wave_sum(ss);
      const float rs = rsqrtf(ss * (1.f / 1024.f) + EPS);
#pragma unroll
      for (int q = 0; q < 4; ++q) {
        const int col = lane * 16 + q * 4;
        const f32x4 fg = *(const f32x4*)(p.final_g + col);
        f32x4 o;
#pragma unroll
        for (int j = 0; j < 4; ++j) o[j] = xo[q * 4 + j] * rs * fg[j];
        *(f32x4*)(p.out + (size_t)tok * DM + col) = o;
      }
    }
#undef GA_PREP
    __syncthreads();
  }
}

template <int MODE>
__global__ void __launch_bounds__(NTHREADS) mk_fwd(Params p) {
  extern __shared__ __attribute__((aligned(16))) char smem[];
  if (MODE < 0) {
    cg::grid_group grid = cg::this_grid();
    typedef const __attribute__((address_space(4))) Params* KPP;
    { KPP kp = (KPP)__builtin_amdgcn_kernarg_segment_ptr(); asm volatile("" : "+s"(kp)); phase0(*kp, smem); }
    grid.sync();
    { KPP kp = (KPP)__builtin_amdgcn_kernarg_segment_ptr(); asm volatile("" : "+s"(kp)); phase1(*kp, smem); }
    grid.sync();
    { KPP kp = (KPP)__builtin_amdgcn_kernarg_segment_ptr(); asm volatile("" : "+s"(kp)); phase2(*kp, smem); }
    grid.sync();
    { KPP kp = (KPP)__builtin_amdgcn_kernarg_segment_ptr(); asm volatile("" : "+s"(kp)); phase3(*kp, smem); }
#ifdef PROBE_P3X2
    grid.sync();
    phase3(p, smem);
#endif
#ifdef PROBE_P1X2
    grid.sync();
    phase1(p, smem);
#endif
  } else {
    typedef const __attribute__((address_space(4))) Params* KPP;
    KPP kp = (KPP)__builtin_amdgcn_kernarg_segment_ptr();
    if (MODE == 0) phase0(*kp, smem);
    if (MODE == 1) phase1(*kp, smem);
    if (MODE == 2) phase2(*kp, smem);
    if (MODE == 3) phase3(*kp, smem);
  }
}

static size_t align_up(size_t v) { return (v + 255) & ~(size_t)255; }

extern "C" void kernel_launch(void* const* d_in, const int* in_sizes, int n_in, void* d_out, int out_size, void* d_ws, size_t ws_size, hipStream_t stream) {
  static int grid = 0;
  if (grid == 0) {
    int dev = 0, cus = 0, per_cu = 0;
    (void)hipGetDevice(&dev);
    (void)hipDeviceGetAttribute(&cus, hipDeviceAttributeMultiprocessorCount, dev);
#if N_LAUNCH_MODE == 1
    (void)hipFuncSetAttribute((const void*)mk_fwd<-1>, hipFuncAttributeMaxDynamicSharedMemorySize, LDS_BYTES);
    (void)hipOccupancyMaxActiveBlocksPerMultiprocessor(&per_cu, (const void*)mk_fwd<-1>, NTHREADS, LDS_BYTES);
#else
    (void)hipFuncSetAttribute((const void*)mk_fwd<0>, hipFuncAttributeMaxDynamicSharedMemorySize, LDS_BYTES);
    (void)hipFuncSetAttribute((const void*)mk_fwd<1>, hipFuncAttributeMaxDynamicSharedMemorySize, LDS_BYTES);
    (void)hipFuncSetAttribute((const void*)mk_fwd<2>, hipFuncAttributeMaxDynamicSharedMemorySize, LDS_BYTES);
    (void)hipFuncSetAttribute((const void*)mk_fwd<3>, hipFuncAttributeMaxDynamicSharedMemorySize, LDS_BYTES);
    (void)hipOccupancyMaxActiveBlocksPerMultiprocessor(&per_cu, (const void*)mk_fwd<3>, NTHREADS, LDS_BYTES);
#endif
    if (per_cu < 1) { fprintf(stderr, "kernel_launch: occupancy query says %d blocks/CU\n", per_cu); per_cu = 1; }
    if (per_cu > 1) per_cu = 1;
    grid = cus * per_cu;
    if (grid > 256) grid = 256;
    (void)hipGetLastError();
  }
  Params p{};
  const float* const* fin = (const float* const*)d_in;
  p.x = fin[0]; p.c = fin[1]; p.pos = (const int*)d_in[2];
  p.w_ada = fin[3]; p.b_ada = fin[4]; p.norm1_g = fin[5]; p.w_in = fin[6]; p.conv_w = fin[7]; p.conv_b = fin[8];
  p.lru_wa = fin[9]; p.lru_ba = fin[10]; p.lru_wx = fin[11]; p.lru_bx = fin[12]; p.lru_lambda = fin[13];
  p.q_norm_g = fin[14]; p.w_uq = fin[15]; p.kv_norm_g = fin[16]; p.w_ukv = fin[17]; p.lru_out_g = fin[18]; p.mla_out_g = fin[19];
  p.w_out = fin[20]; p.norm2_g = fin[21]; p.peer_wq = fin[22]; p.peer_keys = fin[23]; p.peer_u = fin[24]; p.peer_v = fin[25]; p.final_g = fin[26];
  p.out = (float*)d_out;
  char* w = (char*)d_ws; size_t off = 0;
  auto take = [&](size_t bytes) { char* r = w + off; off = align_up(off + bytes); return r; };
  p.mod = (float*)take((size_t)NB * 6144 * 4);
  p.ssq_lru = (float*)take((size_t)NTOK * 4);
  p.ssq_mla = (float*)take((size_t)NTOK * 4);
  p.invfreq = (double*)take(16 * 8);
  p.Wf_in = (bf16x8*)take((size_t)INW * 1024 * 2);
  p.Wf_uq = (bf16x8*)take((size_t)768 * 256 * 2);
  p.Wf_ukv = (bf16x8*)take((size_t)1024 * 128 * 2);
  p.Wf_a = (bf16x8*)take((size_t)8 * 64 * 64 * 2);
  p.Wf_x = (bf16x8*)take((size_t)8 * 64 * 64 * 2);
  p.Wf_out = (bf16x8*)take((size_t)1024 * 1024 * 2);
  p.Wf_s = (i32x4*)take((size_t)2048 * 1024);
  p.Wsf = (float*)take((size_t)2048 * 1024 * 4);
  p.wsmaxp = (float*)take((size_t)2048 * 16 * 4);
  p.wsc = (float*)take((size_t)2048 * 4);
  p.Uq = (unsigned char*)take((size_t)2 * 16384 * QROWB);
  p.Vq = p.Uq + (size_t)16384 * QROWB;
  p.uscale = (float*)take((size_t)16384 * 16);
  p.vscale = p.uscale; p.ubias = p.uscale;
  p.xlru = (u16*)take((size_t)NTOK * 512 * 2);
  p.gate = (u16*)take((size_t)NTOK * 512 * 2);
  p.Q = (u16*)take((size_t)NTOK * 768 * 2);
  p.Kn = (u16*)take((size_t)NTOK * 512 * 2);
  p.Kr = (u16*)take((size_t)NTOK * 32 * 2);
  p.Vt = (u16*)take((size_t)NTOK * 512 * 2);
  p.y = (u16*)take((size_t)NTOK * 1024 * 2);
  p.scratch = take((size_t)256 * 655360);
  if (off > ws_size) { fprintf(stderr, "kernel_launch: workspace too small: need %zu have %zu\n", off, ws_size); return; }
#if N_LAUNCH_MODE == 1
  void* args[] = {&p};
  hipError_t e = hipLaunchCooperativeKernel((const void*)mk_fwd<-1>, dim3(grid), dim3(NTHREADS), args, LDS_BYTES, stream);
  if (e != hipSuccess) fprintf(stderr, "cooperative launch failed: %s (grid %d)\n", hipGetErrorString(e), grid);
#else
  hipLaunchKernelGGL(mk_fwd<0>, dim3(grid), dim3(NTHREADS), LDS_BYTES, stream, p);
  hipLaunchKernelGGL(mk_fwd<1>, dim3(grid), dim3(NTHREADS), LDS_BYTES, stream, p);
  hipLaunchKernelGGL(mk_fwd<2>, dim3(grid), dim3(NTHREADS), LDS_BYTES, stream, p);
  hipLaunchKernelGGL(mk_fwd<3>, dim3(grid), dim3(NTHREADS), LDS_BYTES, stream, p);
#endif
}
```

```cpp
#include <hip/hip_runtime.h>
#include <hip/hip_cooperative_groups.h>
#include <cstdio>
#include <cstdint>
namespace cg = cooperative_groups;

#ifndef QBITS
#define QBITS 4
#endif
#ifndef N_LAUNCH_MODE
#define N_LAUNCH_MODE 1
#endif

typedef short bf16x8 __attribute__((ext_vector_type(8)));
typedef float f32x16 __attribute__((ext_vector_type(16)));
typedef float f32x4 __attribute__((ext_vector_type(4)));
typedef float f32x2 __attribute__((ext_vector_type(2)));
typedef unsigned u32x4 __attribute__((ext_vector_type(4)));
typedef unsigned u32x2 __attribute__((ext_vector_type(2)));
typedef __bf16 bf16x2_t __attribute__((ext_vector_type(2)));
typedef unsigned short u16;
typedef _Float16 h16x2 __attribute__((ext_vector_type(2)));

#define DI __device__ __forceinline__
#define MFMA32(a, b, c) __builtin_amdgcn_mfma_f32_32x32x16_bf16((a), (b), (c), 0, 0, 0)
typedef int i32x4 __attribute__((ext_vector_type(4)));
typedef int i32x16 __attribute__((ext_vector_type(16)));
#define MFMA8(a, b, c) __builtin_amdgcn_mfma_i32_32x32x32_i8((a), (b), (c), 0, 0, 0)

constexpr int NB = 32, SEQ = 2048, DM = 1024, NTOK = NB * SEQ;
constexpr int INW = 1440;
constexpr int NTHREADS = 512;
constexpr int LDA = 1032;
constexpr int LDA8 = 1040;
constexpr int LDS_BYTES = 147456;
constexpr float EPS = 1e-6f;

struct Params {
  const float* x; const float* c; const int* pos;
  const float* w_ada; const float* b_ada; const float* norm1_g; const float* w_in; const float* conv_w; const float* conv_b;
  const float* lru_wa; const float* lru_ba; const float* lru_wx; const float* lru_bx; const float* lru_lambda;
  const float* q_norm_g; const float* w_uq; const float* kv_norm_g; const float* w_ukv; const float* lru_out_g; const float* mla_out_g;
  const float* w_out; const float* norm2_g; const float* peer_wq; const float* peer_keys; const float* peer_u; const float* peer_v; const float* final_g;
  float* out;
  float* mod; float* ssq_lru; float* ssq_mla; double* invfreq;
  bf16x8* Wf_in; bf16x8* Wf_uq; bf16x8* Wf_ukv; bf16x8* Wf_a; bf16x8* Wf_x; bf16x8* Wf_out; i32x4* Wf_s;
  float* Wsf; float* wsmaxp; float* wsc;
  i32x4* Wf_out8; float* wopm; float* wosc;
  unsigned char* Uq; unsigned char* Vq; float* uscale; float* vscale; float* ubias; u16* xlru; u16* gate; u16* Q; u16* Kn; u16* Kr; u16* Vt; u16* y;
  char* scratch;
};

typedef const __attribute__((address_space(4))) Params& KP;

DI unsigned pk2(float a, float b) { f32x2 v = {a, b}; bf16x2_t r = __builtin_convertvector(v, bf16x2_t); return __builtin_bit_cast(unsigned, r); }
DI u16 f2bf(float a) { return (u16)(pk2(a, 0.f) & 0xffffu); }
DI float bflo(unsigned u) { return __uint_as_float(u << 16); }
DI float bfhi(unsigned u) { return __uint_as_float(u & 0xffff0000u); }
DI float bf2f(u16 h) { return __uint_as_float(((unsigned)h) << 16); }
template <int CTRL> DI float dppf(float v) { return __builtin_bit_cast(float, __builtin_amdgcn_update_dpp(0, __builtin_bit_cast(int, v), CTRL, 0xF, 0xF, true)); }
typedef unsigned u32x2_ __attribute__((ext_vector_type(2)));
DI float wave_sum(float v) {
  v += dppf<0xB1>(v); v += dppf<0x4E>(v); v += dppf<0x141>(v); v += dppf<0x140>(v);
  u32x2_ r = __builtin_amdgcn_permlane16_swap(__float_as_uint(v), __float_as_uint(v), false, false); v = __uint_as_float(r[0]) + __uint_as_float(r[1]);
  r = __builtin_amdgcn_permlane32_swap(__float_as_uint(v), __float_as_uint(v), false, false); v = __uint_as_float(r[0]) + __uint_as_float(r[1]);
  return v;
}
DI float wave_max(float v) {
  v = fmaxf(v, dppf<0xB1>(v)); v = fmaxf(v, dppf<0x4E>(v)); v = fmaxf(v, dppf<0x141>(v)); v = fmaxf(v, dppf<0x140>(v));
  u32x2_ r = __builtin_amdgcn_permlane16_swap(__float_as_uint(v), __float_as_uint(v), false, false); v = fmaxf(__uint_as_float(r[0]), __uint_as_float(r[1]));
  r = __builtin_amdgcn_permlane32_swap(__float_as_uint(v), __float_as_uint(v), false, false); v = fmaxf(__uint_as_float(r[0]), __uint_as_float(r[1]));
  return v;
}
template <int CTRL> DI unsigned dppu(unsigned v) { return (unsigned)__builtin_amdgcn_update_dpp(0, (int)v, CTRL, 0xF, 0xF, true); }
template <int J> DI unsigned lane_xor_u(unsigned v, int lane) {
  if (J == 1) return dppu<0xB1>(v);
  if (J == 2) return dppu<0x4E>(v);
  if (J == 4) return dppu<0x141>(dppu<0x1B>(v));
  if (J == 8) return dppu<0x128>(v);
  if (J == 16) { const u32x2_ r = __builtin_amdgcn_permlane16_swap(v, v, false, false); return (lane & 16) ? r[0] : r[1]; }
  const u32x2_ r = __builtin_amdgcn_permlane32_swap(v, v, false, false); return (lane & 32) ? r[0] : r[1];
}
template <int J> DI float lane_xor_f(float v, int lane) { return __uint_as_float(lane_xor_u<J>(__float_as_uint(v), lane)); }
DI float sum_xor32(float v) { const u32x2_ r = __builtin_amdgcn_permlane32_swap(__float_as_uint(v), __float_as_uint(v), false, false); return __uint_as_float(r[0]) + __uint_as_float(r[1]); }
DI float max_xor32(float v) { const u32x2_ r = __builtin_amdgcn_permlane32_swap(__float_as_uint(v), __float_as_uint(v), false, false); return fmaxf(__uint_as_float(r[0]), __uint_as_float(r[1])); }
DI float other_xor32(float v, int lane) { const u32x2_ r = __builtin_amdgcn_permlane32_swap(__float_as_uint(v), __float_as_uint(v), false, false); return __uint_as_float((lane & 32) ? r[0] : r[1]); }
DI float reduce8(const float (&v)[8], int lane) {
  float q4[4], r2[2];
#pragma unroll
  for (int j = 0; j < 4; ++j) {
    const u32x2_ r = __builtin_amdgcn_permlane32_swap(__float_as_uint(v[j]), __float_as_uint(v[4 + j]), false, false);
    q4[j] = __uint_as_float(r[0]) + __uint_as_float(r[1]);
  }
#pragma unroll
  for (int j = 0; j < 2; ++j) {
    const u32x2_ r = __builtin_amdgcn_permlane16_swap(__float_as_uint(q4[j]), __float_as_uint(q4[2 + j]), false, false);
    r2[j] = __uint_as_float(r[0]) + __uint_as_float(r[1]);
  }
  const float s0 = r2[0] + dppf<0x128>(r2[0]), s1b = r2[1] + dppf<0x128>(r2[1]);
  float s1 = (lane & 8) ? s1b : s0;
  s1 += dppf<0xB1>(s1);
  s1 += dppf<0x4E>(s1);
  s1 += dppf<0x141>(s1);
  return s1;
}
DI float reduce32(const float (&v)[32], int lane) {
  const bool b3 = (lane & 8) != 0, b2 = (lane & 4) != 0, b1 = (lane & 2) != 0, b0 = (lane & 1) != 0;
  float a16[16], a8[8], a4[4], a2[2];
#pragma unroll
  for (int j = 0; j < 16; ++j) {
    const u32x2_ r = __builtin_amdgcn_permlane16_swap(__float_as_uint(v[j]), __float_as_uint(v[16 + j]), false, false);
    a16[j] = __uint_as_float(r[0]) + __uint_as_float(r[1]);
  }
#pragma unroll
  for (int j = 0; j < 8; ++j) { const float keep = b3 ? a16[8 + j] : a16[j], send = b3 ? a16[j] : a16[8 + j]; a8[j] = keep + lane_xor_f<8>(send, lane); }
#pragma unroll
  for (int j = 0; j < 4; ++j) { const float keep = b2 ? a8[4 + j] : a8[j], send = b2 ? a8[j] : a8[4 + j]; a4[j] = keep + lane_xor_f<4>(send, lane); }
#pragma unroll
  for (int j = 0; j < 2; ++j) { const float keep = b1 ? a4[2 + j] : a4[j], send = b1 ? a4[j] : a4[2 + j]; a2[j] = keep + lane_xor_f<2>(send, lane); }
  const float keep = b0 ? a2[1] : a2[0], send = b0 ? a2[0] : a2[1];
  return keep + lane_xor_f<1>(send, lane);
}
DI float sigmoidf_(float x) { return __builtin_amdgcn_rcpf(1.f + __builtin_amdgcn_exp2f(-1.4426950408889634f * x)); }
DI float gelu_tanh(float x) { const float u = 0.7978845608028654f * (x + 0.044715f * x * x * x); return x * __builtin_amdgcn_rcpf(1.f + __builtin_amdgcn_exp2f(-2.f * 1.4426950408889634f * u)); }
DI float one_minus_exp_small(float z) {
  float q = 1.f + z * (1.f / 6.f);
  q = 1.f + z * (1.f / 5.f) * q;
  q = 1.f + z * (1.f / 4.f) * q;
  q = 1.f + z * (1.f / 3.f) * q;
  q = 1.f + z * (1.f / 2.f) * q;
  return -z * q;
}
DI f32x16 zero16() { f32x16 z; for (int i = 0; i < 16; ++i) z[i] = 0.f; return z; }
DI int crow(int reg, int h) { return (reg & 3) + 8 * (reg >> 2) + 4 * h; }

template <int NT, int PD>
DI void gemm_pro(const bf16x8* __restrict__ Wf, int KS, const int (&tile)[NT], int lane, bf16x8 (&bq)[PD][NT]) {
#pragma unroll
  for (int d = 0; d < PD; ++d)
#pragma unroll
    for (int t = 0; t < NT; ++t) bq[d][t] = Wf[((size_t)tile[t] * KS + d) * 64 + lane];
}
template <int NT, int PD, bool SWAP, bool APF = false>
DI void gemm_main(const u16* As, int lda, int nks, const bf16x8* __restrict__ Wf, int KS, const int (&tile)[NT], f32x16 (&acc)[NT][2], int lane, bf16x8 (&bq)[PD][NT]) {
  const bf16x8* a0p = (const bf16x8*)(As + (lane & 31) * lda + 8 * (lane >> 5));
  const bf16x8* a1p = (const bf16x8*)(As + ((lane & 31) + 32) * lda + 8 * (lane >> 5));
  const bf16x8* bp[NT];
#pragma unroll
  for (int t = 0; t < NT; ++t) bp[t] = Wf + (size_t)tile[t] * KS * 64 + lane;
  bf16x8 a0n = a0p[0], a1n = a1p[0];
#pragma unroll 1
  for (int ks = 0; ks < nks; ks += PD) {
#pragma unroll
    for (int d = 0; d < PD; ++d) {
      bf16x8 a0, a1;
      if (APF) { a0 = a0n; a1 = a1n; const int ka = (ks + d + 1 < nks) ? (ks + d + 1) : (ks + d); a0n = a0p[2 * ka]; a1n = a1p[2 * ka]; }
      else { a0 = a0p[2 * (ks + d)]; a1 = a1p[2 * (ks + d)]; }
      const int kn = (ks + d + PD < nks) ? (ks + d + PD) : (ks + d);
#pragma unroll
      for (int t = 0; t < NT; ++t) {
        const bf16x8 b = bq[d][t];
        bq[d][t] = bp[t][kn * 64];
        acc[t][0] = SWAP ? MFMA32(b, a0, acc[t][0]) : MFMA32(a0, b, acc[t][0]);
        acc[t][1] = SWAP ? MFMA32(b, a1, acc[t][1]) : MFMA32(a1, b, acc[t][1]);
      }
    }
  }
}
template <int NT, int PD = 8, bool SWAP = false>
DI void gemm_core(const u16* As, int lda, int nks, const bf16x8* __restrict__ Wf, int KS, const int (&tile)[NT], f32x16 (&acc)[NT][2], int lane) {
  bf16x8 bq[PD][NT];
  gemm_pro<NT, PD>(Wf, KS, tile, lane, bq);
  gemm_main<NT, PD, SWAP>(As, lda, nks, Wf, KS, tile, acc, lane, bq);
}

template <int NT, int PD>
DI void gemm8_pro(const i32x4* __restrict__ Wf, int KS, const int (&tile)[NT], int lane, i32x4 (&bq)[PD][NT]) {
#pragma unroll
  for (int d = 0; d < PD; ++d)
#pragma unroll
    for (int t = 0; t < NT; ++t) bq[d][t] = Wf[((size_t)tile[t] * KS + d) * 64 + lane];
}
template <int NT, int PD, bool SWAP = true>
DI void gemm8_main(const signed char* As, int lda, int nks, const i32x4* __restrict__ Wf, int KS, const int (&tile)[NT], i32x16 (&acc)[NT][2], int lane, i32x4 (&bq)[PD][NT]) {
  const i32x4* a0p = (const i32x4*)(As + (lane & 31) * lda + 16 * (lane >> 5));
  const i32x4* a1p = (const i32x4*)(As + ((lane & 31) + 32) * lda + 16 * (lane >> 5));
  const i32x4* bp[NT];
#pragma unroll
  for (int t = 0; t < NT; ++t) bp[t] = Wf + (size_t)tile[t] * KS * 64 + lane;
#pragma unroll 1
  for (int ks = 0; ks < nks; ks += PD) {
#pragma unroll
    for (int d = 0; d < PD; ++d) {
      const i32x4 a0 = a0p[2 * (ks + d)], a1 = a1p[2 * (ks + d)];
      const int kn = (ks + d + PD < nks) ? (ks + d + PD) : (ks + d);
#pragma unroll
      for (int t = 0; t < NT; ++t) {
        const i32x4 b = bq[d][t];
        bq[d][t] = bp[t][kn * 64];
        acc[t][0] = SWAP ? MFMA8(b, a0, acc[t][0]) : MFMA8(a0, b, acc[t][0]);
        acc[t][1] = SWAP ? MFMA8(b, a1, acc[t][1]) : MFMA8(a1, b, acc[t][1]);
      }
    }
  }
}

DI void conv_frag(const float* __restrict__ W, long sk, long sn, int K, int N, const float* ks1, const float* ks2, int ksplit, bf16x8* out, int gtid, int gthreads) {
  const int KS = K / 16; const int total = (N / 32) * KS * 64;
  for (int i = gtid; i < total; i += gthreads) {
    const int lane = i & 63; const int t = i >> 6; const int ks = t % KS; const int nt = t / KS;
    const int n = nt * 32 + (lane & 31); const int k0 = ks * 16 + 8 * (lane >> 5);
    float v[8];
#pragma unroll
    for (int j = 0; j < 8; ++j) {
      const int k = k0 + j;
      float s = 1.f;
      if (ks1) s = (k < ksplit) ? ks1[k] : ks2[k - ksplit];
      v[j] = W[(long)k * sk + (long)n * sn] * s;
    }
    u32x4 o; o[0] = pk2(v[0], v[1]); o[1] = pk2(v[2], v[3]); o[2] = pk2(v[4], v[5]); o[3] = pk2(v[6], v[7]);
    out[i] = __builtin_bit_cast(bf16x8, o);
  }
}

DI void conv_one(const float* __restrict__ W, long sk, int KS, const float* ks1, const float* ks2, int ksplit, bf16x8* out, int i) {
  const int lane = i & 63; const int t = i >> 6; const int ks = t % KS; const int nt = t / KS;
  const int n = nt * 32 + (lane & 31); const int k0 = ks * 16 + 8 * (lane >> 5);
  float v[8];
#pragma unroll
  for (int j = 0; j < 8; ++j) v[j] = W[(long)(k0 + j) * sk + n];
  if (ks1) {
#pragma unroll
    for (int j = 0; j < 8; ++j) { const int k = k0 + j; v[j] *= (k < ksplit) ? ks1[k] : ks2[k - ksplit]; }
  }
  u32x4 o; o[0] = pk2(v[0], v[1]); o[1] = pk2(v[2], v[3]); o[2] = pk2(v[4], v[5]); o[3] = pk2(v[6], v[7]);
  out[i] = __builtin_bit_cast(bf16x8, o);
}

DI void phase0(KP p, char* smem) {
  const int tid = threadIdx.x; const int gtid = blockIdx.x * NTHREADS + tid; const int gthreads = gridDim.x * NTHREADS;
  for (int i = gtid; i < NTOK; i += gthreads) { p.ssq_lru[i] = 0.f; p.ssq_mla[i] = 0.f; }
  if (gtid < 16) p.invfreq[gtid] = pow(10000.0, -(double)gtid / 16.0);
  {
    float* cact = (float*)smem;
    float* red = (float*)(smem + 65536);
    const int lane = tid & 63, wv = tid >> 6;
    for (int item = blockIdx.x; item < 192; item += gridDim.x) {
      const int cg = item >> 1, bh = item & 1;
      for (int i = tid; i < 16 * DM; i += NTHREADS) { const int bb = i >> 10, k = i & 1023; const float v = p.c[(bh * 16 + bb) * DM + k]; cact[k * 16 + bb] = v / (1.f + __expf(-v)); }
      __syncthreads();
      float acc[16];
#pragma unroll
      for (int bb = 0; bb < 16; ++bb) acc[bb] = 0.f;
      const float* wp = p.w_ada + (size_t)(wv * 128) * 6144 + cg * 64 + lane;
#pragma unroll 32
      for (int kk = 0; kk < 128; ++kk) {
        const float w = wp[(size_t)kk * 6144];
        const f32x4* cp = (const f32x4*)(cact + (wv * 128 + kk) * 16);
#pragma unroll
        for (int q = 0; q < 4; ++q) { const f32x4 cv = cp[q]; acc[4 * q] += cv[0] * w; acc[4 * q + 1] += cv[1] * w; acc[4 * q + 2] += cv[2] * w; acc[4 * q + 3] += cv[3] * w; }
      }
#pragma unroll
      for (int bb = 0; bb < 16; ++bb) red[(wv * 16 + bb) * 64 + lane] = acc[bb];
      __syncthreads();
      for (int o = tid; o < 1024; o += NTHREADS) {
        const int bb = o >> 6, c2 = o & 63;
        float sum = 0.f;
#pragma unroll
        for (int w8 = 0; w8 < 8; ++w8) sum += red[(w8 * 16 + bb) * 64 + c2];
        p.mod[(size_t)(bh * 16 + bb) * 6144 + cg * 64 + c2] = sum + p.b_ada[cg * 64 + c2];
      }
      __syncthreads();
    }
  }
  {
    constexpr int N_IN = 45 * 64 * 64, N_UQ = 24 * 16 * 64, N_UKV = 32 * 8 * 64, N_LRU = 16 * 512, N_OUT = 32 * 64 * 64;
    for (int i = gtid; i < N_IN + N_UQ + N_UKV + N_LRU + N_OUT; i += gthreads) {
      int j = i;
      if (j < N_OUT) {
        if (j < 32 * 1024) {
          const int n = j & 1023, kc = j >> 10;
          float m = 0.f;
#pragma unroll 8
          for (int q = 0; q < 32; ++q) { const int k = kc * 32 + q; m = fmaxf(m, fabsf(p.w_out[(size_t)k * 1024 + n] * (k < 512 ? p.lru_out_g[k] : p.mla_out_g[k - 512]))); }
          p.wopm[j] = m;
        }
        continue;
      }
      j -= N_OUT;
      if (j < N_IN) { conv_one(p.w_in, INW, 64, nullptr, nullptr, 0, p.Wf_in, j); continue; }
      j -= N_IN;
      if (j < N_UQ) { conv_one(p.w_uq, 768, 16, p.q_norm_g, p.q_norm_g, 256, p.Wf_uq, j); continue; }
      j -= N_UQ;
      if (j < N_UKV) { conv_one(p.w_ukv, 1024, 8, p.kv_norm_g, p.kv_norm_g, 128, p.Wf_ukv, j); continue; }
      j -= N_UKV;
      { const int h = j >> 10, m = (j >> 9) & 1, f = j & 511; conv_one((m ? p.lru_wx : p.lru_wa) + h * 4096, 64, 4, nullptr, nullptr, 0, (m ? p.Wf_x : p.Wf_a) + h * 512, f); }
    }
  }
  {
    float* kl = (float*)smem;
    float* wl = (float*)(smem + 67584);
    const int lane = tid & 63, wv = tid >> 6, l31 = lane & 31, lh = lane >> 5;
    for (int item = blockIdx.x; item < 256; item += gridDim.x) {
      const int hp = item >> 4, cc = item & 15;
      __syncthreads();
#pragma unroll
      for (int i = 0; i < 8; ++i) { const int e = tid + NTHREADS * i; const int r = e >> 5, q = e & 31; *(f32x4*)(kl + r * 132 + q * 4) = *(const f32x4*)(p.peer_keys + (size_t)hp * 16384 + r * 128 + q * 4); }
#pragma unroll
      for (int i = 0; i < 4; ++i) { const int e = tid + NTHREADS * i; const int c = e >> 5, q = e & 31; *(f32x4*)(wl + c * 132 + q * 4) = *(const f32x4*)(p.peer_wq + (size_t)(cc * 64 + c) * 2048 + hp * 128 + q * 4); }
      __syncthreads();
      const int rt = wv >> 1, ct = wv & 1;
      const float* ap = kl + (rt * 32 + l31) * 132 + 8 * lh;
      const float* bp = wl + (ct * 32 + l31) * 132 + 8 * lh;
      f32x16 acc = zero16();
#pragma unroll
      for (int ks = 0; ks < 8; ++ks) {
        const f32x4 a0 = *(const f32x4*)(ap + 16 * ks), a1 = *(const f32x4*)(ap + 16 * ks + 4);
        const f32x4 b0 = *(const f32x4*)(bp + 16 * ks), b1 = *(const f32x4*)(bp + 16 * ks + 4);
        u32x4 av, bv;
        av[0] = pk2(a0[0], a0[1]); av[1] = pk2(a0[2], a0[3]); av[2] = pk2(a1[0], a1[1]); av[3] = pk2(a1[2], a1[3]);
        bv[0] = pk2(b0[0], b0[1]); bv[1] = pk2(b0[2], b0[3]); bv[2] = pk2(b1[0], b1[1]); bv[3] = pk2(b1[2], b1[3]);
        acc = MFMA32(__builtin_bit_cast(bf16x8, av), __builtin_bit_cast(bf16x8, bv), acc);
      }
      float* dst = p.Wsf + (size_t)(hp * 128 + rt * 32) * 1024 + cc * 64 + ct * 32 + l31;
#pragma unroll
      for (int r = 0; r < 16; ++r) dst[(size_t)crow(r, lh) * 1024] = acc[r];
    }
    __syncthreads();
  }
#if QBITS == 8
  {
    const int lane = tid & 63; const int gw = gtid >> 6; const int nw = gthreads >> 6;
    for (int row = gw; row < 32768; row += nw) {
      const int r = row & 16383; const bool isv = row >= 16384;
      const f32x4* src = (const f32x4*)((isv ? p.peer_v : p.peer_u) + (size_t)r * 1024) + lane * 4;
      f32x4 a[4];
#pragma unroll
      for (int i = 0; i < 4; ++i) a[i] = src[i];
#if QBITS == 8
      float am = 0.f;
#pragma unroll
      for (int i = 0; i < 4; ++i)
#pragma unroll
        for (int j = 0; j < 4; ++j) am = fmaxf(am, fabsf(a[i][j]));
      am = wave_max(am);
      const float inv = am > 0.f ? 127.f / am : 0.f;
      u32x4 o;
#pragma unroll
      for (int i = 0; i < 4; ++i) {
        unsigned w = 0;
#pragma unroll
        for (int j = 0; j < 4; ++j) { const int q = (int)__builtin_rintf(a[i][j] * inv) + 128; w |= (unsigned)q << (8 * j); }
        o[i] = w;
      }
      ((u32x4*)(isv ? p.Vq : p.Uq))[(size_t)r * 64 + lane] = o;
      const float step = am * (1.f / 127.f);
      if (lane == 0) p.uscale[r * 4 + (isv ? 1 : 0)] = step;
      float ns = 0.f;
#pragma unroll
      for (int i = 0; i < 4; ++i) ns += (float)(o[i] & 255u) + (float)((o[i] >> 8) & 255u) + (float)((o[i] >> 16) & 255u) + (float)(o[i] >> 24);
      ns = wave_sum(ns);
      if (lane == 0 && !isv) p.uscale[r * 4 + 2] = step * 128.f * ns;
#else
      float ssum = 0.f;
#pragma unroll
      for (int i = 0; i < 4; ++i)
#pragma unroll
        for (int j = 0; j < 4; ++j) ssum += a[i][j] * a[i][j];
      ssum = wave_sum(ssum);
      const float rms = sqrtf(ssum * (1.f / 1024.f));
      const float step = (isv ? 0.49f : 0.3352f) * rms;
      const float inv = step > 0.f ? 1.f / step : 0.f;
      u32x2 o;
#pragma unroll
      for (int jd = 0; jd < 2; ++jd) {
        unsigned w = 0;
#pragma unroll
        for (int e = 0; e < 8; ++e) {
          const float x = a[(8 * jd + e) >> 2][(8 * jd + e) & 3];
          if (isv) {
            const float m = fabsf(x) * inv;
            const int mag = (m > 0.25f) + (m > 0.75f) + (m > 1.25f) + (m > 1.75f) + (m > 2.5f) + (m > 3.5f) + (m > 5.0f);
            w |= (unsigned)(mag | (x < 0.f ? 8 : 0)) << (4 * e);
          } else {
            int q = (int)__builtin_rintf(x * inv + 7.5f); q = q < 0 ? 0 : (q > 15 ? 15 : q);
            w |= (unsigned)q << (8 * (e & 3) + 4 * (e >> 2));
          }
        }
        o[jd] = w;
      }
      ((u32x2*)(p.Uq + (size_t)r * 1024))[2 * lane + (isv ? 1 : 0)] = o;
      if (lane == 0) p.uscale[r * 4 + (isv ? 1 : 0)] = step;
      float ns = 0.f;
#pragma unroll
      for (int jd = 0; jd < 2; ++jd)
#pragma unroll
        for (int e = 0; e < 8; ++e) ns += (float)((o[jd] >> (4 * e)) & 15u);
      ns = wave_sum(ns);
      if (lane == 0 && !isv) p.uscale[r * 4 + 2] = step * 128.f * ns;
#endif
    }
  }
#else
  {
    const int lane = tid & 63; const int gw = gtid >> 6; const int nw = gthreads >> 6;
    for (int r = gw; r < 16384; r += nw) {
      const f32x4* su = (const f32x4*)(p.peer_u + (size_t)r * 1024) + lane * 4;
      const f32x4* sv = (const f32x4*)(p.peer_v + (size_t)r * 1024) + lane * 4;
      f32x4 au[4], av[4];
#pragma unroll
      for (int i = 0; i < 4; ++i) { au[i] = su[i]; av[i] = sv[i]; }
      float ssu = 0.f, ssv = 0.f;
#pragma unroll
      for (int i = 0; i < 4; ++i)
#pragma unroll
        for (int j = 0; j < 4; ++j) { ssu += au[i][j] * au[i][j]; ssv += av[i][j] * av[i][j]; }
      ssu = wave_sum(ssu); ssv = wave_sum(ssv);
      const float ustep = 0.3352f * sqrtf(ssu * (1.f / 1024.f)), vstep = 0.49f * sqrtf(ssv * (1.f / 1024.f));
      const float uinv = ustep > 0.f ? 1.f / ustep : 0.f, vinv = vstep > 0.f ? 1.f / vstep : 0.f;
      u32x4 o;
      float ns = 0.f;
#pragma unroll
      for (int jd = 0; jd < 2; ++jd) {
        unsigned wu = 0, wv = 0;
#pragma unroll
        for (int e = 0; e < 8; ++e) {
          const float xu = au[(8 * jd + e) >> 2][(8 * jd + e) & 3], xv = av[(8 * jd + e) >> 2][(8 * jd + e) & 3];
          int q = (int)__builtin_rintf(xu * uinv + 7.5f); q = q < 0 ? 0 : (q > 15 ? 15 : q);
          wu |= (unsigned)q << (8 * (e & 3) + 4 * (e >> 2)); ns += (float)q;
          const float m = fabsf(xv) * vinv;
          const int mag = (m > 0.25f) + (m > 0.75f) + (m > 1.25f) + (m > 1.75f) + (m > 2.5f) + (m > 3.5f) + (m > 5.0f);
          wv |= (unsigned)(mag | (xv < 0.f ? 8 : 0)) << (4 * e);
        }
        o[jd] = wu; o[2 + jd] = wv;
      }
      ((u32x4*)(p.Uq + (size_t)r * 1024))[lane] = o;
      ns = wave_sum(ns);
      if (lane == 0) *(f32x4*)(p.uscale + r * 4) = (f32x4){ustep, vstep, ustep * 128.f * ns, 0.f};
    }
  }
#endif
}

DI void ws_quant(KP p) {
  const int lane = threadIdx.x & 63; const int gw = (blockIdx.x * NTHREADS + threadIdx.x) >> 6; const int nw = (gridDim.x * NTHREADS) >> 6;
  for (int row = gw; row < 2048; row += nw) {
    const f32x4* src = (const f32x4*)(p.Wsf + (size_t)row * 1024 + lane * 16);
    f32x4 v[4];
    float m = 0.f;
#pragma unroll
    for (int q = 0; q < 4; ++q) { v[q] = src[q]; m = fmaxf(fmaxf(m, fmaxf(fabsf(v[q][0]), fabsf(v[q][1]))), fmaxf(fabsf(v[q][2]), fabsf(v[q][3]))); }
    m = wave_max(m);
    const float inv = m > 0.f ? 127.f / m : 0.f;
    i32x4 o;
#pragma unroll
    for (int q = 0; q < 4; ++q) {
      unsigned w = 0;
#pragma unroll
      for (int j = 0; j < 4; ++j) w |= ((unsigned)(int)__builtin_rintf(v[q][j] * inv) & 255u) << (8 * j);
      o[q] = (int)w;
    }
    p.Wf_s[(size_t)((row >> 5) * 32 + (lane >> 1)) * 64 + (row & 31) + 32 * (lane & 1)] = o;
    if (lane == 0) p.wsc[row] = m * (1.f / 127.f);
  }
}

DI void wout_quant(KP p) {
  const int gtid = blockIdx.x * NTHREADS + threadIdx.x; const int gthreads = gridDim.x * NTHREADS;
  for (int i = gtid; i < 32 * 32 * 64; i += gthreads) {
    const int lane = i & 63; const int ks = (i >> 6) & 31; const int tile = i >> 11;
    const int n = tile * 32 + (lane & 31); const int k0 = 32 * ks + 16 * (lane >> 5);
    float m = 0.f;
#pragma unroll
    for (int q = 0; q < 32; ++q) m = fmaxf(m, p.wopm[q * 1024 + n]);
    const float inv = m > 0.f ? 127.f / m : 0.f;
    i32x4 o;
#pragma unroll
    for (int q = 0; q < 4; ++q) {
      unsigned w = 0;
#pragma unroll
      for (int j = 0; j < 4; ++j) {
        const int k = k0 + 4 * q + j;
        const float v = p.w_out[(size_t)k * 1024 + n] * (k < 512 ? p.lru_out_g[k] : p.mla_out_g[k - 512]);
        w |= ((unsigned)(int)__builtin_rintf(v * inv) & 255u) << (8 * j);
      }
      o[q] = (int)w;
    }
    p.Wf_out8[i] = o;
    if (ks == 0 && lane < 32) p.wosc[n] = m * (1.f / 127.f);
  }
}

DI void phase1(KP p, char* smem) {
  const int tid = threadIdx.x, wave = __builtin_amdgcn_readfirstlane(tid >> 6);
  u16* hA = (u16*)smem;
  float* cs = (float*)(smem + 132096);
  float* ssq = (float*)(smem + 132096 + 8192);
  constexpr int LDL = 424;
  ws_quant(p);
  wout_quant(p);
  for (int tile = blockIdx.x; tile < NTOK / 64; tile += gridDim.x) {
    int lane_o = tid & 63; asm volatile("" : "+v"(lane_o));
    const int lane = lane_o, l31 = lane & 31, lh = lane >> 5;
    const int tok0 = tile * 64; const int b = tok0 / SEQ; const int s0 = tok0 % SEQ;
    const float* modb = p.mod + (size_t)b * 6144;
    for (int i = tid; i < 1024; i += NTHREADS) {
      const int r = i >> 4, j = i & 15;
      const double ang = (double)p.pos[tok0 + r] * p.invfreq[j];
      double rev = ang * 0.15915494309189535; rev -= floor(rev);
      const float rf = (float)rev;
      cs[2 * i] = __builtin_amdgcn_cosf(rf); cs[2 * i + 1] = __builtin_amdgcn_sinf(rf);
    }
    if (tid < 128) ssq[tid] = 0.f;
    {
      f32x4 cm[4], ca[4];
#pragma unroll
      for (int i = 0; i < 4; ++i) {
        const int col = i * 256 + lane * 4;
        const f32x4 g = *(const f32x4*)(p.norm1_g + col); const f32x4 sc = *(const f32x4*)(modb + 1024 + col);
        cm[i] = g * (sc + 1.0f); ca[i] = *(const f32x4*)(modb + col);
      }
#pragma unroll 2
      for (int rr = 0; rr < 8; rr += 4) {
        f32x4 xv[4][4];
#pragma unroll
        for (int q = 0; q < 4; ++q)
#pragma unroll
          for (int i = 0; i < 4; ++i) xv[q][i] = *(const f32x4*)(p.x + (size_t)(tok0 + wave * 8 + rr + q) * DM + i * 256 + lane * 4);
#pragma unroll
        for (int q = 0; q < 4; ++q) {
          float ss = 0.f;
#pragma unroll
          for (int i = 0; i < 4; ++i) ss += xv[q][i][0] * xv[q][i][0] + xv[q][i][1] * xv[q][i][1] + xv[q][i][2] * xv[q][i][2] + xv[q][i][3] * xv[q][i][3];
          ss = wave_sum(ss);
          const float rs = rsqrtf(ss * (1.f / 1024.f) + EPS);
          const int row = wave * 8 + rr + q;
#pragma unroll
          for (int i = 0; i < 4; ++i) {
            const f32x4 h = xv[q][i] * rs * cm[i] + ca[i];
            u32x2 o; o[0] = pk2(h[0], h[1]); o[1] = pk2(h[2], h[3]);
            *(u32x2*)(hA + row * LDA + i * 256 + lane * 4) = o;
          }
        }
      }
    }
    __syncthreads();
    bf16x8 ring1[8][2];
    const bool has2 = (wave + 40) < 45;
    { const int tl0[2] = {wave, wave + 8}; gemm_pro<2, 8>(p.Wf_in, 64, tl0, lane, ring1); }
#pragma unroll 1
    for (int pass = 0; pass < 2; ++pass) {
      f32x16 acc[2][2];
#pragma unroll
      for (int t = 0; t < 2; ++t) { acc[t][0] = zero16(); acc[t][1] = zero16(); }
      const int tl[2] = {wave + 16 * pass, wave + 16 * pass + 8};
      gemm_main<2, 8, false, true>(hA, LDA, 64, p.Wf_in, 64, tl, acc, lane, ring1);
      { const int tn[2] = {wave + 16 * (pass + 1), (pass == 0 || has2) ? wave + 16 * (pass + 1) + 8 : wave + 32}; gemm_pro<2, 8>(p.Wf_in, 64, tn, lane, ring1); }
      int el_ = lane; asm volatile("" : "+v"(el_));
      const int l31 = el_ & 31, lh = el_ >> 5;
      u16* dstb[2];
#pragma unroll
      for (int t = 0; t < 2; ++t) { const int col = tl[t] * 32 + l31; dstb[t] = (col < 512) ? (p.xlru + col) : (p.gate + (col - 512)); }
#pragma unroll
      for (int rt = 0; rt < 2; ++rt)
#pragma unroll
        for (int r = 0; r < 16; ++r) {
          const size_t ro = (size_t)(tok0 + rt * 32 + crow(r, lh)) * 512;
#pragma unroll
          for (int t = 0; t < 2; ++t) dstb[t][ro] = f2bf(acc[t][rt][r]);
        }
    }
    {
      f32x16 acc[2][2];
#pragma unroll
      for (int t = 0; t < 2; ++t) { acc[t][0] = zero16(); acc[t][1] = zero16(); }
      const int tl[2] = {wave + 32, has2 ? wave + 40 : wave + 32};
      gemm_main<2, 8, false, true>(hA, LDA, 64, p.Wf_in, 64, tl, acc, lane, ring1);
      int el_ = lane; asm volatile("" : "+v"(el_));
      const int l31 = el_ & 31, lh = el_ >> 5;
      __syncthreads();
      u16* lat = hA;
#pragma unroll
      for (int t = 0; t < 2; ++t) {
        if (t == 1 && !has2) continue;
        const int lc = tl[t] * 32 - 1024 + l31;
        if (tl[t] < 44) {
          float sq[32];
#pragma unroll
          for (int rt = 0; rt < 2; ++rt)
#pragma unroll
            for (int r = 0; r < 16; ++r) { const float v = acc[t][rt][r]; sq[rt * 16 + r] = v * v; }
          const float tot = reduce32(sq, lane);
          __hip_atomic_fetch_add(&ssq[(tl[t] < 40 ? 0 : 64) + (l31 >> 4) * 32 + crow(l31 & 15, lh)], tot, __ATOMIC_RELAXED, __HIP_MEMORY_SCOPE_WORKGROUP);
        }
#pragma unroll
        for (int rt = 0; rt < 2; ++rt)
#pragma unroll
          for (int r = 0; r < 16; ++r) {
            const int row = rt * 32 + crow(r, lh);
            const float v = acc[t][rt][r];
            if (lc < 384) {
              lat[row * LDL + lc] = f2bf(v);
            } else {
              const float pv = lane_xor_f<16>(v, lane);
              const int j = lc - 384; const int jj = j & 15;
              const float co = cs[(row * 16 + jj) * 2], si = cs[(row * 16 + jj) * 2 + 1];
              const float o = (j < 16) ? (v * co - pv * si) : (v * co + pv * si);
              p.Kr[(size_t)(tok0 + row) * 32 + j] = f2bf(o);
            }
          }
      }
    }
    __syncthreads();
    {
      const u16* lat = hA;
      const float qscale = 0.10206207261596577f * 1.4426950408889634f;
      const int jj = l31 & 15;
#pragma unroll 1
      for (int pass = 0; pass < 2; ++pass) {
        f32x16 acc[2][2];
#pragma unroll
        for (int t = 0; t < 2; ++t) { acc[t][0] = zero16(); acc[t][1] = zero16(); }
        const int tl[2] = {pass == 0 ? wave : wave + 16, pass == 0 ? wave + 8 : wave + 16};
        gemm_core<2>(lat, LDL, 16, p.Wf_uq, 16, tl, acc, lane);
        int el_ = lane; asm volatile("" : "+v"(el_));
        const int l31 = el_ & 31, lh = el_ >> 5;
#pragma unroll
        for (int rt = 0; rt < 2; ++rt)
#pragma unroll
          for (int r = 0; r < 16; ++r) {
            const int row = rt * 32 + crow(r, lh);
            const float rs = rsqrtf(ssq[row] * (1.f / 256.f) + EPS) * qscale;
            const float co = cs[(row * 16 + jj) * 2], si = cs[(row * 16 + jj) * 2 + 1];
#pragma unroll
            for (int t = 0; t < 2; ++t) {
              if (t == 1 && pass == 1) continue;
              const int head = tl[t] / 3, part = tl[t] % 3;
              float v = acc[t][rt][r] * rs;
              if (part == 2) {
                const float pv = lane_xor_f<16>(v, lane);
                v = (l31 < 16) ? (v * co - pv * si) : (v * co + pv * si);
              }
              p.Q[((size_t)(b * 8 + head) * SEQ + s0 + row) * 96 + part * 32 + l31] = f2bf(v);
            }
          }
      }
#pragma unroll 1
      for (int pass = 0; pass < 2; ++pass) {
        f32x16 acc[2][2];
#pragma unroll
        for (int t = 0; t < 2; ++t) { acc[t][0] = zero16(); acc[t][1] = zero16(); }
        const int tl[2] = {wave + 16 * pass, wave + 16 * pass + 8};
        gemm_core<2>(lat + 256, LDL, 8, p.Wf_ukv, 8, tl, acc, lane);
        int el_ = lane; asm volatile("" : "+v"(el_));
        const int l31 = el_ & 31, lh = el_ >> 5;
#pragma unroll
        for (int rt = 0; rt < 2; ++rt)
#pragma unroll
          for (int g = 0; g < 4; ++g) {
            const int row = rt * 32 + 8 * g + 4 * lh;
            float rs4[4];
#pragma unroll
            for (int q = 0; q < 4; ++q) rs4[q] = rsqrtf(ssq[64 + row + q] * (1.f / 128.f) + EPS);
#pragma unroll
            for (int t = 0; t < 2; ++t) {
              const int head = tl[t] >> 2, sub = tl[t] & 3;
              float v4[4];
#pragma unroll
              for (int q = 0; q < 4; ++q) v4[q] = acc[t][rt][4 * g + q] * rs4[q];
              if (sub < 2) {
#pragma unroll
                for (int q = 0; q < 4; ++q) p.Kn[((size_t)(b * 8 + head) * SEQ + s0 + row + q) * 64 + sub * 32 + l31] = f2bf(v4[q]);
              } else {
                const int d = (sub - 2) * 32 + l31;
                u32x2 o; o[0] = pk2(v4[0], v4[1]); o[1] = pk2(v4[2], v4[3]);
                *(u32x2*)(p.Vt + ((size_t)(b * 8 + head) * 64 + d) * SEQ + s0 + row) = o;
              }
            }
          }
      }
    }
    __syncthreads();
  }
}

DI void lru_item(KP p, char* smem, int item) {
  const int tid = threadIdx.x, lane = tid & 63, wave = __builtin_amdgcn_readfirstlane(tid >> 6);
  const int l31 = lane & 31, lh = lane >> 5;
  const int b = item >> 3, cb = item & 7;
  const int c = lane; const int ch = cb * 64 + c; const int tg = wave;
  const float cw0 = p.conv_w[ch], cw1 = p.conv_w[512 + ch], cw2 = p.conv_w[1024 + ch], cw3 = p.conv_w[1536 + ch], cbias = p.conv_b[ch];
  const float ba = p.lru_ba[ch], bx = p.lru_bx[ch];
  const float sp = log1pf(__expf(-p.lru_lambda[ch]));
  float carry = 0.f;
  const u16* xl = p.xlru + (size_t)b * SEQ * 512 + ch;
  const u16* gt = p.gate + (size_t)b * SEQ * 512 + ch;
  u16* yo = p.y + (size_t)b * SEQ * 1024 + ch;
  const int mat = wave >> 2, rt = (wave >> 1) & 1, ct = wave & 1;
  const bf16x8* wf = (mat == 0 ? p.Wf_a : p.Wf_x) + cb * 512 + ct * 256 + lane;
  bf16x8 bw[4];
#pragma unroll
  for (int ks = 0; ks < 4; ++ks) bw[ks] = wf[ks * 64];
  constexpr int NCH = SEQ / 64;
  u16 xin_n[11], gv_n[8];
#pragma unroll
  for (int i = 0; i < 11; ++i) { const int t = tg * 8 - 3 + i; xin_n[i] = (t >= 0) ? xl[(size_t)t * 512] : (u16)0; }
#pragma unroll
  for (int i = 0; i < 8; ++i) gv_n[i] = gt[(size_t)(tg * 8 + i) * 512];
  float xcB[8], gvB[8], xcC[8], gvC[8], avD[8], bvD[8], gvD[8];
#pragma unroll
  for (int i = 0; i < 8; ++i) { xcB[i] = gvB[i] = xcC[i] = gvC[i] = avD[i] = bvD[i] = gvD[i] = 0.f; }
  __syncthreads();
#pragma unroll 1
  for (int it = 0; it < NCH + 3; ++it) {
    float xcA[8], gvA[8], avC[8], bvC[8];
    if (it < NCH) {
      const int t0 = it * 64 + tg * 8;
      float xin[11];
#pragma unroll
      for (int i = 0; i < 11; ++i) xin[i] = bf2f(xin_n[i]);
#pragma unroll
      for (int i = 0; i < 8; ++i) gvA[i] = bf2f(gv_n[i]);
      if (it + 1 < NCH) {
#pragma unroll
        for (int i = 0; i < 11; ++i) xin_n[i] = xl[(size_t)(t0 + 64 - 3 + i) * 512];
#pragma unroll
        for (int i = 0; i < 8; ++i) gv_n[i] = gt[(size_t)(t0 + 64 + i) * 512];
      }
      u16* xcb = (u16*)(smem + (it & 1) * 9216);
#pragma unroll
      for (int i = 0; i < 8; ++i) {
        xcA[i] = cbias + cw0 * xin[i] + cw1 * xin[i + 1] + cw2 * xin[i + 2] + cw3 * xin[i + 3];
        xcb[(tg * 8 + i) * 72 + c] = f2bf(xcA[i]);
      }
    } else {
#pragma unroll
      for (int i = 0; i < 8; ++i) { xcA[i] = 0.f; gvA[i] = 0.f; }
    }
    if (it >= 1 && it - 1 < NCH) {
      const u16* xcb = (const u16*)(smem + ((it - 1) & 1) * 9216);
      float* pm = (float*)(smem + 18432 + ((it - 1) & 1) * 33280) + mat * 4160;
      f32x16 acc = zero16();
      const bf16x8* ap = (const bf16x8*)(xcb + (rt * 32 + l31) * 72 + 8 * lh);
#pragma unroll
      for (int ks = 0; ks < 4; ++ks) acc = MFMA32(ap[2 * ks], bw[ks], acc);
#pragma unroll
      for (int r = 0; r < 16; ++r) pm[(rt * 32 + crow(r, lh)) * 65 + ct * 32 + l31] = acc[r];
    }
    if (it >= 2 && it - 2 < NCH) {
      const float* pre = (const float*)(smem + 18432 + ((it - 2) & 1) * 33280);
      float* seg = (float*)(smem + 84992 + ((it - 2) & 1) * 4096);
      float A = 1.f, Bc = 0.f;
#pragma unroll
      for (int i = 0; i < 8; ++i) {
        const int tl = tg * 8 + i;
        const float r = sigmoidf_(pre[tl * 65 + c] + ba);
        const float ig = sigmoidf_(pre[4160 + tl * 65 + c] + bx);
        const float log_a = -8.f * r * sp;
        const float a = __builtin_amdgcn_exp2f(1.4426950408889634f * log_a);
        const float z = 2.f * log_a;
        const float om = (z > -0.25f) ? one_minus_exp_small(z) : -expm1f(z);
        const float m = __builtin_amdgcn_sqrtf(om);
        avC[i] = a; bvC[i] = m * ig * xcC[i];
        A *= a; Bc = a * Bc + bvC[i];
      }
      seg[(tg * 64 + c) * 2] = A; seg[(tg * 64 + c) * 2 + 1] = Bc;
    } else {
#pragma unroll
      for (int i = 0; i < 8; ++i) { avC[i] = 0.f; bvC[i] = 0.f; }
    }
    if (it >= 3) {
      const int t0 = (it - 3) * 64 + tg * 8;
      const float* seg = (const float*)(smem + 84992 + ((it - 3) & 1) * 4096);
      float h = carry, hin = 0.f;
#pragma unroll
      for (int s2 = 0; s2 < 8; ++s2) {
        if (s2 == tg) hin = h;
        h = seg[(s2 * 64 + c) * 2] * h + seg[(s2 * 64 + c) * 2 + 1];
      }
      carry = h;
      h = hin;
      float sq[8];
#pragma unroll
      for (int i = 0; i < 8; ++i) {
        h = avD[i] * h + bvD[i];
        const float yv = gelu_tanh(gvD[i]) * h;
        yo[(size_t)(t0 + i) * 1024] = f2bf(yv);
        sq[i] = yv * yv;
      }
      const float tot = reduce8(sq, lane);
      if ((lane & 7) == 0) unsafeAtomicAdd(p.ssq_lru + (size_t)b * SEQ + t0 + (lane >> 3), tot);
    }
#pragma unroll
    for (int i = 0; i < 8; ++i) {
      avD[i] = avC[i]; bvD[i] = bvC[i]; gvD[i] = gvC[i];
      xcC[i] = xcB[i]; gvC[i] = gvB[i];
      xcB[i] = xcA[i]; gvB[i] = gvA[i];
    }
    __syncthreads();
  }
}

DI void attn_unit(KP p, char* smem, int b, int hd, int qb) {
  const int tid = threadIdx.x, lane = tid & 63, wave = __builtin_amdgcn_readfirstlane(tid >> 6);
  const int l31 = lane & 31, lh = lane >> 5;
  const int q0 = qb * 256 + wave * 32;
  const size_t bh = (size_t)(b * 8 + hd);
  const int nkt = qb * 4 + 4;
  const int qidx = q0 + l31;
  const int skey = tid >> 3, schn = tid & 7;
  const int rkey = (tid & 255) >> 2, rchn = tid & 3;
  const u16* kn_src = p.Kn + (bh * SEQ + skey) * 64 + schn * 8;
  const u16* kr_src = p.Kr + ((size_t)b * SEQ + rkey) * 32 + rchn * 8;
  const u16* vt_src = p.Vt + (bh * 64 + skey) * SEQ + schn * 8;
  u32x4 rk, rr, rv;
  rk = *(const u32x4*)(kn_src); rv = *(const u32x4*)(vt_src);
  if (tid < 256) rr = *(const u32x4*)(kr_src);
  bf16x8 qf[6];
  {
    const bf16x8* qp = (const bf16x8*)(p.Q + (bh * SEQ + q0 + l31) * 96 + 8 * lh);
#pragma unroll
    for (int ks = 0; ks < 6; ++ks) qf[ks] = qp[2 * ks];
  }
  __syncthreads();
  {
    u16* Kl = (u16*)smem; u16* Vl = (u16*)(smem + 13312);
    *(u32x4*)(Kl + skey * 104 + schn * 8) = rk;
    if (tid < 256) *(u32x4*)(Kl + rkey * 104 + 64 + rchn * 8) = rr;
    *(u32x4*)(Vl + skey * 72 + schn * 8) = rv;
  }
  __syncthreads();
  f32x16 o0 = zero16(), o1 = zero16();
  float m_run = -1e30f, l_run = 0.f;
  for (int kt = 0; kt < nkt; ++kt) {
    const u16* Kl = (const u16*)(smem + (kt & 1) * 22528);
    const u16* Vl = (const u16*)(smem + (kt & 1) * 22528 + 13312);
    const bool more = (kt + 1) < nkt;
    if (more) {
      rk = *(const u32x4*)(kn_src + (size_t)(kt + 1) * 64 * 64);
      rv = *(const u32x4*)(vt_src + (kt + 1) * 64);
      if (tid < 256) rr = *(const u32x4*)(kr_src + (size_t)(kt + 1) * 64 * 32);
    }
    if (kt * 64 <= q0 + 31) {
      f32x16 s[2];
      bf16x8 kfr[2][6];
#pragma unroll
      for (int st = 0; st < 2; ++st) {
        const bf16x8* kp = (const bf16x8*)(Kl + (st * 32 + l31) * 104 + 8 * lh);
#pragma unroll
        for (int ks = 0; ks < 6; ++ks) kfr[st][ks] = kp[2 * ks];
      }
#pragma unroll
      for (int st = 0; st < 2; ++st) {
        s[st] = zero16();
#pragma unroll
        for (int ks = 0; ks < 6; ++ks) s[st] = MFMA32(kfr[st][ks], qf[ks], s[st]);
      }
      u32x2 vfr[2][4][2];
#pragma unroll
      for (int dt = 0; dt < 2; ++dt)
#pragma unroll
        for (int c4 = 0; c4 < 4; ++c4) {
          const int kbase = c4 * 16 + 4 * lh;
          vfr[dt][c4][0] = *(const u32x2*)(Vl + (dt * 32 + l31) * 72 + kbase);
          vfr[dt][c4][1] = *(const u32x2*)(Vl + (dt * 32 + l31) * 72 + kbase + 8);
        }
      if (kt * 64 + 63 > q0) {
#pragma unroll
        for (int st = 0; st < 2; ++st)
#pragma unroll
          for (int r = 0; r < 16; ++r) { const int key = kt * 64 + st * 32 + crow(r, lh); if (key > qidx) s[st][r] = -1e30f; }
      }
      float mloc = s[0][0];
#pragma unroll
      for (int st = 0; st < 2; ++st)
#pragma unroll
        for (int r = 0; r < 16; ++r) mloc = fmaxf(mloc, s[st][r]);
      mloc = max_xor32(mloc);
      const float m_new = fmaxf(m_run, mloc);
      const float alpha = __builtin_amdgcn_exp2f(m_run - m_new);
      m_run = m_new;
      float lsum = 0.f;
#pragma unroll
      for (int st = 0; st < 2; ++st)
#pragma unroll
        for (int r = 0; r < 16; ++r) { const float e = __builtin_amdgcn_exp2f(s[st][r] - m_new); s[st][r] = e; lsum += e; }
      l_run = l_run * alpha + lsum;
#pragma unroll
      for (int r = 0; r < 16; ++r) { o0[r] *= alpha; o1[r] *= alpha; }
#pragma unroll
      for (int st = 0; st < 2; ++st)
#pragma unroll
        for (int s2 = 0; s2 < 2; ++s2) {
          u32x4 pw;
#pragma unroll
          for (int j = 0; j < 4; ++j) pw[j] = pk2(s[st][8 * s2 + 2 * j], s[st][8 * s2 + 2 * j + 1]);
          const bf16x8 pf = __builtin_bit_cast(bf16x8, pw);
          const int c4 = st * 2 + s2;
          {
            u32x4 vv; vv[0] = vfr[0][c4][0][0]; vv[1] = vfr[0][c4][0][1]; vv[2] = vfr[0][c4][1][0]; vv[3] = vfr[0][c4][1][1];
            o0 = MFMA32(__builtin_bit_cast(bf16x8, vv), pf, o0);
          }
          {
            u32x4 vv; vv[0] = vfr[1][c4][0][0]; vv[1] = vfr[1][c4][0][1]; vv[2] = vfr[1][c4][1][0]; vv[3] = vfr[1][c4][1][1];
            o1 = MFMA32(__builtin_bit_cast(bf16x8, vv), pf, o1);
          }
        }
    }
    if (more) {
      u16* Kn2 = (u16*)(smem + ((kt + 1) & 1) * 22528); u16* Vn2 = (u16*)(smem + ((kt + 1) & 1) * 22528 + 13312);
      *(u32x4*)(Kn2 + skey * 104 + schn * 8) = rk;
      if (tid < 256) *(u32x4*)(Kn2 + rkey * 104 + 64 + rchn * 8) = rr;
      *(u32x4*)(Vn2 + skey * 72 + schn * 8) = rv;
    }
    __syncthreads();
  }
  const float ltot = sum_xor32(l_run);
  const float inv = 1.f / ltot;
  float ss = 0.f;
  u16* yrow = p.y + ((size_t)b * SEQ + qidx) * 1024 + 512 + hd * 64;
#pragma unroll
  for (int g = 0; g < 4; ++g) {
    float v0[4], v1[4];
#pragma unroll
    for (int q = 0; q < 4; ++q) { v0[q] = o0[4 * g + q] * inv; v1[q] = o1[4 * g + q] * inv; ss += v0[q] * v0[q] + v1[q] * v1[q]; }
    u32x2 a; a[0] = pk2(v0[0], v0[1]); a[1] = pk2(v0[2], v0[3]);
    u32x2 c2; c2[0] = pk2(v1[0], v1[1]); c2[1] = pk2(v1[2], v1[3]);
    *(u32x2*)(yrow + 8 * g + 4 * lh) = a;
    *(u32x2*)(yrow + 32 + 8 * g + 4 * lh) = c2;
  }
  ss = sum_xor32(ss);
  if (lh == 0) unsafeAtomicAdd(p.ssq_mla + (size_t)b * SEQ + qidx, ss);
}

DI void phase2(KP p, char* smem) {
  for (int item = blockIdx.x; item < 256; item += gridDim.x) lru_item(p, smem, item);
  for (int it = blockIdx.x; it < 1024; it += gridDim.x) {
    const int j = it & 3; const int bh = it >> 2; const int hd = bh & 7; const int b = bh >> 3;
    attn_unit(p, smem, b, hd, 7 - j);
    attn_unit(p, smem, b, hd, j);
  }
}

DI void sort128_asc(unsigned& k0, unsigned& k1, int lane) {
#pragma unroll
  for (int k = 2; k <= 128; k <<= 1) {
#pragma unroll
    for (int j = k >> 1; j > 0; j >>= 1) {
      if (j == 64) {
        const unsigned lo = k0 < k1 ? k0 : k1, hi = k0 < k1 ? k1 : k0; k0 = lo; k1 = hi;
      } else {
        const unsigned o0 = (j == 1) ? lane_xor_u<1>(k0, lane) : (j == 2) ? lane_xor_u<2>(k0, lane) : (j == 4) ? lane_xor_u<4>(k0, lane) : (j == 8) ? lane_xor_u<8>(k0, lane) : (j == 16) ? lane_xor_u<16>(k0, lane) : lane_xor_u<32>(k0, lane);
        const unsigned o1 = (j == 1) ? lane_xor_u<1>(k1, lane) : (j == 2) ? lane_xor_u<2>(k1, lane) : (j == 4) ? lane_xor_u<4>(k1, lane) : (j == 8) ? lane_xor_u<8>(k1, lane) : (j == 16) ? lane_xor_u<16>(k1, lane) : lane_xor_u<32>(k1, lane);
        const bool lower = (lane & j) == 0;
        const bool asc0 = (k == 128) ? true : ((lane & k) == 0);
        const bool asc1 = (k == 128) ? true : (k == 64 ? false : ((lane & k) == 0));
        const unsigned mn0 = k0 < o0 ? k0 : o0, mx0 = k0 < o0 ? o0 : k0;
        const unsigned mn1 = k1 < o1 ? k1 : o1, mx1 = k1 < o1 ? o1 : k1;
        k0 = (asc0 == lower) ? mn0 : mx0;
        k1 = (asc1 == lower) ? mn1 : mx1;
      }
    }
  }
}
#if QBITS == 8
typedef u32x4 qrow_t;
#else
typedef u32x2 qrow_t;
#endif
constexpr int QROWB = (QBITS == 8) ? 1024 : 512;
DI void ga_load(__amdgpu_buffer_rsrc_t rs, int iv, int gl, int voff_u, int voff_v, qrow_t (&uq)[8], qrow_t (&vq)[8]) {
#pragma unroll
  for (int k = 0; k < 8; ++k) {
    const int so = __builtin_amdgcn_readlane(iv, gl + k);
#if QBITS == 8
    uq[k] = __builtin_amdgcn_raw_buffer_load_b128(rs, voff_u, so, 0);
    vq[k] = __builtin_amdgcn_raw_buffer_load_b128(rs, voff_v, so, 0);
#else
    const u32x4 rec = __builtin_amdgcn_raw_buffer_load_b128(rs, voff_u, so, 16);
    uq[k] = (u32x2){rec[0], rec[1]}; vq[k] = (u32x2){rec[2], rec[3]};
#endif
  }
}
DI unsigned qword(const qrow_t& r, int j) {
#if QBITS == 8
  return r[j];
#else
  const unsigned w0 = r[j >> 1];
  return (j & 1) ? ((w0 >> 4) & 0x0f0f0f0fu) : (w0 & 0x0f0f0f0fu);
#endif
}
#if QBITS == 8
typedef f32x2 oacc_t;
constexpr float OACC_SCALE = 1.f;
#else
typedef h16x2 oacc_t;
constexpr float OACC_SCALE = 16.f;
#endif
DI void ga_compute(float gsel, float asel, float bsel, int gl, int lane, float kt, float hscale, const unsigned (&hq)[4],
                   const qrow_t (&uq)[8], const qrow_t (&vq)[8], oacc_t (&oacc)[8], float& csum) {
  const float mg = __shfl(gsel, gl + (lane >> 3));
  const float ma = __shfl(asel, gl + (lane >> 3));
  const float mb = __shfl(bsel, gl + (lane >> 3));
  float pp[8];
#pragma unroll
  for (int k = 0; k < 8; ++k) {
#if QBITS == 8
    unsigned d = 0;
#pragma unroll
    for (int j = 0; j < 4; ++j) d = __builtin_amdgcn_udot4(qword(uq[k], j), hq[j], d, false);
#else
    unsigned dh = __builtin_amdgcn_udot8(uq[k][0], hq[0], 0u, false); dh = __builtin_amdgcn_udot8(uq[k][1], hq[1], dh, false);
    unsigned dl = __builtin_amdgcn_udot8(uq[k][0], hq[2], 0u, false); dl = __builtin_amdgcn_udot8(uq[k][1], hq[3], dl, false);
    const unsigned d = dh * 16u + dl;
#endif
    pp[k] = (float)d;
  }
  const float s1 = reduce8(pp, lane);
  const float pre = hscale * (ma * (s1 - kt) - mb);
  const float cf = mg * gelu_tanh(pre);
  csum += cf;
#if QBITS != 8
  const _Float16 cfs = (_Float16)(cf * OACC_SCALE);
  const unsigned cfp = __builtin_bit_cast(unsigned, (h16x2){cfs, cfs});
#endif
#pragma unroll
  for (int k = 0; k < 8; ++k) {
#if QBITS == 8
    const float c = __uint_as_float(__builtin_amdgcn_readlane(__float_as_uint(cf), 8 * k));
    const f32x2 cc = {c, c};
#pragma unroll
    for (int j = 0; j < 4; ++j) {
      unsigned w = qword(vq[k], j);
      asm volatile("" : "+v"(w));
      const f32x2 v0 = {(float)(w & 255u), (float)((w >> 8) & 255u)}, v1 = {(float)((w >> 16) & 255u), (float)(w >> 24)};
      oacc[2 * j] = v0 * cc + oacc[2 * j];
      oacc[2 * j + 1] = v1 * cc + oacc[2 * j + 1];
    }
#else
    const h16x2 cc = __builtin_bit_cast(h16x2, (unsigned)__builtin_amdgcn_readlane((int)cfp, 8 * k));
#pragma unroll
    for (int jd = 0; jd < 2; ++jd) {
      const unsigned w = vq[k][jd];
      oacc[4 * jd + 0] = __builtin_amdgcn_cvt_scalef32_pk_f16_fp4(w, 1.0f, 0) * cc + oacc[4 * jd + 0];
      oacc[4 * jd + 1] = __builtin_amdgcn_cvt_scalef32_pk_f16_fp4(w, 1.0f, 1) * cc + oacc[4 * jd + 1];
      oacc[4 * jd + 2] = __builtin_amdgcn_cvt_scalef32_pk_f16_fp4(w, 1.0f, 2) * cc + oacc[4 * jd + 2];
      oacc[4 * jd + 3] = __builtin_amdgcn_cvt_scalef32_pk_f16_fp4(w, 1.0f, 3) * cc + oacc[4 * jd + 3];
    }
#endif
  }
}

DI void ins16(float (&lst)[16], float x, const int P) {
#pragma unroll
  for (int i = 0; i < 16; ++i) if (i >= P) { const float hi = fmaxf(lst[i], x); x = fminf(lst[i], x); lst[i] = hi; }
}
DI void ce_desc(float& a, float& b) { const float hi = fmaxf(a, b), lo = fminf(a, b); a = hi; b = lo; }
DI void sort16_desc(float (&a)[16]) {
#define CE_(i, j) ce_desc(a[i], a[j]);
  CE_(0, 13) CE_(1, 12) CE_(2, 15) CE_(3, 14) CE_(4, 8) CE_(5, 6) CE_(7, 11) CE_(9, 10)
  CE_(0, 5) CE_(1, 7) CE_(2, 9) CE_(3, 4) CE_(6, 13) CE_(8, 14) CE_(10, 15) CE_(11, 12)
  CE_(0, 1) CE_(2, 3) CE_(4, 5) CE_(6, 8) CE_(7, 9) CE_(10, 11) CE_(12, 13) CE_(14, 15)
  CE_(0, 2) CE_(1, 3) CE_(4, 10) CE_(5, 11) CE_(6, 7) CE_(8, 9) CE_(12, 14) CE_(13, 15)
  CE_(1, 2) CE_(3, 12) CE_(4, 6) CE_(5, 7) CE_(8, 10) CE_(9, 11) CE_(13, 14)
  CE_(1, 4) CE_(2, 6) CE_(5, 8) CE_(7, 10) CE_(9, 13) CE_(11, 14)
  CE_(2, 4) CE_(3, 6) CE_(9, 12) CE_(11, 13)
  CE_(3, 5) CE_(6, 8) CE_(7, 9) CE_(10, 12)
  CE_(3, 4) CE_(5, 6) CE_(7, 8) CE_(9, 10) CE_(11, 12)
  CE_(6, 7) CE_(8, 9)
#undef CE_
}
DI void merge16_desc(float (&x)[16], const float (&y)[16]) {
#pragma unroll
  for (int i = 0; i < 16; ++i) x[i] = fmaxf(x[i], y[15 - i]);
#pragma unroll
  for (int d = 8; d >= 1; d >>= 1)
#pragma unroll
    for (int i = 0; i < 16; ++i)
      if ((i & d) == 0) ce_desc(x[i], x[i + d]);
}
DI void merge_partner(float (&lst)[16], int lane) {
  float o[16];
#pragma unroll
  for (int i = 0; i < 16; ++i) o[i] = other_xor32(lst[i], lane);
  float c[16];
#pragma unroll
  for (int i = 0; i < 16; ++i) c[i] = fmaxf(lst[i], o[15 - i]);
#pragma unroll
  for (int d = 8; d >= 1; d >>= 1) {
#pragma unroll
    for (int i = 0; i < 16; ++i) {
      if ((i & d) == 0) { const float hi = fmaxf(c[i], c[i + d]), lo = fminf(c[i], c[i + d]); c[i] = hi; c[i + d] = lo; }
    }
  }
#pragma unroll
  for (int i = 0; i < 16; ++i) lst[i] = c[i];
}

DI void phase3(KP p, char* smem) {
  const int tid = threadIdx.x, wave = __builtin_amdgcn_readfirstlane(tid >> 6);
  u16* A = (u16*)smem;
  float* ssq2 = (float*)(smem + 146944);
  signed char* A8 = (signed char*)smem;
  float* hs = (float*)(smem + 146944 + 256);
  constexpr int ELD = 132;
  int* eidx = (int*)(smem + 66560);
  float* egate = (float*)(smem + 100352);
  float* ys = (float*)(smem + 134144);
  char* scr = p.scratch + (size_t)blockIdx.x * 655360;
  float* x1s = (float*)scr;
  u16* qp = (u16*)(scr + 262144);
  for (int tile = blockIdx.x; tile < NTOK / 64; tile += gridDim.x) {
    int lane_o = tid & 63; asm volatile("" : "+v"(lane_o));
    const int lane = lane_o, l31 = lane & 31, lh = lane >> 5;
    const int tok0 = tile * 64; const int b = tok0 / SEQ;
    const float* modb = p.mod + (size_t)b * 6144;
    if (tid < 64) ssq2[tid] = 0.f;
#pragma unroll 2
    for (int rr = 0; rr < 8; ++rr) {
      const int row = wave * 8 + rr; const int tok = tok0 + row;
      const float rl = rsqrtf(p.ssq_lru[tok] * (1.f / 512.f) + EPS), rm = rsqrtf(p.ssq_mla[tok] * (1.f / 512.f) + EPS);
      float yv[2][8]; float ymax = 0.f;
#pragma unroll
      for (int i = 0; i < 2; ++i) {
        const u32x4 v = *(const u32x4*)(p.y + (size_t)tok * 1024 + (i * 64 + lane) * 8);
        const float sc = i == 0 ? rl : rm;
#pragma unroll
        for (int j = 0; j < 4; ++j) { yv[i][2 * j] = bflo(v[j]) * sc; yv[i][2 * j + 1] = bfhi(v[j]) * sc; ymax = fmaxf(ymax, fmaxf(fabsf(yv[i][2 * j]), fabsf(yv[i][2 * j + 1]))); }
      }
      ymax = wave_max(ymax);
      const float yinv = ymax > 0.f ? 127.f / ymax : 0.f;
#pragma unroll
      for (int i = 0; i < 2; ++i) {
        u32x2 o;
#pragma unroll
        for (int hh = 0; hh < 2; ++hh) {
          unsigned w = 0;
#pragma unroll
          for (int j = 0; j < 4; ++j) w |= ((unsigned)(int)__builtin_rintf(yv[i][4 * hh + j] * yinv) & 255u) << (8 * j);
          o[hh] = w;
        }
        *(u32x2*)(A8 + row * LDA8 + (i * 64 + lane) * 8) = o;
      }
      if (lane == 0) ys[row] = ymax * (1.f / 127.f);
    }
    __syncthreads();
    float sqa[32];
#pragma unroll
    for (int i = 0; i < 32; ++i) sqa[i] = 0.f;
    i32x4 ring3[4][2];
    { const int tl0[2] = {wave, wave + 8}; gemm8_pro<2, 4>(p.Wf_out8, 32, tl0, lane, ring3); }
#pragma unroll 1
    for (int pass = 0; pass < 2; ++pass) {
      i32x16 acc[2][2];
#pragma unroll
      for (int t = 0; t < 2; ++t)
#pragma unroll
        for (int r = 0; r < 16; ++r) { acc[t][0][r] = 0; acc[t][1][r] = 0; }
      const int tl[2] = {pass * 16 + wave, pass * 16 + wave + 8};
      gemm8_main<2, 4, false>(A8, LDA8, 32, p.Wf_out8, 32, tl, acc, lane, ring3);
      if (pass == 0) { const int tn[2] = {16 + wave, 16 + wave + 8}; gemm8_pro<2, 4>(p.Wf_out8, 32, tn, lane, ring3); }
      int el_ = lane; asm volatile("" : "+v"(el_));
      const int l31 = el_ & 31, lh = el_ >> 5;
      float g1[2];
#pragma unroll
      for (int t = 0; t < 2; ++t) g1[t] = modb[2048 + tl[t] * 32 + l31] * p.wosc[tl[t] * 32 + l31];
#pragma unroll
      for (int rt = 0; rt < 2; ++rt)
#pragma unroll
        for (int r = 0; r < 16; ++r) {
          const int row = rt * 32 + crow(r, lh);
          const float ysr = ys[row];
#pragma unroll
          for (int t = 0; t < 2; ++t) {
            const int col = tl[t] * 32 + l31;
            const float v = p.x[(size_t)(tok0 + row) * DM + col] + g1[t] * ysr * (float)acc[t][rt][r];
            x1s[row * 1024 + col] = v;
            sqa[rt * 16 + r] += v * v;
          }
        }
    }
    {
      const float tot = reduce32(sqa, lane);
      const int l31 = lane & 31, lh = lane >> 5;
      __hip_atomic_fetch_add(&ssq2[(l31 >> 4) * 32 + crow(l31 & 15, lh)], tot, __ATOMIC_RELAXED, __HIP_MEMORY_SCOPE_WORKGROUP);
    }
    __syncthreads();
    {
      f32x4 cm[4], ca[4];
#pragma unroll
      for (int i = 0; i < 4; ++i) {
        const int col = (i >> 1) * 512 + lane * 8 + (i & 1) * 4;
        const f32x4 g = *(const f32x4*)(p.norm2_g + col); const f32x4 sc = *(const f32x4*)(modb + 4096 + col);
        cm[i] = g * (sc + 1.0f); ca[i] = *(const f32x4*)(modb + 3072 + col);
      }
#pragma unroll 2
      for (int rr = 0; rr < 8; ++rr) {
        const int row = wave * 8 + rr;
        const float rs = rsqrtf(ssq2[row] * (1.f / 1024.f) + EPS);
        f32x4 hv[4];
        float hmax = 0.f;
#pragma unroll
        for (int i = 0; i < 2; ++i) {
          const f32x4 xa = *(const f32x4*)(x1s + row * 1024 + i * 512 + lane * 8), xb = *(const f32x4*)(x1s + row * 1024 + i * 512 + lane * 8 + 4);
          hv[2 * i] = xa * rs * cm[2 * i] + ca[2 * i]; hv[2 * i + 1] = xb * rs * cm[2 * i + 1] + ca[2 * i + 1];
#pragma unroll
          for (int j = 0; j < 4; ++j) hmax = fmaxf(hmax, fmaxf(fabsf(hv[2 * i][j]), fabsf(hv[2 * i + 1][j])));
        }
        hmax = wave_max(hmax);
        const float hinv = hmax > 0.f ? 127.f / hmax : 0.f;
#pragma unroll
        for (int i = 0; i < 2; ++i) {
          u32x2 o;
#pragma unroll
          for (int hh = 0; hh < 2; ++hh) {
            unsigned w = 0;
#pragma unroll
            for (int j = 0; j < 4; ++j) w |= ((unsigned)(int)__builtin_rintf(hv[2 * i + hh][j] * hinv) & 255u) << (8 * j);
            o[hh] = w;
          }
          *(u32x2*)(A8 + row * LDA8 + i * 512 + lane * 8) = o;
        }
        if (lane == 0) hs[row] = hmax * (1.f / 127.f);
      }
    }
    __syncthreads();
    float s12[2][16];
    i32x4 ring8[8][2];
    { const int t0[2] = {wave * 8, wave * 8 + 1}; gemm8_pro<2, 8>(p.Wf_s, 32, t0, lane, ring8); }
#pragma unroll 1
    for (int ph = 0; ph < 2; ++ph) {
      const int hd = wave;
      float lst0[16], lst1[16];
#pragma unroll
      for (int i = 0; i < 16; ++i) { lst0[i] = -3.0e38f; lst1[i] = -3.0e38f; }
#pragma unroll 1
      for (int mtp = 0; mtp < 2; ++mtp) {
        i32x16 acc[2][2];
#pragma unroll
        for (int t = 0; t < 2; ++t)
#pragma unroll
          for (int r = 0; r < 16; ++r) { acc[t][0][r] = 0; acc[t][1][r] = 0; }
        const int tl[2] = {(hd * 2 + ph) * 4 + 2 * mtp, (hd * 2 + ph) * 4 + 2 * mtp + 1};
        gemm8_main<2, 8>(A8, LDA8, 32, p.Wf_s, 32, tl, acc, lane, ring8);
        if (ph * 2 + mtp < 3) { const int pn = ph * 2 + mtp + 1; const int tn[2] = {wave * 8 + 2 * pn, wave * 8 + 2 * pn + 1}; gemm8_pro<2, 8>(p.Wf_s, 32, tn, lane, ring8); }
        int el_ = lane; asm volatile("" : "+v"(el_));
        const int lh = el_ >> 5;
#pragma unroll
        for (int t = 0; t < 2; ++t) {
          f32x4 w4[4];
#pragma unroll
          for (int g = 0; g < 4; ++g) w4[g] = *(const f32x4*)(p.wsc + tl[t] * 32 + 8 * g + 4 * lh);
          float nv[16];
#pragma unroll
          for (int r = 0; r < 16; ++r) nv[r] = __uint_as_float((__float_as_uint((float)acc[t][0][r] * w4[r >> 2][r & 3]) & 0xffffff80u) | (unsigned)((2 * mtp + t) * 32 + crow(r, lh)));
          sort16_desc(nv);
          if (t == 0 && mtp == 0) {
#pragma unroll
            for (int r = 0; r < 16; ++r) lst0[r] = nv[r];
          } else merge16_desc(lst0, nv);
#pragma unroll
          for (int r = 0; r < 16; ++r) nv[r] = __uint_as_float((__float_as_uint((float)acc[t][1][r] * w4[r >> 2][r & 3]) & 0xffffff80u) | (unsigned)((2 * mtp + t) * 32 + crow(r, lh)));
          sort16_desc(nv);
          if (t == 0 && mtp == 0) {
#pragma unroll
            for (int r = 0; r < 16; ++r) lst1[r] = nv[r];
          } else merge16_desc(lst1, nv);
        }
      }
      merge_partner(lst0, lane);
      merge_partner(lst1, lane);
      if (ph == 0) {
#pragma unroll
        for (int i = 0; i < 16; ++i) s12[0][i] = lh ? lst1[i] : lst0[i];
      } else {
#pragma unroll
        for (int i = 0; i < 16; ++i) s12[1][i] = lh ? lst1[i] : lst0[i];
      }
    }
    {
      const int hd = wave;
      unsigned long long t1lo = 0, t1hi = 0, t2lo = 0, t2hi = 0;
#pragma unroll
      for (int i = 0; i < 8; ++i) {
        t1lo |= (unsigned long long)(__float_as_uint(s12[0][i]) & 127u) << (8 * i);
        t1hi |= (unsigned long long)(__float_as_uint(s12[0][8 + i]) & 127u) << (8 * i);
        t2lo |= (unsigned long long)(__float_as_uint(s12[1][i]) & 127u) << (8 * i);
        t2hi |= (unsigned long long)(__float_as_uint(s12[1][8 + i]) & 127u) << (8 * i);
      }
      const float hst = hs[lh * 32 + l31];
      float bv[16];
#pragma unroll
      for (int j = 0; j < 16; ++j) {
        const float sv = (s12[0][0] + s12[1][j]) * hst;
        bv[j] = __uint_as_float((__float_as_uint(sv) & 0xffffff00u) | (unsigned)j);
      }
#pragma unroll
      for (int i = 1; i < 16; ++i) {
#pragma unroll
        for (int j = 0; j < 16; ++j)
          if ((i + 1) * (j + 1) <= 16) {
            const float sv = (s12[0][i] + s12[1][j]) * hst;
            ins16(bv, __uint_as_float((__float_as_uint(sv) & 0xffffff00u) | (unsigned)(i * 16 + j)), (i + 1) * (j + 1) - 1);
          }
      }
      int bi[16];
#pragma unroll
      for (int k = 0; k < 16; ++k) {
        const unsigned code = __float_as_uint(bv[k]) & 255u;
        const unsigned ci = code >> 4, cj = code & 15u;
        const unsigned long long w1 = (ci & 8u) ? t1hi : t1lo, w2 = (cj & 8u) ? t2hi : t2lo;
        const unsigned i1 = (unsigned)(w1 >> ((ci & 7u) * 8)) & 0xffu, i2 = (unsigned)(w2 >> ((cj & 7u) * 8)) & 0xffu;
        bi[k] = (int)(i1 * 128u + i2);
      }
      float esum = 0.f, ev[16];
#pragma unroll
      for (int i = 0; i < 16; ++i) { ev[i] = __expf(bv[i] - bv[0]); esum += ev[i]; }
      const float einv = 1.f / esum;
      {
        const int row = lh * 32 + l31;
#pragma unroll
        for (int i4 = 0; i4 < 4; ++i4) {
          *(i32x4*)(eidx + row * ELD + hd * 16 + i4 * 4) = (i32x4){bi[i4 * 4], bi[i4 * 4 + 1], bi[i4 * 4 + 2], bi[i4 * 4 + 3]};
          *(f32x4*)(egate + row * ELD + hd * 16 + i4 * 4) = (f32x4){ev[i4 * 4] * einv, ev[i4 * 4 + 1] * einv, ev[i4 * 4 + 2] * einv, ev[i4 * 4 + 3] * einv};
        }
      }
    }
    __syncthreads();
    const __amdgpu_buffer_rsrc_t qrs = __builtin_amdgcn_make_buffer_rsrc((void*)p.Uq, 0, 2 * 16384 * QROWB, 0x00020000);
    const int voff_u = (QBITS == 8) ? lane * 16 : lane * 16, voff_v = voff_u + 16384 * QROWB;
    int n_ia, n_ib; float n_ga, n_gb, n_ua, n_ub, n_ba, n_bb, n_kt, n_hscale; unsigned n_hq[4];
    qrow_t bufA_u[8], bufA_v[8], bufB_u[8], bufB_v[8];
#define GA_PREP(ROW)                                                                                                              \
    {                                                                                                                             \
      const int prow = (ROW);                                                                                                     \
      n_ia = eidx[prow * ELD + lane]; n_ib = eidx[prow * ELD + 64 + lane];                                                        \
      n_ga = egate[prow * ELD + lane]; n_gb = egate[prow * ELD + 64 + lane];                                                      \
      {     \
        unsigned k0 = ((unsigned)n_ia << 7) | (unsigned)lane, k1 = ((unsigned)n_ib << 7) | (unsigned)(64 + lane);                 \
        sort128_asc(k0, k1, lane);                                                                                                \
        const int p0 = (int)(k0 & 127u), p1 = (int)(k1 & 127u);                                                                   \
        const f32x4 sa = ((const f32x4*)p.uscale)[k0 >> 7], sb = ((const f32x4*)p.uscale)[k1 >> 7];        \
        const float ga0 = __shfl(n_ga, p0 & 63), gb0 = __shfl(n_gb, p0 & 63), ga1 = __shfl(n_ga, p1 & 63), gb1 = __shfl(n_gb, p1 & 63); \
        n_ia = (int)(k0 >> 7) * (QBITS == 8 ? QROWB : 2 * QROWB); n_ib = (int)(k1 >> 7) * (QBITS == 8 ? QROWB : 2 * QROWB);       \
        n_ga = ((p0 & 64) ? gb0 : ga0) * sa[1]; n_gb = ((p1 & 64) ? gb1 : ga1) * sb[1];                                           \
        n_ua = sa[0]; n_ub = sb[0]; n_ba = sa[2]; n_bb = sb[2];                                                                   \
      }                                                                                                                           \
      u32x4 hc = *(const u32x4*)(A8 + prow * LDA8 + lane * 16);        \
      _Pragma("unroll") for (int j = 0; j < 4; ++j) hc[j] ^= 0x80808080u;                                                         \
      n_hscale = hs[prow];                                                                                                        \
      unsigned hsi = 0;                                                                                                           \
      _Pragma("unroll") for (int j = 0; j < 4; ++j) hsi = __builtin_amdgcn_udot4(hc[j], 0x01010101u, hsi, false);                 \
      const float hsum = (float)hsi;                                                                                              \
      if (QBITS == 8) {                                                                                                           \
        _Pragma("unroll") for (int j = 0; j < 4; ++j) n_hq[j] = hc[j];                                                            \
      } else {               \
        _Pragma("unroll") for (int jd = 0; jd < 2; ++jd) {                                                                        \
          n_hq[jd] = ((hc[2 * jd] >> 4) & 0x0f0f0f0fu) | (hc[2 * jd + 1] & 0xf0f0f0f0u);                                          \
          n_hq[2 + jd] = (hc[2 * jd] & 0x0f0f0f0fu) | ((hc[2 * jd + 1] & 0x0f0f0f0fu) << 4);                                      \
        }                                                                                                                         \
      }                                                                                                                           \
      n_kt = (QBITS == 8 ? 128.f : 7.5f) * (wave_sum(hsum) - 131072.f);                                                           \
    }
    GA_PREP(wave)
    ga_load(qrs, n_ia, 0, voff_u, voff_v, bufA_u, bufA_v);
#pragma unroll 1
    for (int rr = 0; rr < 8; ++rr) {
      const int row = rr * 8 + wave; const int tok = tok0 + row;
      const int ia = n_ia, ib = n_ib; const float ga = n_ga, gb = n_gb, ua = n_ua, ub = n_ub, ba = n_ba, bb = n_bb, kt = n_kt, hscale = n_hscale;
      unsigned hq[4];
#pragma unroll
      for (int j = 0; j < 4; ++j) hq[j] = n_hq[j];
      f32x4 xv4[4];
#pragma unroll
      for (int q = 0; q < 4; ++q) xv4[q] = *(const f32x4*)(x1s + row * 1024 + lane * 16 + q * 4);
      if (rr + 1 < 8) GA_PREP(row + 8)
      oacc_t oacc[8];
#pragma unroll
      for (int j = 0; j < 8; ++j) { oacc[j][0] = 0; oacc[j][1] = 0; }
      float csum = 0.f;
#pragma unroll 1
      for (int half = 0; half < 2; ++half) {
        const int iv = half ? ib : ia, ivn = half ? n_ia : ib;
        const float gs = half ? gb : ga, us = half ? ub : ua, bs = half ? bb : ba;
        const bool has_next = (half == 0) || (rr + 1 < 8);
#pragma unroll 1
        for (int g8 = 0; g8 < 8; g8 += 2) {
          ga_load(qrs, iv, (g8 + 1) * 8, voff_u, voff_v, bufB_u, bufB_v);
          ga_compute(gs, us, bs, g8 * 8, lane, kt, hscale, hq, bufA_u, bufA_v, oacc, csum);
          if (g8 + 2 < 8) ga_load(qrs, iv, (g8 + 2) * 8, voff_u, voff_v, bufA_u, bufA_v);
          else if (has_next) ga_load(qrs, ivn, 0, voff_u, voff_v, bufA_u, bufA_v);
          ga_compute(gs, us, bs, (g8 + 1) * 8, lane, kt, hscale, hq, bufB_u, bufB_v, oacc, csum);
        }
      }
      {
#if QBITS == 8
        const float corr = wave_sum(csum) * (128.f / 8.f);
#pragma unroll
        for (int j = 0; j < 8; ++j) oacc[j] = oacc[j] - corr;
#endif
      }
      float xo[16]; float ss = 0.f;
#pragma unroll
      for (int q = 0; q < 4; ++q) {
        const int col = lane * 16 + q * 4;
        const f32x4 xv = xv4[q];
        const f32x4 g2 = *(const f32x4*)(modb + 5120 + col);
#pragma unroll
        for (int j = 0; j < 4; ++j) { const float v = xv[j] + g2[j] * ((float)oacc[q * 2 + (j >> 1)][j & 1] * (1.f / OACC_SCALE)); xo[q * 4 + j] = v; ss += v * v; }
      }
      ss = wave_sum(ss);
      const float rs = rsqrtf(ss * (1.f / 1024.f) + EPS);
#pragma unroll
      for (int q = 0; q < 4; ++q) {
        const int col = lane * 16 + q * 4;
        const f32x4 fg = *(const f32x4*)(p.final_g + col);
        f32x4 o;
#pragma unroll
        for (int j = 0; j < 4; ++j) o[j] = xo[q * 4 + j] * rs * fg[j];
        *(f32x4*)(p.out + (size_t)tok * DM + col) = o;
      }
    }
#undef GA_PREP
    __syncthreads();
  }
}

template <int MODE>
__global__ void __launch_bounds__(NTHREADS) mk_fwd(Params p) {
  extern __shared__ __attribute__((aligned(16))) char smem[];
  if (MODE < 0) {
    cg::grid_group grid = cg::this_grid();
    typedef const __attribute__((address_space(4))) Params* KPP;
    { KPP kp = (KPP)__builtin_amdgcn_kernarg_segment_ptr(); asm volatile("" : "+s"(kp)); phase0(*kp, smem); }
    grid.sync();
    { KPP kp = (KPP)__builtin_amdgcn_kernarg_segment_ptr(); asm volatile("" : "+s"(kp)); phase1(*kp, smem); }
    grid.sync();
    { KPP kp = (KPP)__builtin_amdgcn_kernarg_segment_ptr(); asm volatile("" : "+s"(kp)); phase2(*kp, smem); }
    grid.sync();
    { KPP kp = (KPP)__builtin_amdgcn_kernarg_segment_ptr(); asm volatile("" : "+s"(kp)); phase3(*kp, smem); }
#ifdef PROBE_P3X2
    grid.sync();
    phase3(p, smem);
#endif
#ifdef PROBE_P1X2
    grid.sync();
    phase1(p, smem);
#endif
  } else {
    typedef const __attribute__((address_space(4))) Params* KPP;
    KPP kp = (KPP)__builtin_amdgcn_kernarg_segment_ptr();
    if (MODE == 0) phase0(*kp, smem);
    if (MODE == 1) phase1(*kp, smem);
    if (MODE == 2) phase2(*kp, smem);
    if (MODE == 3) phase3(*kp, smem);
  }
}

static size_t align_up(size_t v) { return (v + 255) & ~(size_t)255; }

extern "C" void kernel_launch(void* const* d_in, const int* in_sizes, int n_in, void* d_out, int out_size, void* d_ws, size_t ws_size, hipStream_t stream) {
  static int grid = 0;
  if (grid == 0) {
    int dev = 0, cus = 0, per_cu = 0;
    (void)hipGetDevice(&dev);
    (void)hipDeviceGetAttribute(&cus, hipDeviceAttributeMultiprocessorCount, dev);
#if N_LAUNCH_MODE == 1
    (void)hipFuncSetAttribute((const void*)mk_fwd<-1>, hipFuncAttributeMaxDynamicSharedMemorySize, LDS_BYTES);
    (void)hipOccupancyMaxActiveBlocksPerMultiprocessor(&per_cu, (const void*)mk_fwd<-1>, NTHREADS, LDS_BYTES);
#else
    (void)hipFuncSetAttribute((const void*)mk_fwd<0>, hipFuncAttributeMaxDynamicSharedMemorySize, LDS_BYTES);
    (void)hipFuncSetAttribute((const void*)mk_fwd<1>, hipFuncAttributeMaxDynamicSharedMemorySize, LDS_BYTES);
    (void)hipFuncSetAttribute((const void*)mk_fwd<2>, hipFuncAttributeMaxDynamicSharedMemorySize, LDS_BYTES);
    (void)hipFuncSetAttribute((const void*)mk_fwd<3>, hipFuncAttributeMaxDynamicSharedMemorySize, LDS_BYTES);
    (void)hipOccupancyMaxActiveBlocksPerMultiprocessor(&per_cu, (const void*)mk_fwd<3>, NTHREADS, LDS_BYTES);
#endif
    if (per_cu < 1) { fprintf(stderr, "kernel_launch: occupancy query says %d blocks/CU\n", per_cu); per_cu = 1; }
    if (per_cu > 1) per_cu = 1;
    grid = cus * per_cu;
    if (grid > 256) grid = 256;
    (void)hipGetLastError();
  }
  Params p{};
  const float* const* fin = (const float* const*)d_in;
  p.x = fin[0]; p.c = fin[1]; p.pos = (const int*)d_in[2];
  p.w_ada = fin[3]; p.b_ada = fin[4]; p.norm1_g = fin[5]; p.w_in = fin[6]; p.conv_w = fin[7]; p.conv_b = fin[8];
  p.lru_wa = fin[9]; p.lru_ba = fin[10]; p.lru_wx = fin[11]; p.lru_bx = fin[12]; p.lru_lambda = fin[13];
  p.q_norm_g = fin[14]; p.w_uq = fin[15]; p.kv_norm_g = fin[16]; p.w_ukv = fin[17]; p.lru_out_g = fin[18]; p.mla_out_g = fin[19];
  p.w_out = fin[20]; p.norm2_g = fin[21]; p.peer_wq = fin[22]; p.peer_keys = fin[23]; p.peer_u = fin[24]; p.peer_v = fin[25]; p.final_g = fin[26];
  p.out = (float*)d_out;
  char* w = (char*)d_ws; size_t off = 0;
  auto take = [&](size_t bytes) { char* r = w + off; off = align_up(off + bytes); return r; };
  p.mod = (float*)take((size_t)NB * 6144 * 4);
  p.ssq_lru = (float*)take((size_t)NTOK * 4);
  p.ssq_mla = (float*)take((size_t)NTOK * 4);
  p.invfreq = (double*)take(16 * 8);
  p.Wf_in = (bf16x8*)take((size_t)INW * 1024 * 2);
  p.Wf_uq = (bf16x8*)take((size_t)768 * 256 * 2);
  p.Wf_ukv = (bf16x8*)take((size_t)1024 * 128 * 2);
  p.Wf_a = (bf16x8*)take((size_t)8 * 64 * 64 * 2);
  p.Wf_x = (bf16x8*)take((size_t)8 * 64 * 64 * 2);
  p.Wf_out = (bf16x8*)take((size_t)1024 * 1024 * 2);
  p.Wf_s = (i32x4*)take((size_t)2048 * 1024);
  p.Wsf = (float*)take((size_t)2048 * 1024 * 4);
  p.wsmaxp = (float*)take((size_t)2048 * 16 * 4);
  p.wsc = (float*)take((size_t)2048 * 4);
  p.Wf_out8 = (i32x4*)take((size_t)1024 * 1024);
  p.wopm = (float*)take((size_t)32 * 1024 * 4);
  p.wosc = (float*)take((size_t)1024 * 4);
  p.Uq = (unsigned char*)take((size_t)2 * 16384 * QROWB);
  p.Vq = p.Uq + (size_t)16384 * QROWB;
  p.uscale = (float*)take((size_t)16384 * 16);
  p.vscale = p.uscale; p.ubias = p.uscale;
  p.xlru = (u16*)take((size_t)NTOK * 512 * 2);
  p.gate = (u16*)take((size_t)NTOK * 512 * 2);
  p.Q = (u16*)take((size_t)NTOK * 768 * 2);
  p.Kn = (u16*)take((size_t)NTOK * 512 * 2);
  p.Kr = (u16*)take((size_t)NTOK * 32 * 2);
  p.Vt = (u16*)take((size_t)NTOK * 512 * 2);
  p.y = (u16*)take((size_t)NTOK * 1024 * 2);
  p.scratch = take((size_t)256 * 655360);
  if (off > ws_size) { fprintf(stderr, "kernel_launch: workspace too small: need %zu have %zu\n", off, ws_size); return; }
#if N_LAUNCH_MODE == 1
  void* args[] = {&p};
  hipError_t e = hipLaunchCooperativeKernel((const void*)mk_fwd<-1>, dim3(grid), dim3(NTHREADS), args, LDS_BYTES, stream);
  if (e != hipSuccess) fprintf(stderr, "cooperative launch failed: %s (grid %d)\n", hipGetErrorString(e), grid);
#else
  hipLaunchKernelGGL(mk_fwd<0>, dim3(grid), dim3(NTHREADS), LDS_BYTES, stream, p);
  hipLaunchKernelGGL(mk_fwd<1>, dim3(grid), dim3(NTHREADS), LDS_BYTES, stream, p);
  hipLaunchKernelGGL(mk_fwd<2>, dim3(grid), dim3(NTHREADS), LDS_BYTES, stream, p);
  hipLaunchKernelGGL(mk_fwd<3>, dim3(grid), dim3(NTHREADS), LDS_BYTES, stream, p);
#endif
}
```

```cpp
#include <hip/hip_runtime.h>
#include <hip/hip_cooperative_groups.h>
#include <cstdio>
#include <cstdint>
namespace cg = cooperative_groups;

#ifndef QBITS
#define QBITS 4
#endif
#ifndef N_LAUNCH_MODE
#define N_LAUNCH_MODE 1
#endif

typedef short bf16x8 __attribute__((ext_vector_type(8)));
typedef float f32x16 __attribute__((ext_vector_type(16)));
typedef float f32x4 __attribute__((ext_vector_type(4)));
typedef float f32x2 __attribute__((ext_vector_type(2)));
typedef unsigned u32x4 __attribute__((ext_vector_type(4)));
typedef unsigned u32x2 __attribute__((ext_vector_type(2)));
typedef __bf16 bf16x2_t __attribute__((ext_vector_type(2)));
typedef unsigned short u16;
typedef _Float16 h16x2 __attribute__((ext_vector_type(2)));

#define DI __device__ __forceinline__
#define MFMA32(a, b, c) __builtin_amdgcn_mfma_f32_32x32x16_bf16((a), (b), (c), 0, 0, 0)
typedef int i32x4 __attribute__((ext_vector_type(4)));
typedef int i32x16 __attribute__((ext_vector_type(16)));
#define MFMA8(a, b, c) __builtin_amdgcn_mfma_i32_32x32x32_i8((a), (b), (c), 0, 0, 0)

constexpr int NB = 32, SEQ = 2048, DM = 1024, NTOK = NB * SEQ;
constexpr int INW = 1440;
constexpr int NTHREADS = 512;
constexpr int LDA = 1032;
constexpr int LDA8 = 1040;
constexpr int LDS_BYTES = 147456;
constexpr float EPS = 1e-6f;

struct Params {
  const float* x; const float* c; const int* pos;
  const float* w_ada; const float* b_ada; const float* norm1_g; const float* w_in; const float* conv_w; const float* conv_b;
  const float* lru_wa; const float* lru_ba; const float* lru_wx; const float* lru_bx; const float* lru_lambda;
  const float* q_norm_g; const float* w_uq; const float* kv_norm_g; const float* w_ukv; const float* lru_out_g; const float* mla_out_g;
  const float* w_out; const float* norm2_g; const float* peer_wq; const float* peer_keys; const float* peer_u; const float* peer_v; const float* final_g;
  float* out;
  float* mod; float* ssq_lru; float* ssq_mla; double* invfreq;
  bf16x8* Wf_in; bf16x8* Wf_uq; bf16x8* Wf_ukv; bf16x8* Wf_a; bf16x8* Wf_x; bf16x8* Wf_out; i32x4* Wf_s;
  float* Wsf; float* wsmaxp; float* wsc;
  unsigned char* Uq; unsigned char* Vq; float* uscale; float* vscale; float* ubias; u16* xlru; u16* gate; u16* Q; u16* Kn; u16* Kr; u16* Vt; u16* y;
  char* scratch;
};

typedef const __attribute__((address_space(4))) Params& KP;

DI unsigned pk2(float a, float b) { f32x2 v = {a, b}; bf16x2_t r = __builtin_convertvector(v, bf16x2_t); return __builtin_bit_cast(unsigned, r); }
DI u16 f2bf(float a) { return (u16)(pk2(a, 0.f) & 0xffffu); }
DI float bflo(unsigned u) { return __uint_as_float(u << 16); }
DI float bfhi(unsigned u) { return __uint_as_float(u & 0xffff0000u); }
DI float bf2f(u16 h) { return __uint_as_float(((unsigned)h) << 16); }
template <int CTRL> DI float dppf(float v) { return __builtin_bit_cast(float, __builtin_amdgcn_update_dpp(0, __builtin_bit_cast(int, v), CTRL, 0xF, 0xF, true)); }
typedef unsigned u32x2_ __attribute__((ext_vector_type(2)));
DI float wave_sum(float v) {
  v += dppf<0xB1>(v); v += dppf<0x4E>(v); v += dppf<0x141>(v); v += dppf<0x140>(v);
  u32x2_ r = __builtin_amdgcn_permlane16_swap(__float_as_uint(v), __float_as_uint(v), false, false); v = __uint_as_float(r[0]) + __uint_as_float(r[1]);
  r = __builtin_amdgcn_permlane32_swap(__float_as_uint(v), __float_as_uint(v), false, false); v = __uint_as_float(r[0]) + __uint_as_float(r[1]);
  return v;
}
DI float wave_max(float v) {
  v = fmaxf(v, dppf<0xB1>(v)); v = fmaxf(v, dppf<0x4E>(v)); v = fmaxf(v, dppf<0x141>(v)); v = fmaxf(v, dppf<0x140>(v));
  u32x2_ r = __builtin_amdgcn_permlane16_swap(__float_as_uint(v), __float_as_uint(v), false, false); v = fmaxf(__uint_as_float(r[0]), __uint_as_float(r[1]));
  r = __builtin_amdgcn_permlane32_swap(__float_as_uint(v), __float_as_uint(v), false, false); v = fmaxf(__uint_as_float(r[0]), __uint_as_float(r[1]));
  return v;
}
template <int CTRL> DI unsigned dppu(unsigned v) { return (unsigned)__builtin_amdgcn_update_dpp(0, (int)v, CTRL, 0xF, 0xF, true); }
template <int J> DI unsigned lane_xor_u(unsigned v, int lane) {
  if (J == 1) return dppu<0xB1>(v);
  if (J == 2) return dppu<0x4E>(v);
  if (J == 4) return dppu<0x141>(dppu<0x1B>(v));
  if (J == 8) return dppu<0x128>(v);
  if (J == 16) { const u32x2_ r = __builtin_amdgcn_permlane16_swap(v, v, false, false); return (lane & 16) ? r[0] : r[1]; }
  const u32x2_ r = __builtin_amdgcn_permlane32_swap(v, v, false, false); return (lane & 32) ? r[0] : r[1];
}
template <int J> DI float lane_xor_f(float v, int lane) { return __uint_as_float(lane_xor_u<J>(__float_as_uint(v), lane)); }
DI float sum_xor32(float v) { const u32x2_ r = __builtin_amdgcn_permlane32_swap(__float_as_uint(v), __float_as_uint(v), false, false); return __uint_as_float(r[0]) + __uint_as_float(r[1]); }
DI float max_xor32(float v) { const u32x2_ r = __builtin_amdgcn_permlane32_swap(__float_as_uint(v), __float_as_uint(v), false, false); return fmaxf(__uint_as_float(r[0]), __uint_as_float(r[1])); }
DI float other_xor32(float v, int lane) { const u32x2_ r = __builtin_amdgcn_permlane32_swap(__float_as_uint(v), __float_as_uint(v), false, false); return __uint_as_float((lane & 32) ? r[0] : r[1]); }
DI float reduce8(const float (&v)[8], int lane) {
  float q4[4], r2[2];
#pragma unroll
  for (int j = 0; j < 4; ++j) {
    const u32x2_ r = __builtin_amdgcn_permlane32_swap(__float_as_uint(v[j]), __float_as_uint(v[4 + j]), false, false);
    q4[j] = __uint_as_float(r[0]) + __uint_as_float(r[1]);
  }
#pragma unroll
  for (int j = 0; j < 2; ++j) {
    const u32x2_ r = __builtin_amdgcn_permlane16_swap(__float_as_uint(q4[j]), __float_as_uint(q4[2 + j]), false, false);
    r2[j] = __uint_as_float(r[0]) + __uint_as_float(r[1]);
  }
  const float s0 = r2[0] + dppf<0x128>(r2[0]), s1b = r2[1] + dppf<0x128>(r2[1]);
  float s1 = (lane & 8) ? s1b : s0;
  s1 += dppf<0xB1>(s1);
  s1 += dppf<0x4E>(s1);
  s1 += dppf<0x141>(s1);
  return s1;
}
DI float reduce32(const float (&v)[32], int lane) {
  const bool b3 = (lane & 8) != 0, b2 = (lane & 4) != 0, b1 = (lane & 2) != 0, b0 = (lane & 1) != 0;
  float a16[16], a8[8], a4[4], a2[2];
#pragma unroll
  for (int j = 0; j < 16; ++j) {
    const u32x2_ r = __builtin_amdgcn_permlane16_swap(__float_as_uint(v[j]), __float_as_uint(v[16 + j]), false, false);
    a16[j] = __uint_as_float(r[0]) + __uint_as_float(r[1]);
  }
#pragma unroll
  for (int j = 0; j < 8; ++j) { const float keep = b3 ? a16[8 + j] : a16[j], send = b3 ? a16[j] : a16[8 + j]; a8[j] = keep + lane_xor_f<8>(send, lane); }
#pragma unroll
  for (int j = 0; j < 4; ++j) { const float keep = b2 ? a8[4 + j] : a8[j], send = b2 ? a8[j] : a8[4 + j]; a4[j] = keep + lane_xor_f<4>(send, lane); }
#pragma unroll
  for (int j = 0; j < 2; ++j) { const float keep = b1 ? a4[2 + j] : a4[j], send = b1 ? a4[j] : a4[2 + j]; a2[j] = keep + lane_xor_f<2>(send, lane); }
  const float keep = b0 ? a2[1] : a2[0], send = b0 ? a2[0] : a2[1];
  return keep + lane_xor_f<1>(send, lane);
}
DI float sigmoidf_(float x) { return __builtin_amdgcn_rcpf(1.f + __builtin_amdgcn_exp2f(-1.4426950408889634f * x)); }
DI float gelu_tanh(float x) { const float u = 0.7978845608028654f * (x + 0.044715f * x * x * x); return x * __builtin_amdgcn_rcpf(1.f + __builtin_amdgcn_exp2f(-2.f * 1.4426950408889634f * u)); }
DI float one_minus_exp_small(float z) {
  float q = 1.f + z * (1.f / 6.f);
  q = 1.f + z * (1.f / 5.f) * q;
  q = 1.f + z * (1.f / 4.f) * q;
  q = 1.f + z * (1.f / 3.f) * q;
  q = 1.f + z * (1.f / 2.f) * q;
  return -z * q;
}
DI f32x16 zero16() { f32x16 z; for (int i = 0; i < 16; ++i) z[i] = 0.f; return z; }
DI int crow(int reg, int h) { return (reg & 3) + 8 * (reg >> 2) + 4 * h; }

template <int NT, int PD>
DI void gemm_pro(const bf16x8* __restrict__ Wf, int KS, const int (&tile)[NT], int lane, bf16x8 (&bq)[PD][NT]) {
#pragma unroll
  for (int d = 0; d < PD; ++d)
#pragma unroll
    for (int t = 0; t < NT; ++t) bq[d][t] = Wf[((size_t)tile[t] * KS + d) * 64 + lane];
}
template <int NT, int PD, bool SWAP, bool APF = false>
DI void gemm_main(const u16* As, int lda, int nks, const bf16x8* __restrict__ Wf, int KS, const int (&tile)[NT], f32x16 (&acc)[NT][2], int lane, bf16x8 (&bq)[PD][NT]) {
  const bf16x8* a0p = (const bf16x8*)(As + (lane & 31) * lda + 8 * (lane >> 5));
  const bf16x8* a1p = (const bf16x8*)(As + ((lane & 31) + 32) * lda + 8 * (lane >> 5));
  const bf16x8* bp[NT];
#pragma unroll
  for (int t = 0; t < NT; ++t) bp[t] = Wf + (size_t)tile[t] * KS * 64 + lane;
  bf16x8 a0n = a0p[0], a1n = a1p[0];
#pragma unroll 1
  for (int ks = 0; ks < nks; ks += PD) {
#pragma unroll
    for (int d = 0; d < PD; ++d) {
      bf16x8 a0, a1;
      if (APF) { a0 = a0n; a1 = a1n; const int ka = (ks + d + 1 < nks) ? (ks + d + 1) : (ks + d); a0n = a0p[2 * ka]; a1n = a1p[2 * ka]; }
      else { a0 = a0p[2 * (ks + d)]; a1 = a1p[2 * (ks + d)]; }
      const int kn = (ks + d + PD < nks) ? (ks + d + PD) : (ks + d);
#pragma unroll
      for (int t = 0; t < NT; ++t) {
        const bf16x8 b = bq[d][t];
        bq[d][t] = bp[t][kn * 64];
        acc[t][0] = SWAP ? MFMA32(b, a0, acc[t][0]) : MFMA32(a0, b, acc[t][0]);
        acc[t][1] = SWAP ? MFMA32(b, a1, acc[t][1]) : MFMA32(a1, b, acc[t][1]);
      }
    }
  }
}
template <int NT, int PD = 8, bool SWAP = false>
DI void gemm_core(const u16* As, int lda, int nks, const bf16x8* __restrict__ Wf, int KS, const int (&tile)[NT], f32x16 (&acc)[NT][2], int lane) {
  bf16x8 bq[PD][NT];
  gemm_pro<NT, PD>(Wf, KS, tile, lane, bq);
  gemm_main<NT, PD, SWAP>(As, lda, nks, Wf, KS, tile, acc, lane, bq);
}

template <int NT, int PD>
DI void gemm8_pro(const i32x4* __restrict__ Wf, int KS, const int (&tile)[NT], int lane, i32x4 (&bq)[PD][NT]) {
#pragma unroll
  for (int d = 0; d < PD; ++d)
#pragma unroll
    for (int t = 0; t < NT; ++t) bq[d][t] = Wf[((size_t)tile[t] * KS + d) * 64 + lane];
}
template <int NT, int PD>
DI void gemm8_main(const signed char* As, int lda, int nks, const i32x4* __restrict__ Wf, int KS, const int (&tile)[NT], i32x16 (&acc)[NT][2], int lane, i32x4 (&bq)[PD][NT]) {
  const i32x4* a0p = (const i32x4*)(As + (lane & 31) * lda + 16 * (lane >> 5));
  const i32x4* a1p = (const i32x4*)(As + ((lane & 31) + 32) * lda + 16 * (lane >> 5));
  const i32x4* bp[NT];
#pragma unroll
  for (int t = 0; t < NT; ++t) bp[t] = Wf + (size_t)tile[t] * KS * 64 + lane;
#pragma unroll 1
  for (int ks = 0; ks < nks; ks += PD) {
#pragma unroll
    for (int d = 0; d < PD; ++d) {
      const i32x4 a0 = a0p[2 * (ks + d)], a1 = a1p[2 * (ks + d)];
      const int kn = (ks + d + PD < nks) ? (ks + d + PD) : (ks + d);
#pragma unroll
      for (int t = 0; t < NT; ++t) {
        const i32x4 b = bq[d][t];
        bq[d][t] = bp[t][kn * 64];
        acc[t][0] = MFMA8(b, a0, acc[t][0]);
        acc[t][1] = MFMA8(b, a1, acc[t][1]);
      }
    }
  }
}

DI void conv_frag(const float* __restrict__ W, long sk, long sn, int K, int N, const float* ks1, const float* ks2, int ksplit, bf16x8* out, int gtid, int gthreads) {
  const int KS = K / 16; const int total = (N / 32) * KS * 64;
  for (int i = gtid; i < total; i += gthreads) {
    const int lane = i & 63; const int t = i >> 6; const int ks = t % KS; const int nt = t / KS;
    const int n = nt * 32 + (lane & 31); const int k0 = ks * 16 + 8 * (lane >> 5);
    float v[8];
#pragma unroll
    for (int j = 0; j < 8; ++j) {
      const int k = k0 + j;
      float s = 1.f;
      if (ks1) s = (k < ksplit) ? ks1[k] : ks2[k - ksplit];
      v[j] = W[(long)k * sk + (long)n * sn] * s;
    }
    u32x4 o; o[0] = pk2(v[0], v[1]); o[1] = pk2(v[2], v[3]); o[2] = pk2(v[4], v[5]); o[3] = pk2(v[6], v[7]);
    out[i] = __builtin_bit_cast(bf16x8, o);
  }
}

DI void conv_one(const float* __restrict__ W, long sk, int KS, const float* ks1, const float* ks2, int ksplit, bf16x8* out, int i) {
  const int lane = i & 63; const int t = i >> 6; const int ks = t % KS; const int nt = t / KS;
  const int n = nt * 32 + (lane & 31); const int k0 = ks * 16 + 8 * (lane >> 5);
  float v[8];
#pragma unroll
  for (int j = 0; j < 8; ++j) v[j] = W[(long)(k0 + j) * sk + n];
  if (ks1) {
#pragma unroll
    for (int j = 0; j < 8; ++j) { const int k = k0 + j; v[j] *= (k < ksplit) ? ks1[k] : ks2[k - ksplit]; }
  }
  u32x4 o; o[0] = pk2(v[0], v[1]); o[1] = pk2(v[2], v[3]); o[2] = pk2(v[4], v[5]); o[3] = pk2(v[6], v[7]);
  out[i] = __builtin_bit_cast(bf16x8, o);
}

DI void phase0(KP p, char* smem) {
  const int tid = threadIdx.x; const int gtid = blockIdx.x * NTHREADS + tid; const int gthreads = gridDim.x * NTHREADS;
  for (int i = gtid; i < NTOK; i += gthreads) { p.ssq_lru[i] = 0.f; p.ssq_mla[i] = 0.f; }
  if (gtid < 16) p.invfreq[gtid] = pow(10000.0, -(double)gtid / 16.0);
  {
    float* cact = (float*)smem;
    float* red = (float*)(smem + 65536);
    const int lane = tid & 63, wv = tid >> 6;
    for (int item = blockIdx.x; item < 192; item += gridDim.x) {
      const int cg = item >> 1, bh = item & 1;
      for (int i = tid; i < 16 * DM; i += NTHREADS) { const int bb = i >> 10, k = i & 1023; const float v = p.c[(bh * 16 + bb) * DM + k]; cact[k * 16 + bb] = v / (1.f + __expf(-v)); }
      __syncthreads();
      float acc[16];
#pragma unroll
      for (int bb = 0; bb < 16; ++bb) acc[bb] = 0.f;
      const float* wp = p.w_ada + (size_t)(wv * 128) * 6144 + cg * 64 + lane;
#pragma unroll 32
      for (int kk = 0; kk < 128; ++kk) {
        const float w = wp[(size_t)kk * 6144];
        const f32x4* cp = (const f32x4*)(cact + (wv * 128 + kk) * 16);
#pragma unroll
        for (int q = 0; q < 4; ++q) { const f32x4 cv = cp[q]; acc[4 * q] += cv[0] * w; acc[4 * q + 1] += cv[1] * w; acc[4 * q + 2] += cv[2] * w; acc[4 * q + 3] += cv[3] * w; }
      }
#pragma unroll
      for (int bb = 0; bb < 16; ++bb) red[(wv * 16 + bb) * 64 + lane] = acc[bb];
      __syncthreads();
      for (int o = tid; o < 1024; o += NTHREADS) {
        const int bb = o >> 6, c2 = o & 63;
        float sum = 0.f;
#pragma unroll
        for (int w8 = 0; w8 < 8; ++w8) sum += red[(w8 * 16 + bb) * 64 + c2];
        p.mod[(size_t)(bh * 16 + bb) * 6144 + cg * 64 + c2] = sum + p.b_ada[cg * 64 + c2];
      }
      __syncthreads();
    }
  }
  {
    constexpr int N_IN = 45 * 64 * 64, N_UQ = 24 * 16 * 64, N_UKV = 32 * 8 * 64, N_LRU = 16 * 512, N_OUT = 32 * 64 * 64;
    for (int i = gtid; i < N_IN + N_UQ + N_UKV + N_LRU + N_OUT; i += gthreads) {
      int j = i;
      if (j < N_OUT) { conv_one(p.w_out, 1024, 64, p.lru_out_g, p.mla_out_g, 512, p.Wf_out, j); continue; }
      j -= N_OUT;
      if (j < N_IN) { conv_one(p.w_in, INW, 64, nullptr, nullptr, 0, p.Wf_in, j); continue; }
      j -= N_IN;
      if (j < N_UQ) { conv_one(p.w_uq, 768, 16, p.q_norm_g, p.q_norm_g, 256, p.Wf_uq, j); continue; }
      j -= N_UQ;
      if (j < N_UKV) { conv_one(p.w_ukv, 1024, 8, p.kv_norm_g, p.kv_norm_g, 128, p.Wf_ukv, j); continue; }
      j -= N_UKV;
      { const int h = j >> 10, m = (j >> 9) & 1, f = j & 511; conv_one((m ? p.lru_wx : p.lru_wa) + h * 4096, 64, 4, nullptr, nullptr, 0, (m ? p.Wf_x : p.Wf_a) + h * 512, f); }
    }
  }
  {
    float* kl = (float*)smem;
    float* wl = (float*)(smem + 67584);
    const int lane = tid & 63, wv = tid >> 6, l31 = lane & 31, lh = lane >> 5;
    for (int item = blockIdx.x; item < 256; item += gridDim.x) {
      const int hp = item >> 4, cc = item & 15;
      __syncthreads();
#pragma unroll
      for (int i = 0; i < 8; ++i) { const int e = tid + NTHREADS * i; const int r = e >> 5, q = e & 31; *(f32x4*)(kl + r * 132 + q * 4) = *(const f32x4*)(p.peer_keys + (size_t)hp * 16384 + r * 128 + q * 4); }
#pragma unroll
      for (int i = 0; i < 4; ++i) { const int e = tid + NTHREADS * i; const int c = e >> 5, q = e & 31; *(f32x4*)(wl + c * 132 + q * 4) = *(const f32x4*)(p.peer_wq + (size_t)(cc * 64 + c) * 2048 + hp * 128 + q * 4); }
      __syncthreads();
      const int rt = wv >> 1, ct = wv & 1;
      const float* ap = kl + (rt * 32 + l31) * 132 + 8 * lh;
      const float* bp = wl + (ct * 32 + l31) * 132 + 8 * lh;
      f32x16 acc = zero16();
#pragma unroll
      for (int ks = 0; ks < 8; ++ks) {
        const f32x4 a0 = *(const f32x4*)(ap + 16 * ks), a1 = *(const f32x4*)(ap + 16 * ks + 4);
        const f32x4 b0 = *(const f32x4*)(bp + 16 * ks), b1 = *(const f32x4*)(bp + 16 * ks + 4);
        u32x4 av, bv;
        av[0] = pk2(a0[0], a0[1]); av[1] = pk2(a0[2], a0[3]); av[2] = pk2(a1[0], a1[1]); av[3] = pk2(a1[2], a1[3]);
        bv[0] = pk2(b0[0], b0[1]); bv[1] = pk2(b0[2], b0[3]); bv[2] = pk2(b1[0], b1[1]); bv[3] = pk2(b1[2], b1[3]);
        acc = MFMA32(__builtin_bit_cast(bf16x8, av), __builtin_bit_cast(bf16x8, bv), acc);
      }
      float* dst = p.Wsf + (size_t)(hp * 128 + rt * 32) * 1024 + cc * 64 + ct * 32 + l31;
#pragma unroll
      for (int r = 0; r < 16; ++r) dst[(size_t)crow(r, lh) * 1024] = acc[r];
    }
    __syncthreads();
  }
#if QBITS == 8
  {
    const int lane = tid & 63; const int gw = gtid >> 6; const int nw = gthreads >> 6;
    for (int row = gw; row < 32768; row += nw) {
      const int r = row & 16383; const bool isv = row >= 16384;
      const f32x4* src = (const f32x4*)((isv ? p.peer_v : p.peer_u) + (size_t)r * 1024) + lane * 4;
      f32x4 a[4];
#pragma unroll
      for (int i = 0; i < 4; ++i) a[i] = src[i];
#if QBITS == 8
      float am = 0.f;
#pragma unroll
      for (int i = 0; i < 4; ++i)
#pragma unroll
        for (int j = 0; j < 4; ++j) am = fmaxf(am, fabsf(a[i][j]));
      am = wave_max(am);
      const float inv = am > 0.f ? 127.f / am : 0.f;
      u32x4 o;
#pragma unroll
      for (int i = 0; i < 4; ++i) {
        unsigned w = 0;
#pragma unroll
        for (int j = 0; j < 4; ++j) { const int q = (int)__builtin_rintf(a[i][j] * inv) + 128; w |= (unsigned)q << (8 * j); }
        o[i] = w;
      }
      ((u32x4*)(isv ? p.Vq : p.Uq))[(size_t)r * 64 + lane] = o;
      const float step = am * (1.f / 127.f);
      if (lane == 0) p.uscale[r * 4 + (isv ? 1 : 0)] = step;
      float ns = 0.f;
#pragma unroll
      for (int i = 0; i < 4; ++i) ns += (float)(o[i] & 255u) + (float)((o[i] >> 8) & 255u) + (float)((o[i] >> 16) & 255u) + (float)(o[i] >> 24);
      ns = wave_sum(ns);
      if (lane == 0 && !isv) p.uscale[r * 4 + 2] = step * 128.f * ns;
#else
      float ssum = 0.f;
#pragma unroll
      for (int i = 0; i < 4; ++i)
#pragma unroll
        for (int j = 0; j < 4; ++j) ssum += a[i][j] * a[i][j];
      ssum = wave_sum(ssum);
      const float rms = sqrtf(ssum * (1.f / 1024.f));
      const float step = (isv ? 0.49f : 0.3352f) * rms;
      const float inv = step > 0.f ? 1.f / step : 0.f;
      u32x2 o;
#pragma unroll
      for (int jd = 0; jd < 2; ++jd) {
        unsigned w = 0;
#pragma unroll
        for (int e = 0; e < 8; ++e) {
          const float x = a[(8 * jd + e) >> 2][(8 * jd + e) & 3];
          if (isv) {
            const float m = fabsf(x) * inv;
            const int mag = (m > 0.25f) + (m > 0.75f) + (m > 1.25f) + (m > 1.75f) + (m > 2.5f) + (m > 3.5f) + (m > 5.0f);
            w |= (unsigned)(mag | (x < 0.f ? 8 : 0)) << (4 * e);
          } else {
            int q = (int)__builtin_rintf(x * inv + 7.5f); q = q < 0 ? 0 : (q > 15 ? 15 : q);
            w |= (unsigned)q << (8 * (e & 3) + 4 * (e >> 2));
          }
        }
        o[jd] = w;
      }
      ((u32x2*)(p.Uq + (size_t)r * 1024))[2 * lane + (isv ? 1 : 0)] = o;
      if (lane == 0) p.uscale[r * 4 + (isv ? 1 : 0)] = step;
      float ns = 0.f;
#pragma unroll
      for (int jd = 0; jd < 2; ++jd)
#pragma unroll
        for (int e = 0; e < 8; ++e) ns += (float)((o[jd] >> (4 * e)) & 15u);
      ns = wave_sum(ns);
      if (lane == 0 && !isv) p.uscale[r * 4 + 2] = step * 128.f * ns;
#endif
    }
  }
#else
  {
    const int lane = tid & 63; const int gw = gtid >> 6; const int nw = gthreads >> 6;
    for (int r = gw; r < 16384; r += nw) {
      const f32x4* su = (const f32x4*)(p.peer_u + (size_t)r * 1024) + lane * 4;
      const f32x4* sv = (const f32x4*)(p.peer_v + (size_t)r * 1024) + lane * 4;
      f32x4 au[4], av[4];
#pragma unroll
      for (int i = 0; i < 4; ++i) { au[i] = su[i]; av[i] = sv[i]; }
      float ssu = 0.f, ssv = 0.f;
#pragma unroll
      for (int i = 0; i < 4; ++i)
#pragma unroll
        for (int j = 0; j < 4; ++j) { ssu += au[i][j] * au[i][j]; ssv += av[i][j] * av[i][j]; }
      ssu = wave_sum(ssu); ssv = wave_sum(ssv);
      const float ustep = 0.3352f * sqrtf(ssu * (1.f / 1024.f)), vstep = 0.49f * sqrtf(ssv * (1.f / 1024.f));
      const float uinv = ustep > 0.f ? 1.f / ustep : 0.f, vinv = vstep > 0.f ? 1.f / vstep : 0.f;
      u32x4 o;
      float ns = 0.f;
#pragma unroll
      for (int jd = 0; jd < 2; ++jd) {
        unsigned wu = 0, wv = 0;
#pragma unroll
        for (int e = 0; e < 8; ++e) {
          const float xu = au[(8 * jd + e) >> 2][(8 * jd + e) & 3], xv = av[(8 * jd + e) >> 2][(8 * jd + e) & 3];
          int q = (int)__builtin_rintf(xu * uinv + 7.5f); q = q < 0 ? 0 : (q > 15 ? 15 : q);
          wu |= (unsigned)q << (8 * (e & 3) + 4 * (e >> 2)); ns += (float)q;
          const float m = fabsf(xv) * vinv;
          const int mag = (m > 0.25f) + (m > 0.75f) + (m > 1.25f) + (m > 1.75f) + (m > 2.5f) + (m > 3.5f) + (m > 5.0f);
          wv |= (unsigned)(mag | (xv < 0.f ? 8 : 0)) << (4 * e);
        }
        o[jd] = wu; o[2 + jd] = wv;
      }
      ((u32x4*)(p.Uq + (size_t)r * 1024))[lane] = o;
      ns = wave_sum(ns);
      if (lane == 0) *(f32x4*)(p.uscale + r * 4) = (f32x4){ustep, vstep, ustep * 128.f * ns, 0.f};
    }
  }
#endif
}

DI void ws_quant(KP p) {
  const int lane = threadIdx.x & 63; const int gw = (blockIdx.x * NTHREADS + threadIdx.x) >> 6; const int nw = (gridDim.x * NTHREADS) >> 6;
  for (int row = gw; row < 2048; row += nw) {
    const f32x4* src = (const f32x4*)(p.Wsf + (size_t)row * 1024 + lane * 16);
    f32x4 v[4];
    float m = 0.f;
#pragma unroll
    for (int q = 0; q < 4; ++q) { v[q] = src[q]; m = fmaxf(fmaxf(m, fmaxf(fabsf(v[q][0]), fabsf(v[q][1]))), fmaxf(fabsf(v[q][2]), fabsf(v[q][3]))); }
    m = wave_max(m);
    const float inv = m > 0.f ? 127.f / m : 0.f;
    i32x4 o;
#pragma unroll
    for (int q = 0; q < 4; ++q) {
      unsigned w = 0;
#pragma unroll
      for (int j = 0; j < 4; ++j) w |= ((unsigned)(int)__builtin_rintf(v[q][j] * inv) & 255u) << (8 * j);
      o[q] = (int)w;
    }
    p.Wf_s[(size_t)((row >> 5) * 32 + (lane >> 1)) * 64 + (row & 31) + 32 * (lane & 1)] = o;
    if (lane == 0) p.wsc[row] = m * (1.f / 127.f);
  }
}

DI void phase1(KP p, char* smem) {
  const int tid = threadIdx.x, wave = __builtin_amdgcn_readfirstlane(tid >> 6);
  u16* hA = (u16*)smem;
  float* cs = (float*)(smem + 132096);
  float* ssq = (float*)(smem + 132096 + 8192);
  constexpr int LDL = 424;
  ws_quant(p);
  for (int tile = blockIdx.x; tile < NTOK / 64; tile += gridDim.x) {
    int lane_o = tid & 63; asm volatile("" : "+v"(lane_o));
    const int lane = lane_o, l31 = lane & 31, lh = lane >> 5;
    const int tok0 = tile * 64; const int b = tok0 / SEQ; const int s0 = tok0 % SEQ;
    const float* modb = p.mod + (size_t)b * 6144;
    for (int i = tid; i < 1024; i += NTHREADS) {
      const int r = i >> 4, j = i & 15;
      const double ang = (double)p.pos[tok0 + r] * p.invfreq[j];
      double rev = ang * 0.15915494309189535; rev -= floor(rev);
      const float rf = (float)rev;
      cs[2 * i] = __builtin_amdgcn_cosf(rf); cs[2 * i + 1] = __builtin_amdgcn_sinf(rf);
    }
    if (tid < 128) ssq[tid] = 0.f;
    {
      f32x4 cm[4], ca[4];
#pragma unroll
      for (int i = 0; i < 4; ++i) {
        const int col = i * 256 + lane * 4;
        const f32x4 g = *(const f32x4*)(p.norm1_g + col); const f32x4 sc = *(const f32x4*)(modb + 1024 + col);
        cm[i] = g * (sc + 1.0f); ca[i] = *(const f32x4*)(modb + col);
      }
#pragma unroll 2
      for (int rr = 0; rr < 8; rr += 4) {
        f32x4 xv[4][4];
#pragma unroll
        for (int q = 0; q < 4; ++q)
#pragma unroll
          for (int i = 0; i < 4; ++i) xv[q][i] = *(const f32x4*)(p.x + (size_t)(tok0 + wave * 8 + rr + q) * DM + i * 256 + lane * 4);
#pragma unroll
        for (int q = 0; q < 4; ++q) {
          float ss = 0.f;
#pragma unroll
          for (int i = 0; i < 4; ++i) ss += xv[q][i][0] * xv[q][i][0] + xv[q][i][1] * xv[q][i][1] + xv[q][i][2] * xv[q][i][2] + xv[q][i][3] * xv[q][i][3];
          ss = wave_sum(ss);
          const float rs = rsqrtf(ss * (1.f / 1024.f) + EPS);
          const int row = wave * 8 + rr + q;
#pragma unroll
          for (int i = 0; i < 4; ++i) {
            const f32x4 h = xv[q][i] * rs * cm[i] + ca[i];
            u32x2 o; o[0] = pk2(h[0], h[1]); o[1] = pk2(h[2], h[3]);
            *(u32x2*)(hA + row * LDA + i * 256 + lane * 4) = o;
          }
        }
      }
    }
    __syncthreads();
    bf16x8 ring1[8][2];
    const bool has2 = (wave + 40) < 45;
    { const int tl0[2] = {wave, wave + 8}; gemm_pro<2, 8>(p.Wf_in, 64, tl0, lane, ring1); }
#pragma unroll 1
    for (int pass = 0; pass < 2; ++pass) {
      f32x16 acc[2][2];
#pragma unroll
      for (int t = 0; t < 2; ++t) { acc[t][0] = zero16(); acc[t][1] = zero16(); }
      const int tl[2] = {wave + 16 * pass, wave + 16 * pass + 8};
      gemm_main<2, 8, false, true>(hA, LDA, 64, p.Wf_in, 64, tl, acc, lane, ring1);
      { const int tn[2] = {wave + 16 * (pass + 1), (pass == 0 || has2) ? wave + 16 * (pass + 1) + 8 : wave + 32}; gemm_pro<2, 8>(p.Wf_in, 64, tn, lane, ring1); }
      int el_ = lane; asm volatile("" : "+v"(el_));
      const int l31 = el_ & 31, lh = el_ >> 5;
      u16* dstb[2];
#pragma unroll
      for (int t = 0; t < 2; ++t) { const int col = tl[t] * 32 + l31; dstb[t] = (col < 512) ? (p.xlru + col) : (p.gate + (col - 512)); }
#pragma unroll
      for (int rt = 0; rt < 2; ++rt)
#pragma unroll
        for (int r = 0; r < 16; ++r) {
          const size_t ro = (size_t)(tok0 + rt * 32 + crow(r, lh)) * 512;
#pragma unroll
          for (int t = 0; t < 2; ++t) dstb[t][ro] = f2bf(acc[t][rt][r]);
        }
    }
    {
      f32x16 acc[2][2];
#pragma unroll
      for (int t = 0; t < 2; ++t) { acc[t][0] = zero16(); acc[t][1] = zero16(); }
      const int tl[2] = {wave + 32, has2 ? wave + 40 : wave + 32};
      gemm_main<2, 8, false, true>(hA, LDA, 64, p.Wf_in, 64, tl, acc, lane, ring1);
      int el_ = lane; asm volatile("" : "+v"(el_));
      const int l31 = el_ & 31, lh = el_ >> 5;
      __syncthreads();
      u16* lat = hA;
#pragma unroll
      for (int t = 0; t < 2; ++t) {
        if (t == 1 && !has2) continue;
        const int lc = tl[t] * 32 - 1024 + l31;
        if (tl[t] < 44) {
          float sq[32];
#pragma unroll
          for (int rt = 0; rt < 2; ++rt)
#pragma unroll
            for (int r = 0; r < 16; ++r) { const float v = acc[t][rt][r]; sq[rt * 16 + r] = v * v; }
          const float tot = reduce32(sq, lane);
          __hip_atomic_fetch_add(&ssq[(tl[t] < 40 ? 0 : 64) + (l31 >> 4) * 32 + crow(l31 & 15, lh)], tot, __ATOMIC_RELAXED, __HIP_MEMORY_SCOPE_WORKGROUP);
        }
#pragma unroll
        for (int rt = 0; rt < 2; ++rt)
#pragma unroll
          for (int r = 0; r < 16; ++r) {
            const int row = rt * 32 + crow(r, lh);
            const float v = acc[t][rt][r];
            if (lc < 384) {
              lat[row * LDL + lc] = f2bf(v);
            } else {
              const float pv = lane_xor_f<16>(v, lane);
              const int j = lc - 384; const int jj = j & 15;
              const float co = cs[(row * 16 + jj) * 2], si = cs[(row * 16 + jj) * 2 + 1];
              const float o = (j < 16) ? (v * co - pv * si) : (v * co + pv * si);
              p.Kr[(size_t)(tok0 + row) * 32 + j] = f2bf(o);
            }
          }
      }
    }
    __syncthreads();
    {
      const u16* lat = hA;
      const float qscale = 0.10206207261596577f * 1.4426950408889634f;
      const int jj = l31 & 15;
#pragma unroll 1
      for (int pass = 0; pass < 2; ++pass) {
        f32x16 acc[2][2];
#pragma unroll
        for (int t = 0; t < 2; ++t) { acc[t][0] = zero16(); acc[t][1] = zero16(); }
        const int tl[2] = {pass == 0 ? wave : wave + 16, pass == 0 ? wave + 8 : wave + 16};
        gemm_core<2>(lat, LDL, 16, p.Wf_uq, 16, tl, acc, lane);
        int el_ = lane; asm volatile("" : "+v"(el_));
        const int l31 = el_ & 31, lh = el_ >> 5;
#pragma unroll
        for (int rt = 0; rt < 2; ++rt)
#pragma unroll
          for (int r = 0; r < 16; ++r) {
            const int row = rt * 32 + crow(r, lh);
            const float rs = rsqrtf(ssq[row] * (1.f / 256.f) + EPS) * qscale;
            const float co = cs[(row * 16 + jj) * 2], si = cs[(row * 16 + jj) * 2 + 1];
#pragma unroll
            for (int t = 0; t < 2; ++t) {
              if (t == 1 && pass == 1) continue;
              const int head = tl[t] / 3, part = tl[t] % 3;
              float v = acc[t][rt][r] * rs;
              if (part == 2) {
                const float pv = lane_xor_f<16>(v, lane);
                v = (l31 < 16) ? (v * co - pv * si) : (v * co + pv * si);
              }
              p.Q[((size_t)(b * 8 + head) * SEQ + s0 + row) * 96 + part * 32 + l31] = f2bf(v);
            }
          }
      }
#pragma unroll 1
      for (int pass = 0; pass < 2; ++pass) {
        f32x16 acc[2][2];
#pragma unroll
        for (int t = 0; t < 2; ++t) { acc[t][0] = zero16(); acc[t][1] = zero16(); }
        const int tl[2] = {wave + 16 * pass, wave + 16 * pass + 8};
        gemm_core<2>(lat + 256, LDL, 8, p.Wf_ukv, 8, tl, acc, lane);
        int el_ = lane; asm volatile("" : "+v"(el_));
        const int l31 = el_ & 31, lh = el_ >> 5;
#pragma unroll
        for (int rt = 0; rt < 2; ++rt)
#pragma unroll
          for (int g = 0; g < 4; ++g) {
            const int row = rt * 32 + 8 * g + 4 * lh;
            float rs4[4];
#pragma unroll
            for (int q = 0; q < 4; ++q) rs4[q] = rsqrtf(ssq[64 + row + q] * (1.f / 128.f) + EPS);
#pragma unroll
            for (int t = 0; t < 2; ++t) {
              const int head = tl[t] >> 2, sub = tl[t] & 3;
              float v4[4];
#pragma unroll
              for (int q = 0; q < 4; ++q) v4[q] = acc[t][rt][4 * g + q] * rs4[q];
              if (sub < 2) {
#pragma unroll
                for (int q = 0; q < 4; ++q) p.Kn[((size_t)(b * 8 + head) * SEQ + s0 + row + q) * 64 + sub * 32 + l31] = f2bf(v4[q]);
              } else {
                const int d = (sub - 2) * 32 + l31;
                u32x2 o; o[0] = pk2(v4[0], v4[1]); o[1] = pk2(v4[2], v4[3]);
                *(u32x2*)(p.Vt + ((size_t)(b * 8 + head) * 64 + d) * SEQ + s0 + row) = o;
              }
            }
          }
      }
    }
    __syncthreads();
  }
}

DI void lru_item(KP p, char* smem, int item) {
  const int tid = threadIdx.x, lane = tid & 63, wave = __builtin_amdgcn_readfirstlane(tid >> 6);
  const int l31 = lane & 31, lh = lane >> 5;
  const int b = item >> 3, cb = item & 7;
  const int c = lane; const int ch = cb * 64 + c; const int tg = wave;
  const float cw0 = p.conv_w[ch], cw1 = p.conv_w[512 + ch], cw2 = p.conv_w[1024 + ch], cw3 = p.conv_w[1536 + ch], cbias = p.conv_b[ch];
  const float ba = p.lru_ba[ch], bx = p.lru_bx[ch];
  const float sp = log1pf(__expf(-p.lru_lambda[ch]));
  float carry = 0.f;
  const u16* xl = p.xlru + (size_t)b * SEQ * 512 + ch;
  const u16* gt = p.gate + (size_t)b * SEQ * 512 + ch;
  u16* yo = p.y + (size_t)b * SEQ * 1024 + ch;
  const int mat = wave >> 2, rt = (wave >> 1) & 1, ct = wave & 1;
  const bf16x8* wf = (mat == 0 ? p.Wf_a : p.Wf_x) + cb * 512 + ct * 256 + lane;
  bf16x8 bw[4];
#pragma unroll
  for (int ks = 0; ks < 4; ++ks) bw[ks] = wf[ks * 64];
  constexpr int NCH = SEQ / 64;
  u16 xin_n[11], gv_n[8];
#pragma unroll
  for (int i = 0; i < 11; ++i) { const int t = tg * 8 - 3 + i; xin_n[i] = (t >= 0) ? xl[(size_t)t * 512] : (u16)0; }
#pragma unroll
  for (int i = 0; i < 8; ++i) gv_n[i] = gt[(size_t)(tg * 8 + i) * 512];
  float xcB[8], gvB[8], xcC[8], gvC[8], avD[8], bvD[8], gvD[8];
#pragma unroll
  for (int i = 0; i < 8; ++i) { xcB[i] = gvB[i] = xcC[i] = gvC[i] = avD[i] = bvD[i] = gvD[i] = 0.f; }
  __syncthreads();
#pragma unroll 1
  for (int it = 0; it < NCH + 3; ++it) {
    float xcA[8], gvA[8], avC[8], bvC[8];
    if (it < NCH) {
      const int t0 = it * 64 + tg * 8;
      float xin[11];
#pragma unroll
      for (int i = 0; i < 11; ++i) xin[i] = bf2f(xin_n[i]);
#pragma unroll
      for (int i = 0; i < 8; ++i) gvA[i] = bf2f(gv_n[i]);
      if (it + 1 < NCH) {
#pragma unroll
        for (int i = 0; i < 11; ++i) xin_n[i] = xl[(size_t)(t0 + 64 - 3 + i) * 512];
#pragma unroll
        for (int i = 0; i < 8; ++i) gv_n[i] = gt[(size_t)(t0 + 64 + i) * 512];
      }
      u16* xcb = (u16*)(smem + (it & 1) * 9216);
#pragma unroll
      for (int i = 0; i < 8; ++i) {
        xcA[i] = cbias + cw0 * xin[i] + cw1 * xin[i + 1] + cw2 * xin[i + 2] + cw3 * xin[i + 3];
        xcb[(tg * 8 + i) * 72 + c] = f2bf(xcA[i]);
      }
    } else {
#pragma unroll
      for (int i = 0; i < 8; ++i) { xcA[i] = 0.f; gvA[i] = 0.f; }
    }
    if (it >= 1 && it - 1 < NCH) {
      const u16* xcb = (const u16*)(smem + ((it - 1) & 1) * 9216);
      float* pm = (float*)(smem + 18432 + ((it - 1) & 1) * 33280) + mat * 4160;
      f32x16 acc = zero16();
      const bf16x8* ap = (const bf16x8*)(xcb + (rt * 32 + l31) * 72 + 8 * lh);
#pragma unroll
      for (int ks = 0; ks < 4; ++ks) acc = MFMA32(ap[2 * ks], bw[ks], acc);
#pragma unroll
      for (int r = 0; r < 16; ++r) pm[(rt * 32 + crow(r, lh)) * 65 + ct * 32 + l31] = acc[r];
    }
    if (it >= 2 && it - 2 < NCH) {
      const float* pre = (const float*)(smem + 18432 + ((it - 2) & 1) * 33280);
      float* seg = (float*)(smem + 84992 + ((it - 2) & 1) * 4096);
      float A = 1.f, Bc = 0.f;
#pragma unroll
      for (int i = 0; i < 8; ++i) {
        const int tl = tg * 8 + i;
        const float r = sigmoidf_(pre[tl * 65 + c] + ba);
        const float ig = sigmoidf_(pre[4160 + tl * 65 + c] + bx);
        const float log_a = -8.f * r * sp;
        const float a = __builtin_amdgcn_exp2f(1.4426950408889634f * log_a);
        const float z = 2.f * log_a;
        const float om = (z > -0.25f) ? one_minus_exp_small(z) : -expm1f(z);
        const float m = __builtin_amdgcn_sqrtf(om);
        avC[i] = a; bvC[i] = m * ig * xcC[i];
        A *= a; Bc = a * Bc + bvC[i];
      }
      seg[(tg * 64 + c) * 2] = A; seg[(tg * 64 + c) * 2 + 1] = Bc;
    } else {
#pragma unroll
      for (int i = 0; i < 8; ++i) { avC[i] = 0.f; bvC[i] = 0.f; }
    }
    if (it >= 3) {
      const int t0 = (it - 3) * 64 + tg * 8;
      const float* seg = (const float*)(smem + 84992 + ((it - 3) & 1) * 4096);
      float h = carry, hin = 0.f;
#pragma unroll
      for (int s2 = 0; s2 < 8; ++s2) {
        if (s2 == tg) hin = h;
        h = seg[(s2 * 64 + c) * 2] * h + seg[(s2 * 64 + c) * 2 + 1];
      }
      carry = h;
      h = hin;
      float sq[8];
#pragma unroll
      for (int i = 0; i < 8; ++i) {
        h = avD[i] * h + bvD[i];
        const float yv = gelu_tanh(gvD[i]) * h;
        yo[(size_t)(t0 + i) * 1024] = f2bf(yv);
        sq[i] = yv * yv;
      }
      const float tot = reduce8(sq, lane);
      if ((lane & 7) == 0) unsafeAtomicAdd(p.ssq_lru + (size_t)b * SEQ + t0 + (lane >> 3), tot);
    }
#pragma unroll
    for (int i = 0; i < 8; ++i) {
      avD[i] = avC[i]; bvD[i] = bvC[i]; gvD[i] = gvC[i];
      xcC[i] = xcB[i]; gvC[i] = gvB[i];
      xcB[i] = xcA[i]; gvB[i] = gvA[i];
    }
    __syncthreads();
  }
}

DI void attn_unit(KP p, char* smem, int b, int hd, int qb) {
  const int tid = threadIdx.x, lane = tid & 63, wave = __builtin_amdgcn_readfirstlane(tid >> 6);
  const int l31 = lane & 31, lh = lane >> 5;
  const int q0 = qb * 256 + wave * 32;
  const size_t bh = (size_t)(b * 8 + hd);
  const int nkt = qb * 4 + 4;
  const int qidx = q0 + l31;
  const int skey = tid >> 3, schn = tid & 7;
  const int rkey = (tid & 255) >> 2, rchn = tid & 3;
  const u16* kn_src = p.Kn + (bh * SEQ + skey) * 64 + schn * 8;
  const u16* kr_src = p.Kr + ((size_t)b * SEQ + rkey) * 32 + rchn * 8;
  const u16* vt_src = p.Vt + (bh * 64 + skey) * SEQ + schn * 8;
  u32x4 rk, rr, rv;
  rk = *(const u32x4*)(kn_src); rv = *(const u32x4*)(vt_src);
  if (tid < 256) rr = *(const u32x4*)(kr_src);
  bf16x8 qf[6];
  {
    const bf16x8* qp = (const bf16x8*)(p.Q + (bh * SEQ + q0 + l31) * 96 + 8 * lh);
#pragma unroll
    for (int ks = 0; ks < 6; ++ks) qf[ks] = qp[2 * ks];
  }
  __syncthreads();
  {
    u16* Kl = (u16*)smem; u16* Vl = (u16*)(smem + 13312);
    *(u32x4*)(Kl + skey * 104 + schn * 8) = rk;
    if (tid < 256) *(u32x4*)(Kl + rkey * 104 + 64 + rchn * 8) = rr;
    *(u32x4*)(Vl + skey * 72 + schn * 8) = rv;
  }
  __syncthreads();
  f32x16 o0 = zero16(), o1 = zero16();
  float m_run = -1e30f, l_run = 0.f;
  for (int kt = 0; kt < nkt; ++kt) {
    const u16* Kl = (const u16*)(smem + (kt & 1) * 22528);
    const u16* Vl = (const u16*)(smem + (kt & 1) * 22528 + 13312);
    const bool more = (kt + 1) < nkt;
    if (more) {
      rk = *(const u32x4*)(kn_src + (size_t)(kt + 1) * 64 * 64);
      rv = *(const u32x4*)(vt_src + (kt + 1) * 64);
      if (tid < 256) rr = *(const u32x4*)(kr_src + (size_t)(kt + 1) * 64 * 32);
    }
    if (kt * 64 <= q0 + 31) {
      f32x16 s[2];
      bf16x8 kfr[2][6];
#pragma unroll
      for (int st = 0; st < 2; ++st) {
        const bf16x8* kp = (const bf16x8*)(Kl + (st * 32 + l31) * 104 + 8 * lh);
#pragma unroll
        for (int ks = 0; ks < 6; ++ks) kfr[st][ks] = kp[2 * ks];
      }
#pragma unroll
      for (int st = 0; st < 2; ++st) {
        s[st] = zero16();
#pragma unroll
        for (int ks = 0; ks < 6; ++ks) s[st] = MFMA32(kfr[st][ks], qf[ks], s[st]);
      }
      u32x2 vfr[2][4][2];
#pragma unroll
      for (int dt = 0; dt < 2; ++dt)
#pragma unroll
        for (int c4 = 0; c4 < 4; ++c4) {
          const int kbase = c4 * 16 + 4 * lh;
          vfr[dt][c4][0] = *(const u32x2*)(Vl + (dt * 32 + l31) * 72 + kbase);
          vfr[dt][c4][1] = *(const u32x2*)(Vl + (dt * 32 + l31) * 72 + kbase + 8);
        }
      if (kt * 64 + 63 > q0) {
#pragma unroll
        for (int st = 0; st < 2; ++st)
#pragma unroll
          for (int r = 0; r < 16; ++r) { const int key = kt * 64 + st * 32 + crow(r, lh); if (key > qidx) s[st][r] = -1e30f; }
      }
      float mloc = s[0][0];
#pragma unroll
      for (int st = 0; st < 2; ++st)
#pragma unroll
        for (int r = 0; r < 16; ++r) mloc = fmaxf(mloc, s[st][r]);
      mloc = max_xor32(mloc);
      const float m_new = fmaxf(m_run, mloc);
      const float alpha = __builtin_amdgcn_exp2f(m_run - m_new);
      m_run = m_new;
      float lsum = 0.f;
#pragma unroll
      for (int st = 0; st < 2; ++st)
#pragma unroll
        for (int r = 0; r < 16; ++r) { const float e = __builtin_amdgcn_exp2f(s[st][r] - m_new); s[st][r] = e; lsum += e; }
      l_run = l_run * alpha + lsum;
#pragma unroll
      for (int r = 0; r < 16; ++r) { o0[r] *= alpha; o1[r] *= alpha; }
#pragma unroll
      for (int st = 0; st < 2; ++st)
#pragma unroll
        for (int s2 = 0; s2 < 2; ++s2) {
          u32x4 pw;
#pragma unroll
          for (int j = 0; j < 4; ++j) pw[j] = pk2(s[st][8 * s2 + 2 * j], s[st][8 * s2 + 2 * j + 1]);
          const bf16x8 pf = __builtin_bit_cast(bf16x8, pw);
          const int c4 = st * 2 + s2;
          {
            u32x4 vv; vv[0] = vfr[0][c4][0][0]; vv[1] = vfr[0][c4][0][1]; vv[2] = vfr[0][c4][1][0]; vv[3] = vfr[0][c4][1][1];
            o0 = MFMA32(__builtin_bit_cast(bf16x8, vv), pf, o0);
          }
          {
            u32x4 vv; vv[0] = vfr[1][c4][0][0]; vv[1] = vfr[1][c4][0][1]; vv[2] = vfr[1][c4][1][0]; vv[3] = vfr[1][c4][1][1];
            o1 = MFMA32(__builtin_bit_cast(bf16x8, vv), pf, o1);
          }
        }
    }
    if (more) {
      u16* Kn2 = (u16*)(smem + ((kt + 1) & 1) * 22528); u16* Vn2 = (u16*)(smem + ((kt + 1) & 1) * 22528 + 13312);
      *(u32x4*)(Kn2 + skey * 104 + schn * 8) = rk;
      if (tid < 256) *(u32x4*)(Kn2 + rkey * 104 + 64 + rchn * 8) = rr;
      *(u32x4*)(Vn2 + skey * 72 + schn * 8) = rv;
    }
    __syncthreads();
  }
  const float ltot = sum_xor32(l_run);
  const float inv = 1.f / ltot;
  float ss = 0.f;
  u16* yrow = p.y + ((size_t)b * SEQ + qidx) * 1024 + 512 + hd * 64;
#pragma unroll
  for (int g = 0; g < 4; ++g) {
    float v0[4], v1[4];
#pragma unroll
    for (int q = 0; q < 4; ++q) { v0[q] = o0[4 * g + q] * inv; v1[q] = o1[4 * g + q] * inv; ss += v0[q] * v0[q] + v1[q] * v1[q]; }
    u32x2 a; a[0] = pk2(v0[0], v0[1]); a[1] = pk2(v0[2], v0[3]);
    u32x2 c2; c2[0] = pk2(v1[0], v1[1]); c2[1] = pk2(v1[2], v1[3]);
    *(u32x2*)(yrow + 8 * g + 4 * lh) = a;
    *(u32x2*)(yrow + 32 + 8 * g + 4 * lh) = c2;
  }
  ss = sum_xor32(ss);
  if (lh == 0) unsafeAtomicAdd(p.ssq_mla + (size_t)b * SEQ + qidx, ss);
}

DI void phase2(KP p, char* smem) {
  for (int item = blockIdx.x; item < 256; item += gridDim.x) lru_item(p, smem, item);
  for (int it = blockIdx.x; it < 1024; it += gridDim.x) {
    const int j = it & 3; const int bh = it >> 2; const int hd = bh & 7; const int b = bh >> 3;
    attn_unit(p, smem, b, hd, 7 - j);
    attn_unit(p, smem, b, hd, j);
  }
}

DI void sort128_asc(unsigned& k0, unsigned& k1, int lane) {
#pragma unroll
  for (int k = 2; k <= 128; k <<= 1) {
#pragma unroll
    for (int j = k >> 1; j > 0; j >>= 1) {
      if (j == 64) {
        const unsigned lo = k0 < k1 ? k0 : k1, hi = k0 < k1 ? k1 : k0; k0 = lo; k1 = hi;
      } else {
        const unsigned o0 = (j == 1) ? lane_xor_u<1>(k0, lane) : (j == 2) ? lane_xor_u<2>(k0, lane) : (j == 4) ? lane_xor_u<4>(k0, lane) : (j == 8) ? lane_xor_u<8>(k0, lane) : (j == 16) ? lane_xor_u<16>(k0, lane) : lane_xor_u<32>(k0, lane);
        const unsigned o1 = (j == 1) ? lane_xor_u<1>(k1, lane) : (j == 2) ? lane_xor_u<2>(k1, lane) : (j == 4) ? lane_xor_u<4>(k1, lane) : (j == 8) ? lane_xor_u<8>(k1, lane) : (j == 16) ? lane_xor_u<16>(k1, lane) : lane_xor_u<32>(k1, lane);
        const bool lower = (lane & j) == 0;
        const bool asc0 = (k == 128) ? true : ((lane & k) == 0);
        const bool asc1 = (k == 128) ? true : (k == 64 ? false : ((lane & k) == 0));
        const unsigned mn0 = k0 < o0 ? k0 : o0, mx0 = k0 < o0 ? o0 : k0;
        const unsigned mn1 = k1 < o1 ? k1 : o1, mx1 = k1 < o1 ? o1 : k1;
        k0 = (asc0 == lower) ? mn0 : mx0;
        k1 = (asc1 == lower) ? mn1 : mx1;
      }
    }
  }
}
#if QBITS == 8
typedef u32x4 qrow_t;
#else
typedef u32x2 qrow_t;
#endif
constexpr int QROWB = (QBITS == 8) ? 1024 : 512;
DI void ga_load(__amdgpu_buffer_rsrc_t rs, int iv, int gl, int voff_u, int voff_v, qrow_t (&uq)[8], qrow_t (&vq)[8]) {
#pragma unroll
  for (int k = 0; k < 8; ++k) {
    const int so = __builtin_amdgcn_readlane(iv, gl + k);
#if QBITS == 8
    uq[k] = __builtin_amdgcn_raw_buffer_load_b128(rs, voff_u, so, 0);
    vq[k] = __builtin_amdgcn_raw_buffer_load_b128(rs, voff_v, so, 0);
#else
    const u32x4 rec = __builtin_amdgcn_raw_buffer_load_b128(rs, voff_u, so, 16);
    uq[k] = (u32x2){rec[0], rec[1]}; vq[k] = (u32x2){rec[2], rec[3]};
#endif
  }
}
DI unsigned qword(const qrow_t& r, int j) {
#if QBITS == 8
  return r[j];
#else
  const unsigned w0 = r[j >> 1];
  return (j & 1) ? ((w0 >> 4) & 0x0f0f0f0fu) : (w0 & 0x0f0f0f0fu);
#endif
}
#if QBITS == 8
typedef f32x2 oacc_t;
constexpr float OACC_SCALE = 1.f;
#else
typedef h16x2 oacc_t;
constexpr float OACC_SCALE = 16.f;
#endif
DI void ga_compute(float gsel, float asel, float bsel, int gl, int lane, float kt, float hscale, const unsigned (&hq)[4],
                   const qrow_t (&uq)[8], const qrow_t (&vq)[8], oacc_t (&oacc)[8], float& csum) {
  const float mg = __shfl(gsel, gl + (lane >> 3));
  const float ma = __shfl(asel, gl + (lane >> 3));
  const float mb = __shfl(bsel, gl + (lane >> 3));
  float pp[8];
#pragma unroll
  for (int k = 0; k < 8; ++k) {
#if QBITS == 8
    unsigned d = 0;
#pragma unroll
    for (int j = 0; j < 4; ++j) d = __builtin_amdgcn_udot4(qword(uq[k], j), hq[j], d, false);
#else
    unsigned dh = __builtin_amdgcn_udot8(uq[k][0], hq[0], 0u, false); dh = __builtin_amdgcn_udot8(uq[k][1], hq[1], dh, false);
    unsigned dl = __builtin_amdgcn_udot8(uq[k][0], hq[2], 0u, false); dl = __builtin_amdgcn_udot8(uq[k][1], hq[3], dl, false);
    const unsigned d = dh * 16u + dl;
#endif
    pp[k] = (float)d;
  }
  const float s1 = reduce8(pp, lane);
  const float pre = hscale * (ma * (s1 - kt) - mb);
  const float cf = mg * gelu_tanh(pre);
  csum += cf;
#if QBITS != 8
  const _Float16 cfs = (_Float16)(cf * OACC_SCALE);
  const unsigned cfp = __builtin_bit_cast(unsigned, (h16x2){cfs, cfs});
#endif
#pragma unroll
  for (int k = 0; k < 8; ++k) {
#if QBITS == 8
    const float c = __uint_as_float(__builtin_amdgcn_readlane(__float_as_uint(cf), 8 * k));
    const f32x2 cc = {c, c};
#pragma unroll
    for (int j = 0; j < 4; ++j) {
      unsigned w = qword(vq[k], j);
      asm volatile("" : "+v"(w));
      const f32x2 v0 = {(float)(w & 255u), (float)((w >> 8) & 255u)}, v1 = {(float)((w >> 16) & 255u), (float)(w >> 24)};
      oacc[2 * j] = v0 * cc + oacc[2 * j];
      oacc[2 * j + 1] = v1 * cc + oacc[2 * j + 1];
    }
#else
    const h16x2 cc = __builtin_bit_cast(h16x2, (unsigned)__builtin_amdgcn_readlane((int)cfp, 8 * k));
#pragma unroll
    for (int jd = 0; jd < 2; ++jd) {
      const unsigned w = vq[k][jd];
      oacc[4 * jd + 0] = __builtin_amdgcn_cvt_scalef32_pk_f16_fp4(w, 1.0f, 0) * cc + oacc[4 * jd + 0];
      oacc[4 * jd + 1] = __builtin_amdgcn_cvt_scalef32_pk_f16_fp4(w, 1.0f, 1) * cc + oacc[4 * jd + 1];
      oacc[4 * jd + 2] = __builtin_amdgcn_cvt_scalef32_pk_f16_fp4(w, 1.0f, 2) * cc + oacc[4 * jd + 2];
      oacc[4 * jd + 3] = __builtin_amdgcn_cvt_scalef32_pk_f16_fp4(w, 1.0f, 3) * cc + oacc[4 * jd + 3];
    }
#endif
  }
}

DI void ins16(float (&lst)[16], float x, const int P) {
#pragma unroll
  for (int i = 0; i < 16; ++i) if (i >= P) { const float hi = fmaxf(lst[i], x); x = fminf(lst[i], x); lst[i] = hi; }
}
DI void ce_desc(float& a, float& b) { const float hi = fmaxf(a, b), lo = fminf(a, b); a = hi; b = lo; }
DI void sort16_desc(float (&a)[16]) {
#define CE_(i, j) ce_desc(a[i], a[j]);
  CE_(0, 13) CE_(1, 12) CE_(2, 15) CE_(3, 14) CE_(4, 8) CE_(5, 6) CE_(7, 11) CE_(9, 10)
  CE_(0, 5) CE_(1, 7) CE_(2, 9) CE_(3, 4) CE_(6, 13) CE_(8, 14) CE_(10, 15) CE_(11, 12)
  CE_(0, 1) CE_(2, 3) CE_(4, 5) CE_(6, 8) CE_(7, 9) CE_(10, 11) CE_(12, 13) CE_(14, 15)
  CE_(0, 2) CE_(1, 3) CE_(4, 10) CE_(5, 11) CE_(6, 7) CE_(8, 9) CE_(12, 14) CE_(13, 15)
  CE_(1, 2) CE_(3, 12) CE_(4, 6) CE_(5, 7) CE_(8, 10) CE_(9, 11) CE_(13, 14)
  CE_(1, 4) CE_(2, 6) CE_(5, 8) CE_(7, 10) CE_(9, 13) CE_(11, 14)
  CE_(2, 4) CE_(3, 6) CE_(9, 12) CE_(11, 13)
  CE_(3, 5) CE_(6, 8) CE_(7, 9) CE_(10, 12)
  CE_(3, 4) CE_(5, 6) CE_(7, 8) CE_(9, 10) CE_(11, 12)
  CE_(6, 7) CE_(8, 9)
#undef CE_
}
DI void merge16_desc(float (&x)[16], const float (&y)[16]) {
#pragma unroll
  for (int i = 0; i < 16; ++i) x[i] = fmaxf(x[i], y[15 - i]);
#pragma unroll
  for (int d = 8; d >= 1; d >>= 1)
#pragma unroll
    for (int i = 0; i < 16; ++i)
      if ((i & d) == 0) ce_desc(x[i], x[i + d]);
}
DI void merge_partner(float (&lst)[16], int lane) {
  float o[16];
#pragma unroll
  for (int i = 0; i < 16; ++i) o[i] = other_xor32(lst[i], lane);
  float c[16];
#pragma unroll
  for (int i = 0; i < 16; ++i) c[i] = fmaxf(lst[i], o[15 - i]);
#pragma unroll
  for (int d = 8; d >= 1; d >>= 1) {
#pragma unroll
    for (int i = 0; i < 16; ++i) {
      if ((i & d) == 0) { const float hi = fmaxf(c[i], c[i + d]), lo = fminf(c[i], c[i + d]); c[i] = hi; c[i + d] = lo; }
    }
  }
#pragma unroll
  for (int i = 0; i < 16; ++i) lst[i] = c[i];
}

DI void phase3(KP p, char* smem) {
  const int tid = threadIdx.x, wave = __builtin_amdgcn_readfirstlane(tid >> 6);
  u16* A = (u16*)smem;
  float* ssq2 = (float*)(smem + 146944);
  signed char* A8 = (signed char*)smem;
  float* hs = (float*)(smem + 146944 + 256);
  constexpr int ELD = 132;
  int* eidx = (int*)(smem + 66560);
  float* egate = (float*)(smem + 100352);
  char* scr = p.scratch + (size_t)blockIdx.x * 655360;
  float* x1s = (float*)scr;
  u16* qp = (u16*)(scr + 262144);
  for (int tile = blockIdx.x; tile < NTOK / 64; tile += gridDim.x) {
    int lane_o = tid & 63; asm volatile("" : "+v"(lane_o));
    const int lane = lane_o, l31 = lane & 31, lh = lane >> 5;
    const int tok0 = tile * 64; const int b = tok0 / SEQ;
    const float* modb = p.mod + (size_t)b * 6144;
#pragma unroll 2
    for (int rr = 0; rr < 8; ++rr) {
      const int row = wave * 8 + rr; const int tok = tok0 + row;
      const float rl = rsqrtf(p.ssq_lru[tok] * (1.f / 512.f) + EPS), rm = rsqrtf(p.ssq_mla[tok] * (1.f / 512.f) + EPS);
#pragma unroll
      for (int i = 0; i < 2; ++i) {
        const u32x4 v = *(const u32x4*)(p.y + (size_t)tok * 1024 + (i * 64 + lane) * 8);
        const float sc = i == 0 ? rl : rm;
        u32x4 o;
#pragma unroll
        for (int j = 0; j < 4; ++j) o[j] = pk2(bflo(v[j]) * sc, bfhi(v[j]) * sc);
        *(u32x4*)(A + row * LDA + (i * 64 + lane) * 8) = o;
      }
    }
    __syncthreads();
    bf16x8 ring3[8][2];
    { const int tl0[2] = {wave, wave + 8}; gemm_pro<2, 8>(p.Wf_out, 64, tl0, lane, ring3); }
#pragma unroll 1
    for (int pass = 0; pass < 2; ++pass) {
      f32x16 acc[2][2];
#pragma unroll
      for (int t = 0; t < 2; ++t) { acc[t][0] = zero16(); acc[t][1] = zero16(); }
      const int tl[2] = {pass * 16 + wave, pass * 16 + wave + 8};
      gemm_main<2, 8, false, true>(A, LDA, 64, p.Wf_out, 64, tl, acc, lane, ring3);
      if (pass == 0) { const int tn[2] = {16 + wave, 16 + wave + 8}; gemm_pro<2, 8>(p.Wf_out, 64, tn, lane, ring3); }
      int el_ = lane; asm volatile("" : "+v"(el_));
      const int l31 = el_ & 31, lh = el_ >> 5;
      float g1[2];
#pragma unroll
      for (int t = 0; t < 2; ++t) g1[t] = modb[2048 + tl[t] * 32 + l31];
#pragma unroll
      for (int rt = 0; rt < 2; ++rt)
#pragma unroll
        for (int r = 0; r < 16; ++r) {
          const int row = rt * 32 + crow(r, lh);
#pragma unroll
          for (int t = 0; t < 2; ++t) {
            const int col = tl[t] * 32 + l31;
            x1s[row * 1024 + col] = g1[t] * acc[t][rt][r];
          }
        }
    }
    __syncthreads();
    {
      f32x4 cm[4], ca[4];
#pragma unroll
      for (int i = 0; i < 4; ++i) {
        const int col = (i >> 1) * 512 + lane * 8 + (i & 1) * 4;
        const f32x4 g = *(const f32x4*)(p.norm2_g + col); const f32x4 sc = *(const f32x4*)(modb + 4096 + col);
        cm[i] = g * (sc + 1.0f); ca[i] = *(const f32x4*)(modb + 3072 + col);
      }
#pragma unroll 2
      for (int rr = 0; rr < 8; ++rr) {
        const int row = wave * 8 + rr;
        f32x4 x1v[4];
        float ss = 0.f;
#pragma unroll
        for (int i = 0; i < 2; ++i) {
          float* xr = x1s + row * 1024 + i * 512 + lane * 8;
          const float* xg = p.x + (size_t)(tok0 + row) * DM + i * 512 + lane * 8;
          x1v[2 * i] = *(const f32x4*)xr + *(const f32x4*)xg; x1v[2 * i + 1] = *(const f32x4*)(xr + 4) + *(const f32x4*)(xg + 4);
          *(f32x4*)xr = x1v[2 * i]; *(f32x4*)(xr + 4) = x1v[2 * i + 1];
#pragma unroll
          for (int j = 0; j < 4; ++j) ss += x1v[2 * i][j] * x1v[2 * i][j] + x1v[2 * i + 1][j] * x1v[2 * i + 1][j];
        }
        ss = wave_sum(ss);
        const float rs = rsqrtf(ss * (1.f / 1024.f) + EPS);
        f32x4 hv[4];
        float hmax = 0.f;
#pragma unroll
        for (int i = 0; i < 2; ++i) {
          const f32x4 xa = x1v[2 * i], xb = x1v[2 * i + 1];
          hv[2 * i] = xa * rs * cm[2 * i] + ca[2 * i]; hv[2 * i + 1] = xb * rs * cm[2 * i + 1] + ca[2 * i + 1];
#pragma unroll
          for (int j = 0; j < 4; ++j) hmax = fmaxf(hmax, fmaxf(fabsf(hv[2 * i][j]), fabsf(hv[2 * i + 1][j])));
        }
        hmax = wave_max(hmax);
        const float hinv = hmax > 0.f ? 127.f / hmax : 0.f;
#pragma unroll
        for (int i = 0; i < 2; ++i) {
          u32x2 o;
#pragma unroll
          for (int hh = 0; hh < 2; ++hh) {
            unsigned w = 0;
#pragma unroll
            for (int j = 0; j < 4; ++j) w |= ((unsigned)(int)__builtin_rintf(hv[2 * i + hh][j] * hinv) & 255u) << (8 * j);
            o[hh] = w;
          }
          *(u32x2*)(A8 + row * LDA8 + i * 512 + lane * 8) = o;
        }
        if (lane == 0) hs[row] = hmax * (1.f / 127.f);
      }
    }
    __syncthreads();
    float s12[2][16];
    i32x4 ring8[8][2];
    { const int t0[2] = {wave * 8, wave * 8 + 1}; gemm8_pro<2, 8>(p.Wf_s, 32, t0, lane, ring8); }
#pragma unroll 1
    for (int ph = 0; ph < 2; ++ph) {
      const int hd = wave;
      float lst0[16], lst1[16];
#pragma unroll
      for (int i = 0; i < 16; ++i) { lst0[i] = -3.0e38f; lst1[i] = -3.0e38f; }
#pragma unroll 1
      for (int mtp = 0; mtp < 2; ++mtp) {
        i32x16 acc[2][2];
#pragma unroll
        for (int t = 0; t < 2; ++t)
#pragma unroll
          for (int r = 0; r < 16; ++r) { acc[t][0][r] = 0; acc[t][1][r] = 0; }
        const int tl[2] = {(hd * 2 + ph) * 4 + 2 * mtp, (hd * 2 + ph) * 4 + 2 * mtp + 1};
        gemm8_main<2, 8>(A8, LDA8, 32, p.Wf_s, 32, tl, acc, lane, ring8);
        if (ph * 2 + mtp < 3) { const int pn = ph * 2 + mtp + 1; const int tn[2] = {wave * 8 + 2 * pn, wave * 8 + 2 * pn + 1}; gemm8_pro<2, 8>(p.Wf_s, 32, tn, lane, ring8); }
        int el_ = lane; asm volatile("" : "+v"(el_));
        const int lh = el_ >> 5;
#pragma unroll
        for (int t = 0; t < 2; ++t) {
          f32x4 w4[4];
#pragma unroll
          for (int g = 0; g < 4; ++g) w4[g] = *(const f32x4*)(p.wsc + tl[t] * 32 + 8 * g + 4 * lh);
          float nv[16];
#pragma unroll
          for (int r = 0; r < 16; ++r) nv[r] = __uint_as_float((__float_as_uint((float)acc[t][0][r] * w4[r >> 2][r & 3]) & 0xffffff80u) | (unsigned)((2 * mtp + t) * 32 + crow(r, lh)));
          sort16_desc(nv);
          if (t == 0 && mtp == 0) {
#pragma unroll
            for (int r = 0; r < 16; ++r) lst0[r] = nv[r];
          } else merge16_desc(lst0, nv);
#pragma unroll
          for (int r = 0; r < 16; ++r) nv[r] = __uint_as_float((__float_as_uint((float)acc[t][1][r] * w4[r >> 2][r & 3]) & 0xffffff80u) | (unsigned)((2 * mtp + t) * 32 + crow(r, lh)));
          sort16_desc(nv);
          if (t == 0 && mtp == 0) {
#pragma unroll
            for (int r = 0; r < 16; ++r) lst1[r] = nv[r];
          } else merge16_desc(lst1, nv);
        }
      }
      merge_partner(lst0, lane);
      merge_partner(lst1, lane);
      if (ph == 0) {
#pragma unroll
        for (int i = 0; i < 16; ++i) s12[0][i] = lh ? lst1[i] : lst0[i];
      } else {
#pragma unroll
        for (int i = 0; i < 16; ++i) s12[1][i] = lh ? lst1[i] : lst0[i];
      }
    }
    {
      const int hd = wave;
      unsigned long long t1lo = 0, t1hi = 0, t2lo = 0, t2hi = 0;
#pragma unroll
      for (int i = 0; i < 8; ++i) {
        t1lo |= (unsigned long long)(__float_as_uint(s12[0][i]) & 127u) << (8 * i);
        t1hi |= (unsigned long long)(__float_as_uint(s12[0][8 + i]) & 127u) << (8 * i);
        t2lo |= (unsigned long long)(__float_as_uint(s12[1][i]) & 127u) << (8 * i);
        t2hi |= (unsigned long long)(__float_as_uint(s12[1][8 + i]) & 127u) << (8 * i);
      }
      const float hst = hs[lh * 32 + l31];
      float bv[16];
#pragma unroll
      for (int j = 0; j < 16; ++j) {
        const float sv = (s12[0][0] + s12[1][j]) * hst;
        bv[j] = __uint_as_float((__float_as_uint(sv) & 0xffffff00u) | (unsigned)j);
      }
#pragma unroll
      for (int i = 1; i < 16; ++i) {
#pragma unroll
        for (int j = 0; j < 16; ++j)
          if ((i + 1) * (j + 1) <= 16) {
            const float sv = (s12[0][i] + s12[1][j]) * hst;
            ins16(bv, __uint_as_float((__float_as_uint(sv) & 0xffffff00u) | (unsigned)(i * 16 + j)), (i + 1) * (j + 1) - 1);
          }
      }
      int bi[16];
#pragma unroll
      for (int k = 0; k < 16; ++k) {
        const unsigned code = __float_as_uint(bv[k]) & 255u;
        const unsigned ci = code >> 4, cj = code & 15u;
        const unsigned long long w1 = (ci & 8u) ? t1hi : t1lo, w2 = (cj & 8u) ? t2hi : t2lo;
        const unsigned i1 = (unsigned)(w1 >> ((ci & 7u) * 8)) & 0xffu, i2 = (unsigned)(w2 >> ((cj & 7u) * 8)) & 0xffu;
        bi[k] = (int)(i1 * 128u + i2);
      }
      float esum = 0.f, ev[16];
#pragma unroll
      for (int i = 0; i < 16; ++i) { ev[i] = __expf(bv[i] - bv[0]); esum += ev[i]; }
      const float einv = 1.f / esum;
      {
        const int row = lh * 32 + l31;
#pragma unroll
        for (int i4 = 0; i4 < 4; ++i4) {
          *(i32x4*)(eidx + row * ELD + hd * 16 + i4 * 4) = (i32x4){bi[i4 * 4], bi[i4 * 4 + 1], bi[i4 * 4 + 2], bi[i4 * 4 + 3]};
          *(f32x4*)(egate + row * ELD + hd * 16 + i4 * 4) = (f32x4){ev[i4 * 4] * einv, ev[i4 * 4 + 1] * einv, ev[i4 * 4 + 2] * einv, ev[i4 * 4 + 3] * einv};
        }
      }
    }
    __syncthreads();
    const __amdgpu_buffer_rsrc_t qrs = __builtin_amdgcn_make_buffer_rsrc((void*)p.Uq, 0, 2 * 16384 * QROWB, 0x00020000);
    const int voff_u = (QBITS == 8) ? lane * 16 : lane * 16, voff_v = voff_u + 16384 * QROWB;
    int n_ia, n_ib; float n_ga, n_gb, n_ua, n_ub, n_ba, n_bb, n_kt, n_hscale; unsigned n_hq[4];
    qrow_t bufA_u[8], bufA_v[8], bufB_u[8], bufB_v[8];
#define GA_PREP(ROW)                                                                                                              \
    {                                                                                                                             \
      const int prow = (ROW);                                                                                                     \
      n_ia = eidx[prow * ELD + lane]; n_ib = eidx[prow * ELD + 64 + lane];                                                        \
      n_ga = egate[prow * ELD + lane]; n_gb = egate[prow * ELD + 64 + lane];                                                      \
      {     \
        unsigned k0 = ((unsigned)n_ia << 7) | (unsigned)lane, k1 = ((unsigned)n_ib << 7) | (unsigned)(64 + lane);                 \
        sort128_asc(k0, k1, lane);                                                                                                \
        const int p0 = (int)(k0 & 127u), p1 = (int)(k1 & 127u);                                                                   \
        const f32x4 sa = ((const f32x4*)p.uscale)[k0 >> 7], sb = ((const f32x4*)p.uscale)[k1 >> 7];        \
        const float ga0 = __shfl(n_ga, p0 & 63), gb0 = __shfl(n_gb, p0 & 63), ga1 = __shfl(n_ga, p1 & 63), gb1 = __shfl(n_gb, p1 & 63); \
        n_ia = (int)(k0 >> 7) * (QBITS == 8 ? QROWB : 2 * QROWB); n_ib = (int)(k1 >> 7) * (QBITS == 8 ? QROWB : 2 * QROWB);       \
        n_ga = ((p0 & 64) ? gb0 : ga0) * sa[1]; n_gb = ((p1 & 64) ? gb1 : ga1) * sb[1];                                           \
        n_ua = sa[0]; n_ub = sb[0]; n_ba = sa[2]; n_bb = sb[2];                                                                   \
      }                                                                                                                           \
      u32x4 hc = *(const u32x4*)(A8 + prow * LDA8 + lane * 16);        \
      _Pragma("unroll") for (int j = 0; j < 4; ++j) hc[j] ^= 0x80808080u;                                                         \
      n_hscale = hs[prow];                                                                                                        \
      unsigned hsi = 0;                                                                                                           \
      _Pragma("unroll") for (int j = 0; j < 4; ++j) hsi = __builtin_amdgcn_udot4(hc[j], 0x01010101u, hsi, false);                 \
      const float hsum = (float)hsi;                                                                                              \
      if (QBITS == 8) {                                                                                                           \
        _Pragma("unroll") for (int j = 0; j < 4; ++j) n_hq[j] = hc[j];                                                            \
      } else {               \
        _Pragma("unroll") for (int jd = 0; jd < 2; ++jd) {                                                                        \
          n_hq[jd] = ((hc[2 * jd] >> 4) & 0x0f0f0f0fu) | (hc[2 * jd + 1] & 0xf0f0f0f0u);                                          \
          n_hq[2 + jd] = (hc[2 * jd] & 0x0f0f0f0fu) | ((hc[2 * jd + 1] & 0x0f0f0f0fu) << 4);                                      \
        }                                                                                                                         \
      }                                                                                                                           \
      n_kt = (QBITS == 8 ? 128.f : 7.5f) * (wave_sum(hsum) - 131072.f);                                                           \
    }
    GA_PREP(wave)
    ga_load(qrs, n_ia, 0, voff_u, voff_v, bufA_u, bufA_v);
#pragma unroll 1
    for (int rr = 0; rr < 8; ++rr) {
      const int row = rr * 8 + wave; const int tok = tok0 + row;
      const int ia = n_ia, ib = n_ib; const float ga = n_ga, gb = n_gb, ua = n_ua, ub = n_ub, ba = n_ba, bb = n_bb, kt = n_kt, hscale = n_hscale;
      unsigned hq[4];
#pragma unroll
      for (int j = 0; j < 4; ++j) hq[j] = n_hq[j];
      f32x4 xv4[4];
#pragma unroll
      for (int q = 0; q < 4; ++q) xv4[q] = *(const f32x4*)(x1s + row * 1024 + lane * 16 + q * 4);
      if (rr + 1 < 8) GA_PREP(row + 8)
      oacc_t oacc[8];
#pragma unroll
      for (int j = 0; j < 8; ++j) { oacc[j][0] = 0; oacc[j][1] = 0; }
      float csum = 0.f;
#pragma unroll 1
      for (int half = 0; half < 2; ++half) {
        const int iv = half ? ib : ia, ivn = half ? n_ia : ib;
        const float gs = half ? gb : ga, us = half ? ub : ua, bs = half ? bb : ba;
        const bool has_next = (half == 0) || (rr + 1 < 8);
#pragma unroll 1
        for (int g8 = 0; g8 < 8; g8 += 2) {
          ga_load(qrs, iv, (g8 + 1) * 8, voff_u, voff_v, bufB_u, bufB_v);
          ga_compute(gs, us, bs, g8 * 8, lane, kt, hscale, hq, bufA_u, bufA_v, oacc, csum);
          if (g8 + 2 < 8) ga_load(qrs, iv, (g8 + 2) * 8, voff_u, voff_v, bufA_u, bufA_v);
          else if (has_next) ga_load(qrs, ivn, 0, voff_u, voff_v, bufA_u, bufA_v);
          ga_compute(gs, us, bs, (g8 + 1) * 8, lane, kt, hscale, hq, bufB_u, bufB_v, oacc, csum);
        }
      }
      {
#if QBITS == 8
        const float corr = wave_sum(csum) * (128.f / 8.f);
#pragma unroll
        for (int j = 0; j < 8; ++j) oacc[j] = oacc[j] - corr;
#endif
      }
      float xo[16]; float ss = 0.f;
#pragma unroll
      for (int q = 0; q < 4; ++q) {
        const int col = lane * 16 + q * 4;
        const f32x4 xv = xv4[q];
        const f32x4 g2 = *(const f32x4*)(modb + 5120 + col);
#pragma unroll
        for (int j = 0; j < 4; ++j) { const float v = xv[j] + g2[j] * ((float)oacc[q * 2 + (j >> 1)][j & 1] * (1.f / OACC_SCALE)); xo[q * 4 + j] = v; ss += v * v; }
      }
      ss = wave_sum(ss);
      const float rs = rsqrtf(ss * (1.f / 1024.f) + EPS);
#pragma unroll
      for (int q = 0; q < 4; ++q) {
        const int col = lane * 16 + q * 4;
        const f32x4 fg = *(const f32x4*)(p.final_g + col);
        f32x4 o;
#pragma unroll
        for (int j = 0; j < 4; ++j) o[j] = xo[q * 4 + j] * rs * fg[j];
        *(f32x4*)(p.out + (size_t)tok * DM + col) = o;
      }
    }
#undef GA_PREP
    __syncthreads();
  }
}

template <int MODE>
__global__ void __launch_bounds__(NTHREADS) mk_fwd(Params p) {
  extern __shared__ __attribute__((aligned(16))) char smem[];
  if (MODE < 0) {
    cg::grid_group grid = cg::this_grid();
    typedef const __attribute__((address_space(4))) Params* KPP;
    { KPP kp = (KPP)__builtin_amdgcn_kernarg_segment_ptr(); asm volatile("" : "+s"(kp)); phase0(*kp, smem); }
    grid.sync();
    { KPP kp = (KPP)__builtin_amdgcn_kernarg_segment_ptr(); asm volatile("" : "+s"(kp)); phase1(*kp, smem); }
    grid.sync();
    { KPP kp = (KPP)__builtin_amdgcn_kernarg_segment_ptr(); asm volatile("" : "+s"(kp)); phase2(*kp, smem); }
    grid.sync();
    { KPP kp = (KPP)__builtin_amdgcn_kernarg_segment_ptr(); asm volatile("" : "+s"(kp)); phase3(*kp, smem); }
#ifdef PROBE_P3X2
    grid.sync();
    phase3(p, smem);
#endif
#ifdef PROBE_P1X2
    grid.sync();
    phase1(p, smem);
#endif
  } else {
    typedef const __attribute__((address_space(4))) Params* KPP;
    KPP kp = (KPP)__builtin_amdgcn_kernarg_segment_ptr();
    if (MODE == 0) phase0(*kp, smem);
    if (MODE == 1) phase1(*kp, smem);
    if (MODE == 2) phase2(*kp, smem);
    if (MODE == 3) phase3(*kp, smem);
  }
}

static size_t align_up(size_t v) { return (v + 255) & ~(size_t)255; }

extern "C" void kernel_launch(void* const* d_in, const int* in_sizes, int n_in, void* d_out, int out_size, void* d_ws, size_t ws_size, hipStream_t stream) {
  static int grid = 0;
  if (grid == 0) {
    int dev = 0, cus = 0, per_cu = 0;
    (void)hipGetDevice(&dev);
    (void)hipDeviceGetAttribute(&cus, hipDeviceAttributeMultiprocessorCount, dev);
#if N_LAUNCH_MODE == 1
    (void)hipFuncSetAttribute((const void*)mk_fwd<-1>, hipFuncAttributeMaxDynamicSharedMemorySize, LDS_BYTES);
    (void)hipOccupancyMaxActiveBlocksPerMultiprocessor(&per_cu, (const void*)mk_fwd<-1>, NTHREADS, LDS_BYTES);
#else
    (void)hipFuncSetAttribute((const void*)mk_fwd<0>, hipFuncAttributeMaxDynamicSharedMemorySize, LDS_BYTES);
    (void)hipFuncSetAttribute((const void*)mk_fwd<1>, hipFuncAttributeMaxDynamicSharedMemorySize, LDS_BYTES);
    (void)hipFuncSetAttribute((const void*)mk_fwd<2>, hipFuncAttributeMaxDynamicSharedMemorySize, LDS_BYTES);
    (void)hipFuncSetAttribute((const void*)mk_fwd<3>, hipFuncAttributeMaxDynamicSharedMemorySize, LDS_BYTES);
    (void)hipOccupancyMaxActiveBlocksPerMultiprocessor(&per_cu, (const void*)mk_fwd<3>, NTHREADS, LDS_BYTES);
#endif
    if (per_cu < 1) { fprintf(stderr, "kernel_launch: occupancy query says %d blocks/CU\n", per_cu); per_cu = 1; }
    if (per_cu > 1) per_cu = 1;
    grid = cus * per_cu;
    if (grid > 256) grid = 256;
    (void)hipGetLastError();
  }
  Params p{};
  const float* const* fin = (const float* const*)d_in;
  p.x = fin[0]; p.c = fin[1]; p.pos = (const int*)d_in[2];
  p.w_ada = fin[3]; p.b_ada = fin[4]; p.norm1_g = fin[5]; p.w_in = fin[6]; p.conv_w = fin[7]; p.conv_b = fin[8];
  p.lru_wa = fin[9]; p.lru_ba = fin[10]; p.lru_wx = fin[11]; p.lru_bx = fin[12]; p.lru_lambda = fin[13];
  p.q_norm_g = fin[14]; p.w_uq = fin[15]; p.kv_norm_g = fin[16]; p.w_ukv = fin[17]; p.lru_out_g = fin[18]; p.mla_out_g = fin[19];
  p.w_out = fin[20]; p.norm2_g = fin[21]; p.peer_wq = fin[22]; p.peer_keys = fin[23]; p.peer_u = fin[24]; p.peer_v = fin[25]; p.final_g = fin[26];
  p.out = (float*)d_out;
  char* w = (char*)d_ws; size_t off = 0;
  auto take = [&](size_t bytes) { char* r = w + off; off = align_up(off + bytes); return r; };
  p.mod = (float*)take((size_t)NB * 6144 * 4);
  p.ssq_lru = (float*)take((size_t)NTOK * 4);
  p.ssq_mla = (float*)take((size_t)NTOK * 4);
  p.invfreq = (double*)take(16 * 8);
  p.Wf_in = (bf16x8*)take((size_t)INW * 1024 * 2);
  p.Wf_uq = (bf16x8*)take((size_t)768 * 256 * 2);
  p.Wf_ukv = (bf16x8*)take((size_t)1024 * 128 * 2);
  p.Wf_a = (bf16x8*)take((size_t)8 * 64 * 64 * 2);
  p.Wf_x = (bf16x8*)take((size_t)8 * 64 * 64 * 2);
  p.Wf_out = (bf16x8*)take((size_t)1024 * 1024 * 2);
  p.Wf_s = (i32x4*)take((size_t)2048 * 1024);
  p.Wsf = (float*)take((size_t)2048 * 1024 * 4);
  p.wsmaxp = (float*)take((size_t)2048 * 16 * 4);
  p.wsc = (float*)take((size_t)2048 * 4);
  p.Uq = (unsigned char*)take((size_t)2 * 16384 * QROWB);
  p.Vq = p.Uq + (size_t)16384 * QROWB;
  p.uscale = (float*)take((size_t)16384 * 16);
  p.vscale = p.uscale; p.ubias = p.uscale;
  p.xlru = (u16*)take((size_t)NTOK * 512 * 2);
  p.gate = (u16*)take((size_t)NTOK * 512 * 2);
  p.Q = (u16*)take((size_t)NTOK * 768 * 2);
  p.Kn = (u16*)take((size_t)NTOK * 512 * 2);
  p.Kr = (u16*)take((size_t)NTOK * 32 * 2);
  p.Vt = (u16*)take((size_t)NTOK * 512 * 2);
  p.y = (u16*)take((size_t)NTOK * 1024 * 2);
  p.scratch = take((size_t)256 * 655360);
  if (off > ws_size) { fprintf(stderr, "kernel_launch: workspace too small: need %zu have %zu\n", off, ws_size); return; }
#if N_LAUNCH_MODE == 1
  void* args[] = {&p};
  hipError_t e = hipLaunchCooperativeKernel((const void*)mk_fwd<-1>, dim3(grid), dim3(NTHREADS), args, LDS_BYTES, stream);
  if (e != hipSuccess) fprintf(stderr, "cooperative launch failed: %s (grid %d)\n", hipGetErrorString(e), grid);
#else
  hipLaunchKernelGGL(mk_fwd<0>, dim3(grid), dim3(NTHREADS), LDS_BYTES, stream, p);
  hipLaunchKernelGGL(mk_fwd<1>, dim3(grid), dim3(NTHREADS), LDS_BYTES, stream, p);
  hipLaunchKernelGGL(mk_fwd<2>, dim3(grid), dim3(NTHREADS), LDS_BYTES, stream, p);
  hipLaunchKernelGGL(mk_fwd<3>, dim3(grid), dim3(NTHREADS), LDS_BYTES, stream, p);
#endif
}
```

```cpp
#include <hip/hip_runtime.h>
#include <hip/hip_cooperative_groups.h>
#include <cstdio>
#include <cstdint>
namespace cg = cooperative_groups;

#ifndef QBITS
#define QBITS 4
#endif
#ifndef N_LAUNCH_MODE
#define N_LAUNCH_MODE 1
#endif

typedef short bf16x8 __attribute__((ext_vector_type(8)));
typedef float f32x16 __attribute__((ext_vector_type(16)));
typedef float f32x4 __attribute__((ext_vector_type(4)));
typedef float f32x2 __attribute__((ext_vector_type(2)));
typedef unsigned u32x4 __attribute__((ext_vector_type(4)));
typedef unsigned u32x2 __attribute__((ext_vector_type(2)));
typedef __bf16 bf16x2_t __attribute__((ext_vector_type(2)));
typedef unsigned short u16;
typedef _Float16 h16x2 __attribute__((ext_vector_type(2)));

#define DI __device__ __forceinline__
#define MFMA32(a, b, c) __builtin_amdgcn_mfma_f32_32x32x16_bf16((a), (b), (c), 0, 0, 0)
typedef int i32x4 __attribute__((ext_vector_type(4)));
typedef int i32x16 __attribute__((ext_vector_type(16)));
#define MFMA8(a, b, c) __builtin_amdgcn_mfma_i32_32x32x32_i8((a), (b), (c), 0, 0, 0)

constexpr int NB = 32, SEQ = 2048, DM = 1024, NTOK = NB * SEQ;
constexpr int INW = 1440;
constexpr int NTHREADS = 512;
constexpr int LDA = 1032;
constexpr int LDA8 = 1040;
constexpr int LDS_BYTES = 147456;
constexpr float EPS = 1e-6f;

struct Params {
  const float* x; const float* c; const int* pos;
  const float* w_ada; const float* b_ada; const float* norm1_g; const float* w_in; const float* conv_w; const float* conv_b;
  const float* lru_wa; const float* lru_ba; const float* lru_wx; const float* lru_bx; const float* lru_lambda;
  const float* q_norm_g; const float* w_uq; const float* kv_norm_g; const float* w_ukv; const float* lru_out_g; const float* mla_out_g;
  const float* w_out; const float* norm2_g; const float* peer_wq; const float* peer_keys; const float* peer_u; const float* peer_v; const float* final_g;
  float* out;
  float* mod; float* ssq_lru; float* ssq_mla; double* invfreq;
  bf16x8* Wf_in; bf16x8* Wf_uq; bf16x8* Wf_ukv; bf16x8* Wf_a; bf16x8* Wf_x; bf16x8* Wf_out; i32x4* Wf_s;
  float* Wsf; float* wsmaxp; float* wsc;
  unsigned char* Uq; unsigned char* Vq; float* uscale; float* vscale; float* ubias; u16* xlru; u16* gate; u16* Q; u16* Kn; u16* Kr; u16* Vt; u16* y;
  char* scratch;
};

typedef const __attribute__((address_space(4))) Params& KP;

DI unsigned pk2(float a, float b) { f32x2 v = {a, b}; bf16x2_t r = __builtin_convertvector(v, bf16x2_t); return __builtin_bit_cast(unsigned, r); }
DI u16 f2bf(float a) { return (u16)(pk2(a, 0.f) & 0xffffu); }
DI float bflo(unsigned u) { return __uint_as_float(u << 16); }
DI float bfhi(unsigned u) { return __uint_as_float(u & 0xffff0000u); }
DI float bf2f(u16 h) { return __uint_as_float(((unsigned)h) << 16); }
template <int CTRL> DI float dppf(float v) { return __builtin_bit_cast(float, __builtin_amdgcn_update_dpp(0, __builtin_bit_cast(int, v), CTRL, 0xF, 0xF, true)); }
typedef unsigned u32x2_ __attribute__((ext_vector_type(2)));
DI float wave_sum(float v) {
  v += dppf<0xB1>(v); v += dppf<0x4E>(v); v += dppf<0x141>(v); v += dppf<0x140>(v);
  u32x2_ r = __builtin_amdgcn_permlane16_swap(__float_as_uint(v), __float_as_uint(v), false, false); v = __uint_as_float(r[0]) + __uint_as_float(r[1]);
  r = __builtin_amdgcn_permlane32_swap(__float_as_uint(v), __float_as_uint(v), false, false); v = __uint_as_float(r[0]) + __uint_as_float(r[1]);
  return v;
}
DI float wave_max(float v) {
  v = fmaxf(v, dppf<0xB1>(v)); v = fmaxf(v, dppf<0x4E>(v)); v = fmaxf(v, dppf<0x141>(v)); v = fmaxf(v, dppf<0x140>(v));
  u32x2_ r = __builtin_amdgcn_permlane16_swap(__float_as_uint(v), __float_as_uint(v), false, false); v = fmaxf(__uint_as_float(r[0]), __uint_as_float(r[1]));
  r = __builtin_amdgcn_permlane32_swap(__float_as_uint(v), __float_as_uint(v), false, false); v = fmaxf(__uint_as_float(r[0]), __uint_as_float(r[1]));
  return v;
}
template <int CTRL> DI unsigned dppu(unsigned v) { return (unsigned)__builtin_amdgcn_update_dpp(0, (int)v, CTRL, 0xF, 0xF, true); }
template <int J> DI unsigned lane_xor_u(unsigned v, int lane) {
  if (J == 1) return dppu<0xB1>(v);
  if (J == 2) return dppu<0x4E>(v);
  if (J == 4) return dppu<0x141>(dppu<0x1B>(v));
  if (J == 8) return dppu<0x128>(v);
  if (J == 16) { const u32x2_ r = __builtin_amdgcn_permlane16_swap(v, v, false, false); return (lane & 16) ? r[0] : r[1]; }
  const u32x2_ r = __builtin_amdgcn_permlane32_swap(v, v, false, false); return (lane & 32) ? r[0] : r[1];
}
template <int J> DI float lane_xor_f(float v, int lane) { return __uint_as_float(lane_xor_u<J>(__float_as_uint(v), lane)); }
DI float sum_xor32(float v) { const u32x2_ r = __builtin_amdgcn_permlane32_swap(__float_as_uint(v), __float_as_uint(v), false, false); return __uint_as_float(r[0]) + __uint_as_float(r[1]); }
DI float max_xor32(float v) { const u32x2_ r = __builtin_amdgcn_permlane32_swap(__float_as_uint(v), __float_as_uint(v), false, false); return fmaxf(__uint_as_float(r[0]), __uint_as_float(r[1])); }
DI float other_xor32(float v, int lane) { const u32x2_ r = __builtin_amdgcn_permlane32_swap(__float_as_uint(v), __float_as_uint(v), false, false); return __uint_as_float((lane & 32) ? r[0] : r[1]); }
DI float reduce8(const float (&v)[8], int lane) {
  float q4[4], r2[2];
#pragma unroll
  for (int j = 0; j < 4; ++j) {
    const u32x2_ r = __builtin_amdgcn_permlane32_swap(__float_as_uint(v[j]), __float_as_uint(v[4 + j]), false, false);
    q4[j] = __uint_as_float(r[0]) + __uint_as_float(r[1]);
  }
#pragma unroll
  for (int j = 0; j < 2; ++j) {
    const u32x2_ r = __builtin_amdgcn_permlane16_swap(__float_as_uint(q4[j]), __float_as_uint(q4[2 + j]), false, false);
    r2[j] = __uint_as_float(r[0]) + __uint_as_float(r[1]);
  }
  const float s0 = r2[0] + dppf<0x128>(r2[0]), s1b = r2[1] + dppf<0x128>(r2[1]);
  float s1 = (lane & 8) ? s1b : s0;
  s1 += dppf<0xB1>(s1);
  s1 += dppf<0x4E>(s1);
  s1 += dppf<0x141>(s1);
  return s1;
}
DI float reduce32(const float (&v)[32], int lane) {
  const bool b3 = (lane & 8) != 0, b2 = (lane & 4) != 0, b1 = (lane & 2) != 0, b0 = (lane & 1) != 0;
  float a16[16], a8[8], a4[4], a2[2];
#pragma unroll
  for (int j = 0; j < 16; ++j) {
    const u32x2_ r = __builtin_amdgcn_permlane16_swap(__float_as_uint(v[j]), __float_as_uint(v[16 + j]), false, false);
    a16[j] = __uint_as_float(r[0]) + __uint_as_float(r[1]);
  }
#pragma unroll
  for (int j = 0; j < 8; ++j) { const float keep = b3 ? a16[8 + j] : a16[j], send = b3 ? a16[j] : a16[8 + j]; a8[j] = keep + lane_xor_f<8>(send, lane); }
#pragma unroll
  for (int j = 0; j < 4; ++j) { const float keep = b2 ? a8[4 + j] : a8[j], send = b2 ? a8[j] : a8[4 + j]; a4[j] = keep + lane_xor_f<4>(send, lane); }
#pragma unroll
  for (int j = 0; j < 2; ++j) { const float keep = b1 ? a4[2 + j] : a4[j], send = b1 ? a4[j] : a4[2 + j]; a2[j] = keep + lane_xor_f<2>(send, lane); }
  const float keep = b0 ? a2[1] : a2[0], send = b0 ? a2[0] : a2[1];
  return keep + lane_xor_f<1>(send, lane);
}
DI float sigmoidf_(float x) { return __builtin_amdgcn_rcpf(1.f + __builtin_amdgcn_exp2f(-1.4426950408889634f * x)); }
DI float gelu_tanh(float x) { const float u = 0.7978845608028654f * (x + 0.044715f * x * x * x); return x * __builtin_amdgcn_rcpf(1.f + __builtin_amdgcn_exp2f(-2.f * 1.4426950408889634f * u)); }
DI float one_minus_exp_small(float z) {
  float q = 1.f + z * (1.f / 6.f);
  q = 1.f + z * (1.f / 5.f) * q;
  q = 1.f + z * (1.f / 4.f) * q;
  q = 1.f + z * (1.f / 3.f) * q;
  q = 1.f + z * (1.f / 2.f) * q;
  return -z * q;
}
DI f32x16 zero16() { f32x16 z; for (int i = 0; i < 16; ++i) z[i] = 0.f; return z; }
DI int crow(int reg, int h) { return (reg & 3) + 8 * (reg >> 2) + 4 * h; }

template <int NT, int PD>
DI void gemm_pro(const bf16x8* __restrict__ Wf, int KS, const int (&tile)[NT], int lane, bf16x8 (&bq)[PD][NT]) {
#pragma unroll
  for (int d = 0; d < PD; ++d)
#pragma unroll
    for (int t = 0; t < NT; ++t) bq[d][t] = Wf[((size_t)tile[t] * KS + d) * 64 + lane];
}
template <int NT, int PD, bool SWAP, bool APF = false>
DI void gemm_main(const u16* As, int lda, int nks, const bf16x8* __restrict__ Wf, int KS, const int (&tile)[NT], f32x16 (&acc)[NT][2], int lane, bf16x8 (&bq)[PD][NT]) {
  const bf16x8* a0p = (const bf16x8*)(As + (lane & 31) * lda + 8 * (lane >> 5));
  const bf16x8* a1p = (const bf16x8*)(As + ((lane & 31) + 32) * lda + 8 * (lane >> 5));
  const bf16x8* bp[NT];
#pragma unroll
  for (int t = 0; t < NT; ++t) bp[t] = Wf + (size_t)tile[t] * KS * 64 + lane;
  bf16x8 a0n = a0p[0], a1n = a1p[0];
#pragma unroll 1
  for (int ks = 0; ks < nks; ks += PD) {
#pragma unroll
    for (int d = 0; d < PD; ++d) {
      bf16x8 a0, a1;
      if (APF) { a0 = a0n; a1 = a1n; const int ka = (ks + d + 1 < nks) ? (ks + d + 1) : (ks + d); a0n = a0p[2 * ka]; a1n = a1p[2 * ka]; }
      else { a0 = a0p[2 * (ks + d)]; a1 = a1p[2 * (ks + d)]; }
      const int kn = (ks + d + PD < nks) ? (ks + d + PD) : (ks + d);
#pragma unroll
      for (int t = 0; t < NT; ++t) {
        const bf16x8 b = bq[d][t];
        bq[d][t] = bp[t][kn * 64];
        acc[t][0] = SWAP ? MFMA32(b, a0, acc[t][0]) : MFMA32(a0, b, acc[t][0]);
        acc[t][1] = SWAP ? MFMA32(b, a1, acc[t][1]) : MFMA32(a1, b, acc[t][1]);
      }
    }
  }
}
template <int NT, int PD = 8, bool SWAP = false>
DI void gemm_core(const u16* As, int lda, int nks, const bf16x8* __restrict__ Wf, int KS, const int (&tile)[NT], f32x16 (&acc)[NT][2], int lane) {
  bf16x8 bq[PD][NT];
  gemm_pro<NT, PD>(Wf, KS, tile, lane, bq);
  gemm_main<NT, PD, SWAP>(As, lda, nks, Wf, KS, tile, acc, lane, bq);
}

template <int NT, int PD>
DI void gemm8_pro(const i32x4* __restrict__ Wf, int KS, const int (&tile)[NT], int lane, i32x4 (&bq)[PD][NT]) {
#pragma unroll
  for (int d = 0; d < PD; ++d)
#pragma unroll
    for (int t = 0; t < NT; ++t) bq[d][t] = Wf[((size_t)tile[t] * KS + d) * 64 + lane];
}
template <int NT, int PD>
DI void gemm8_main(const signed char* As, int lda, int nks, const i32x4* __restrict__ Wf, int KS, const int (&tile)[NT], i32x16 (&acc)[NT][2], int lane, i32x4 (&bq)[PD][NT]) {
  const i32x4* a0p = (const i32x4*)(As + (lane & 31) * lda + 16 * (lane >> 5));
  const i32x4* a1p = (const i32x4*)(As + ((lane & 31) + 32) * lda + 16 * (lane >> 5));
  const i32x4* bp[NT];
#pragma unroll
  for (int t = 0; t < NT; ++t) bp[t] = Wf + (size_t)tile[t] * KS * 64 + lane;
#pragma unroll 1
  for (int ks = 0; ks < nks; ks += PD) {
#pragma unroll
    for (int d = 0; d < PD; ++d) {
      const i32x4 a0 = a0p[2 * (ks + d)], a1 = a1p[2 * (ks + d)];
      const int kn = (ks + d + PD < nks) ? (ks + d + PD) : (ks + d);
#pragma unroll
      for (int t = 0; t < NT; ++t) {
        const i32x4 b = bq[d][t];
        bq[d][t] = bp[t][kn * 64];
        acc[t][0] = MFMA8(b, a0, acc[t][0]);
        acc[t][1] = MFMA8(b, a1, acc[t][1]);
      }
    }
  }
}

DI void conv_frag(const float* __restrict__ W, long sk, long sn, int K, int N, const float* ks1, const float* ks2, int ksplit, bf16x8* out, int gtid, int gthreads) {
  const int KS = K / 16; const int total = (N / 32) * KS * 64;
  for (int i = gtid; i < total; i += gthreads) {
    const int lane = i & 63; const int t = i >> 6; const int ks = t % KS; const int nt = t / KS;
    const int n = nt * 32 + (lane & 31); const int k0 = ks * 16 + 8 * (lane >> 5);
    float v[8];
#pragma unroll
    for (int j = 0; j < 8; ++j) {
      const int k = k0 + j;
      float s = 1.f;
      if (ks1) s = (k < ksplit) ? ks1[k] : ks2[k - ksplit];
      v[j] = W[(long)k * sk + (long)n * sn] * s;
    }
    u32x4 o; o[0] = pk2(v[0], v[1]); o[1] = pk2(v[2], v[3]); o[2] = pk2(v[4], v[5]); o[3] = pk2(v[6], v[7]);
    out[i] = __builtin_bit_cast(bf16x8, o);
  }
}

DI void conv_one(const float* __restrict__ W, long sk, int KS, const float* ks1, const float* ks2, int ksplit, bf16x8* out, int i) {
  const int lane = i & 63; const int t = i >> 6; const int ks = t % KS; const int nt = t / KS;
  const int n = nt * 32 + (lane & 31); const int k0 = ks * 16 + 8 * (lane >> 5);
  float v[8];
#pragma unroll
  for (int j = 0; j < 8; ++j) v[j] = W[(long)(k0 + j) * sk + n];
  if (ks1) {
#pragma unroll
    for (int j = 0; j < 8; ++j) { const int k = k0 + j; v[j] *= (k < ksplit) ? ks1[k] : ks2[k - ksplit]; }
  }
  u32x4 o; o[0] = pk2(v[0], v[1]); o[1] = pk2(v[2], v[3]); o[2] = pk2(v[4], v[5]); o[3] = pk2(v[6], v[7]);
  out[i] = __builtin_bit_cast(bf16x8, o);
}

DI void phase0(KP p, char* smem) {
  const int tid = threadIdx.x; const int gtid = blockIdx.x * NTHREADS + tid; const int gthreads = gridDim.x * NTHREADS;
  for (int i = gtid; i < NTOK; i += gthreads) { p.ssq_lru[i] = 0.f; p.ssq_mla[i] = 0.f; }
  if (gtid < 16) p.invfreq[gtid] = pow(10000.0, -(double)gtid / 16.0);
  {
    float* cact = (float*)smem;
    float* red = (float*)(smem + 65536);
    const int lane = tid & 63, wv = tid >> 6;
    for (int item = blockIdx.x; item < 192; item += gridDim.x) {
      const int cg = item >> 1, bh = item & 1;
      for (int i = tid; i < 16 * DM; i += NTHREADS) { const int bb = i >> 10, k = i & 1023; const float v = p.c[(bh * 16 + bb) * DM + k]; cact[k * 16 + bb] = v / (1.f + __expf(-v)); }
      __syncthreads();
      float acc[16];
#pragma unroll
      for (int bb = 0; bb < 16; ++bb) acc[bb] = 0.f;
      const float* wp = p.w_ada + (size_t)(wv * 128) * 6144 + cg * 64 + lane;
#pragma unroll 32
      for (int kk = 0; kk < 128; ++kk) {
        const float w = wp[(size_t)kk * 6144];
        const f32x4* cp = (const f32x4*)(cact + (wv * 128 + kk) * 16);
#pragma unroll
        for (int q = 0; q < 4; ++q) { const f32x4 cv = cp[q]; acc[4 * q] += cv[0] * w; acc[4 * q + 1] += cv[1] * w; acc[4 * q + 2] += cv[2] * w; acc[4 * q + 3] += cv[3] * w; }
      }
#pragma unroll
      for (int bb = 0; bb < 16; ++bb) red[(wv * 16 + bb) * 64 + lane] = acc[bb];
      __syncthreads();
      for (int o = tid; o < 1024; o += NTHREADS) {
        const int bb = o >> 6, c2 = o & 63;
        float sum = 0.f;
#pragma unroll
        for (int w8 = 0; w8 < 8; ++w8) sum += red[(w8 * 16 + bb) * 64 + c2];
        p.mod[(size_t)(bh * 16 + bb) * 6144 + cg * 64 + c2] = sum + p.b_ada[cg * 64 + c2];
      }
      __syncthreads();
    }
  }
  {
    constexpr int N_IN = 45 * 64 * 64, N_UQ = 24 * 16 * 64, N_UKV = 32 * 8 * 64, N_LRU = 16 * 512, N_OUT = 32 * 64 * 64;
    for (int i = gtid; i < N_IN + N_UQ + N_UKV + N_LRU + N_OUT; i += gthreads) {
      int j = i;
      if (j < N_OUT) { conv_one(p.w_out, 1024, 64, p.lru_out_g, p.mla_out_g, 512, p.Wf_out, j); continue; }
      j -= N_OUT;
      if (j < N_IN) { conv_one(p.w_in, INW, 64, nullptr, nullptr, 0, p.Wf_in, j); continue; }
      j -= N_IN;
      if (j < N_UQ) { conv_one(p.w_uq, 768, 16, p.q_norm_g, p.q_norm_g, 256, p.Wf_uq, j); continue; }
      j -= N_UQ;
      if (j < N_UKV) { conv_one(p.w_ukv, 1024, 8, p.kv_norm_g, p.kv_norm_g, 128, p.Wf_ukv, j); continue; }
      j -= N_UKV;
      { const int h = j >> 10, m = (j >> 9) & 1, f = j & 511; conv_one((m ? p.lru_wx : p.lru_wa) + h * 4096, 64, 4, nullptr, nullptr, 0, (m ? p.Wf_x : p.Wf_a) + h * 512, f); }
    }
  }
  {
    float* kl = (float*)smem;
    float* wl = (float*)(smem + 67584);
    const int lane = tid & 63, wv = tid >> 6, l31 = lane & 31, lh = lane >> 5;
    for (int item = blockIdx.x; item < 256; item += gridDim.x) {
      const int hp = item >> 4, cc = item & 15;
      __syncthreads();
#pragma unroll
      for (int i = 0; i < 8; ++i) { const int e = tid + NTHREADS * i; const int r = e >> 5, q = e & 31; *(f32x4*)(kl + r * 132 + q * 4) = *(const f32x4*)(p.peer_keys + (size_t)hp * 16384 + r * 128 + q * 4); }
#pragma unroll
      for (int i = 0; i < 4; ++i) { const int e = tid + NTHREADS * i; const int c = e >> 5, q = e & 31; *(f32x4*)(wl + c * 132 + q * 4) = *(const f32x4*)(p.peer_wq + (size_t)(cc * 64 + c) * 2048 + hp * 128 + q * 4); }
      __syncthreads();
      const int rt = wv >> 1, ct = wv & 1;
      const float* ap = kl + (rt * 32 + l31) * 132 + 8 * lh;
      const float* bp = wl + (ct * 32 + l31) * 132 + 8 * lh;
      f32x16 acc = zero16();
#pragma unroll
      for (int ks = 0; ks < 8; ++ks) {
        const f32x4 a0 = *(const f32x4*)(ap + 16 * ks), a1 = *(const f32x4*)(ap + 16 * ks + 4);
        const f32x4 b0 = *(const f32x4*)(bp + 16 * ks), b1 = *(const f32x4*)(bp + 16 * ks + 4);
        u32x4 av, bv;
        av[0] = pk2(a0[0], a0[1]); av[1] = pk2(a0[2], a0[3]); av[2] = pk2(a1[0], a1[1]); av[3] = pk2(a1[2], a1[3]);
        bv[0] = pk2(b0[0], b0[1]); bv[1] = pk2(b0[2], b0[3]); bv[2] = pk2(b1[0], b1[1]); bv[3] = pk2(b1[2], b1[3]);
        acc = MFMA32(__builtin_bit_cast(bf16x8, av), __builtin_bit_cast(bf16x8, bv), acc);
      }
      float* dst = p.Wsf + (size_t)(hp * 128 + rt * 32) * 1024 + cc * 64 + ct * 32 + l31;
#pragma unroll
      for (int r = 0; r < 16; ++r) dst[(size_t)crow(r, lh) * 1024] = acc[r];
    }
    __syncthreads();
  }
#if QBITS == 8
  {
    const int lane = tid & 63; const int gw = gtid >> 6; const int nw = gthreads >> 6;
    for (int row = gw; row < 32768; row += nw) {
      const int r = row & 16383; const bool isv = row >= 16384;
      const f32x4* src = (const f32x4*)((isv ? p.peer_v : p.peer_u) + (size_t)r * 1024) + lane * 4;
      f32x4 a[4];
#pragma unroll
      for (int i = 0; i < 4; ++i) a[i] = src[i];
#if QBITS == 8
      float am = 0.f;
#pragma unroll
      for (int i = 0; i < 4; ++i)
#pragma unroll
        for (int j = 0; j < 4; ++j) am = fmaxf(am, fabsf(a[i][j]));
      am = wave_max(am);
      const float inv = am > 0.f ? 127.f / am : 0.f;
      u32x4 o;
#pragma unroll
      for (int i = 0; i < 4; ++i) {
        unsigned w = 0;
#pragma unroll
        for (int j = 0; j < 4; ++j) { const int q = (int)__builtin_rintf(a[i][j] * inv) + 128; w |= (unsigned)q << (8 * j); }
        o[i] = w;
      }
      ((u32x4*)(isv ? p.Vq : p.Uq))[(size_t)r * 64 + lane] = o;
      const float step = am * (1.f / 127.f);
      if (lane == 0) p.uscale[r * 4 + (isv ? 1 : 0)] = step;
      float ns = 0.f;
#pragma unroll
      for (int i = 0; i < 4; ++i) ns += (float)(o[i] & 255u) + (float)((o[i] >> 8) & 255u) + (float)((o[i] >> 16) & 255u) + (float)(o[i] >> 24);
      ns = wave_sum(ns);
      if (lane == 0 && !isv) p.uscale[r * 4 + 2] = step * 128.f * ns;
#else
      float ssum = 0.f;
#pragma unroll
      for (int i = 0; i < 4; ++i)
#pragma unroll
        for (int j = 0; j < 4; ++j) ssum += a[i][j] * a[i][j];
      ssum = wave_sum(ssum);
      const float rms = sqrtf(ssum * (1.f / 1024.f));
      const float step = (isv ? 0.49f : 0.3352f) * rms;
      const float inv = step > 0.f ? 1.f / step : 0.f;
      u32x2 o;
#pragma unroll
      for (int jd = 0; jd < 2; ++jd) {
        unsigned w = 0;
#pragma unroll
        for (int e = 0; e < 8; ++e) {
          const float x = a[(8 * jd + e) >> 2][(8 * jd + e) & 3];
          if (isv) {
            const float m = fabsf(x) * inv;
            const int mag = (m > 0.25f) + (m > 0.75f) + (m > 1.25f) + (m > 1.75f) + (m > 2.5f) + (m > 3.5f) + (m > 5.0f);
            w |= (unsigned)(mag | (x < 0.f ? 8 : 0)) << (4 * e);
          } else {
            int q = (int)__builtin_rintf(x * inv + 7.5f); q = q < 0 ? 0 : (q > 15 ? 15 : q);
            w |= (unsigned)q << (8 * (e & 3) + 4 * (e >> 2));
          }
        }
        o[jd] = w;
      }
      ((u32x2*)(p.Uq + (size_t)r * 1024))[2 * lane + (isv ? 1 : 0)] = o;
      if (lane == 0) p.uscale[r * 4 + (isv ? 1 : 0)] = step;
      float ns = 0.f;
#pragma unroll
      for (int jd = 0; jd < 2; ++jd)
#pragma unroll
        for (int e = 0; e < 8; ++e) ns += (float)((o[jd] >> (4 * e)) & 15u);
      ns = wave_sum(ns);
      if (lane == 0 && !isv) p.uscale[r * 4 + 2] = step * 128.f * ns;
#endif
    }
  }
#else
  {
    const int lane = tid & 63; const int gw = gtid >> 6; const int nw = gthreads >> 6;
    for (int r = gw; r < 16384; r += nw) {
      const f32x4* su = (const f32x4*)(p.peer_u + (size_t)r * 1024) + lane * 4;
      const f32x4* sv = (const f32x4*)(p.peer_v + (size_t)r * 1024) + lane * 4;
      f32x4 au[4], av[4];
#pragma unroll
      for (int i = 0; i < 4; ++i) { au[i] = su[i]; av[i] = sv[i]; }
      float ssu = 0.f, ssv = 0.f;
#pragma unroll
      for (int i = 0; i < 4; ++i)
#pragma unroll
        for (int j = 0; j < 4; ++j) { ssu += au[i][j] * au[i][j]; ssv += av[i][j] * av[i][j]; }
      ssu = wave_sum(ssu); ssv = wave_sum(ssv);
      const float ustep = 0.3352f * sqrtf(ssu * (1.f / 1024.f)), vstep = 0.49f * sqrtf(ssv * (1.f / 1024.f));
      const float uinv = ustep > 0.f ? 1.f / ustep : 0.f, vinv = vstep > 0.f ? 1.f / vstep : 0.f;
      u32x4 o;
      float ns = 0.f;
#pragma unroll
      for (int jd = 0; jd < 2; ++jd) {
        unsigned wu = 0, wv = 0;
#pragma unroll
        for (int e = 0; e < 8; ++e) {
          const float xu = au[(8 * jd + e) >> 2][(8 * jd + e) & 3], xv = av[(8 * jd + e) >> 2][(8 * jd + e) & 3];
          int q = (int)__builtin_rintf(xu * uinv + 7.5f); q = q < 0 ? 0 : (q > 15 ? 15 : q);
          wu |= (unsigned)q << (8 * (e & 3) + 4 * (e >> 2)); ns += (float)q;
          const float m = fabsf(xv) * vinv;
          const int mag = (m > 0.25f) + (m > 0.75f) + (m > 1.25f) + (m > 1.75f) + (m > 2.5f) + (m > 3.5f) + (m > 5.0f);
          wv |= (unsigned)(mag | (xv < 0.f ? 8 : 0)) << (4 * e);
        }
        o[jd] = wu; o[2 + jd] = wv;
      }
      ((u32x4*)(p.Uq + (size_t)r * 1024))[lane] = o;
      ns = wave_sum(ns);
      if (lane == 0) *(f32x4*)(p.uscale + r * 4) = (f32x4){ustep, vstep, ustep * 128.f * ns, 0.f};
    }
  }
#endif
}

DI void ws_quant(KP p) {
  const int lane = threadIdx.x & 63; const int gw = (blockIdx.x * NTHREADS + threadIdx.x) >> 6; const int nw = (gridDim.x * NTHREADS) >> 6;
  for (int row = gw; row < 2048; row += nw) {
    const f32x4* src = (const f32x4*)(p.Wsf + (size_t)row * 1024 + lane * 16);
    f32x4 v[4];
    float m = 0.f;
#pragma unroll
    for (int q = 0; q < 4; ++q) { v[q] = src[q]; m = fmaxf(fmaxf(m, fmaxf(fabsf(v[q][0]), fabsf(v[q][1]))), fmaxf(fabsf(v[q][2]), fabsf(v[q][3]))); }
    m = wave_max(m);
    const float inv = m > 0.f ? 127.f / m : 0.f;
    i32x4 o;
#pragma unroll
    for (int q = 0; q < 4; ++q) {
      unsigned w = 0;
#pragma unroll
      for (int j = 0; j < 4; ++j) w |= ((unsigned)(int)__builtin_rintf(v[q][j] * inv) & 255u) << (8 * j);
      o[q] = (int)w;
    }
    p.Wf_s[(size_t)((row >> 5) * 32 + (lane >> 1)) * 64 + (row & 31) + 32 * (lane & 1)] = o;
    if (lane == 0) p.wsc[row] = m * (1.f / 127.f);
  }
}

DI void phase1(KP p, char* smem) {
  const int tid = threadIdx.x, wave = __builtin_amdgcn_readfirstlane(tid >> 6);
  u16* hA = (u16*)smem;
  float* cs = (float*)(smem + 132096);
  float* ssq = (float*)(smem + 132096 + 8192);
  constexpr int LDL = 424;
  ws_quant(p);
  for (int tile = blockIdx.x; tile < NTOK / 64; tile += gridDim.x) {
    int lane_o = tid & 63; asm volatile("" : "+v"(lane_o));
    const int lane = lane_o, l31 = lane & 31, lh = lane >> 5;
    const int tok0 = tile * 64; const int b = tok0 / SEQ; const int s0 = tok0 % SEQ;
    const float* modb = p.mod + (size_t)b * 6144;
    for (int i = tid; i < 1024; i += NTHREADS) {
      const int r = i >> 4, j = i & 15;
      const double ang = (double)p.pos[tok0 + r] * p.invfreq[j];
      double rev = ang * 0.15915494309189535; rev -= floor(rev);
      const float rf = (float)rev;
      cs[2 * i] = __builtin_amdgcn_cosf(rf); cs[2 * i + 1] = __builtin_amdgcn_sinf(rf);
    }
    if (tid < 128) ssq[tid] = 0.f;
    {
      f32x4 cm[4], ca[4];
#pragma unroll
      for (int i = 0; i < 4; ++i) {
        const int col = i * 256 + lane * 4;
        const f32x4 g = *(const f32x4*)(p.norm1_g + col); const f32x4 sc = *(const f32x4*)(modb + 1024 + col);
        cm[i] = g * (sc + 1.0f); ca[i] = *(const f32x4*)(modb + col);
      }
#pragma unroll 2
      for (int rr = 0; rr < 8; rr += 4) {
        f32x4 xv[4][4];
#pragma unroll
        for (int q = 0; q < 4; ++q)
#pragma unroll
          for (int i = 0; i < 4; ++i) xv[q][i] = *(const f32x4*)(p.x + (size_t)(tok0 + wave * 8 + rr + q) * DM + i * 256 + lane * 4);
#pragma unroll
        for (int q = 0; q < 4; ++q) {
          float ss = 0.f;
#pragma unroll
          for (int i = 0; i < 4; ++i) ss += xv[q][i][0] * xv[q][i][0] + xv[q][i][1] * xv[q][i][1] + xv[q][i][2] * xv[q][i][2] + xv[q][i][3] * xv[q][i][3];
          ss = wave_sum(ss);
          const float rs = rsqrtf(ss * (1.f / 1024.f) + EPS);
          const int row = wave * 8 + rr + q;
#pragma unroll
          for (int i = 0; i < 4; ++i) {
            const f32x4 h = xv[q][i] * rs * cm[i] + ca[i];
            u32x2 o; o[0] = pk2(h[0], h[1]); o[1] = pk2(h[2], h[3]);
            *(u32x2*)(hA + row * LDA + i * 256 + lane * 4) = o;
          }
        }
      }
    }
    __syncthreads();
    bf16x8 ring1[8][2];
    const bool has2 = (wave + 40) < 45;
    { const int tl0[2] = {wave, wave + 8}; gemm_pro<2, 8>(p.Wf_in, 64, tl0, lane, ring1); }
#pragma unroll 1
    for (int pass = 0; pass < 2; ++pass) {
      f32x16 acc[2][2];
#pragma unroll
      for (int t = 0; t < 2; ++t) { acc[t][0] = zero16(); acc[t][1] = zero16(); }
      const int tl[2] = {wave + 16 * pass, wave + 16 * pass + 8};
      gemm_main<2, 8, false, true>(hA, LDA, 64, p.Wf_in, 64, tl, acc, lane, ring1);
      { const int tn[2] = {wave + 16 * (pass + 1), (pass == 0 || has2) ? wave + 16 * (pass + 1) + 8 : wave + 32}; gemm_pro<2, 8>(p.Wf_in, 64, tn, lane, ring1); }
      int el_ = lane; asm volatile("" : "+v"(el_));
      const int l31 = el_ & 31, lh = el_ >> 5;
      u16* dstb[2];
#pragma unroll
      for (int t = 0; t < 2; ++t) { const int col = tl[t] * 32 + l31; dstb[t] = (col < 512) ? (p.xlru + col) : (p.gate + (col - 512)); }
#pragma unroll
      for (int rt = 0; rt < 2; ++rt)
#pragma unroll
        for (int r = 0; r < 16; ++r) {
          const size_t ro = (size_t)(tok0 + rt * 32 + crow(r, lh)) * 512;
#pragma unroll
          for (int t = 0; t < 2; ++t) dstb[t][ro] = f2bf(acc[t][rt][r]);
        }
    }
    {
      f32x16 acc[2][2];
#pragma unroll
      for (int t = 0; t < 2; ++t) { acc[t][0] = zero16(); acc[t][1] = zero16(); }
      const int tl[2] = {wave + 32, has2 ? wave + 40 : wave + 32};
      gemm_main<2, 8, false, true>(hA, LDA, 64, p.Wf_in, 64, tl, acc, lane, ring1);
      int el_ = lane; asm volatile("" : "+v"(el_));
      const int l31 = el_ & 31, lh = el_ >> 5;
      __syncthreads();
      u16* lat = hA;
#pragma unroll
      for (int t = 0; t < 2; ++t) {
        if (t == 1 && !has2) continue;
        const int lc = tl[t] * 32 - 1024 + l31;
        if (tl[t] < 44) {
          float sq[32];
#pragma unroll
          for (int rt = 0; rt < 2; ++rt)
#pragma unroll
            for (int r = 0; r < 16; ++r) { const float v = acc[t][rt][r]; sq[rt * 16 + r] = v * v; }
          const float tot = reduce32(sq, lane);
          __hip_atomic_fetch_add(&ssq[(tl[t] < 40 ? 0 : 64) + (l31 >> 4) * 32 + crow(l31 & 15, lh)], tot, __ATOMIC_RELAXED, __HIP_MEMORY_SCOPE_WORKGROUP);
        }
#pragma unroll
        for (int rt = 0; rt < 2; ++rt)
#pragma unroll
          for (int r = 0; r < 16; ++r) {
            const int row = rt * 32 + crow(r, lh);
            const float v = acc[t][rt][r];
            if (lc < 384) {
              lat[row * LDL + lc] = f2bf(v);
            } else {
              const float pv = lane_xor_f<16>(v, lane);
              const int j = lc - 384; const int jj = j & 15;
              const float co = cs[(row * 16 + jj) * 2], si = cs[(row * 16 + jj) * 2 + 1];
              const float o = (j < 16) ? (v * co - pv * si) : (v * co + pv * si);
              p.Kr[(size_t)(tok0 + row) * 32 + j] = f2bf(o);
            }
          }
      }
    }
    __syncthreads();
    {
      const u16* lat = hA;
      const float qscale = 0.10206207261596577f * 1.4426950408889634f;
      const int jj = l31 & 15;
#pragma unroll 1
      for (int pass = 0; pass < 2; ++pass) {
        f32x16 acc[2][2];
#pragma unroll
        for (int t = 0; t < 2; ++t) { acc[t][0] = zero16(); acc[t][1] = zero16(); }
        const int tl[2] = {pass == 0 ? wave : wave + 16, pass == 0 ? wave + 8 : wave + 16};
        gemm_core<2>(lat, LDL, 16, p.Wf_uq, 16, tl, acc, lane);
        int el_ = lane; asm volatile("" : "+v"(el_));
        const int l31 = el_ & 31, lh = el_ >> 5;
#pragma unroll
        for (int rt = 0; rt < 2; ++rt)
#pragma unroll
          for (int r = 0; r < 16; ++r) {
            const int row = rt * 32 + crow(r, lh);
            const float rs = rsqrtf(ssq[row] * (1.f / 256.f) + EPS) * qscale;
            const float co = cs[(row * 16 + jj) * 2], si = cs[(row * 16 + jj) * 2 + 1];
#pragma unroll
            for (int t = 0; t < 2; ++t) {
              if (t == 1 && pass == 1) continue;
              const int head = tl[t] / 3, part = tl[t] % 3;
              float v = acc[t][rt][r] * rs;
              if (part == 2) {
                const float pv = lane_xor_f<16>(v, lane);
                v = (l31 < 16) ? (v * co - pv * si) : (v * co + pv * si);
              }
              p.Q[((size_t)(b * 8 + head) * SEQ + s0 + row) * 96 + part * 32 + l31] = f2bf(v);
            }
          }
      }
#pragma unroll 1
      for (int pass = 0; pass < 2; ++pass) {
        f32x16 acc[2][2];
#pragma unroll
        for (int t = 0; t < 2; ++t) { acc[t][0] = zero16(); acc[t][1] = zero16(); }
        const int tl[2] = {wave + 16 * pass, wave + 16 * pass + 8};
        gemm_core<2>(lat + 256, LDL, 8, p.Wf_ukv, 8, tl, acc, lane);
        int el_ = lane; asm volatile("" : "+v"(el_));
        const int l31 = el_ & 31, lh = el_ >> 5;
#pragma unroll
        for (int rt = 0; rt < 2; ++rt)
#pragma unroll
          for (int g = 0; g < 4; ++g) {
            const int row = rt * 32 + 8 * g + 4 * lh;
            float rs4[4];
#pragma unroll
            for (int q = 0; q < 4; ++q) rs4[q] = rsqrtf(ssq[64 + row + q] * (1.f / 128.f) + EPS);
#pragma unroll
            for (int t = 0; t < 2; ++t) {
              const int head = tl[t] >> 2, sub = tl[t] & 3;
              float v4[4];
#pragma unroll
              for (int q = 0; q < 4; ++q) v4[q] = acc[t][rt][4 * g + q] * rs4[q];
              if (sub < 2) {
#pragma unroll
                for (int q = 0; q < 4; ++q) p.Kn[((size_t)(b * 8 + head) * SEQ + s0 + row + q) * 64 + sub * 32 + l31] = f2bf(v4[q]);
              } else {
                const int d = (sub - 2) * 32 + l31;
                u32x2 o; o[0] = pk2(v4[0], v4[1]); o[1] = pk2(v4[2], v4[3]);
                *(u32x2*)(p.Vt + ((size_t)(b * 8 + head) * 64 + d) * SEQ + s0 + row) = o;
              }
            }
          }
      }
    }
    __syncthreads();
  }
}

DI void lru_item(KP p, char* smem, int item) {
  const int tid = threadIdx.x, lane = tid & 63, wave = __builtin_amdgcn_readfirstlane(tid >> 6);
  const int l31 = lane & 31, lh = lane >> 5;
  const int b = item >> 3, cb = item & 7;
  const int c = lane; const int ch = cb * 64 + c; const int tg = wave;
  const float cw0 = p.conv_w[ch], cw1 = p.conv_w[512 + ch], cw2 = p.conv_w[1024 + ch], cw3 = p.conv_w[1536 + ch], cbias = p.conv_b[ch];
  const float ba = p.lru_ba[ch], bx = p.lru_bx[ch];
  const float sp = log1pf(__expf(-p.lru_lambda[ch]));
  float carry = 0.f;
  const u16* xl = p.xlru + (size_t)b * SEQ * 512 + ch;
  const u16* gt = p.gate + (size_t)b * SEQ * 512 + ch;
  u16* yo = p.y + (size_t)b * SEQ * 1024 + ch;
  const int mat = wave >> 2, rt = (wave >> 1) & 1, ct = wave & 1;
  const bf16x8* wf = (mat == 0 ? p.Wf_a : p.Wf_x) + cb * 512 + ct * 256 + lane;
  bf16x8 bw[4];
#pragma unroll
  for (int ks = 0; ks < 4; ++ks) bw[ks] = wf[ks * 64];
  constexpr int NCH = SEQ / 64;
  u16 xin_n[11], gv_n[8];
#pragma unroll
  for (int i = 0; i < 11; ++i) { const int t = tg * 8 - 3 + i; xin_n[i] = (t >= 0) ? xl[(size_t)t * 512] : (u16)0; }
#pragma unroll
  for (int i = 0; i < 8; ++i) gv_n[i] = gt[(size_t)(tg * 8 + i) * 512];
  float xcB[8], gvB[8], xcC[8], gvC[8], avD[8], bvD[8], gvD[8];
#pragma unroll
  for (int i = 0; i < 8; ++i) { xcB[i] = gvB[i] = xcC[i] = gvC[i] = avD[i] = bvD[i] = gvD[i] = 0.f; }
  __syncthreads();
#pragma unroll 1
  for (int it = 0; it < NCH + 3; ++it) {
    float xcA[8], gvA[8], avC[8], bvC[8];
    if (it < NCH) {
      const int t0 = it * 64 + tg * 8;
      float xin[11];
#pragma unroll
      for (int i = 0; i < 11; ++i) xin[i] = bf2f(xin_n[i]);
#pragma unroll
      for (int i = 0; i < 8; ++i) gvA[i] = bf2f(gv_n[i]);
      if (it + 1 < NCH) {
#pragma unroll
        for (int i = 0; i < 11; ++i) xin_n[i] = xl[(size_t)(t0 + 64 - 3 + i) * 512];
#pragma unroll
        for (int i = 0; i < 8; ++i) gv_n[i] = gt[(size_t)(t0 + 64 + i) * 512];
      }
      u16* xcb = (u16*)(smem + (it & 1) * 9216);
#pragma unroll
      for (int i = 0; i < 8; ++i) {
        xcA[i] = cbias + cw0 * xin[i] + cw1 * xin[i + 1] + cw2 * xin[i + 2] + cw3 * xin[i + 3];
        xcb[(tg * 8 + i) * 72 + c] = f2bf(xcA[i]);
      }
    } else {
#pragma unroll
      for (int i = 0; i < 8; ++i) { xcA[i] = 0.f; gvA[i] = 0.f; }
    }
    if (it >= 1 && it - 1 < NCH) {
      const u16* xcb = (const u16*)(smem + ((it - 1) & 1) * 9216);
      float* pm = (float*)(smem + 18432 + ((it - 1) & 1) * 33280) + mat * 4160;
      f32x16 acc = zero16();
      const bf16x8* ap = (const bf16x8*)(xcb + (rt * 32 + l31) * 72 + 8 * lh);
#pragma unroll
      for (int ks = 0; ks < 4; ++ks) acc = MFMA32(ap[2 * ks], bw[ks], acc);
#pragma unroll
      for (int r = 0; r < 16; ++r) pm[(rt * 32 + crow(r, lh)) * 65 + ct * 32 + l31] = acc[r];
    }
    if (it >= 2 && it - 2 < NCH) {
      const float* pre = (const float*)(smem + 18432 + ((it - 2) & 1) * 33280);
      float* seg = (float*)(smem + 84992 + ((it - 2) & 1) * 4096);
      float A = 1.f, Bc = 0.f;
#pragma unroll
      for (int i = 0; i < 8; ++i) {
        const int tl = tg * 8 + i;
        const float r = sigmoidf_(pre[tl * 65 + c] + ba);
        const float ig = sigmoidf_(pre[4160 + tl * 65 + c] + bx);
        const float log_a = -8.f * r * sp;
        const float a = __builtin_amdgcn_exp2f(1.4426950408889634f * log_a);
        const float z = 2.f * log_a;
        const float om = (z > -0.25f) ? one_minus_exp_small(z) : -expm1f(z);
        const float m = __builtin_amdgcn_sqrtf(om);
        avC[i] = a; bvC[i] = m * ig * xcC[i];
        A *= a; Bc = a * Bc + bvC[i];
      }
      seg[(tg * 64 + c) * 2] = A; seg[(tg * 64 + c) * 2 + 1] = Bc;
    } else {
#pragma unroll
      for (int i = 0; i < 8; ++i) { avC[i] = 0.f; bvC[i] = 0.f; }
    }
    if (it >= 3) {
      const int t0 = (it - 3) * 64 + tg * 8;
      const float* seg = (const float*)(smem + 84992 + ((it - 3) & 1) * 4096);
      float h = carry, hin = 0.f;
#pragma unroll
      for (int s2 = 0; s2 < 8; ++s2) {
        if (s2 == tg) hin = h;
        h = seg[(s2 * 64 + c) * 2] * h + seg[(s2 * 64 + c) * 2 + 1];
      }
      carry = h;
      h = hin;
      float sq[8];
#pragma unroll
      for (int i = 0; i < 8; ++i) {
        h = avD[i] * h + bvD[i];
        const float yv = gelu_tanh(gvD[i]) * h;
        yo[(size_t)(t0 + i) * 1024] = f2bf(yv);
        sq[i] = yv * yv;
      }
      const float tot = reduce8(sq, lane);
      if ((lane & 7) == 0) unsafeAtomicAdd(p.ssq_lru + (size_t)b * SEQ + t0 + (lane >> 3), tot);
    }
#pragma unroll
    for (int i = 0; i < 8; ++i) {
      avD[i] = avC[i]; bvD[i] = bvC[i]; gvD[i] = gvC[i];
      xcC[i] = xcB[i]; gvC[i] = gvB[i];
      xcB[i] = xcA[i]; gvB[i] = gvA[i];
    }
    __syncthreads();
  }
}

DI void attn_unit(KP p, char* smem, int b, int hd, int qb) {
  const int tid = threadIdx.x, lane = tid & 63, wave = __builtin_amdgcn_readfirstlane(tid >> 6);
  const int l31 = lane & 31, lh = lane >> 5;
  const int q0 = qb * 256 + wave * 32;
  const size_t bh = (size_t)(b * 8 + hd);
  const int nkt = qb * 4 + 4;
  const int qidx = q0 + l31;
  const int skey = tid >> 3, schn = tid & 7;
  const int rkey = (tid & 255) >> 2, rchn = tid & 3;
  const u16* kn_src = p.Kn + (bh * SEQ + skey) * 64 + schn * 8;
  const u16* kr_src = p.Kr + ((size_t)b * SEQ + rkey) * 32 + rchn * 8;
  const u16* vt_src = p.Vt + (bh * 64 + skey) * SEQ + schn * 8;
  u32x4 rk, rr, rv;
  rk = *(const u32x4*)(kn_src); rv = *(const u32x4*)(vt_src);
  if (tid < 256) rr = *(const u32x4*)(kr_src);
  bf16x8 qf[6];
  {
    const bf16x8* qp = (const bf16x8*)(p.Q + (bh * SEQ + q0 + l31) * 96 + 8 * lh);
#pragma unroll
    for (int ks = 0; ks < 6; ++ks) qf[ks] = qp[2 * ks];
  }
  __syncthreads();
  {
    u16* Kl = (u16*)smem; u16* Vl = (u16*)(smem + 13312);
    *(u32x4*)(Kl + skey * 104 + schn * 8) = rk;
    if (tid < 256) *(u32x4*)(Kl + rkey * 104 + 64 + rchn * 8) = rr;
    *(u32x4*)(Vl + skey * 72 + schn * 8) = rv;
  }
  __syncthreads();
  f32x16 o0 = zero16(), o1 = zero16();
  float m_run = -1e30f, l_run = 0.f;
  for (int kt = 0; kt < nkt; ++kt) {
    const u16* Kl = (const u16*)(smem + (kt & 1) * 22528);
    const u16* Vl = (const u16*)(smem + (kt & 1) * 22528 + 13312);
    const bool more = (kt + 1) < nkt;
    if (more) {
      rk = *(const u32x4*)(kn_src + (size_t)(kt + 1) * 64 * 64);
      rv = *(const u32x4*)(vt_src + (kt + 1) * 64);
      if (tid < 256) rr = *(const u32x4*)(kr_src + (size_t)(kt + 1) * 64 * 32);
    }
    if (kt * 64 <= q0 + 31) {
      f32x16 s[2];
      bf16x8 kfr[2][6];
#pragma unroll
      for (int st = 0; st < 2; ++st) {
        const bf16x8* kp = (const bf16x8*)(Kl + (st * 32 + l31) * 104 + 8 * lh);
#pragma unroll
        for (int ks = 0; ks < 6; ++ks) kfr[st][ks] = kp[2 * ks];
      }
#pragma unroll
      for (int st = 0; st < 2; ++st) {
        s[st] = zero16();
#pragma unroll
        for (int ks = 0; ks < 6; ++ks) s[st] = MFMA32(kfr[st][ks], qf[ks], s[st]);
      }
      u32x2 vfr[2][4][2];
#pragma unroll
      for (int dt = 0; dt < 2; ++dt)
#pragma unroll
        for (int c4 = 0; c4 < 4; ++c4) {
          const int kbase = c4 * 16 + 4 * lh;
          vfr[dt][c4][0] = *(const u32x2*)(Vl + (dt * 32 + l31) * 72 + kbase);
          vfr[dt][c4][1] = *(const u32x2*)(Vl + (dt * 32 + l31) * 72 + kbase + 8);
        }
      if (kt * 64 + 63 > q0) {
#pragma unroll
        for (int st = 0; st < 2; ++st)
#pragma unroll
          for (int r = 0; r < 16; ++r) { const int key = kt * 64 + st * 32 + crow(r, lh); if (key > qidx) s[st][r] = -1e30f; }
      }
      float mloc = s[0][0];
#pragma unroll
      for (int st = 0; st < 2; ++st)
#pragma unroll
        for (int r = 0; r < 16; ++r) mloc = fmaxf(mloc, s[st][r]);
      mloc = max_xor32(mloc);
      const float m_new = fmaxf(m_run, mloc);
      const float alpha = __builtin_amdgcn_exp2f(m_run - m_new);
      m_run = m_new;
      float lsum = 0.f;
#pragma unroll
      for (int st = 0; st < 2; ++st)
#pragma unroll
        for (int r = 0; r < 16; ++r) { const float e = __builtin_amdgcn_exp2f(s[st][r] - m_new); s[st][r] = e; lsum += e; }
      l_run = l_run * alpha + lsum;
#pragma unroll
      for (int r = 0; r < 16; ++r) { o0[r] *= alpha; o1[r] *= alpha; }
#pragma unroll
      for (int st = 0; st < 2; ++st)
#pragma unroll
        for (int s2 = 0; s2 < 2; ++s2) {
          u32x4 pw;
#pragma unroll
          for (int j = 0; j < 4; ++j) pw[j] = pk2(s[st][8 * s2 + 2 * j], s[st][8 * s2 + 2 * j + 1]);
          const bf16x8 pf = __builtin_bit_cast(bf16x8, pw);
          const int c4 = st * 2 + s2;
          {
            u32x4 vv; vv[0] = vfr[0][c4][0][0]; vv[1] = vfr[0][c4][0][1]; vv[2] = vfr[0][c4][1][0]; vv[3] = vfr[0][c4][1][1];
            o0 = MFMA32(__builtin_bit_cast(bf16x8, vv), pf, o0);
          }
          {
            u32x4 vv; vv[0] = vfr[1][c4][0][0]; vv[1] = vfr[1][c4][0][1]; vv[2] = vfr[1][c4][1][0]; vv[3] = vfr[1][c4][1][1];
            o1 = MFMA32(__builtin_bit_cast(bf16x8, vv), pf, o1);
          }
        }
    }
    if (more) {
      u16* Kn2 = (u16*)(smem + ((kt + 1) & 1) * 22528); u16* Vn2 = (u16*)(smem + ((kt + 1) & 1) * 22528 + 13312);
      *(u32x4*)(Kn2 + skey * 104 + schn * 8) = rk;
      if (tid < 256) *(u32x4*)(Kn2 + rkey * 104 + 64 + rchn * 8) = rr;
      *(u32x4*)(Vn2 + skey * 72 + schn * 8) = rv;
    }
    __syncthreads();
  }
  const float ltot = sum_xor32(l_run);
  const float inv = 1.f / ltot;
  float ss = 0.f;
  u16* yrow = p.y + ((size_t)b * SEQ + qidx) * 1024 + 512 + hd * 64;
#pragma unroll
  for (int g = 0; g < 4; ++g) {
    float v0[4], v1[4];
#pragma unroll
    for (int q = 0; q < 4; ++q) { v0[q] = o0[4 * g + q] * inv; v1[q] = o1[4 * g + q] * inv; ss += v0[q] * v0[q] + v1[q] * v1[q]; }
    u32x2 a; a[0] = pk2(v0[0], v0[1]); a[1] = pk2(v0[2], v0[3]);
    u32x2 c2; c2[0] = pk2(v1[0], v1[1]); c2[1] = pk2(v1[2], v1[3]);
    *(u32x2*)(yrow + 8 * g + 4 * lh) = a;
    *(u32x2*)(yrow + 32 + 8 * g + 4 * lh) = c2;
  }
  ss = sum_xor32(ss);
  if (lh == 0) unsafeAtomicAdd(p.ssq_mla + (size_t)b * SEQ + qidx, ss);
}

DI void phase2(KP p, char* smem) {
  for (int item = blockIdx.x; item < 256; item += gridDim.x) lru_item(p, smem, item);
  for (int it = blockIdx.x; it < 1024; it += gridDim.x) {
    const int j = it & 3; const int bh = it >> 2; const int hd = bh & 7; const int b = bh >> 3;
    attn_unit(p, smem, b, hd, 7 - j);
    attn_unit(p, smem, b, hd, j);
  }
}

DI void sort128_asc(unsigned& k0, unsigned& k1, int lane) {
#pragma unroll
  for (int k = 2; k <= 128; k <<= 1) {
#pragma unroll
    for (int j = k >> 1; j > 0; j >>= 1) {
      if (j == 64) {
        const unsigned lo = k0 < k1 ? k0 : k1, hi = k0 < k1 ? k1 : k0; k0 = lo; k1 = hi;
      } else {
        const unsigned o0 = (j == 1) ? lane_xor_u<1>(k0, lane) : (j == 2) ? lane_xor_u<2>(k0, lane) : (j == 4) ? lane_xor_u<4>(k0, lane) : (j == 8) ? lane_xor_u<8>(k0, lane) : (j == 16) ? lane_xor_u<16>(k0, lane) : lane_xor_u<32>(k0, lane);
        const unsigned o1 = (j == 1) ? lane_xor_u<1>(k1, lane) : (j == 2) ? lane_xor_u<2>(k1, lane) : (j == 4) ? lane_xor_u<4>(k1, lane) : (j == 8) ? lane_xor_u<8>(k1, lane) : (j == 16) ? lane_xor_u<16>(k1, lane) : lane_xor_u<32>(k1, lane);
        const bool lower = (lane & j) == 0;
        const bool asc0 = (k == 128) ? true : ((lane & k) == 0);
        const bool asc1 = (k == 128) ? true : (k == 64 ? false : ((lane & k) == 0));
        const unsigned mn0 = k0 < o0 ? k0 : o0, mx0 = k0 < o0 ? o0 : k0;
        const unsigned mn1 = k1 < o1 ? k1 : o1, mx1 = k1 < o1 ? o1 : k1;
        k0 = (asc0 == lower) ? mn0 : mx0;
        k1 = (asc1 == lower) ? mn1 : mx1;
      }
    }
  }
}
#if QBITS == 8
typedef u32x4 qrow_t;
#else
typedef u32x2 qrow_t;
#endif
constexpr int QROWB = (QBITS == 8) ? 1024 : 512;
DI void ga_load(__amdgpu_buffer_rsrc_t rs, int iv, int gl, int voff_u, int voff_v, qrow_t (&uq)[8], qrow_t (&vq)[8]) {
#pragma unroll
  for (int k = 0; k < 8; ++k) {
    const int so = __builtin_amdgcn_readlane(iv, gl + k);
#if QBITS == 8
    uq[k] = __builtin_amdgcn_raw_buffer_load_b128(rs, voff_u, so, 0);
    vq[k] = __builtin_amdgcn_raw_buffer_load_b128(rs, voff_v, so, 0);
#else
    const u32x4 rec = __builtin_amdgcn_raw_buffer_load_b128(rs, voff_u, so, 16);
    uq[k] = (u32x2){rec[0], rec[1]}; vq[k] = (u32x2){rec[2], rec[3]};
#endif
  }
}
DI unsigned qword(const qrow_t& r, int j) {
#if QBITS == 8
  return r[j];
#else
  const unsigned w0 = r[j >> 1];
  return (j & 1) ? ((w0 >> 4) & 0x0f0f0f0fu) : (w0 & 0x0f0f0f0fu);
#endif
}
#if QBITS == 8
typedef f32x2 oacc_t;
constexpr float OACC_SCALE = 1.f;
#else
typedef h16x2 oacc_t;
constexpr float OACC_SCALE = 16.f;
#endif
DI void ga_compute(float gsel, float asel, float bsel, int gl, int lane, float kt, float hscale, const unsigned (&hq)[4],
                   const qrow_t (&uq)[8], const qrow_t (&vq)[8], oacc_t (&oacc)[8], float& csum) {
  const float mg = __shfl(gsel, gl + (lane >> 3));
  const float ma = __shfl(asel, gl + (lane >> 3));
  const float mb = __shfl(bsel, gl + (lane >> 3));
  float pp[8];
#pragma unroll
  for (int k = 0; k < 8; ++k) {
#if QBITS == 8
    unsigned d = 0;
#pragma unroll
    for (int j = 0; j < 4; ++j) d = __builtin_amdgcn_udot4(qword(uq[k], j), hq[j], d, false);
#else
    unsigned dh = __builtin_amdgcn_udot8(uq[k][0], hq[0], 0u, false); dh = __builtin_amdgcn_udot8(uq[k][1], hq[1], dh, false);
    unsigned dl = __builtin_amdgcn_udot8(uq[k][0], hq[2], 0u, false); dl = __builtin_amdgcn_udot8(uq[k][1], hq[3], dl, false);
    const unsigned d = dh * 16u + dl;
#endif
    pp[k] = (float)d;
  }
  const float s1 = reduce8(pp, lane);
  const float pre = hscale * (ma * (s1 - kt) - mb);
  const float cf = mg * gelu_tanh(pre);
  csum += cf;
#if QBITS != 8
  const _Float16 cfs = (_Float16)(cf * OACC_SCALE);
  const unsigned cfp = __builtin_bit_cast(unsigned, (h16x2){cfs, cfs});
#endif
#pragma unroll
  for (int k = 0; k < 8; ++k) {
#if QBITS == 8
    const float c = __uint_as_float(__builtin_amdgcn_readlane(__float_as_uint(cf), 8 * k));
    const f32x2 cc = {c, c};
#pragma unroll
    for (int j = 0; j < 4; ++j) {
      unsigned w = qword(vq[k], j);
      asm volatile("" : "+v"(w));
      const f32x2 v0 = {(float)(w & 255u), (float)((w >> 8) & 255u)}, v1 = {(float)((w >> 16) & 255u), (float)(w >> 24)};
      oacc[2 * j] = v0 * cc + oacc[2 * j];
      oacc[2 * j + 1] = v1 * cc + oacc[2 * j + 1];
    }
#else
    const h16x2 cc = __builtin_bit_cast(h16x2, (unsigned)__builtin_amdgcn_readlane((int)cfp, 8 * k));
#pragma unroll
    for (int jd = 0; jd < 2; ++jd) {
      const unsigned w = vq[k][jd];
      oacc[4 * jd + 0] = __builtin_amdgcn_cvt_scalef32_pk_f16_fp4(w, 1.0f, 0) * cc + oacc[4 * jd + 0];
      oacc[4 * jd + 1] = __builtin_amdgcn_cvt_scalef32_pk_f16_fp4(w, 1.0f, 1) * cc + oacc[4 * jd + 1];
      oacc[4 * jd + 2] = __builtin_amdgcn_cvt_scalef32_pk_f16_fp4(w, 1.0f, 2) * cc + oacc[4 * jd + 2];
      oacc[4 * jd + 3] = __builtin_amdgcn_cvt_scalef32_pk_f16_fp4(w, 1.0f, 3) * cc + oacc[4 * jd + 3];
    }
#endif
  }
}

DI void ins16(float (&lst)[16], float x, const int P) {
#pragma unroll
  for (int i = 0; i < 16; ++i) if (i >= P) { const float hi = fmaxf(lst[i], x); x = fminf(lst[i], x); lst[i] = hi; }
}
DI void ce_desc(float& a, float& b) { const float hi = fmaxf(a, b), lo = fminf(a, b); a = hi; b = lo; }
DI void sort16_desc(float (&a)[16]) {
#define CE_(i, j) ce_desc(a[i], a[j]);
  CE_(0, 13) CE_(1, 12) CE_(2, 15) CE_(3, 14) CE_(4, 8) CE_(5, 6) CE_(7, 11) CE_(9, 10)
  CE_(0, 5) CE_(1, 7) CE_(2, 9) CE_(3, 4) CE_(6, 13) CE_(8, 14) CE_(10, 15) CE_(11, 12)
  CE_(0, 1) CE_(2, 3) CE_(4, 5) CE_(6, 8) CE_(7, 9) CE_(10, 11) CE_(12, 13) CE_(14, 15)
  CE_(0, 2) CE_(1, 3) CE_(4, 10) CE_(5, 11) CE_(6, 7) CE_(8, 9) CE_(12, 14) CE_(13, 15)
  CE_(1, 2) CE_(3, 12) CE_(4, 6) CE_(5, 7) CE_(8, 10) CE_(9, 11) CE_(13, 14)
  CE_(1, 4) CE_(2, 6) CE_(5, 8) CE_(7, 10) CE_(9, 13) CE_(11, 14)
  CE_(2, 4) CE_(3, 6) CE_(9, 12) CE_(11, 13)
  CE_(3, 5) CE_(6, 8) CE_(7, 9) CE_(10, 12)
  CE_(3, 4) CE_(5, 6) CE_(7, 8) CE_(9, 10) CE_(11, 12)
  CE_(6, 7) CE_(8, 9)
#undef CE_
}
DI void merge16_desc(float (&x)[16], const float (&y)[16]) {
#pragma unroll
  for (int i = 0; i < 16; ++i) x[i] = fmaxf(x[i], y[15 - i]);
#pragma unroll
  for (int d = 8; d >= 1; d >>= 1)
#pragma unroll
    for (int i = 0; i < 16; ++i)
      if ((i & d) == 0) ce_desc(x[i], x[i + d]);
}
DI void merge_partner(float (&lst)[16], int lane) {
  float o[16];
#pragma unroll
  for (int i = 0; i < 16; ++i) o[i] = other_xor32(lst[i], lane);
  float c[16];
#pragma unroll
  for (int i = 0; i < 16; ++i) c[i] = fmaxf(lst[i], o[15 - i]);
#pragma unroll
  for (int d = 8; d >= 1; d >>= 1) {
#pragma unroll
    for (int i = 0; i < 16; ++i) {
      if ((i & d) == 0) { const float hi = fmaxf(c[i], c[i + d]), lo = fminf(c[i], c[i + d]); c[i] = hi; c[i + d] = lo; }
    }
  }
#pragma unroll
  for (int i = 0; i < 16; ++i) lst[i] = c[i];
}

DI void phase3(KP p, char* smem) {
  const int tid = threadIdx.x, wave = __builtin_amdgcn_readfirstlane(tid >> 6);
  u16* A = (u16*)smem;
  float* ssq2 = (float*)(smem + 146944);
  signed char* A8 = (signed char*)smem;
  float* hs = (float*)(smem + 146944 + 256);
  constexpr int ELD = 132;
  int* eidx = (int*)(smem + 66560);
  float* egate = (float*)(smem + 100352);
  float* g2s = (float*)(smem + 134144);
  float* fgs = (float*)(smem + 138240);
  char* scr = p.scratch + (size_t)blockIdx.x * 655360;
  float* x1s = (float*)scr;
  u16* qp = (u16*)(scr + 262144);
  for (int tile = blockIdx.x; tile < NTOK / 64; tile += gridDim.x) {
    int lane_o = tid & 63; asm volatile("" : "+v"(lane_o));
    const int lane = lane_o, l31 = lane & 31, lh = lane >> 5;
    const int tok0 = tile * 64; const int b = tok0 / SEQ;
    const float* modb = p.mod + (size_t)b * 6144;
#pragma unroll 2
    for (int rr = 0; rr < 8; ++rr) {
      const int row = wave * 8 + rr; const int tok = tok0 + row;
      const float rl = rsqrtf(p.ssq_lru[tok] * (1.f / 512.f) + EPS), rm = rsqrtf(p.ssq_mla[tok] * (1.f / 512.f) + EPS);
#pragma unroll
      for (int i = 0; i < 2; ++i) {
        const u32x4 v = *(const u32x4*)(p.y + (size_t)tok * 1024 + (i * 64 + lane) * 8);
        const float sc = i == 0 ? rl : rm;
        u32x4 o;
#pragma unroll
        for (int j = 0; j < 4; ++j) o[j] = pk2(bflo(v[j]) * sc, bfhi(v[j]) * sc);
        *(u32x4*)(A + row * LDA + (i * 64 + lane) * 8) = o;
      }
    }
    __syncthreads();
    bf16x8 ring3[8][2];
    { const int tl0[2] = {wave, wave + 8}; gemm_pro<2, 8>(p.Wf_out, 64, tl0, lane, ring3); }
#pragma unroll 1
    for (int pass = 0; pass < 2; ++pass) {
      f32x16 acc[2][2];
#pragma unroll
      for (int t = 0; t < 2; ++t) { acc[t][0] = zero16(); acc[t][1] = zero16(); }
      const int tl[2] = {pass * 16 + wave, pass * 16 + wave + 8};
      gemm_main<2, 8, false, true>(A, LDA, 64, p.Wf_out, 64, tl, acc, lane, ring3);
      if (pass == 0) { const int tn[2] = {16 + wave, 16 + wave + 8}; gemm_pro<2, 8>(p.Wf_out, 64, tn, lane, ring3); }
      int el_ = lane; asm volatile("" : "+v"(el_));
      const int l31 = el_ & 31, lh = el_ >> 5;
      float g1[2];
#pragma unroll
      for (int t = 0; t < 2; ++t) g1[t] = modb[2048 + tl[t] * 32 + l31];
#pragma unroll
      for (int rt = 0; rt < 2; ++rt)
#pragma unroll
        for (int r = 0; r < 16; ++r) {
          const int row = rt * 32 + crow(r, lh);
#pragma unroll
          for (int t = 0; t < 2; ++t) {
            const int col = tl[t] * 32 + l31;
            x1s[row * 1024 + col] = g1[t] * acc[t][rt][r];
          }
        }
    }
    __builtin_amdgcn_sched_barrier(0);
    for (int i = tid; i < 256; i += NTHREADS) { *(f32x4*)(g2s + i * 4) = *(const f32x4*)(modb + 5120 + i * 4); *(f32x4*)(fgs + i * 4) = *(const f32x4*)(p.final_g + i * 4); }
    f32x4 xg[2][4];
#pragma unroll
    for (int q = 0; q < 2; ++q)
#pragma unroll
      for (int i = 0; i < 4; ++i) xg[q][i] = *(const f32x4*)(p.x + (size_t)(tok0 + wave * 8 + q) * DM + (i >> 1) * 512 + lane * 8 + (i & 1) * 4);
    __syncthreads();
    {
      f32x4 cm[4], ca[4];
#pragma unroll
      for (int i = 0; i < 4; ++i) {
        const int col = (i >> 1) * 512 + lane * 8 + (i & 1) * 4;
        const f32x4 g = *(const f32x4*)(p.norm2_g + col); const f32x4 sc = *(const f32x4*)(modb + 4096 + col);
        cm[i] = g * (sc + 1.0f); ca[i] = *(const f32x4*)(modb + 3072 + col);
      }
#pragma unroll
      for (int bt = 0; bt < 4; ++bt) {
        f32x4 x1v[2][4];
#pragma unroll
        for (int q = 0; q < 2; ++q)
#pragma unroll
          for (int i = 0; i < 4; ++i) x1v[q][i] = *(const f32x4*)(x1s + (wave * 8 + bt * 2 + q) * 1024 + (i >> 1) * 512 + lane * 8 + (i & 1) * 4);
#pragma unroll
        for (int q = 0; q < 2; ++q)
#pragma unroll
          for (int i = 0; i < 4; ++i) x1v[q][i] += xg[q][i];
        if (bt < 3) {
#pragma unroll
          for (int q = 0; q < 2; ++q)
#pragma unroll
            for (int i = 0; i < 4; ++i) xg[q][i] = *(const f32x4*)(p.x + (size_t)(tok0 + wave * 8 + bt * 2 + 2 + q) * DM + (i >> 1) * 512 + lane * 8 + (i & 1) * 4);
        }
#pragma unroll
        for (int q = 0; q < 2; ++q) {
          const int row = wave * 8 + bt * 2 + q;
          float ss = 0.f;
#pragma unroll
          for (int i = 0; i < 4; ++i) {
            *(f32x4*)(x1s + row * 1024 + (i >> 1) * 512 + lane * 8 + (i & 1) * 4) = x1v[q][i];
#pragma unroll
            for (int j = 0; j < 4; ++j) ss += x1v[q][i][j] * x1v[q][i][j];
          }
          ss = wave_sum(ss);
          const float rs = rsqrtf(ss * (1.f / 1024.f) + EPS);
          f32x4 hv[4];
          float hmax = 0.f;
#pragma unroll
          for (int i = 0; i < 4; ++i) {
            hv[i] = x1v[q][i] * rs * cm[i] + ca[i];
#pragma unroll
            for (int j = 0; j < 4; ++j) hmax = fmaxf(hmax, fabsf(hv[i][j]));
          }
          hmax = wave_max(hmax);
          const float hinv = hmax > 0.f ? 127.f / hmax : 0.f;
#pragma unroll
          for (int i = 0; i < 2; ++i) {
            u32x2 o;
#pragma unroll
            for (int hh = 0; hh < 2; ++hh) {
              unsigned w = 0;
#pragma unroll
              for (int j = 0; j < 4; ++j) w |= ((unsigned)(int)__builtin_rintf(hv[2 * i + hh][j] * hinv) & 255u) << (8 * j);
              o[hh] = w;
            }
            *(u32x2*)(A8 + row * LDA8 + i * 512 + lane * 8) = o;
          }
          if (lane == 0) hs[row] = hmax * (1.f / 127.f);
        }
      }
    }
    __syncthreads();
    float s12[2][16];
    i32x4 ring8[8][2];
    { const int t0[2] = {wave * 8, wave * 8 + 1}; gemm8_pro<2, 8>(p.Wf_s, 32, t0, lane, ring8); }
#pragma unroll 1
    for (int ph = 0; ph < 2; ++ph) {
      const int hd = wave;
      float lst0[16], lst1[16];
#pragma unroll
      for (int i = 0; i < 16; ++i) { lst0[i] = -3.0e38f; lst1[i] = -3.0e38f; }
#pragma unroll 1
      for (int mtp = 0; mtp < 2; ++mtp) {
        i32x16 acc[2][2];
#pragma unroll
        for (int t = 0; t < 2; ++t)
#pragma unroll
          for (int r = 0; r < 16; ++r) { acc[t][0][r] = 0; acc[t][1][r] = 0; }
        const int tl[2] = {(hd * 2 + ph) * 4 + 2 * mtp, (hd * 2 + ph) * 4 + 2 * mtp + 1};
        gemm8_main<2, 8>(A8, LDA8, 32, p.Wf_s, 32, tl, acc, lane, ring8);
        if (ph * 2 + mtp < 3) { const int pn = ph * 2 + mtp + 1; const int tn[2] = {wave * 8 + 2 * pn, wave * 8 + 2 * pn + 1}; gemm8_pro<2, 8>(p.Wf_s, 32, tn, lane, ring8); }
        int el_ = lane; asm volatile("" : "+v"(el_));
        const int lh = el_ >> 5;
#pragma unroll
        for (int t = 0; t < 2; ++t) {
          f32x4 w4[4];
#pragma unroll
          for (int g = 0; g < 4; ++g) w4[g] = *(const f32x4*)(p.wsc + tl[t] * 32 + 8 * g + 4 * lh);
          float nv[16];
#pragma unroll
          for (int r = 0; r < 16; ++r) nv[r] = __uint_as_float((__float_as_uint((float)acc[t][0][r] * w4[r >> 2][r & 3]) & 0xffffff80u) | (unsigned)((2 * mtp + t) * 32 + crow(r, lh)));
          sort16_desc(nv);
          if (t == 0 && mtp == 0) {
#pragma unroll
            for (int r = 0; r < 16; ++r) lst0[r] = nv[r];
          } else merge16_desc(lst0, nv);
#pragma unroll
          for (int r = 0; r < 16; ++r) nv[r] = __uint_as_float((__float_as_uint((float)acc[t][1][r] * w4[r >> 2][r & 3]) & 0xffffff80u) | (unsigned)((2 * mtp + t) * 32 + crow(r, lh)));
          sort16_desc(nv);
          if (t == 0 && mtp == 0) {
#pragma unroll
            for (int r = 0; r < 16; ++r) lst1[r] = nv[r];
          } else merge16_desc(lst1, nv);
        }
      }
      merge_partner(lst0, lane);
      merge_partner(lst1, lane);
      if (ph == 0) {
#pragma unroll
        for (int i = 0; i < 16; ++i) s12[0][i] = lh ? lst1[i] : lst0[i];
      } else {
#pragma unroll
        for (int i = 0; i < 16; ++i) s12[1][i] = lh ? lst1[i] : lst0[i];
      }
    }
    {
      const int hd = wave;
      unsigned long long t1lo = 0, t1hi = 0, t2lo = 0, t2hi = 0;
#pragma unroll
      for (int i = 0; i < 8; ++i) {
        t1lo |= (unsigned long long)(__float_as_uint(s12[0][i]) & 127u) << (8 * i);
        t1hi |= (unsigned long long)(__float_as_uint(s12[0][8 + i]) & 127u) << (8 * i);
        t2lo |= (unsigned long long)(__float_as_uint(s12[1][i]) & 127u) << (8 * i);
        t2hi |= (unsigned long long)(__float_as_uint(s12[1][8 + i]) & 127u) << (8 * i);
      }
      const float hst = hs[lh * 32 + l31];
      float bv[16];
#pragma unroll
      for (int j = 0; j < 16; ++j) {
        const float sv = (s12[0][0] + s12[1][j]) * hst;
        bv[j] = __uint_as_float((__float_as_uint(sv) & 0xffffff00u) | (unsigned)j);
      }
#pragma unroll
      for (int i = 1; i < 16; ++i) {
#pragma unroll
        for (int j = 0; j < 16; ++j)
          if ((i + 1) * (j + 1) <= 16) {
            const float sv = (s12[0][i] + s12[1][j]) * hst;
            ins16(bv, __uint_as_float((__float_as_uint(sv) & 0xffffff00u) | (unsigned)(i * 16 + j)), (i + 1) * (j + 1) - 1);
          }
      }
      int bi[16];
#pragma unroll
      for (int k = 0; k < 16; ++k) {
        const unsigned code = __float_as_uint(bv[k]) & 255u;
        const unsigned ci = code >> 4, cj = code & 15u;
        const unsigned long long w1 = (ci & 8u) ? t1hi : t1lo, w2 = (cj & 8u) ? t2hi : t2lo;
        const unsigned i1 = (unsigned)(w1 >> ((ci & 7u) * 8)) & 0xffu, i2 = (unsigned)(w2 >> ((cj & 7u) * 8)) & 0xffu;
        bi[k] = (int)(i1 * 128u + i2);
      }
      float esum = 0.f, ev[16];
#pragma unroll
      for (int i = 0; i < 16; ++i) { ev[i] = __expf(bv[i] - bv[0]); esum += ev[i]; }
      const float einv = 1.f / esum;
      {
        const int row = lh * 32 + l31;
#pragma unroll
        for (int i4 = 0; i4 < 4; ++i4) {
          *(i32x4*)(eidx + row * ELD + hd * 16 + i4 * 4) = (i32x4){bi[i4 * 4], bi[i4 * 4 + 1], bi[i4 * 4 + 2], bi[i4 * 4 + 3]};
          *(f32x4*)(egate + row * ELD + hd * 16 + i4 * 4) = (f32x4){ev[i4 * 4] * einv, ev[i4 * 4 + 1] * einv, ev[i4 * 4 + 2] * einv, ev[i4 * 4 + 3] * einv};
        }
      }
    }
    __syncthreads();
    const __amdgpu_buffer_rsrc_t qrs = __builtin_amdgcn_make_buffer_rsrc((void*)p.Uq, 0, 2 * 16384 * QROWB, 0x00020000);
    const int voff_u = (QBITS == 8) ? lane * 16 : lane * 16, voff_v = voff_u + 16384 * QROWB;
    int n_ia, n_ib; float n_ga, n_gb, n_ua, n_ub, n_ba, n_bb, n_kt, n_hscale; unsigned n_hq[4];
    qrow_t bufA_u[8], bufA_v[8], bufB_u[8], bufB_v[8];
#define GA_PREP(ROW)                                                                                                              \
    {                                                                                                                             \
      const int prow = (ROW);                                                                                                     \
      n_ia = eidx[prow * ELD + lane]; n_ib = eidx[prow * ELD + 64 + lane];                                                        \
      n_ga = egate[prow * ELD + lane]; n_gb = egate[prow * ELD + 64 + lane];                                                      \
      {     \
        unsigned k0 = ((unsigned)n_ia << 7) | (unsigned)lane, k1 = ((unsigned)n_ib << 7) | (unsigned)(64 + lane);                 \
        sort128_asc(k0, k1, lane);                                                                                                \
        const int p0 = (int)(k0 & 127u), p1 = (int)(k1 & 127u);                                                                   \
        const f32x4 sa = ((const f32x4*)p.uscale)[k0 >> 7], sb = ((const f32x4*)p.uscale)[k1 >> 7];        \
        const float ga0 = __shfl(n_ga, p0 & 63), gb0 = __shfl(n_gb, p0 & 63), ga1 = __shfl(n_ga, p1 & 63), gb1 = __shfl(n_gb, p1 & 63); \
        n_ia = (int)(k0 >> 7) * (QBITS == 8 ? QROWB : 2 * QROWB); n_ib = (int)(k1 >> 7) * (QBITS == 8 ? QROWB : 2 * QROWB);       \
        n_ga = ((p0 & 64) ? gb0 : ga0) * sa[1]; n_gb = ((p1 & 64) ? gb1 : ga1) * sb[1];                                           \
        n_ua = sa[0]; n_ub = sb[0]; n_ba = sa[2]; n_bb = sb[2];                                                                   \
      }                                                                                                                           \
      u32x4 hc = *(const u32x4*)(A8 + prow * LDA8 + lane * 16);        \
      _Pragma("unroll") for (int j = 0; j < 4; ++j) hc[j] ^= 0x80808080u;                                                         \
      n_hscale = hs[prow];                                                                                                        \
      unsigned hsi = 0;                                                                                                           \
      _Pragma("unroll") for (int j = 0; j < 4; ++j) hsi = __builtin_amdgcn_udot4(hc[j], 0x01010101u, hsi, false);                 \
      const float hsum = (float)hsi;                                                                                              \
      if (QBITS == 8) {                                                                                                           \
        _Pragma("unroll") for (int j = 0; j < 4; ++j) n_hq[j] = hc[j];                                                            \
      } else {               \
        _Pragma("unroll") for (int jd = 0; jd < 2; ++jd) {                                                                        \
          n_hq[jd] = ((hc[2 * jd] >> 4) & 0x0f0f0f0fu) | (hc[2 * jd + 1] & 0xf0f0f0f0u);                                          \
          n_hq[2 + jd] = (hc[2 * jd] & 0x0f0f0f0fu) | ((hc[2 * jd + 1] & 0x0f0f0f0fu) << 4);                                      \
        }                                                                                                                         \
      }                                                                                                                           \
      n_kt = (QBITS == 8 ? 128.f : 7.5f) * (wave_sum(hsum) - 131072.f);                                                           \
    }
    GA_PREP(wave)
    ga_load(qrs, n_ia, 0, voff_u, voff_v, bufA_u, bufA_v);
#pragma unroll 1
    for (int rr = 0; rr < 8; ++rr) {
      const int row = rr * 8 + wave; const int tok = tok0 + row;
      const int ia = n_ia, ib = n_ib; const float ga = n_ga, gb = n_gb, ua = n_ua, ub = n_ub, ba = n_ba, bb = n_bb, kt = n_kt, hscale = n_hscale;
      unsigned hq[4];
#pragma unroll
      for (int j = 0; j < 4; ++j) hq[j] = n_hq[j];
      f32x4 xv4[4];
#pragma unroll
      for (int q = 0; q < 4; ++q) xv4[q] = *(const f32x4*)(x1s + row * 1024 + lane * 16 + q * 4);
      if (rr + 1 < 8) GA_PREP(row + 8)
      oacc_t oacc[8];
#pragma unroll
      for (int j = 0; j < 8; ++j) { oacc[j][0] = 0; oacc[j][1] = 0; }
      float csum = 0.f;
#pragma unroll 1
      for (int half = 0; half < 2; ++half) {
        const int iv = half ? ib : ia, ivn = half ? n_ia : ib;
        const float gs = half ? gb : ga, us = half ? ub : ua, bs = half ? bb : ba;
        const bool has_next = (half == 0) || (rr + 1 < 8);
#pragma unroll 1
        for (int g8 = 0; g8 < 8; g8 += 2) {
          ga_load(qrs, iv, (g8 + 1) * 8, voff_u, voff_v, bufB_u, bufB_v);
          ga_compute(gs, us, bs, g8 * 8, lane, kt, hscale, hq, bufA_u, bufA_v, oacc, csum);
          if (g8 + 2 < 8) ga_load(qrs, iv, (g8 + 2) * 8, voff_u, voff_v, bufA_u, bufA_v);
          else if (has_next) ga_load(qrs, ivn, 0, voff_u, voff_v, bufA_u, bufA_v);
          ga_compute(gs, us, bs, (g8 + 1) * 8, lane, kt, hscale, hq, bufB_u, bufB_v, oacc, csum);
        }
      }
      {
#if QBITS == 8
        const float corr = wave_sum(csum) * (128.f / 8.f);
#pragma unroll
        for (int j = 0; j < 8; ++j) oacc[j] = oacc[j] - corr;
#endif
      }
      float xo[16]; float ss = 0.f;
#pragma unroll
      for (int q = 0; q < 4; ++q) {
        const int col = lane * 16 + q * 4;
        const f32x4 xv = xv4[q];
        const f32x4 g2 = *(const f32x4*)(g2s + col);
#pragma unroll
        for (int j = 0; j < 4; ++j) { const float v = xv[j] + g2[j] * ((float)oacc[q * 2 + (j >> 1)][j & 1] * (1.f / OACC_SCALE)); xo[q * 4 + j] = v; ss += v * v; }
      }
      ss = wave_sum(ss);
      const float rs = rsqrtf(ss * (1.f / 1024.f) + EPS);
#pragma unroll
      for (int q = 0; q < 4; ++q) {
        const int col = lane * 16 + q * 4;
        const f32x4 fg = *(const f32x4*)(fgs + col);
        f32x4 o;
#pragma unroll
        for (int j = 0; j < 4; ++j) o[j] = xo[q * 4 + j] * rs * fg[j];
        *(f32x4*)(p.out + (size_t)tok * DM + col) = o;
      }
    }
#undef GA_PREP
    __syncthreads();
  }
}

template <int MODE>
__global__ void __launch_bounds__(NTHREADS) mk_fwd(Params p) {
  extern __shared__ __attribute__((aligned(16))) char smem[];
  if (MODE < 0) {
    cg::grid_group grid = cg::this_grid();
    typedef const __attribute__((address_space(4))) Params* KPP;
    { KPP kp = (KPP)__builtin_amdgcn_kernarg_segment_ptr(); asm volatile("" : "+s"(kp)); phase0(*kp, smem); }
    grid.sync();
    { KPP kp = (KPP)__builtin_amdgcn_kernarg_segment_ptr(); asm volatile("" : "+s"(kp)); phase1(*kp, smem); }
    grid.sync();
    { KPP kp = (KPP)__builtin_amdgcn_kernarg_segment_ptr(); asm volatile("" : "+s"(kp)); phase2(*kp, smem); }
    grid.sync();
    { KPP kp = (KPP)__builtin_amdgcn_kernarg_segment_ptr(); asm volatile("" : "+s"(kp)); phase3(*kp, smem); }
#ifdef PROBE_P3X2
    grid.sync();
    phase3(p, smem);
#endif
#ifdef PROBE_P1X2
    grid.sync();
    phase1(p, smem);
#endif
  } else {
    typedef const __attribute__((address_space(4))) Params* KPP;
    KPP kp = (KPP)__builtin_amdgcn_kernarg_segment_ptr();
    if (MODE == 0) phase0(*kp, smem);
    if (MODE == 1) phase1(*kp, smem);
    if (MODE == 2) phase2(*kp, smem);
    if (MODE == 3) phase3(*kp, smem);
  }
}

static size_t align_up(size_t v) { return (v + 255) & ~(size_t)255; }

extern "C" void kernel_launch(void* const* d_in, const int* in_sizes, int n_in, void* d_out, int out_size, void* d_ws, size_t ws_size, hipStream_t stream) {
  static int grid = 0;
  if (grid == 0) {
    int dev = 0, cus = 0, per_cu = 0;
    (void)hipGetDevice(&dev);
    (void)hipDeviceGetAttribute(&cus, hipDeviceAttributeMultiprocessorCount, dev);
#if N_LAUNCH_MODE == 1
    (void)hipFuncSetAttribute((const void*)mk_fwd<-1>, hipFuncAttributeMaxDynamicSharedMemorySize, LDS_BYTES);
    (void)hipOccupancyMaxActiveBlocksPerMultiprocessor(&per_cu, (const void*)mk_fwd<-1>, NTHREADS, LDS_BYTES);
#else
    (void)hipFuncSetAttribute((const void*)mk_fwd<0>, hipFuncAttributeMaxDynamicSharedMemorySize, LDS_BYTES);
    (void)hipFuncSetAttribute((const void*)mk_fwd<1>, hipFuncAttributeMaxDynamicSharedMemorySize, LDS_BYTES);
    (void)hipFuncSetAttribute((const void*)mk_fwd<2>, hipFuncAttributeMaxDynamicSharedMemorySize, LDS_BYTES);
    (void)hipFuncSetAttribute((const void*)mk_fwd<3>, hipFuncAttributeMaxDynamicSharedMemorySize, LDS_BYTES);
    (void)hipOccupancyMaxActiveBlocksPerMultiprocessor(&per_cu, (const void*)mk_fwd<3>, NTHREADS, LDS_BYTES);
#endif
    if (per_cu < 1) { fprintf(stderr, "kernel_launch: occupancy query says %d blocks/CU\n", per_cu); per_cu = 1; }
    if (per_cu > 1) per_cu = 1;
    grid = cus * per_cu;
    if (grid > 256) grid = 256;
    (void)hipGetLastError();
  }
  Params p{};
  const float* const* fin = (const float* const*)d_in;
  p.x = fin[0]; p.c = fin[1]; p.pos = (const int*)d_in[2];
  p.w_ada = fin[3]; p.b_ada = fin[4]; p.norm1_g = fin[5]; p.w_in = fin[6]; p.conv_w = fin[7]; p.conv_b = fin[8];
  p.lru_wa = fin[9]; p.lru_ba = fin[10]; p.lru_wx = fin[11]; p.lru_bx = fin[12]; p.lru_lambda = fin[13];
  p.q_norm_g = fin[14]; p.w_uq = fin[15]; p.kv_norm_g = fin[16]; p.w_ukv = fin[17]; p.lru_out_g = fin[18]; p.mla_out_g = fin[19];
  p.w_out = fin[20]; p.norm2_g = fin[21]; p.peer_wq = fin[22]; p.peer_keys = fin[23]; p.peer_u = fin[24]; p.peer_v = fin[25]; p.final_g = fin[26];
  p.out = (float*)d_out;
  char* w = (char*)d_ws; size_t off = 0;
  auto take = [&](size_t bytes) { char* r = w + off; off = align_up(off + bytes); return r; };
  p.mod = (float*)take((size_t)NB * 6144 * 4);
  p.ssq_lru = (float*)take((size_t)NTOK * 4);
  p.ssq_mla = (float*)take((size_t)NTOK * 4);
  p.invfreq = (double*)take(16 * 8);
  p.Wf_in = (bf16x8*)take((size_t)INW * 1024 * 2);
  p.Wf_uq = (bf16x8*)take((size_t)768 * 256 * 2);
  p.Wf_ukv = (bf16x8*)take((size_t)1024 * 128 * 2);
  p.Wf_a = (bf16x8*)take((size_t)8 * 64 * 64 * 2);
  p.Wf_x = (bf16x8*)take((size_t)8 * 64 * 64 * 2);
  p.Wf_out = (bf16x8*)take((size_t)1024 * 1024 * 2);
  p.Wf_s = (i32x4*)take((size_t)2048 * 1024);
  p.Wsf = (float*)take((size_t)2048 * 1024 * 4);
  p.wsmaxp = (float*)take((size_t)2048 * 16 * 4);
  p.wsc = (float*)take((size_t)2048 * 4);
  p.Uq = (unsigned char*)take((size_t)2 * 16384 * QROWB);
  p.Vq = p.Uq + (size_t)16384 * QROWB;
  p.uscale = (float*)take((size_t)16384 * 16);
  p.vscale = p.uscale; p.ubias = p.uscale;
  p.xlru = (u16*)take((size_t)NTOK * 512 * 2);
  p.gate = (u16*)take((size_t)NTOK * 512 * 2);
  p.Q = (u16*)take((size_t)NTOK * 768 * 2);
  p.Kn = (u16*)take((size_t)NTOK * 512 * 2);
  p.Kr = (u16*)take((size_t)NTOK * 32 * 2);
  p.Vt = (u16*)take((size_t)NTOK * 512 * 2);
  p.y = (u16*)take((size_t)NTOK * 1024 * 2);
  p.scratch = take((size_t)256 * 655360);
  if (off > ws_size) { fprintf(stderr, "kernel_launch: workspace too small: need %zu have %zu\n", off, ws_size); return; }
#if N_LAUNCH_MODE == 1
  void* args[] = {&p};
  hipError_t e = hipLaunchCooperativeKernel((const void*)mk_fwd<-1>, dim3(grid), dim3(NTHREADS), args, LDS_BYTES, stream);
  if (e != hipSuccess) fprintf(stderr, "cooperative launch failed: %s (grid %d)\n", hipGetErrorString(e), grid);
#else
  hipLaunchKernelGGL(mk_fwd<0>, dim3(grid), dim3(NTHREADS), LDS_BYTES, stream, p);
  hipLaunchKernelGGL(mk_fwd<1>, dim3(grid), dim3(NTHREADS), LDS_BYTES, stream, p);
  hipLaunchKernelGGL(mk_fwd<2>, dim3(grid), dim3(NTHREADS), LDS_BYTES, stream, p);
  hipLaunchKernelGGL(mk_fwd<3>, dim3(grid), dim3(NTHREADS), LDS_BYTES, stream, p);
#endif
}
```

```cpp
#include <hip/hip_runtime.h>
#include <hip/hip_cooperative_groups.h>
#include <cstdio>
#include <cstdint>
namespace cg = cooperative_groups;

#ifndef QBITS
#define QBITS 4
#endif
#ifndef N_LAUNCH_MODE
#define N_LAUNCH_MODE 1
#endif

typedef short bf16x8 __attribute__((ext_vector_type(8)));
typedef float f32x16 __attribute__((ext_vector_type(16)));
typedef float f32x4 __attribute__((ext_vector_type(4)));
typedef float f32x2 __attribute__((ext_vector_type(2)));
typedef unsigned u32x4 __attribute__((ext_vector_type(4)));
typedef unsigned u32x2 __attribute__((ext_vector_type(2)));
typedef __bf16 bf16x2_t __attribute__((ext_vector_type(2)));
typedef unsigned short u16;
typedef _Float16 h16x2 __attribute__((ext_vector_type(2)));

#define DI __device__ __forceinline__
#define MFMA32(a, b, c) __builtin_amdgcn_mfma_f32_32x32x16_bf16((a), (b), (c), 0, 0, 0)
typedef int i32x4 __attribute__((ext_vector_type(4)));
typedef int i32x16 __attribute__((ext_vector_type(16)));
#define MFMA8(a, b, c) __builtin_amdgcn_mfma_i32_32x32x32_i8((a), (b), (c), 0, 0, 0)

constexpr int NB = 32, SEQ = 2048, DM = 1024, NTOK = NB * SEQ;
constexpr int INW = 1440;
constexpr int NTHREADS = 512;
constexpr int LDA = 1032;
constexpr int LDA8 = 1040;
constexpr int LDS_BYTES = 147456;
constexpr float EPS = 1e-6f;

struct Params {
  const float* x; const float* c; const int* pos;
  const float* w_ada; const float* b_ada; const float* norm1_g; const float* w_in; const float* conv_w; const float* conv_b;
  const float* lru_wa; const float* lru_ba; const float* lru_wx; const float* lru_bx; const float* lru_lambda;
  const float* q_norm_g; const float* w_uq; const float* kv_norm_g; const float* w_ukv; const float* lru_out_g; const float* mla_out_g;
  const float* w_out; const float* norm2_g; const float* peer_wq; const float* peer_keys; const float* peer_u; const float* peer_v; const float* final_g;
  float* out;
  float* mod; float* ssq_lru; float* ssq_mla; double* invfreq;
  bf16x8* Wf_in; bf16x8* Wf_uq; bf16x8* Wf_ukv; bf16x8* Wf_a; bf16x8* Wf_x; bf16x8* Wf_out; i32x4* Wf_s;
  float* Wsf; float* wsmaxp; float* wsc;
  unsigned char* Uq; unsigned char* Vq; float* uscale; float* vscale; float* ubias; u16* xlru; u16* gate; u16* Q; u16* Kn; u16* Kr; u16* Vt; u16* y;
  char* scratch;
};

typedef const __attribute__((address_space(4))) Params& KP;

DI unsigned pk2(float a, float b) { f32x2 v = {a, b}; bf16x2_t r = __builtin_convertvector(v, bf16x2_t); return __builtin_bit_cast(unsigned, r); }
DI u16 f2bf(float a) { return (u16)(pk2(a, 0.f) & 0xffffu); }
DI float bflo(unsigned u) { return __uint_as_float(u << 16); }
DI float bfhi(unsigned u) { return __uint_as_float(u & 0xffff0000u); }
DI float bf2f(u16 h) { return __uint_as_float(((unsigned)h) << 16); }
template <int CTRL> DI float dppf(float v) { return __builtin_bit_cast(float, __builtin_amdgcn_update_dpp(0, __builtin_bit_cast(int, v), CTRL, 0xF, 0xF, true)); }
typedef unsigned u32x2_ __attribute__((ext_vector_type(2)));
DI float wave_sum(float v) {
  v += dppf<0xB1>(v); v += dppf<0x4E>(v); v += dppf<0x141>(v); v += dppf<0x140>(v);
  u32x2_ r = __builtin_amdgcn_permlane16_swap(__float_as_uint(v), __float_as_uint(v), false, false); v = __uint_as_float(r[0]) + __uint_as_float(r[1]);
  r = __builtin_amdgcn_permlane32_swap(__float_as_uint(v), __float_as_uint(v), false, false); v = __uint_as_float(r[0]) + __uint_as_float(r[1]);
  return v;
}
DI float wave_max(float v) {
  v = fmaxf(v, dppf<0xB1>(v)); v = fmaxf(v, dppf<0x4E>(v)); v = fmaxf(v, dppf<0x141>(v)); v = fmaxf(v, dppf<0x140>(v));
  u32x2_ r = __builtin_amdgcn_permlane16_swap(__float_as_uint(v), __float_as_uint(v), false, false); v = fmaxf(__uint_as_float(r[0]), __uint_as_float(r[1]));
  r = __builtin_amdgcn_permlane32_swap(__float_as_uint(v), __float_as_uint(v), false, false); v = fmaxf(__uint_as_float(r[0]), __uint_as_float(r[1]));
  return v;
}
template <int CTRL> DI unsigned dppu(unsigned v) { return (unsigned)__builtin_amdgcn_update_dpp(0, (int)v, CTRL, 0xF, 0xF, true); }
template <int J> DI unsigned lane_xor_u(unsigned v, int lane) {
  if (J == 1) return dppu<0xB1>(v);
  if (J == 2) return dppu<0x4E>(v);
  if (J == 4) return dppu<0x141>(dppu<0x1B>(v));
  if (J == 8) return dppu<0x128>(v);
  if (J == 16) { const u32x2_ r = __builtin_amdgcn_permlane16_swap(v, v, false, false); return (lane & 16) ? r[0] : r[1]; }
  const u32x2_ r = __builtin_amdgcn_permlane32_swap(v, v, false, false); return (lane & 32) ? r[0] : r[1];
}
template <int J> DI float lane_xor_f(float v, int lane) { return __uint_as_float(lane_xor_u<J>(__float_as_uint(v), lane)); }
DI float sum_xor32(float v) { const u32x2_ r = __builtin_amdgcn_permlane32_swap(__float_as_uint(v), __float_as_uint(v), false, false); return __uint_as_float(r[0]) + __uint_as_float(r[1]); }
DI float max_xor32(float v) { const u32x2_ r = __builtin_amdgcn_permlane32_swap(__float_as_uint(v), __float_as_uint(v), false, false); return fmaxf(__uint_as_float(r[0]), __uint_as_float(r[1])); }
DI float other_xor32(float v, int lane) { const u32x2_ r = __builtin_amdgcn_permlane32_swap(__float_as_uint(v), __float_as_uint(v), false, false); return __uint_as_float((lane & 32) ? r[0] : r[1]); }
DI float reduce8(const float (&v)[8], int lane) {
  float q4[4], r2[2];
#pragma unroll
  for (int j = 0; j < 4; ++j) {
    const u32x2_ r = __builtin_amdgcn_permlane32_swap(__float_as_uint(v[j]), __float_as_uint(v[4 + j]), false, false);
    q4[j] = __uint_as_float(r[0]) + __uint_as_float(r[1]);
  }
#pragma unroll
  for (int j = 0; j < 2; ++j) {
    const u32x2_ r = __builtin_amdgcn_permlane16_swap(__float_as_uint(q4[j]), __float_as_uint(q4[2 + j]), false, false);
    r2[j] = __uint_as_float(r[0]) + __uint_as_float(r[1]);
  }
  const float s0 = r2[0] + dppf<0x128>(r2[0]), s1b = r2[1] + dppf<0x128>(r2[1]);
  float s1 = (lane & 8) ? s1b : s0;
  s1 += dppf<0xB1>(s1);
  s1 += dppf<0x4E>(s1);
  s1 += dppf<0x141>(s1);
  return s1;
}
DI float reduce32(const float (&v)[32], int lane) {
  const bool b3 = (lane & 8) != 0, b2 = (lane & 4) != 0, b1 = (lane & 2) != 0, b0 = (lane & 1) != 0;
  float a16[16], a8[8], a4[4], a2[2];
#pragma unroll
  for (int j = 0; j < 16; ++j) {
    const u32x2_ r = __builtin_amdgcn_permlane16_swap(__float_as_uint(v[j]), __float_as_uint(v[16 + j]), false, false);
    a16[j] = __uint_as_float(r[0]) + __uint_as_float(r[1]);
  }
#pragma unroll
  for (int j = 0; j < 8; ++j) { const float keep = b3 ? a16[8 + j] : a16[j], send = b3 ? a16[j] : a16[8 + j]; a8[j] = keep + lane_xor_f<8>(send, lane); }
#pragma unroll
  for (int j = 0; j < 4; ++j) { const float keep = b2 ? a8[4 + j] : a8[j], send = b2 ? a8[j] : a8[4 + j]; a4[j] = keep + lane_xor_f<4>(send, lane); }
#pragma unroll
  for (int j = 0; j < 2; ++j) { const float keep = b1 ? a4[2 + j] : a4[j], send = b1 ? a4[j] : a4[2 + j]; a2[j] = keep + lane_xor_f<2>(send, lane); }
  const float keep = b0 ? a2[1] : a2[0], send = b0 ? a2[0] : a2[1];
  return keep + lane_xor_f<1>(send, lane);
}
DI float sigmoidf_(float x) { return __builtin_amdgcn_rcpf(1.f + __builtin_amdgcn_exp2f(-1.4426950408889634f * x)); }
DI float gelu_tanh(float x) { const float u = 0.7978845608028654f * (x + 0.044715f * x * x * x); return x * __builtin_amdgcn_rcpf(1.f + __builtin_amdgcn_exp2f(-2.f * 1.4426950408889634f * u)); }
DI float one_minus_exp_small(float z) {
  float q = 1.f + z * (1.f / 6.f);
  q = 1.f + z * (1.f / 5.f) * q;
  q = 1.f + z * (1.f / 4.f) * q;
  q = 1.f + z * (1.f / 3.f) * q;
  q = 1.f + z * (1.f / 2.f) * q;
  return -z * q;
}
DI f32x16 zero16() { f32x16 z; for (int i = 0; i < 16; ++i) z[i] = 0.f; return z; }
DI int crow(int reg, int h) { return (reg & 3) + 8 * (reg >> 2) + 4 * h; }

template <int NT, int PD>
DI void gemm_pro(const bf16x8* __restrict__ Wf, int KS, const int (&tile)[NT], int lane, bf16x8 (&bq)[PD][NT]) {
#pragma unroll
  for (int d = 0; d < PD; ++d)
#pragma unroll
    for (int t = 0; t < NT; ++t) bq[d][t] = Wf[((size_t)tile[t] * KS + d) * 64 + lane];
}
template <int NT, int PD, bool SWAP, bool APF = false>
DI void gemm_main(const u16* As, int lda, int nks, const bf16x8* __restrict__ Wf, int KS, const int (&tile)[NT], f32x16 (&acc)[NT][2], int lane, bf16x8 (&bq)[PD][NT]) {
  const bf16x8* a0p = (const bf16x8*)(As + (lane & 31) * lda + 8 * (lane >> 5));
  const bf16x8* a1p = (const bf16x8*)(As + ((lane & 31) + 32) * lda + 8 * (lane >> 5));
  const bf16x8* bp[NT];
#pragma unroll
  for (int t = 0; t < NT; ++t) bp[t] = Wf + (size_t)tile[t] * KS * 64 + lane;
  bf16x8 a0n = a0p[0], a1n = a1p[0];
#pragma unroll 1
  for (int ks = 0; ks < nks; ks += PD) {
#pragma unroll
    for (int d = 0; d < PD; ++d) {
      bf16x8 a0, a1;
      if (APF) { a0 = a0n; a1 = a1n; const int ka = (ks + d + 1 < nks) ? (ks + d + 1) : (ks + d); a0n = a0p[2 * ka]; a1n = a1p[2 * ka]; }
      else { a0 = a0p[2 * (ks + d)]; a1 = a1p[2 * (ks + d)]; }
      const int kn = (ks + d + PD < nks) ? (ks + d + PD) : (ks + d);
#pragma unroll
      for (int t = 0; t < NT; ++t) {
        const bf16x8 b = bq[d][t];
        bq[d][t] = bp[t][kn * 64];
        acc[t][0] = SWAP ? MFMA32(b, a0, acc[t][0]) : MFMA32(a0, b, acc[t][0]);
        acc[t][1] = SWAP ? MFMA32(b, a1, acc[t][1]) : MFMA32(a1, b, acc[t][1]);
      }
    }
  }
}
template <int NT, int PD = 8, bool SWAP = false>
DI void gemm_core(const u16* As, int lda, int nks, const bf16x8* __restrict__ Wf, int KS, const int (&tile)[NT], f32x16 (&acc)[NT][2], int lane) {
  bf16x8 bq[PD][NT];
  gemm_pro<NT, PD>(Wf, KS, tile, lane, bq);
  gemm_main<NT, PD, SWAP>(As, lda, nks, Wf, KS, tile, acc, lane, bq);
}

template <int NT, int PD>
DI void gemm8_pro(const i32x4* __restrict__ Wf, int KS, const int (&tile)[NT], int lane, i32x4 (&bq)[PD][NT]) {
#pragma unroll
  for (int d = 0; d < PD; ++d)
#pragma unroll
    for (int t = 0; t < NT; ++t) bq[d][t] = Wf[((size_t)tile[t] * KS + d) * 64 + lane];
}
template <int NT, int PD>
DI void gemm8_main(const signed char* As, int lda, int nks, const i32x4* __restrict__ Wf, int KS, const int (&tile)[NT], i32x16 (&acc)[NT][2], int lane, i32x4 (&bq)[PD][NT]) {
  const i32x4* a0p = (const i32x4*)(As + (lane & 31) * lda + 16 * (lane >> 5));
  const i32x4* a1p = (const i32x4*)(As + ((lane & 31) + 32) * lda + 16 * (lane >> 5));
  const i32x4* bp[NT];
#pragma unroll
  for (int t = 0; t < NT; ++t) bp[t] = Wf + (size_t)tile[t] * KS * 64 + lane;
#pragma unroll 1
  for (int ks = 0; ks < nks; ks += PD) {
#pragma unroll
    for (int d = 0; d < PD; ++d) {
      const i32x4 a0 = a0p[2 * (ks + d)], a1 = a1p[2 * (ks + d)];
      const int kn = (ks + d + PD < nks) ? (ks + d + PD) : (ks + d);
#pragma unroll
      for (int t = 0; t < NT; ++t) {
        const i32x4 b = bq[d][t];
        bq[d][t] = bp[t][kn * 64];
        acc[t][0] = MFMA8(b, a0, acc[t][0]);
        acc[t][1] = MFMA8(b, a1, acc[t][1]);
      }
    }
  }
}

DI void conv_frag(const float* __restrict__ W, long sk, long sn, int K, int N, const float* ks1, const float* ks2, int ksplit, bf16x8* out, int gtid, int gthreads) {
  const int KS = K / 16; const int total = (N / 32) * KS * 64;
  for (int i = gtid; i < total; i += gthreads) {
    const int lane = i & 63; const int t = i >> 6; const int ks = t % KS; const int nt = t / KS;
    const int n = nt * 32 + (lane & 31); const int k0 = ks * 16 + 8 * (lane >> 5);
    float v[8];
#pragma unroll
    for (int j = 0; j < 8; ++j) {
      const int k = k0 + j;
      float s = 1.f;
      if (ks1) s = (k < ksplit) ? ks1[k] : ks2[k - ksplit];
      v[j] = W[(long)k * sk + (long)n * sn] * s;
    }
    u32x4 o; o[0] = pk2(v[0], v[1]); o[1] = pk2(v[2], v[3]); o[2] = pk2(v[4], v[5]); o[3] = pk2(v[6], v[7]);
    out[i] = __builtin_bit_cast(bf16x8, o);
  }
}

DI void conv_one(const float* __restrict__ W, long sk, int KS, const float* ks1, const float* ks2, int ksplit, bf16x8* out, int i) {
  const int lane = i & 63; const int t = i >> 6; const int ks = t % KS; const int nt = t / KS;
  const int n = nt * 32 + (lane & 31); const int k0 = ks * 16 + 8 * (lane >> 5);
  float v[8];
#pragma unroll
  for (int j = 0; j < 8; ++j) v[j] = W[(long)(k0 + j) * sk + n];
  if (ks1) {
#pragma unroll
    for (int j = 0; j < 8; ++j) { const int k = k0 + j; v[j] *= (k < ksplit) ? ks1[k] : ks2[k - ksplit]; }
  }
  u32x4 o; o[0] = pk2(v[0], v[1]); o[1] = pk2(v[2], v[3]); o[2] = pk2(v[4], v[5]); o[3] = pk2(v[6], v[7]);
  out[i] = __builtin_bit_cast(bf16x8, o);
}

DI void phase0(KP p, char* smem) {
  const int tid = threadIdx.x; const int gtid = blockIdx.x * NTHREADS + tid; const int gthreads = gridDim.x * NTHREADS;
  for (int i = gtid; i < NTOK; i += gthreads) { p.ssq_lru[i] = 0.f; p.ssq_mla[i] = 0.f; }
  if (gtid < 16) p.invfreq[gtid] = pow(10000.0, -(double)gtid / 16.0);
  {
    float* cact = (float*)smem;
    float* red = (float*)(smem + 65536);
    const int lane = tid & 63, wv = tid >> 6;
    for (int item = blockIdx.x; item < 192; item += gridDim.x) {
      const int cg = item >> 1, bh = item & 1;
      for (int i = tid; i < 16 * DM; i += NTHREADS) { const int bb = i >> 10, k = i & 1023; const float v = p.c[(bh * 16 + bb) * DM + k]; cact[k * 16 + bb] = v / (1.f + __expf(-v)); }
      __syncthreads();
      float acc[16];
#pragma unroll
      for (int bb = 0; bb < 16; ++bb) acc[bb] = 0.f;
      const float* wp = p.w_ada + (size_t)(wv * 128) * 6144 + cg * 64 + lane;
#pragma unroll 32
      for (int kk = 0; kk < 128; ++kk) {
        const float w = wp[(size_t)kk * 6144];
        const f32x4* cp = (const f32x4*)(cact + (wv * 128 + kk) * 16);
#pragma unroll
        for (int q = 0; q < 4; ++q) { const f32x4 cv = cp[q]; acc[4 * q] += cv[0] * w; acc[4 * q + 1] += cv[1] * w; acc[4 * q + 2] += cv[2] * w; acc[4 * q + 3] += cv[3] * w; }
      }
#pragma unroll
      for (int bb = 0; bb < 16; ++bb) red[(wv * 16 + bb) * 64 + lane] = acc[bb];
      __syncthreads();
      for (int o = tid; o < 1024; o += NTHREADS) {
        const int bb = o >> 6, c2 = o & 63;
        float sum = 0.f;
#pragma unroll
        for (int w8 = 0; w8 < 8; ++w8) sum += red[(w8 * 16 + bb) * 64 + c2];
        p.mod[(size_t)(bh * 16 + bb) * 6144 + cg * 64 + c2] = sum + p.b_ada[cg * 64 + c2];
      }
      __syncthreads();
    }
  }
  {
    constexpr int N_IN = 45 * 64 * 64, N_UQ = 24 * 16 * 64, N_UKV = 32 * 8 * 64, N_LRU = 16 * 512, N_OUT = 32 * 64 * 64;
    for (int i = gtid; i < N_IN + N_UQ + N_UKV + N_LRU + N_OUT; i += gthreads) {
      int j = i;
      if (j < N_OUT) { conv_one(p.w_out, 1024, 64, p.lru_out_g, p.mla_out_g, 512, p.Wf_out, j); continue; }
      j -= N_OUT;
      if (j < N_IN) { conv_one(p.w_in, INW, 64, nullptr, nullptr, 0, p.Wf_in, j); continue; }
      j -= N_IN;
      if (j < N_UQ) { conv_one(p.w_uq, 768, 16, p.q_norm_g, p.q_norm_g, 256, p.Wf_uq, j); continue; }
      j -= N_UQ;
      if (j < N_UKV) { conv_one(p.w_ukv, 1024, 8, p.kv_norm_g, p.kv_norm_g, 128, p.Wf_ukv, j); continue; }
      j -= N_UKV;
      { const int h = j >> 10, m = (j >> 9) & 1, f = j & 511; conv_one((m ? p.lru_wx : p.lru_wa) + h * 4096, 64, 4, nullptr, nullptr, 0, (m ? p.Wf_x : p.Wf_a) + h * 512, f); }
    }
  }
  {
    float* kl = (float*)smem;
    float* wl = (float*)(smem + 67584);
    const int lane = tid & 63, wv = tid >> 6, l31 = lane & 31, lh = lane >> 5;
    for (int item = blockIdx.x; item < 256; item += gridDim.x) {
      const int hp = item >> 4, cc = item & 15;
      __syncthreads();
#pragma unroll
      for (int i = 0; i < 8; ++i) { const int e = tid + NTHREADS * i; const int r = e >> 5, q = e & 31; *(f32x4*)(kl + r * 132 + q * 4) = *(const f32x4*)(p.peer_keys + (size_t)hp * 16384 + r * 128 + q * 4); }
#pragma unroll
      for (int i = 0; i < 4; ++i) { const int e = tid + NTHREADS * i; const int c = e >> 5, q = e & 31; *(f32x4*)(wl + c * 132 + q * 4) = *(const f32x4*)(p.peer_wq + (size_t)(cc * 64 + c) * 2048 + hp * 128 + q * 4); }
      __syncthreads();
      const int rt = wv >> 1, ct = wv & 1;
      const float* ap = kl + (rt * 32 + l31) * 132 + 8 * lh;
      const float* bp = wl + (ct * 32 + l31) * 132 + 8 * lh;
      f32x16 acc = zero16();
#pragma unroll
      for (int ks = 0; ks < 8; ++ks) {
        const f32x4 a0 = *(const f32x4*)(ap + 16 * ks), a1 = *(const f32x4*)(ap + 16 * ks + 4);
        const f32x4 b0 = *(const f32x4*)(bp + 16 * ks), b1 = *(const f32x4*)(bp + 16 * ks + 4);
        u32x4 av, bv;
        av[0] = pk2(a0[0], a0[1]); av[1] = pk2(a0[2], a0[3]); av[2] = pk2(a1[0], a1[1]); av[3] = pk2(a1[2], a1[3]);
        bv[0] = pk2(b0[0], b0[1]); bv[1] = pk2(b0[2], b0[3]); bv[2] = pk2(b1[0], b1[1]); bv[3] = pk2(b1[2], b1[3]);
        acc = MFMA32(__builtin_bit_cast(bf16x8, av), __builtin_bit_cast(bf16x8, bv), acc);
      }
      float* dst = p.Wsf + (size_t)(hp * 128 + rt * 32) * 1024 + cc * 64 + ct * 32 + l31;
#pragma unroll
      for (int r = 0; r < 16; ++r) dst[(size_t)crow(r, lh) * 1024] = acc[r];
    }
    __syncthreads();
  }
#if QBITS == 8
  {
    const int lane = tid & 63; const int gw = gtid >> 6; const int nw = gthreads >> 6;
    for (int row = gw; row < 32768; row += nw) {
      const int r = row & 16383; const bool isv = row >= 16384;
      const f32x4* src = (const f32x4*)((isv ? p.peer_v : p.peer_u) + (size_t)r * 1024) + lane * 4;
      f32x4 a[4];
#pragma unroll
      for (int i = 0; i < 4; ++i) a[i] = src[i];
#if QBITS == 8
      float am = 0.f;
#pragma unroll
      for (int i = 0; i < 4; ++i)
#pragma unroll
        for (int j = 0; j < 4; ++j) am = fmaxf(am, fabsf(a[i][j]));
      am = wave_max(am);
      const float inv = am > 0.f ? 127.f / am : 0.f;
      u32x4 o;
#pragma unroll
      for (int i = 0; i < 4; ++i) {
        unsigned w = 0;
#pragma unroll
        for (int j = 0; j < 4; ++j) { const int q = (int)__builtin_rintf(a[i][j] * inv) + 128; w |= (unsigned)q << (8 * j); }
        o[i] = w;
      }
      ((u32x4*)(isv ? p.Vq : p.Uq))[(size_t)r * 64 + lane] = o;
      const float step = am * (1.f / 127.f);
      if (lane == 0) p.uscale[r * 4 + (isv ? 1 : 0)] = step;
      float ns = 0.f;
#pragma unroll
      for (int i = 0; i < 4; ++i) ns += (float)(o[i] & 255u) + (float)((o[i] >> 8) & 255u) + (float)((o[i] >> 16) & 255u) + (float)(o[i] >> 24);
      ns = wave_sum(ns);
      if (lane == 0 && !isv) p.uscale[r * 4 + 2] = step * 128.f * ns;
#else
      float ssum = 0.f;
#pragma unroll
      for (int i = 0; i < 4; ++i)
#pragma unroll
        for (int j = 0; j < 4; ++j) ssum += a[i][j] * a[i][j];
      ssum = wave_sum(ssum);
      const float rms = sqrtf(ssum * (1.f / 1024.f));
      const float step = (isv ? 0.49f : 0.3352f) * rms;
      const float inv = step > 0.f ? 1.f / step : 0.f;
      u32x2 o;
#pragma unroll
      for (int jd = 0; jd < 2; ++jd) {
        unsigned w = 0;
#pragma unroll
        for (int e = 0; e < 8; ++e) {
          const float x = a[(8 * jd + e) >> 2][(8 * jd + e) & 3];
          if (isv) {
            const float m = fabsf(x) * inv;
            const int mag = (m > 0.25f) + (m > 0.75f) + (m > 1.25f) + (m > 1.75f) + (m > 2.5f) + (m > 3.5f) + (m > 5.0f);
            w |= (unsigned)(mag | (x < 0.f ? 8 : 0)) << (4 * e);
          } else {
            int q = (int)__builtin_rintf(x * inv + 7.5f); q = q < 0 ? 0 : (q > 15 ? 15 : q);
            w |= (unsigned)q << (8 * (e & 3) + 4 * (e >> 2));
          }
        }
        o[jd] = w;
      }
      ((u32x2*)(p.Uq + (size_t)r * 1024))[2 * lane + (isv ? 1 : 0)] = o;
      if (lane == 0) p.uscale[r * 4 + (isv ? 1 : 0)] = step;
      float ns = 0.f;
#pragma unroll
      for (int jd = 0; jd < 2; ++jd)
#pragma unroll
        for (int e = 0; e < 8; ++e) ns += (float)((o[jd] >> (4 * e)) & 15u);
      ns = wave_sum(ns);
      if (lane == 0 && !isv) p.uscale[r * 4 + 2] = step * 128.f * ns;
#endif
    }
  }
#else
  {
    const int lane = tid & 63; const int gw = gtid >> 6; const int nw = gthreads >> 6;
    for (int r = gw; r < 16384; r += nw) {
      const f32x4* su = (const f32x4*)(p.peer_u + (size_t)r * 1024) + lane * 4;
      const f32x4* sv = (const f32x4*)(p.peer_v + (size_t)r * 1024) + lane * 4;
      f32x4 au[4], av[4];
#pragma unroll
      for (int i = 0; i < 4; ++i) { au[i] = su[i]; av[i] = sv[i]; }
      float ssu = 0.f, ssv = 0.f;
#pragma unroll
      for (int i = 0; i < 4; ++i)
#pragma unroll
        for (int j = 0; j < 4; ++j) { ssu += au[i][j] * au[i][j]; ssv += av[i][j] * av[i][j]; }
      ssu = wave_sum(ssu); ssv = wave_sum(ssv);
      const float ustep = 0.3352f * sqrtf(ssu * (1.f / 1024.f)), vstep = 0.49f * sqrtf(ssv * (1.f / 1024.f));
      const float uinv = ustep > 0.f ? 1.f / ustep : 0.f, vinv = vstep > 0.f ? 1.f / vstep : 0.f;
      u32x4 o;
      float ns = 0.f;
#pragma unroll
      for (int jd = 0; jd < 2; ++jd) {
        unsigned wu = 0, wv = 0;
#pragma unroll
        for (int e = 0; e < 8; ++e) {
          const float xu = au[(8 * jd + e) >> 2][(8 * jd + e) & 3], xv = av[(8 * jd + e) >> 2][(8 * jd + e) & 3];
          int q = (int)__builtin_rintf(xu * uinv + 7.5f); q = q < 0 ? 0 : (q > 15 ? 15 : q);
          wu |= (unsigned)q << (8 * (e & 3) + 4 * (e >> 2)); ns += (float)q;
          const float m = fabsf(xv) * vinv;
          const int mag = (m > 0.25f) + (m > 0.75f) + (m > 1.25f) + (m > 1.75f) + (m > 2.5f) + (m > 3.5f) + (m > 5.0f);
          wv |= (unsigned)(mag | (xv < 0.f ? 8 : 0)) << (4 * e);
        }
        o[jd] = wu; o[2 + jd] = wv;
      }
      ((u32x4*)(p.Uq + (size_t)r * 1024))[lane] = o;
      ns = wave_sum(ns);
      if (lane == 0) *(f32x4*)(p.uscale + r * 4) = (f32x4){ustep, vstep, ustep * 128.f * ns, 0.f};
    }
  }
#endif
}

DI void ws_quant(KP p) {
  const int lane = threadIdx.x & 63; const int gw = (blockIdx.x * NTHREADS + threadIdx.x) >> 6; const int nw = (gridDim.x * NTHREADS) >> 6;
  for (int row = gw; row < 2048; row += nw) {
    const f32x4* src = (const f32x4*)(p.Wsf + (size_t)row * 1024 + lane * 16);
    f32x4 v[4];
    float m = 0.f;
#pragma unroll
    for (int q = 0; q < 4; ++q) { v[q] = src[q]; m = fmaxf(fmaxf(m, fmaxf(fabsf(v[q][0]), fabsf(v[q][1]))), fmaxf(fabsf(v[q][2]), fabsf(v[q][3]))); }
    m = wave_max(m);
    const float inv = m > 0.f ? 127.f / m : 0.f;
    i32x4 o;
#pragma unroll
    for (int q = 0; q < 4; ++q) {
      unsigned w = 0;
#pragma unroll
      for (int j = 0; j < 4; ++j) w |= ((unsigned)(int)__builtin_rintf(v[q][j] * inv) & 255u) << (8 * j);
      o[q] = (int)w;
    }
    p.Wf_s[(size_t)((row >> 5) * 32 + (lane >> 1)) * 64 + (row & 31) + 32 * (lane & 1)] = o;
    if (lane == 0) p.wsc[row] = m * (1.f / 127.f);
  }
}

DI void phase1(KP p, char* smem) {
  const int tid = threadIdx.x, wave = __builtin_amdgcn_readfirstlane(tid >> 6);
  u16* hA = (u16*)smem;
  float* cs = (float*)(smem + 132096);
  float* ssq = (float*)(smem + 132096 + 8192);
  constexpr int LDL = 424;
  ws_quant(p);
  for (int tile = blockIdx.x; tile < NTOK / 64; tile += gridDim.x) {
    int lane_o = tid & 63; asm volatile("" : "+v"(lane_o));
    const int lane = lane_o, l31 = lane & 31, lh = lane >> 5;
    const int tok0 = tile * 64; const int b = tok0 / SEQ; const int s0 = tok0 % SEQ;
    const float* modb = p.mod + (size_t)b * 6144;
    for (int i = tid; i < 1024; i += NTHREADS) {
      const int r = i >> 4, j = i & 15;
      const double ang = (double)p.pos[tok0 + r] * p.invfreq[j];
      double rev = ang * 0.15915494309189535; rev -= floor(rev);
      const float rf = (float)rev;
      cs[2 * i] = __builtin_amdgcn_cosf(rf); cs[2 * i + 1] = __builtin_amdgcn_sinf(rf);
    }
    if (tid < 128) ssq[tid] = 0.f;
    {
      f32x4 cm[4], ca[4];
#pragma unroll
      for (int i = 0; i < 4; ++i) {
        const int col = i * 256 + lane * 4;
        const f32x4 g = *(const f32x4*)(p.norm1_g + col); const f32x4 sc = *(const f32x4*)(modb + 1024 + col);
        cm[i] = g * (sc + 1.0f); ca[i] = *(const f32x4*)(modb + col);
      }
#pragma unroll 2
      for (int rr = 0; rr < 8; rr += 4) {
        f32x4 xv[4][4];
#pragma unroll
        for (int q = 0; q < 4; ++q)
#pragma unroll
          for (int i = 0; i < 4; ++i) xv[q][i] = *(const f32x4*)(p.x + (size_t)(tok0 + wave * 8 + rr + q) * DM + i * 256 + lane * 4);
#pragma unroll
        for (int q = 0; q < 4; ++q) {
          float ss = 0.f;
#pragma unroll
          for (int i = 0; i < 4; ++i) ss += xv[q][i][0] * xv[q][i][0] + xv[q][i][1] * xv[q][i][1] + xv[q][i][2] * xv[q][i][2] + xv[q][i][3] * xv[q][i][3];
          ss = wave_sum(ss);
          const float rs = rsqrtf(ss * (1.f / 1024.f) + EPS);
          const int row = wave * 8 + rr + q;
#pragma unroll
          for (int i = 0; i < 4; ++i) {
            const f32x4 h = xv[q][i] * rs * cm[i] + ca[i];
            u32x2 o; o[0] = pk2(h[0], h[1]); o[1] = pk2(h[2], h[3]);
            *(u32x2*)(hA + row * LDA + i * 256 + lane * 4) = o;
          }
        }
      }
    }
    __syncthreads();
    bf16x8 ring1[8][2];
    const bool has2 = (wave + 40) < 45;
    { const int tl0[2] = {wave, wave + 8}; gemm_pro<2, 8>(p.Wf_in, 64, tl0, lane, ring1); }
#pragma unroll 1
    for (int pass = 0; pass < 2; ++pass) {
      f32x16 acc[2][2];
#pragma unroll
      for (int t = 0; t < 2; ++t) { acc[t][0] = zero16(); acc[t][1] = zero16(); }
      const int tl[2] = {wave + 16 * pass, wave + 16 * pass + 8};
      gemm_main<2, 8, false, true>(hA, LDA, 64, p.Wf_in, 64, tl, acc, lane, ring1);
      { const int tn[2] = {wave + 16 * (pass + 1), (pass == 0 || has2) ? wave + 16 * (pass + 1) + 8 : wave + 32}; gemm_pro<2, 8>(p.Wf_in, 64, tn, lane, ring1); }
      int el_ = lane; asm volatile("" : "+v"(el_));
      const int l31 = el_ & 31, lh = el_ >> 5;
      u16* dstb[2];
#pragma unroll
      for (int t = 0; t < 2; ++t) { const int col = tl[t] * 32 + l31; dstb[t] = (col < 512) ? (p.xlru + col) : (p.gate + (col - 512)); }
#pragma unroll
      for (int rt = 0; rt < 2; ++rt)
#pragma unroll
        for (int r = 0; r < 16; ++r) {
          const size_t ro = (size_t)(tok0 + rt * 32 + crow(r, lh)) * 512;
#pragma unroll
          for (int t = 0; t < 2; ++t) dstb[t][ro] = f2bf(acc[t][rt][r]);
        }
    }
    {
      f32x16 acc[2][2];
#pragma unroll
      for (int t = 0; t < 2; ++t) { acc[t][0] = zero16(); acc[t][1] = zero16(); }
      const int tl[2] = {wave + 32, has2 ? wave + 40 : wave + 32};
      gemm_main<2, 8, false, true>(hA, LDA, 64, p.Wf_in, 64, tl, acc, lane, ring1);
      int el_ = lane; asm volatile("" : "+v"(el_));
      const int l31 = el_ & 31, lh = el_ >> 5;
      __syncthreads();
      u16* lat = hA;
#pragma unroll
      for (int t = 0; t < 2; ++t) {
        if (t == 1 && !has2) continue;
        const int lc = tl[t] * 32 - 1024 + l31;
        if (tl[t] < 44) {
          float sq[32];
#pragma unroll
          for (int rt = 0; rt < 2; ++rt)
#pragma unroll
            for (int r = 0; r < 16; ++r) { const float v = acc[t][rt][r]; sq[rt * 16 + r] = v * v; }
          const float tot = reduce32(sq, lane);
          __hip_atomic_fetch_add(&ssq[(tl[t] < 40 ? 0 : 64) + (l31 >> 4) * 32 + crow(l31 & 15, lh)], tot, __ATOMIC_RELAXED, __HIP_MEMORY_SCOPE_WORKGROUP);
        }
#pragma unroll
        for (int rt = 0; rt < 2; ++rt)
#pragma unroll
          for (int r = 0; r < 16; ++r) {
            const int row = rt * 32 + crow(r, lh);
            const float v = acc[t][rt][r];
            if (lc < 384) {
              lat[row * LDL + lc] = f2bf(v);
            } else {
              const float pv = lane_xor_f<16>(v, lane);
              const int j = lc - 384; const int jj = j & 15;
              const float co = cs[(row * 16 + jj) * 2], si = cs[(row * 16 + jj) * 2 + 1];
              const float o = (j < 16) ? (v * co - pv * si) : (v * co + pv * si);
              p.Kr[(size_t)(tok0 + row) * 32 + j] = f2bf(o);
            }
          }
      }
    }
    __syncthreads();
    {
      const u16* lat = hA;
      const float qscale = 0.10206207261596577f * 1.4426950408889634f;
      const int jj = l31 & 15;
#pragma unroll 1
      for (int pass = 0; pass < 2; ++pass) {
        f32x16 acc[2][2];
#pragma unroll
        for (int t = 0; t < 2; ++t) { acc[t][0] = zero16(); acc[t][1] = zero16(); }
        const int tl[2] = {pass == 0 ? wave : wave + 16, pass == 0 ? wave + 8 : wave + 16};
        gemm_core<2>(lat, LDL, 16, p.Wf_uq, 16, tl, acc, lane);
        int el_ = lane; asm volatile("" : "+v"(el_));
        const int l31 = el_ & 31, lh = el_ >> 5;
#pragma unroll
        for (int rt = 0; rt < 2; ++rt)
#pragma unroll
          for (int r = 0; r < 16; ++r) {
            const int row = rt * 32 + crow(r, lh);
            const float rs = rsqrtf(ssq[row] * (1.f / 256.f) + EPS) * qscale;
            const float co = cs[(row * 16 + jj) * 2], si = cs[(row * 16 + jj) * 2 + 1];
#pragma unroll
            for (int t = 0; t < 2; ++t) {
              if (t == 1 && pass == 1) continue;
              const int head = tl[t] / 3, part = tl[t] % 3;
              float v = acc[t][rt][r] * rs;
              if (part == 2) {
                const float pv = lane_xor_f<16>(v, lane);
                v = (l31 < 16) ? (v * co - pv * si) : (v * co + pv * si);
              }
              p.Q[((size_t)(b * 8 + head) * SEQ + s0 + row) * 96 + part * 32 + l31] = f2bf(v);
            }
          }
      }
#pragma unroll 1
      for (int pass = 0; pass < 2; ++pass) {
        f32x16 acc[2][2];
#pragma unroll
        for (int t = 0; t < 2; ++t) { acc[t][0] = zero16(); acc[t][1] = zero16(); }
        const int tl[2] = {wave + 16 * pass, wave + 16 * pass + 8};
        gemm_core<2>(lat + 256, LDL, 8, p.Wf_ukv, 8, tl, acc, lane);
        int el_ = lane; asm volatile("" : "+v"(el_));
        const int l31 = el_ & 31, lh = el_ >> 5;
#pragma unroll
        for (int rt = 0; rt < 2; ++rt)
#pragma unroll
          for (int g = 0; g < 4; ++g) {
            const int row = rt * 32 + 8 * g + 4 * lh;
            float rs4[4];
#pragma unroll
            for (int q = 0; q < 4; ++q) rs4[q] = rsqrtf(ssq[64 + row + q] * (1.f / 128.f) + EPS);
#pragma unroll
            for (int t = 0; t < 2; ++t) {
              const int head = tl[t] >> 2, sub = tl[t] & 3;
              float v4[4];
#pragma unroll
              for (int q = 0; q < 4; ++q) v4[q] = acc[t][rt][4 * g + q] * rs4[q];
              if (sub < 2) {
#pragma unroll
                for (int q = 0; q < 4; ++q) p.Kn[((size_t)(b * 8 + head) * SEQ + s0 + row + q) * 64 + sub * 32 + l31] = f2bf(v4[q]);
              } else {
                const int d = (sub - 2) * 32 + l31;
                u32x2 o; o[0] = pk2(v4[0], v4[1]); o[1] = pk2(v4[2], v4[3]);
                *(u32x2*)(p.Vt + ((size_t)(b * 8 + head) * 64 + d) * SEQ + s0 + row) = o;
              }
            }
          }
      }
    }
    __syncthreads();
  }
}

DI void lru_item(KP p, char* smem, int item) {
  const int tid = threadIdx.x, lane = tid & 63, wave = __builtin_amdgcn_readfirstlane(tid >> 6);
  const int l31 = lane & 31, lh = lane >> 5;
  const int b = item >> 3, cb = item & 7;
  const int c = lane; const int ch = cb * 64 + c; const int tg = wave;
  const float cw0 = p.conv_w[ch], cw1 = p.conv_w[512 + ch], cw2 = p.conv_w[1024 + ch], cw3 = p.conv_w[1536 + ch], cbias = p.conv_b[ch];
  const float ba = p.lru_ba[ch], bx = p.lru_bx[ch];
  const float sp = log1pf(__expf(-p.lru_lambda[ch]));
  float carry = 0.f;
  const u16* xl = p.xlru + (size_t)b * SEQ * 512 + ch;
  const u16* gt = p.gate + (size_t)b * SEQ * 512 + ch;
  u16* yo = p.y + (size_t)b * SEQ * 1024 + ch;
  const int mat = wave >> 2, rt = (wave >> 1) & 1, ct = wave & 1;
  const bf16x8* wf = (mat == 0 ? p.Wf_a : p.Wf_x) + cb * 512 + ct * 256 + lane;
  bf16x8 bw[4];
#pragma unroll
  for (int ks = 0; ks < 4; ++ks) bw[ks] = wf[ks * 64];
  constexpr int NCH = SEQ / 64;
  u16 xin_n[11], gv_n[8];
#pragma unroll
  for (int i = 0; i < 11; ++i) { const int t = tg * 8 - 3 + i; xin_n[i] = (t >= 0) ? xl[(size_t)t * 512] : (u16)0; }
#pragma unroll
  for (int i = 0; i < 8; ++i) gv_n[i] = gt[(size_t)(tg * 8 + i) * 512];
  float xcB[8], gvB[8], xcC[8], gvC[8], avD[8], bvD[8], gvD[8];
#pragma unroll
  for (int i = 0; i < 8; ++i) { xcB[i] = gvB[i] = xcC[i] = gvC[i] = avD[i] = bvD[i] = gvD[i] = 0.f; }
  __syncthreads();
#pragma unroll 1
  for (int it = 0; it < NCH + 3; ++it) {
    float xcA[8], gvA[8], avC[8], bvC[8];
    if (it < NCH) {
      const int t0 = it * 64 + tg * 8;
      float xin[11];
#pragma unroll
      for (int i = 0; i < 11; ++i) xin[i] = bf2f(xin_n[i]);
#pragma unroll
      for (int i = 0; i < 8; ++i) gvA[i] = bf2f(gv_n[i]);
      if (it + 1 < NCH) {
#pragma unroll
        for (int i = 0; i < 11; ++i) xin_n[i] = xl[(size_t)(t0 + 64 - 3 + i) * 512];
#pragma unroll
        for (int i = 0; i < 8; ++i) gv_n[i] = gt[(size_t)(t0 + 64 + i) * 512];
      }
      u16* xcb = (u16*)(smem + (it & 1) * 9216);
#pragma unroll
      for (int i = 0; i < 8; ++i) {
        xcA[i] = cbias + cw0 * xin[i] + cw1 * xin[i + 1] + cw2 * xin[i + 2] + cw3 * xin[i + 3];
        xcb[(tg * 8 + i) * 72 + c] = f2bf(xcA[i]);
      }
    } else {
#pragma unroll
      for (int i = 0; i < 8; ++i) { xcA[i] = 0.f; gvA[i] = 0.f; }
    }
    if (it >= 1 && it - 1 < NCH) {
      const u16* xcb = (const u16*)(smem + ((it - 1) & 1) * 9216);
      float* pm = (float*)(smem + 18432 + ((it - 1) & 1) * 33280) + mat * 4160;
      f32x16 acc = zero16();
      const bf16x8* ap = (const bf16x8*)(xcb + (rt * 32 + l31) * 72 + 8 * lh);
#pragma unroll
      for (int ks = 0; ks < 4; ++ks) acc = MFMA32(ap[2 * ks], bw[ks], acc);
#pragma unroll
      for (int r = 0; r < 16; ++r) pm[(rt * 32 + crow(r, lh)) * 65 + ct * 32 + l31] = acc[r];
    }
    if (it >= 2 && it - 2 < NCH) {
      const float* pre = (const float*)(smem + 18432 + ((it - 2) & 1) * 33280);
      float* seg = (float*)(smem + 84992 + ((it - 2) & 1) * 4096);
      float A = 1.f, Bc = 0.f;
#pragma unroll
      for (int i = 0; i < 8; ++i) {
        const int tl = tg * 8 + i;
        const float r = sigmoidf_(pre[tl * 65 + c] + ba);
        const float ig = sigmoidf_(pre[4160 + tl * 65 + c] + bx);
        const float log_a = -8.f * r * sp;
        const float a = __builtin_amdgcn_exp2f(1.4426950408889634f * log_a);
        const float z = 2.f * log_a;
        const float om = (z > -0.25f) ? one_minus_exp_small(z) : -expm1f(z);
        const float m = __builtin_amdgcn_sqrtf(om);
        avC[i] = a; bvC[i] = m * ig * xcC[i];
        A *= a; Bc = a * Bc + bvC[i];
      }
      seg[(tg * 64 + c) * 2] = A; seg[(tg * 64 + c) * 2 + 1] = Bc;
    } else {
#pragma unroll
      for (int i = 0; i < 8; ++i) { avC[i] = 0.f; bvC[i] = 0.f; }
    }
    if (it >= 3) {
      const int t0 = (it - 3) * 64 + tg * 8;
      const float* seg = (const float*)(smem + 84992 + ((it - 3) & 1) * 4096);
      float h = carry, hin = 0.f;
#pragma unroll
      for (int s2 = 0; s2 < 8; ++s2) {
        if (s2 == tg) hin = h;
        h = seg[(s2 * 64 + c) * 2] * h + seg[(s2 * 64 + c) * 2 + 1];
      }
      carry = h;
      h = hin;
      float sq[8];
#pragma unroll
      for (int i = 0; i < 8; ++i) {
        h = avD[i] * h + bvD[i];
        const float yv = gelu_tanh(gvD[i]) * h;
        yo[(size_t)(t0 + i) * 1024] = f2bf(yv);
        sq[i] = yv * yv;
      }
      const float tot = reduce8(sq, lane);
      if ((lane & 7) == 0) unsafeAtomicAdd(p.ssq_lru + (size_t)b * SEQ + t0 + (lane >> 3), tot);
    }
#pragma unroll
    for (int i = 0; i < 8; ++i) {
      avD[i] = avC[i]; bvD[i] = bvC[i]; gvD[i] = gvC[i];
      xcC[i] = xcB[i]; gvC[i] = gvB[i];
      xcB[i] = xcA[i]; gvB[i] = gvA[i];
    }
    __syncthreads();
  }
}

DI void attn_unit(KP p, char* smem, int b, int hd, int qb) {
  const int tid = threadIdx.x, lane = tid & 63, wave = __builtin_amdgcn_readfirstlane(tid >> 6);
  const int l31 = lane & 31, lh = lane >> 5;
  const int q0 = qb * 256 + wave * 32;
  const size_t bh = (size_t)(b * 8 + hd);
  const int nkt = qb * 4 + 4;
  const int qidx = q0 + l31;
  const int skey = tid >> 3, schn = tid & 7;
  const int rkey = (tid & 255) >> 2, rchn = tid & 3;
  const u16* kn_src = p.Kn + (bh * SEQ + skey) * 64 + schn * 8;
  const u16* kr_src = p.Kr + ((size_t)b * SEQ + rkey) * 32 + rchn * 8;
  const u16* vt_src = p.Vt + (bh * 64 + skey) * SEQ + schn * 8;
  u32x4 rk, rr, rv;
  rk = *(const u32x4*)(kn_src); rv = *(const u32x4*)(vt_src);
  if (tid < 256) rr = *(const u32x4*)(kr_src);
  bf16x8 qf[6];
  {
    const bf16x8* qp = (const bf16x8*)(p.Q + (bh * SEQ + q0 + l31) * 96 + 8 * lh);
#pragma unroll
    for (int ks = 0; ks < 6; ++ks) qf[ks] = qp[2 * ks];
  }
  __syncthreads();
  {
    u16* Kl = (u16*)smem; u16* Vl = (u16*)(smem + 13312);
    *(u32x4*)(Kl + skey * 104 + schn * 8) = rk;
    if (tid < 256) *(u32x4*)(Kl + rkey * 104 + 64 + rchn * 8) = rr;
    *(u32x4*)(Vl + skey * 72 + schn * 8) = rv;
  }
  __syncthreads();
  f32x16 o0 = zero16(), o1 = zero16();
  float m_run = -1e30f, l_run = 0.f;
  for (int kt = 0; kt < nkt; ++kt) {
    const u16* Kl = (const u16*)(smem + (kt & 1) * 22528);
    const u16* Vl = (const u16*)(smem + (kt & 1) * 22528 + 13312);
    const bool more = (kt + 1) < nkt;
    if (more) {
      rk = *(const u32x4*)(kn_src + (size_t)(kt + 1) * 64 * 64);
      rv = *(const u32x4*)(vt_src + (kt + 1) * 64);
      if (tid < 256) rr = *(const u32x4*)(kr_src + (size_t)(kt + 1) * 64 * 32);
    }
    if (kt * 64 <= q0 + 31) {
      f32x16 s[2];
      bf16x8 kfr[2][6];
#pragma unroll
      for (int st = 0; st < 2; ++st) {
        const bf16x8* kp = (const bf16x8*)(Kl + (st * 32 + l31) * 104 + 8 * lh);
#pragma unroll
        for (int ks = 0; ks < 6; ++ks) kfr[st][ks] = kp[2 * ks];
      }
#pragma unroll
      for (int st = 0; st < 2; ++st) {
        s[st] = zero16();
#pragma unroll
        for (int ks = 0; ks < 6; ++ks) s[st] = MFMA32(kfr[st][ks], qf[ks], s[st]);
      }
      u32x2 vfr[2][4][2];
#pragma unroll
      for (int dt = 0; dt < 2; ++dt)
#pragma unroll
        for (int c4 = 0; c4 < 4; ++c4) {
          const int kbase = c4 * 16 + 4 * lh;
          vfr[dt][c4][0] = *(const u32x2*)(Vl + (dt * 32 + l31) * 72 + kbase);
          vfr[dt][c4][1] = *(const u32x2*)(Vl + (dt * 32 + l31) * 72 + kbase + 8);
        }
      if (kt * 64 + 63 > q0) {
#pragma unroll
        for (int st = 0; st < 2; ++st)
#pragma unroll
          for (int r = 0; r < 16; ++r) { const int key = kt * 64 + st * 32 + crow(r, lh); if (key > qidx) s[st][r] = -1e30f; }
      }
      float mloc = s[0][0];
#pragma unroll
      for (int st = 0; st < 2; ++st)
#pragma unroll
        for (int r = 0; r < 16; ++r) mloc = fmaxf(mloc, s[st][r]);
      mloc = max_xor32(mloc);
      const float m_new = fmaxf(m_run, mloc);
      const float alpha = __builtin_amdgcn_exp2f(m_run - m_new);
      m_run = m_new;
      float lsum = 0.f;
#pragma unroll
      for (int st = 0; st < 2; ++st)
#pragma unroll
        for (int r = 0; r < 16; ++r) { const float e = __builtin_amdgcn_exp2f(s[st][r] - m_new); s[st][r] = e; lsum += e; }
      l_run = l_run * alpha + lsum;
#pragma unroll
      for (int r = 0; r < 16; ++r) { o0[r] *= alpha; o1[r] *= alpha; }
#pragma unroll
      for (int st = 0; st < 2; ++st)
#pragma unroll
        for (int s2 = 0; s2 < 2; ++s2) {
          u32x4 pw;
#pragma unroll
          for (int j = 0; j < 4; ++j) pw[j] = pk2(s[st][8 * s2 + 2 * j], s[st][8 * s2 + 2 * j + 1]);
          const bf16x8 pf = __builtin_bit_cast(bf16x8, pw);
          const int c4 = st * 2 + s2;
          {
            u32x4 vv; vv[0] = vfr[0][c4][0][0]; vv[1] = vfr[0][c4][0][1]; vv[2] = vfr[0][c4][1][0]; vv[3] = vfr[0][c4][1][1];
            o0 = MFMA32(__builtin_bit_cast(bf16x8, vv), pf, o0);
          }
          {
            u32x4 vv; vv[0] = vfr[1][c4][0][0]; vv[1] = vfr[1][c4][0][1]; vv[2] = vfr[1][c4][1][0]; vv[3] = vfr[1][c4][1][1];
            o1 = MFMA32(__builtin_bit_cast(bf16x8, vv), pf, o1);
          }
        }
    }
    if (more) {
      u16* Kn2 = (u16*)(smem + ((kt + 1) & 1) * 22528); u16* Vn2 = (u16*)(smem + ((kt + 1) & 1) * 22528 + 13312);
      *(u32x4*)(Kn2 + skey * 104 + schn * 8) = rk;
      if (tid < 256) *(u32x4*)(Kn2 + rkey * 104 + 64 + rchn * 8) = rr;
      *(u32x4*)(Vn2 + skey * 72 + schn * 8) = rv;
    }
    __syncthreads();
  }
  const float ltot = sum_xor32(l_run);
  const float inv = 1.f / ltot;
  float ss = 0.f;
  u16* yrow = p.y + ((size_t)b * SEQ + qidx) * 1024 + 512 + hd * 64;
#pragma unroll
  for (int g = 0; g < 4; ++g) {
    float v0[4], v1[4];
#pragma unroll
    for (int q = 0; q < 4; ++q) { v0[q] = o0[4 * g + q] * inv; v1[q] = o1[4 * g + q] * inv; ss += v0[q] * v0[q] + v1[q] * v1[q]; }
    u32x2 a; a[0] = pk2(v0[0], v0[1]); a[1] = pk2(v0[2], v0[3]);
    u32x2 c2; c2[0] = pk2(v1[0], v1[1]); c2[1] = pk2(v1[2], v1[3]);
    *(u32x2*)(yrow + 8 * g + 4 * lh) = a;
    *(u32x2*)(yrow + 32 + 8 * g + 4 * lh) = c2;
  }
  ss = sum_xor32(ss);
  if (lh == 0) unsafeAtomicAdd(p.ssq_mla + (size_t)b * SEQ + qidx, ss);
}

DI void phase2(KP p, char* smem) {
  for (int item = blockIdx.x; item < 256; item += gridDim.x) lru_item(p, smem, item);
  for (int it = blockIdx.x; it < 1024; it += gridDim.x) {
    const int j = it & 3; const int bh = it >> 2; const int hd = bh & 7; const int b = bh >> 3;
    attn_unit(p, smem, b, hd, 7 - j);
    attn_unit(p, smem, b, hd, j);
  }
}

DI void sort128_asc(unsigned& k0, unsigned& k1, int lane) {
#pragma unroll
  for (int k = 2; k <= 128; k <<= 1) {
#pragma unroll
    for (int j = k >> 1; j > 0; j >>= 1) {
      if (j == 64) {
        const unsigned lo = k0 < k1 ? k0 : k1, hi = k0 < k1 ? k1 : k0; k0 = lo; k1 = hi;
      } else {
        const unsigned o0 = (j == 1) ? lane_xor_u<1>(k0, lane) : (j == 2) ? lane_xor_u<2>(k0, lane) : (j == 4) ? lane_xor_u<4>(k0, lane) : (j == 8) ? lane_xor_u<8>(k0, lane) : (j == 16) ? lane_xor_u<16>(k0, lane) : lane_xor_u<32>(k0, lane);
        const unsigned o1 = (j == 1) ? lane_xor_u<1>(k1, lane) : (j == 2) ? lane_xor_u<2>(k1, lane) : (j == 4) ? lane_xor_u<4>(k1, lane) : (j == 8) ? lane_xor_u<8>(k1, lane) : (j == 16) ? lane_xor_u<16>(k1, lane) : lane_xor_u<32>(k1, lane);
        const bool lower = (lane & j) == 0;
        const bool asc0 = (k == 128) ? true : ((lane & k) == 0);
        const bool asc1 = (k == 128) ? true : (k == 64 ? false : ((lane & k) == 0));
        const unsigned mn0 = k0 < o0 ? k0 : o0, mx0 = k0 < o0 ? o0 : k0;
        const unsigned mn1 = k1 < o1 ? k1 : o1, mx1 = k1 < o1 ? o1 : k1;
        k0 = (asc0 == lower) ? mn0 : mx0;
        k1 = (asc1 == lower) ? mn1 : mx1;
      }
    }
  }
}
#if QBITS == 8
typedef u32x4 qrow_t;
#else
typedef u32x2 qrow_t;
#endif
constexpr int QROWB = (QBITS == 8) ? 1024 : 512;
DI void ga_load(__amdgpu_buffer_rsrc_t rs, int iv, int gl, int voff_u, int voff_v, qrow_t (&uq)[8], qrow_t (&vq)[8]) {
#pragma unroll
  for (int k = 0; k < 8; ++k) {
    const int so = __builtin_amdgcn_readlane(iv, gl + k);
#if QBITS == 8
    uq[k] = __builtin_amdgcn_raw_buffer_load_b128(rs, voff_u, so, 0);
    vq[k] = __builtin_amdgcn_raw_buffer_load_b128(rs, voff_v, so, 0);
#else
    const u32x4 rec = __builtin_amdgcn_raw_buffer_load_b128(rs, voff_u, so, 16);
    uq[k] = (u32x2){rec[0], rec[1]}; vq[k] = (u32x2){rec[2], rec[3]};
#endif
  }
}
DI unsigned qword(const qrow_t& r, int j) {
#if QBITS == 8
  return r[j];
#else
  const unsigned w0 = r[j >> 1];
  return (j & 1) ? ((w0 >> 4) & 0x0f0f0f0fu) : (w0 & 0x0f0f0f0fu);
#endif
}
#if QBITS == 8
typedef f32x2 oacc_t;
constexpr float OACC_SCALE = 1.f;
#else
typedef h16x2 oacc_t;
constexpr float OACC_SCALE = 16.f;
#endif
DI void ga_compute(float gsel, float asel, float bsel, int gl, int lane, float kt, float hscale, const unsigned (&hq)[4],
                   const qrow_t (&uq)[8], const qrow_t (&vq)[8], oacc_t (&oacc)[8], float& csum) {
  const float mg = __shfl(gsel, gl + (lane >> 3));
  const float ma = __shfl(asel, gl + (lane >> 3));
  const float mb = __shfl(bsel, gl + (lane >> 3));
  float pp[8];
#pragma unroll
  for (int k = 0; k < 8; ++k) {
#if QBITS == 8
    unsigned d = 0;
#pragma unroll
    for (int j = 0; j < 4; ++j) d = __builtin_amdgcn_udot4(qword(uq[k], j), hq[j], d, false);
#else
    unsigned dh = __builtin_amdgcn_udot8(uq[k][0], hq[0], 0u, false); dh = __builtin_amdgcn_udot8(uq[k][1], hq[1], dh, false);
    unsigned dl = __builtin_amdgcn_udot8(uq[k][0], hq[2], 0u, false); dl = __builtin_amdgcn_udot8(uq[k][1], hq[3], dl, false);
    const unsigned d = dh * 16u + dl;
#endif
    pp[k] = (float)d;
  }
  const float s1 = reduce8(pp, lane);
  const float pre = hscale * (ma * (s1 - kt) - mb);
  const float cf = mg * gelu_tanh(pre);
  csum += cf;
#if QBITS != 8
  const _Float16 cfs = (_Float16)(cf * OACC_SCALE);
  const unsigned cfp = __builtin_bit_cast(unsigned, (h16x2){cfs, cfs});
#endif
#pragma unroll
  for (int k = 0; k < 8; ++k) {
#if QBITS == 8
    const float c = __uint_as_float(__builtin_amdgcn_readlane(__float_as_uint(cf), 8 * k));
    const f32x2 cc = {c, c};
#pragma unroll
    for (int j = 0; j < 4; ++j) {
      unsigned w = qword(vq[k], j);
      asm volatile("" : "+v"(w));
      const f32x2 v0 = {(float)(w & 255u), (float)((w >> 8) & 255u)}, v1 = {(float)((w >> 16) & 255u), (float)(w >> 24)};
      oacc[2 * j] = v0 * cc + oacc[2 * j];
      oacc[2 * j + 1] = v1 * cc + oacc[2 * j + 1];
    }
#else
    const h16x2 cc = __builtin_bit_cast(h16x2, (unsigned)__builtin_amdgcn_readlane((int)cfp, 8 * k));
#pragma unroll
    for (int jd = 0; jd < 2; ++jd) {
      const unsigned w = vq[k][jd];
      oacc[4 * jd + 0] = __builtin_amdgcn_cvt_scalef32_pk_f16_fp4(w, 1.0f, 0) * cc + oacc[4 * jd + 0];
      oacc[4 * jd + 1] = __builtin_amdgcn_cvt_scalef32_pk_f16_fp4(w, 1.0f, 1) * cc + oacc[4 * jd + 1];
      oacc[4 * jd + 2] = __builtin_amdgcn_cvt_scalef32_pk_f16_fp4(w, 1.0f, 2) * cc + oacc[4 * jd + 2];
      oacc[4 * jd + 3] = __builtin_amdgcn_cvt_scalef32_pk_f16_fp4(w, 1.0f, 3) * cc + oacc[4 * jd + 3];
    }
#endif
  }
}

DI void ins16(float (&lst)[16], float x, const int P) {
#pragma unroll
  for (int i = 0; i < 16; ++i) if (i >= P) { const float hi = fmaxf(lst[i], x); x = fminf(lst[i], x); lst[i] = hi; }
}
DI void ce_desc(float& a, float& b) { const float hi = fmaxf(a, b), lo = fminf(a, b); a = hi; b = lo; }
DI void sort16_desc(float (&a)[16]) {
#define CE_(i, j) ce_desc(a[i], a[j]);
  CE_(0, 13) CE_(1, 12) CE_(2, 15) CE_(3, 14) CE_(4, 8) CE_(5, 6) CE_(7, 11) CE_(9, 10)
  CE_(0, 5) CE_(1, 7) CE_(2, 9) CE_(3, 4) CE_(6, 13) CE_(8, 14) CE_(10, 15) CE_(11, 12)
  CE_(0, 1) CE_(2, 3) CE_(4, 5) CE_(6, 8) CE_(7, 9) CE_(10, 11) CE_(12, 13) CE_(14, 15)
  CE_(0, 2) CE_(1, 3) CE_(4, 10) CE_(5, 11) CE_(6, 7) CE_(8, 9) CE_(12, 14) CE_(13, 15)
  CE_(1, 2) CE_(3, 12) CE_(4, 6) CE_(5, 7) CE_(8, 10) CE_(9, 11) CE_(13, 14)
  CE_(1, 4) CE_(2, 6) CE_(5, 8) CE_(7, 10) CE_(9, 13) CE_(11, 14)
  CE_(2, 4) CE_(3, 6) CE_(9, 12) CE_(11, 13)
  CE_(3, 5) CE_(6, 8) CE_(7, 9) CE_(10, 12)
  CE_(3, 4) CE_(5, 6) CE_(7, 8) CE_(9, 10) CE_(11, 12)
  CE_(6, 7) CE_(8, 9)
#undef CE_
}
DI void merge16_desc(float (&x)[16], const float (&y)[16]) {
#pragma unroll
  for (int i = 0; i < 16; ++i) x[i] = fmaxf(x[i], y[15 - i]);
#pragma unroll
  for (int d = 8; d >= 1; d >>= 1)
#pragma unroll
    for (int i = 0; i < 16; ++i)
      if ((i & d) == 0) ce_desc(x[i], x[i + d]);
}
DI void merge_partner(float (&lst)[16], int lane) {
  float o[16];
#pragma unroll
  for (int i = 0; i < 16; ++i) o[i] = other_xor32(lst[i], lane);
  float c[16];
#pragma unroll
  for (int i = 0; i < 16; ++i) c[i] = fmaxf(lst[i], o[15 - i]);
#pragma unroll
  for (int d = 8; d >= 1; d >>= 1) {
#pragma unroll
    for (int i = 0; i < 16; ++i) {
      if ((i & d) == 0) { const float hi = fmaxf(c[i], c[i + d]), lo = fminf(c[i], c[i + d]); c[i] = hi; c[i + d] = lo; }
    }
  }
#pragma unroll
  for (int i = 0; i < 16; ++i) lst[i] = c[i];
}

DI void phase3(KP p, char* smem) {
  const int tid = threadIdx.x, wave = __builtin_amdgcn_readfirstlane(tid >> 6);
  u16* A = (u16*)smem;
  float* ssq2 = (float*)(smem + 146944);
  signed char* A8 = (signed char*)smem;
  float* hs = (float*)(smem + 146944 + 256);
  constexpr int ELD = 132;
  int* eidx = (int*)(smem + 66560);
  float* egate = (float*)(smem + 100352);
  float* g2s = (float*)(smem + 134144);
  float* fgs = (float*)(smem + 138240);
  char* scr = p.scratch + (size_t)blockIdx.x * 655360;
  float* x1s = (float*)scr;
  u16* qp = (u16*)(scr + 262144);
  for (int tile = blockIdx.x; tile < NTOK / 64; tile += gridDim.x) {
    int lane_o = tid & 63; asm volatile("" : "+v"(lane_o));
    const int lane = lane_o, l31 = lane & 31, lh = lane >> 5;
    const int tok0 = tile * 64; const int b = tok0 / SEQ;
    const float* modb = p.mod + (size_t)b * 6144;
#pragma unroll
    for (int bt = 0; bt < 2; ++bt) {
      u32x4 yv[4][2]; float sl[4], sm[4];
#pragma unroll
      for (int q = 0; q < 4; ++q) {
        const int tok = tok0 + wave * 8 + bt * 4 + q;
        sl[q] = p.ssq_lru[tok]; sm[q] = p.ssq_mla[tok];
#pragma unroll
        for (int i = 0; i < 2; ++i) yv[q][i] = *(const u32x4*)(p.y + (size_t)tok * 1024 + (i * 64 + lane) * 8);
      }
#pragma unroll
      for (int q = 0; q < 4; ++q) {
        const int row = wave * 8 + bt * 4 + q;
        const float rl = rsqrtf(sl[q] * (1.f / 512.f) + EPS), rm = rsqrtf(sm[q] * (1.f / 512.f) + EPS);
#pragma unroll
        for (int i = 0; i < 2; ++i) {
          const u32x4 v = yv[q][i];
          const float sc = i == 0 ? rl : rm;
          u32x4 o;
#pragma unroll
          for (int j = 0; j < 4; ++j) o[j] = pk2(bflo(v[j]) * sc, bfhi(v[j]) * sc);
          *(u32x4*)(A + row * LDA + (i * 64 + lane) * 8) = o;
        }
      }
    }
    __syncthreads();
    bf16x8 ring3[8][2];
    { const int tl0[2] = {wave, wave + 8}; gemm_pro<2, 8>(p.Wf_out, 64, tl0, lane, ring3); }
#pragma unroll 1
    for (int pass = 0; pass < 2; ++pass) {
      f32x16 acc[2][2];
#pragma unroll
      for (int t = 0; t < 2; ++t) { acc[t][0] = zero16(); acc[t][1] = zero16(); }
      const int tl[2] = {pass * 16 + wave, pass * 16 + wave + 8};
      gemm_main<2, 8, false, true>(A, LDA, 64, p.Wf_out, 64, tl, acc, lane, ring3);
      if (pass == 0) { const int tn[2] = {16 + wave, 16 + wave + 8}; gemm_pro<2, 8>(p.Wf_out, 64, tn, lane, ring3); }
      int el_ = lane; asm volatile("" : "+v"(el_));
      const int l31 = el_ & 31, lh = el_ >> 5;
      float g1[2];
#pragma unroll
      for (int t = 0; t < 2; ++t) g1[t] = modb[2048 + tl[t] * 32 + l31];
#pragma unroll
      for (int rt = 0; rt < 2; ++rt)
#pragma unroll
        for (int r = 0; r < 16; ++r) {
          const int row = rt * 32 + crow(r, lh);
#pragma unroll
          for (int t = 0; t < 2; ++t) {
            const int col = tl[t] * 32 + l31;
            x1s[row * 1024 + col] = g1[t] * acc[t][rt][r];
          }
        }
    }
    __builtin_amdgcn_sched_barrier(0);
    for (int i = tid; i < 256; i += NTHREADS) { *(f32x4*)(g2s + i * 4) = *(const f32x4*)(modb + 5120 + i * 4); *(f32x4*)(fgs + i * 4) = *(const f32x4*)(p.final_g + i * 4); }
    f32x4 xg[2][4];
#pragma unroll
    for (int q = 0; q < 2; ++q)
#pragma unroll
      for (int i = 0; i < 4; ++i) xg[q][i] = *(const f32x4*)(p.x + (size_t)(tok0 + wave * 8 + q) * DM + (i >> 1) * 512 + lane * 8 + (i & 1) * 4);
    __syncthreads();
    {
      f32x4 cm[4], ca[4];
#pragma unroll
      for (int i = 0; i < 4; ++i) {
        const int col = (i >> 1) * 512 + lane * 8 + (i & 1) * 4;
        const f32x4 g = *(const f32x4*)(p.norm2_g + col); const f32x4 sc = *(const f32x4*)(modb + 4096 + col);
        cm[i] = g * (sc + 1.0f); ca[i] = *(const f32x4*)(modb + 3072 + col);
      }
#pragma unroll
      for (int bt = 0; bt < 4; ++bt) {
        f32x4 x1v[2][4];
#pragma unroll
        for (int q = 0; q < 2; ++q)
#pragma unroll
          for (int i = 0; i < 4; ++i) x1v[q][i] = *(const f32x4*)(x1s + (wave * 8 + bt * 2 + q) * 1024 + (i >> 1) * 512 + lane * 8 + (i & 1) * 4);
#pragma unroll
        for (int q = 0; q < 2; ++q)
#pragma unroll
          for (int i = 0; i < 4; ++i) x1v[q][i] += xg[q][i];
        if (bt < 3) {
#pragma unroll
          for (int q = 0; q < 2; ++q)
#pragma unroll
            for (int i = 0; i < 4; ++i) xg[q][i] = *(const f32x4*)(p.x + (size_t)(tok0 + wave * 8 + bt * 2 + 2 + q) * DM + (i >> 1) * 512 + lane * 8 + (i & 1) * 4);
        }
#pragma unroll
        for (int q = 0; q < 2; ++q) {
          const int row = wave * 8 + bt * 2 + q;
          float ss = 0.f;
#pragma unroll
          for (int i = 0; i < 4; ++i) {
            *(f32x4*)(x1s + row * 1024 + (i >> 1) * 512 + lane * 8 + (i & 1) * 4) = x1v[q][i];
#pragma unroll
            for (int j = 0; j < 4; ++j) ss += x1v[q][i][j] * x1v[q][i][j];
          }
          ss = wave_sum(ss);
          const float rs = rsqrtf(ss * (1.f / 1024.f) + EPS);
          f32x4 hv[4];
          float hmax = 0.f;
#pragma unroll
          for (int i = 0; i < 4; ++i) {
            hv[i] = x1v[q][i] * rs * cm[i] + ca[i];
#pragma unroll
            for (int j = 0; j < 4; ++j) hmax = fmaxf(hmax, fabsf(hv[i][j]));
          }
          hmax = wave_max(hmax);
          const float hinv = hmax > 0.f ? 127.f / hmax : 0.f;
#pragma unroll
          for (int i = 0; i < 2; ++i) {
            u32x2 o;
#pragma unroll
            for (int hh = 0; hh < 2; ++hh) {
              unsigned w = 0;
#pragma unroll
              for (int j = 0; j < 4; ++j) w |= ((unsigned)(int)__builtin_rintf(hv[2 * i + hh][j] * hinv) & 255u) << (8 * j);
              o[hh] = w;
            }
            *(u32x2*)(A8 + row * LDA8 + i * 512 + lane * 8) = o;
          }
          if (lane == 0) hs[row] = hmax * (1.f / 127.f);
        }
      }
    }
    __syncthreads();
    float s12[2][16];
    i32x4 ring8[8][2];
    { const int t0[2] = {wave * 8, wave * 8 + 1}; gemm8_pro<2, 8>(p.Wf_s, 32, t0, lane, ring8); }
#pragma unroll 1
    for (int ph = 0; ph < 2; ++ph) {
      const int hd = wave;
      float lst0[16], lst1[16];
#pragma unroll
      for (int i = 0; i < 16; ++i) { lst0[i] = -3.0e38f; lst1[i] = -3.0e38f; }
#pragma unroll 1
      for (int mtp = 0; mtp < 2; ++mtp) {
        i32x16 acc[2][2];
#pragma unroll
        for (int t = 0; t < 2; ++t)
#pragma unroll
          for (int r = 0; r < 16; ++r) { acc[t][0][r] = 0; acc[t][1][r] = 0; }
        const int tl[2] = {(hd * 2 + ph) * 4 + 2 * mtp, (hd * 2 + ph) * 4 + 2 * mtp + 1};
        gemm8_main<2, 8>(A8, LDA8, 32, p.Wf_s, 32, tl, acc, lane, ring8);
        if (ph * 2 + mtp < 3) { const int pn = ph * 2 + mtp + 1; const int tn[2] = {wave * 8 + 2 * pn, wave * 8 + 2 * pn + 1}; gemm8_pro<2, 8>(p.Wf_s, 32, tn, lane, ring8); }
        int el_ = lane; asm volatile("" : "+v"(el_));
        const int lh = el_ >> 5;
#pragma unroll
        for (int t = 0; t < 2; ++t) {
          f32x4 w4[4];
#pragma unroll
          for (int g = 0; g < 4; ++g) w4[g] = *(const f32x4*)(p.wsc + tl[t] * 32 + 8 * g + 4 * lh);
          float nv[16];
#pragma unroll
          for (int r = 0; r < 16; ++r) nv[r] = __uint_as_float((__float_as_uint((float)acc[t][0][r] * w4[r >> 2][r & 3]) & 0xffffff80u) | (unsigned)((2 * mtp + t) * 32 + crow(r, lh)));
          sort16_desc(nv);
          if (t == 0 && mtp == 0) {
#pragma unroll
            for (int r = 0; r < 16; ++r) lst0[r] = nv[r];
          } else merge16_desc(lst0, nv);
#pragma unroll
          for (int r = 0; r < 16; ++r) nv[r] = __uint_as_float((__float_as_uint((float)acc[t][1][r] * w4[r >> 2][r & 3]) & 0xffffff80u) | (unsigned)((2 * mtp + t) * 32 + crow(r, lh)));
          sort16_desc(nv);
          if (t == 0 && mtp == 0) {
#pragma unroll
            for (int r = 0; r < 16; ++r) lst1[r] = nv[r];
          } else merge16_desc(lst1, nv);
        }
      }
      merge_partner(lst0, lane);
      merge_partner(lst1, lane);
      if (ph == 0) {
#pragma unroll
        for (int i = 0; i < 16; ++i) s12[0][i] = lh ? lst1[i] : lst0[i];
      } else {
#pragma unroll
        for (int i = 0; i < 16; ++i) s12[1][i] = lh ? lst1[i] : lst0[i];
      }
    }
    {
      const int hd = wave;
      unsigned long long t1lo = 0, t1hi = 0, t2lo = 0, t2hi = 0;
#pragma unroll
      for (int i = 0; i < 8; ++i) {
        t1lo |= (unsigned long long)(__float_as_uint(s12[0][i]) & 127u) << (8 * i);
        t1hi |= (unsigned long long)(__float_as_uint(s12[0][8 + i]) & 127u) << (8 * i);
        t2lo |= (unsigned long long)(__float_as_uint(s12[1][i]) & 127u) << (8 * i);
        t2hi |= (unsigned long long)(__float_as_uint(s12[1][8 + i]) & 127u) << (8 * i);
      }
      const float hst = hs[lh * 32 + l31];
      float bv[16];
#pragma unroll
      for (int j = 0; j < 16; ++j) {
        const float sv = (s12[0][0] + s12[1][j]) * hst;
        bv[j] = __uint_as_float((__float_as_uint(sv) & 0xffffff00u) | (unsigned)j);
      }
#pragma unroll
      for (int i = 1; i < 16; ++i) {
#pragma unroll
        for (int j = 0; j < 16; ++j)
          if ((i + 1) * (j + 1) <= 16) {
            const float sv = (s12[0][i] + s12[1][j]) * hst;
            ins16(bv, __uint_as_float((__float_as_uint(sv) & 0xffffff00u) | (unsigned)(i * 16 + j)), (i + 1) * (j + 1) - 1);
          }
      }
      int bi[16];
#pragma unroll
      for (int k = 0; k < 16; ++k) {
        const unsigned code = __float_as_uint(bv[k]) & 255u;
        const unsigned ci = code >> 4, cj = code & 15u;
        const unsigned long long w1 = (ci & 8u) ? t1hi : t1lo, w2 = (cj & 8u) ? t2hi : t2lo;
        const unsigned i1 = (unsigned)(w1 >> ((ci & 7u) * 8)) & 0xffu, i2 = (unsigned)(w2 >> ((cj & 7u) * 8)) & 0xffu;
        bi[k] = (int)(i1 * 128u + i2);
      }
      float esum = 0.f, ev[16];
#pragma unroll
      for (int i = 0; i < 16; ++i) { ev[i] = __expf(bv[i] - bv[0]); esum += ev[i]; }
      const float einv = 1.f / esum;
      {
        const int row = lh * 32 + l31;
#pragma unroll
        for (int i4 = 0; i4 < 4; ++i4) {
          *(i32x4*)(eidx + row * ELD + hd * 16 + i4 * 4) = (i32x4){bi[i4 * 4], bi[i4 * 4 + 1], bi[i4 * 4 + 2], bi[i4 * 4 + 3]};
          *(f32x4*)(egate + row * ELD + hd * 16 + i4 * 4) = (f32x4){ev[i4 * 4] * einv, ev[i4 * 4 + 1] * einv, ev[i4 * 4 + 2] * einv, ev[i4 * 4 + 3] * einv};
        }
      }
    }
    __syncthreads();
    const __amdgpu_buffer_rsrc_t qrs = __builtin_amdgcn_make_buffer_rsrc((void*)p.Uq, 0, 2 * 16384 * QROWB, 0x00020000);
    const int voff_u = (QBITS == 8) ? lane * 16 : lane * 16, voff_v = voff_u + 16384 * QROWB;
    int n_ia, n_ib; float n_ga, n_gb, n_ua, n_ub, n_ba, n_bb, n_kt, n_hscale; unsigned n_hq[4];
    qrow_t bufA_u[8], bufA_v[8], bufB_u[8], bufB_v[8];
#define GA_PREP(ROW)                                                                                                              \
    {                                                                                                                             \
      const int prow = (ROW);                                                                                                     \
      n_ia = eidx[prow * ELD + lane]; n_ib = eidx[prow * ELD + 64 + lane];                                                        \
      n_ga = egate[prow * ELD + lane]; n_gb = egate[prow * ELD + 64 + lane];                                                      \
      {     \
        unsigned k0 = ((unsigned)n_ia << 7) | (unsigned)lane, k1 = ((unsigned)n_ib << 7) | (unsigned)(64 + lane);                 \
        sort128_asc(k0, k1, lane);                                                                                                \
        const int p0 = (int)(k0 & 127u), p1 = (int)(k1 & 127u);                                                                   \
        const f32x4 sa = ((const f32x4*)p.uscale)[k0 >> 7], sb = ((const f32x4*)p.uscale)[k1 >> 7];        \
        const float ga0 = __shfl(n_ga, p0 & 63), gb0 = __shfl(n_gb, p0 & 63), ga1 = __shfl(n_ga, p1 & 63), gb1 = __shfl(n_gb, p1 & 63); \
        n_ia = (int)(k0 >> 7) * (QBITS == 8 ? QROWB : 2 * QROWB); n_ib = (int)(k1 >> 7) * (QBITS == 8 ? QROWB : 2 * QROWB);       \
        n_ga = ((p0 & 64) ? gb0 : ga0) * sa[1]; n_gb = ((p1 & 64) ? gb1 : ga1) * sb[1];                                           \
        n_ua = sa[0]; n_ub = sb[0]; n_ba = sa[2]; n_bb = sb[2];                                                                   \
      }                                                                                                                           \
      u32x4 hc = *(const u32x4*)(A8 + prow * LDA8 + lane * 16);        \
      _Pragma("unroll") for (int j = 0; j < 4; ++j) hc[j] ^= 0x80808080u;                                                         \
      n_hscale = hs[prow];                                                                                                        \
      unsigned hsi = 0;                                                                                                           \
      _Pragma("unroll") for (int j = 0; j < 4; ++j) hsi = __builtin_amdgcn_udot4(hc[j], 0x01010101u, hsi, false);                 \
      const float hsum = (float)hsi;                                                                                              \
      if (QBITS == 8) {                                                                                                           \
        _Pragma("unroll") for (int j = 0; j < 4; ++j) n_hq[j] = hc[j];                                                            \
      } else {               \
        _Pragma("unroll") for (int jd = 0; jd < 2; ++jd) {                                                                        \
          n_hq[jd] = ((hc[2 * jd] >> 4) & 0x0f0f0f0fu) | (hc[2 * jd + 1] & 0xf0f0f0f0u);                                          \
          n_hq[2 + jd] = (hc[2 * jd] & 0x0f0f0f0fu) | ((hc[2 * jd + 1] & 0x0f0f0f0fu) << 4);                                      \
        }                                                                                                                         \
      }                                                                                                                           \
      n_kt = (QBITS == 8 ? 128.f : 7.5f) * (wave_sum(hsum) - 131072.f);                                                           \
    }
    GA_PREP(wave)
    ga_load(qrs, n_ia, 0, voff_u, voff_v, bufA_u, bufA_v);
#pragma unroll 1
    for (int rr = 0; rr < 8; ++rr) {
      const int row = rr * 8 + wave; const int tok = tok0 + row;
      const int ia = n_ia, ib = n_ib; const float ga = n_ga, gb = n_gb, ua = n_ua, ub = n_ub, ba = n_ba, bb = n_bb, kt = n_kt, hscale = n_hscale;
      unsigned hq[4];
#pragma unroll
      for (int j = 0; j < 4; ++j) hq[j] = n_hq[j];
      f32x4 xv4[4];
#pragma unroll
      for (int q = 0; q < 4; ++q) xv4[q] = *(const f32x4*)(x1s + row * 1024 + lane * 16 + q * 4);
      if (rr + 1 < 8) GA_PREP(row + 8)
      oacc_t oacc[8];
#pragma unroll
      for (int j = 0; j < 8; ++j) { oacc[j][0] = 0; oacc[j][1] = 0; }
      float csum = 0.f;
#pragma unroll 1
      for (int half = 0; half < 2; ++half) {
        const int iv = half ? ib : ia, ivn = half ? n_ia : ib;
        const float gs = half ? gb : ga, us = half ? ub : ua, bs = half ? bb : ba;
        const bool has_next = (half == 0) || (rr + 1 < 8);
#pragma unroll 1
        for (int g8 = 0; g8 < 8; g8 += 2) {
          ga_load(qrs, iv, (g8 + 1) * 8, voff_u, voff_v, bufB_u, bufB_v);
          ga_compute(gs, us, bs, g8 * 8, lane, kt, hscale, hq, bufA_u, bufA_v, oacc, csum);
          if (g8 + 2 < 8) ga_load(qrs, iv, (g8 + 2) * 8, voff_u, voff_v, bufA_u, bufA_v);
          else if (has_next) ga_load(qrs, ivn, 0, voff_u, voff_v, bufA_u, bufA_v);
          ga_compute(gs, us, bs, (g8 + 1) * 8, lane, kt, hscale, hq, bufB_u, bufB_v, oacc, csum);
        }
      }
      {
#if QBITS == 8
        const float corr = wave_sum(csum) * (128.f / 8.f);
#pragma unroll
        for (int j = 0; j < 8; ++j) oacc[j] = oacc[j] - corr;
#endif
      }
      float xo[16]; float ss = 0.f;
#pragma unroll
      for (int q = 0; q < 4; ++q) {
        const int col = lane * 16 + q * 4;
        const f32x4 xv = xv4[q];
        const f32x4 g2 = *(const f32x4*)(g2s + col);
#pragma unroll
        for (int j = 0; j < 4; ++j) { const float v = xv[j] + g2[j] * ((float)oacc[q * 2 + (j >> 1)][j & 1] * (1.f / OACC_SCALE)); xo[q * 4 + j] = v; ss += v * v; }
      }
      ss = wave_sum(ss);
      const float rs = rsqrtf(ss * (1.f / 1024.f) + EPS);
#pragma unroll
      for (int q = 0; q < 4; ++q) {
        const int col = lane * 16 + q * 4;
        const f32x4 fg = *(const f32x4*)(fgs + col);
        f32x4 o;
#pragma unroll
        for (int j = 0; j < 4; ++j) o[j] = xo[q * 4 + j] * rs * fg[j];
        *(f32x4*)(p.out + (size_t)tok * DM + col) = o;
      }
    }
#undef GA_PREP
    __syncthreads();
  }
}

template <int MODE>
__global__ void __launch_bounds__(NTHREADS) mk_fwd(Params p) {
  extern __shared__ __attribute__((aligned(16))) char smem[];
  if (MODE < 0) {
    cg::grid_group grid = cg::this_grid();
    typedef const __attribute__((address_space(4))) Params* KPP;
    { KPP kp = (KPP)__builtin_amdgcn_kernarg_segment_ptr(); asm volatile("" : "+s"(kp)); phase0(*kp, smem); }
    grid.sync();
    { KPP kp = (KPP)__builtin_amdgcn_kernarg_segment_ptr(); asm volatile("" : "+s"(kp)); phase1(*kp, smem); }
    grid.sync();
    { KPP kp = (KPP)__builtin_amdgcn_kernarg_segment_ptr(); asm volatile("" : "+s"(kp)); phase2(*kp, smem); }
    grid.sync();
    { KPP kp = (KPP)__builtin_amdgcn_kernarg_segment_ptr(); asm volatile("" : "+s"(kp)); phase3(*kp, smem); }
#ifdef PROBE_P3X2
    grid.sync();
    phase3(p, smem);
#endif
#ifdef PROBE_P1X2
    grid.sync();
    phase1(p, smem);
#endif
  } else {
    typedef const __attribute__((address_space(4))) Params* KPP;
    KPP kp = (KPP)__builtin_amdgcn_kernarg_segment_ptr();
    if (MODE == 0) phase0(*kp, smem);
    if (MODE == 1) phase1(*kp, smem);
    if (MODE == 2) phase2(*kp, smem);
    if (MODE == 3) phase3(*kp, smem);
  }
}

static size_t align_up(size_t v) { return (v + 255) & ~(size_t)255; }

extern "C" void kernel_launch(void* const* d_in, const int* in_sizes, int n_in, void* d_out, int out_size, void* d_ws, size_t ws_size, hipStream_t stream) {
  static int grid = 0;
  if (grid == 0) {
    int dev = 0, cus = 0, per_cu = 0;
    (void)hipGetDevice(&dev);
    (void)hipDeviceGetAttribute(&cus, hipDeviceAttributeMultiprocessorCount, dev);
#if N_LAUNCH_MODE == 1
    (void)hipFuncSetAttribute((const void*)mk_fwd<-1>, hipFuncAttributeMaxDynamicSharedMemorySize, LDS_BYTES);
    (void)hipOccupancyMaxActiveBlocksPerMultiprocessor(&per_cu, (const void*)mk_fwd<-1>, NTHREADS, LDS_BYTES);
#else
    (void)hipFuncSetAttribute((const void*)mk_fwd<0>, hipFuncAttributeMaxDynamicSharedMemorySize, LDS_BYTES);
    (void)hipFuncSetAttribute((const void*)mk_fwd<1>, hipFuncAttributeMaxDynamicSharedMemorySize, LDS_BYTES);
    (void)hipFuncSetAttribute((const void*)mk_fwd<2>, hipFuncAttributeMaxDynamicSharedMemorySize, LDS_BYTES);
    (void)hipFuncSetAttribute((const void*)mk_fwd<3>, hipFuncAttributeMaxDynamicSharedMemorySize, LDS_BYTES);
    (void)hipOccupancyMaxActiveBlocksPerMultiprocessor(&per_cu, (const void*)mk_fwd<3>, NTHREADS, LDS_BYTES);
#endif
    if (per_cu < 1) { fprintf(stderr, "kernel_launch: occupancy query says %d blocks/CU\n", per_cu); per_cu = 1; }
    if (per_cu > 1) per_cu = 1;
    grid = cus * per_cu;
    if (grid > 256) grid = 256;
    (void)hipGetLastError();
  }
  Params p{};
  const float* const* fin = (const float* const*)d_in;
  p.x = fin[0]; p.c = fin[1]; p.pos = (const int*)d_in[2];
  p.w_ada = fin[3]; p.b_ada = fin[4]; p.norm1_g = fin[5]; p.w_in = fin[6]; p.conv_w = fin[7]; p.conv_b = fin[8];
  p.lru_wa = fin[9]; p.lru_ba = fin[10]; p.lru_wx = fin[11]; p.lru_bx = fin[12]; p.lru_lambda = fin[13];
  p.q_norm_g = fin[14]; p.w_uq = fin[15]; p.kv_norm_g = fin[16]; p.w_ukv = fin[17]; p.lru_out_g = fin[18]; p.mla_out_g = fin[19];
  p.w_out = fin[20]; p.norm2_g = fin[21]; p.peer_wq = fin[22]; p.peer_keys = fin[23]; p.peer_u = fin[24]; p.peer_v = fin[25]; p.final_g = fin[26];
  p.out = (float*)d_out;
  char* w = (char*)d_ws; size_t off = 0;
  auto take = [&](size_t bytes) { char* r = w + off; off = align_up(off + bytes); return r; };
  p.mod = (float*)take((size_t)NB * 6144 * 4);
  p.ssq_lru = (float*)take((size_t)NTOK * 4);
  p.ssq_mla = (float*)take((size_t)NTOK * 4);
  p.invfreq = (double*)take(16 * 8);
  p.Wf_in = (bf16x8*)take((size_t)INW * 1024 * 2);
  p.Wf_uq = (bf16x8*)take((size_t)768 * 256 * 2);
  p.Wf_ukv = (bf16x8*)take((size_t)1024 * 128 * 2);
  p.Wf_a = (bf16x8*)take((size_t)8 * 64 * 64 * 2);
  p.Wf_x = (bf16x8*)take((size_t)8 * 64 * 64 * 2);
  p.Wf_out = (bf16x8*)take((size_t)1024 * 1024 * 2);
  p.Wf_s = (i32x4*)take((size_t)2048 * 1024);
  p.Wsf = (float*)take((size_t)2048 * 1024 * 4);
  p.wsmaxp = (float*)take((size_t)2048 * 16 * 4);
  p.wsc = (float*)take((size_t)2048 * 4);
  p.Uq = (unsigned char*)take((size_t)2 * 16384 * QROWB);
  p.Vq = p.Uq + (size_t)16384 * QROWB;
  p.uscale = (float*)take((size_t)16384 * 16);
  p.vscale = p.uscale; p.ubias = p.uscale;
  p.xlru = (u16*)take((size_t)NTOK * 512 * 2);
  p.gate = (u16*)take((size_t)NTOK * 512 * 2);
  p.Q = (u16*)take((size_t)NTOK * 768 * 2);
  p.Kn = (u16*)take((size_t)NTOK * 512 * 2);
  p.Kr = (u16*)take((size_t)NTOK * 32 * 2);
  p.Vt = (u16*)take((size_t)NTOK * 512 * 2);
  p.y = (u16*)take((size_t)NTOK * 1024 * 2);
  p.scratch = take((size_t)256 * 655360);
  if (off > ws_size) { fprintf(stderr, "kernel_launch: workspace too small: need %zu have %zu\n", off, ws_size); return; }
#if N_LAUNCH_MODE == 1
  void* args[] = {&p};
  hipError_t e = hipLaunchCooperativeKernel((const void*)mk_fwd<-1>, dim3(grid), dim3(NTHREADS), args, LDS_BYTES, stream);
  if (e != hipSuccess) fprintf(stderr, "cooperative launch failed: %s (grid %d)\n", hipGetErrorString(e), grid);
#else
  hipLaunchKernelGGL(mk_fwd<0>, dim3(grid), dim3(NTHREADS), LDS_BYTES, stream, p);
  hipLaunchKernelGGL(mk_fwd<1>, dim3(grid), dim3(NTHREADS), LDS_BYTES, stream, p);
  hipLaunchKernelGGL(mk_fwd<2>, dim3(grid), dim3(NTHREADS), LDS_BYTES, stream, p);
  hipLaunchKernelGGL(mk_fwd<3>, dim3(grid), dim3(NTHREADS), LDS_BYTES, stream, p);
#endif
}
```

```cpp
#include <hip/hip_runtime.h>
#include <hip/hip_cooperative_groups.h>
#include <cstdio>
#include <cstdint>
namespace cg = cooperative_groups;

#ifndef QBITS
#define QBITS 4
#endif
#ifndef N_LAUNCH_MODE
#define N_LAUNCH_MODE 1
#endif

typedef short bf16x8 __attribute__((ext_vector_type(8)));
typedef float f32x16 __attribute__((ext_vector_type(16)));
typedef float f32x4 __attribute__((ext_vector_type(4)));
typedef float f32x2 __attribute__((ext_vector_type(2)));
typedef unsigned u32x4 __attribute__((ext_vector_type(4)));
typedef unsigned u32x2 __attribute__((ext_vector_type(2)));
typedef __bf16 bf16x2_t __attribute__((ext_vector_type(2)));
typedef unsigned short u16;
typedef _Float16 h16x2 __attribute__((ext_vector_type(2)));

#define DI __device__ __forceinline__
#define MFMA32(a, b, c) __builtin_amdgcn_mfma_f32_32x32x16_bf16((a), (b), (c), 0, 0, 0)
typedef int i32x4 __attribute__((ext_vector_type(4)));
typedef int i32x16 __attribute__((ext_vector_type(16)));
#define MFMA8(a, b, c) __builtin_amdgcn_mfma_i32_32x32x32_i8((a), (b), (c), 0, 0, 0)

constexpr int NB = 32, SEQ = 2048, DM = 1024, NTOK = NB * SEQ;
constexpr int INW = 1440;
constexpr int NTHREADS = 512;
constexpr int LDA = 1032;
constexpr int LDA8 = 1040;
constexpr int LDS_BYTES = 147456;
constexpr float EPS = 1e-6f;

struct Params {
  const float* x; const float* c; const int* pos;
  const float* w_ada; const float* b_ada; const float* norm1_g; const float* w_in; const float* conv_w; const float* conv_b;
  const float* lru_wa; const float* lru_ba; const float* lru_wx; const float* lru_bx; const float* lru_lambda;
  const float* q_norm_g; const float* w_uq; const float* kv_norm_g; const float* w_ukv; const float* lru_out_g; const float* mla_out_g;
  const float* w_out; const float* norm2_g; const float* peer_wq; const float* peer_keys; const float* peer_u; const float* peer_v; const float* final_g;
  float* out;
  float* mod; float* ssq_lru; float* ssq_mla; double* invfreq;
  bf16x8* Wf_in; bf16x8* Wf_uq; bf16x8* Wf_ukv; bf16x8* Wf_a; bf16x8* Wf_x; bf16x8* Wf_out; i32x4* Wf_s;
  float* Wsf; float* wsmaxp; float* wsc;
  unsigned char* Uq; unsigned char* Vq; float* uscale; float* vscale; float* ubias; u16* xlru; u16* gate; u16* Q; u16* Kn; u16* Kr; u16* Vt; u16* y;
  char* scratch;
};

typedef const __attribute__((address_space(4))) Params& KP;

DI unsigned pk2(float a, float b) { f32x2 v = {a, b}; bf16x2_t r = __builtin_convertvector(v, bf16x2_t); return __builtin_bit_cast(unsigned, r); }
DI u16 f2bf(float a) { return (u16)(pk2(a, 0.f) & 0xffffu); }
DI float bflo(unsigned u) { return __uint_as_float(u << 16); }
DI float bfhi(unsigned u) { return __uint_as_float(u & 0xffff0000u); }
DI float bf2f(u16 h) { return __uint_as_float(((unsigned)h) << 16); }
template <int CTRL> DI float dppf(float v) { return __builtin_bit_cast(float, __builtin_amdgcn_update_dpp(0, __builtin_bit_cast(int, v), CTRL, 0xF, 0xF, true)); }
typedef unsigned u32x2_ __attribute__((ext_vector_type(2)));
DI float wave_sum(float v) {
  v += dppf<0xB1>(v); v += dppf<0x4E>(v); v += dppf<0x141>(v); v += dppf<0x140>(v);
  u32x2_ r = __builtin_amdgcn_permlane16_swap(__float_as_uint(v), __float_as_uint(v), false, false); v = __uint_as_float(r[0]) + __uint_as_float(r[1]);
  r = __builtin_amdgcn_permlane32_swap(__float_as_uint(v), __float_as_uint(v), false, false); v = __uint_as_float(r[0]) + __uint_as_float(r[1]);
  return v;
}
DI float wave_max(float v) {
  v = fmaxf(v, dppf<0xB1>(v)); v = fmaxf(v, dppf<0x4E>(v)); v = fmaxf(v, dppf<0x141>(v)); v = fmaxf(v, dppf<0x140>(v));
  u32x2_ r = __builtin_amdgcn_permlane16_swap(__float_as_uint(v), __float_as_uint(v), false, false); v = fmaxf(__uint_as_float(r[0]), __uint_as_float(r[1]));
  r = __builtin_amdgcn_permlane32_swap(__float_as_uint(v), __float_as_uint(v), false, false); v = fmaxf(__uint_as_float(r[0]), __uint_as_float(r[1]));
  return v;
}
template <int CTRL> DI unsigned dppu(unsigned v) { return (unsigned)__builtin_amdgcn_update_dpp(0, (int)v, CTRL, 0xF, 0xF, true); }
template <int J> DI unsigned lane_xor_u(unsigned v, int lane) {
  if (J == 1) return dppu<0xB1>(v);
  if (J == 2) return dppu<0x4E>(v);
  if (J == 4) return dppu<0x141>(dppu<0x1B>(v));
  if (J == 8) return dppu<0x128>(v);
  if (J == 16) { const u32x2_ r = __builtin_amdgcn_permlane16_swap(v, v, false, false); return (lane & 16) ? r[0] : r[1]; }
  const u32x2_ r = __builtin_amdgcn_permlane32_swap(v, v, false, false); return (lane & 32) ? r[0] : r[1];
}
template <int J> DI float lane_xor_f(float v, int lane) { return __uint_as_float(lane_xor_u<J>(__float_as_uint(v), lane)); }
DI float sum_xor32(float v) { const u32x2_ r = __builtin_amdgcn_permlane32_swap(__float_as_uint(v), __float_as_uint(v), false, false); return __uint_as_float(r[0]) + __uint_as_float(r[1]); }
DI float max_xor32(float v) { const u32x2_ r = __builtin_amdgcn_permlane32_swap(__float_as_uint(v), __float_as_uint(v), false, false); return fmaxf(__uint_as_float(r[0]), __uint_as_float(r[1])); }
DI float other_xor32(float v, int lane) { const u32x2_ r = __builtin_amdgcn_permlane32_swap(__float_as_uint(v), __float_as_uint(v), false, false); return __uint_as_float((lane & 32) ? r[0] : r[1]); }
DI float reduce8(const float (&v)[8], int lane) {
  float q4[4], r2[2];
#pragma unroll
  for (int j = 0; j < 4; ++j) {
    const u32x2_ r = __builtin_amdgcn_permlane32_swap(__float_as_uint(v[j]), __float_as_uint(v[4 + j]), false, false);
    q4[j] = __uint_as_float(r[0]) + __uint_as_float(r[1]);
  }
#pragma unroll
  for (int j = 0; j < 2; ++j) {
    const u32x2_ r = __builtin_amdgcn_permlane16_swap(__float_as_uint(q4[j]), __float_as_uint(q4[2 + j]), false, false);
    r2[j] = __uint_as_float(r[0]) + __uint_as_float(r[1]);
  }
  const float s0 = r2[0] + dppf<0x128>(r2[0]), s1b = r2[1] + dppf<0x128>(r2[1]);
  float s1 = (lane & 8) ? s1b : s0;
  s1 += dppf<0xB1>(s1);
  s1 += dppf<0x4E>(s1);
  s1 += dppf<0x141>(s1);
  return s1;
}
DI float reduce32(const float (&v)[32], int lane) {
  const bool b3 = (lane & 8) != 0, b2 = (lane & 4) != 0, b1 = (lane & 2) != 0, b0 = (lane & 1) != 0;
  float a16[16], a8[8], a4[4], a2[2];
#pragma unroll
  for (int j = 0; j < 16; ++j) {
    const u32x2_ r = __builtin_amdgcn_permlane16_swap(__float_as_uint(v[j]), __float_as_uint(v[16 + j]), false, false);
    a16[j] = __uint_as_float(r[0]) + __uint_as_float(r[1]);
  }
#pragma unroll
  for (int j = 0; j < 8; ++j) { const float keep = b3 ? a16[8 + j] : a16[j], send = b3 ? a16[j] : a16[8 + j]; a8[j] = keep + lane_xor_f<8>(send, lane); }
#pragma unroll
  for (int j = 0; j < 4; ++j) { const float keep = b2 ? a8[4 + j] : a8[j], send = b2 ? a8[j] : a8[4 + j]; a4[j] = keep + lane_xor_f<4>(send, lane); }
#pragma unroll
  for (int j = 0; j < 2; ++j) { const float keep = b1 ? a4[2 + j] : a4[j], send = b1 ? a4[j] : a4[2 + j]; a2[j] = keep + lane_xor_f<2>(send, lane); }
  const float keep = b0 ? a2[1] : a2[0], send = b0 ? a2[0] : a2[1];
  return keep + lane_xor_f<1>(send, lane);
}
DI float sigmoidf_(float x) { return __builtin_amdgcn_rcpf(1.f + __builtin_amdgcn_exp2f(-1.4426950408889634f * x)); }
DI float gelu_tanh(float x) { const float u = 0.7978845608028654f * (x + 0.044715f * x * x * x); return x * __builtin_amdgcn_rcpf(1.f + __builtin_amdgcn_exp2f(-2.f * 1.4426950408889634f * u)); }
DI float one_minus_exp_small(float z) {
  float q = 1.f + z * (1.f / 6.f);
  q = 1.f + z * (1.f / 5.f) * q;
  q = 1.f + z * (1.f / 4.f) * q;
  q = 1.f + z * (1.f / 3.f) * q;
  q = 1.f + z * (1.f / 2.f) * q;
  return -z * q;
}
DI f32x16 zero16() { f32x16 z; for (int i = 0; i < 16; ++i) z[i] = 0.f; return z; }
DI int crow(int reg, int h) { return (reg & 3) + 8 * (reg >> 2) + 4 * h; }

template <int NT, int PD>
DI void gemm_pro(const bf16x8* __restrict__ Wf, int KS, const int (&tile)[NT], int lane, bf16x8 (&bq)[PD][NT]) {
#pragma unroll
  for (int d = 0; d < PD; ++d)
#pragma unroll
    for (int t = 0; t < NT; ++t) bq[d][t] = Wf[((size_t)tile[t] * KS + d) * 64 + lane];
}
template <int NT, int PD, bool SWAP, bool APF = false>
DI void gemm_main(const u16* As, int lda, int nks, const bf16x8* __restrict__ Wf, int KS, const int (&tile)[NT], f32x16 (&acc)[NT][2], int lane, bf16x8 (&bq)[PD][NT]) {
  const bf16x8* a0p = (const bf16x8*)(As + (lane & 31) * lda + 8 * (lane >> 5));
  const bf16x8* a1p = (const bf16x8*)(As + ((lane & 31) + 32) * lda + 8 * (lane >> 5));
  const bf16x8* bp[NT];
#pragma unroll
  for (int t = 0; t < NT; ++t) bp[t] = Wf + (size_t)tile[t] * KS * 64 + lane;
  bf16x8 a0n = a0p[0], a1n = a1p[0];
#pragma unroll 1
  for (int ks = 0; ks < nks; ks += PD) {
#pragma unroll
    for (int d = 0; d < PD; ++d) {
      bf16x8 a0, a1;
      if (APF) { a0 = a0n; a1 = a1n; const int ka = (ks + d + 1 < nks) ? (ks + d + 1) : (ks + d); a0n = a0p[2 * ka]; a1n = a1p[2 * ka]; }
      else { a0 = a0p[2 * (ks + d)]; a1 = a1p[2 * (ks + d)]; }
      const int kn = (ks + d + PD < nks) ? (ks + d + PD) : (ks + d);
#pragma unroll
      for (int t = 0; t < NT; ++t) {
        const bf16x8 b = bq[d][t];
        bq[d][t] = bp[t][kn * 64];
        acc[t][0] = SWAP ? MFMA32(b, a0, acc[t][0]) : MFMA32(a0, b, acc[t][0]);
        acc[t][1] = SWAP ? MFMA32(b, a1, acc[t][1]) : MFMA32(a1, b, acc[t][1]);
      }
    }
  }
}
template <int NT, int PD = 8, bool SWAP = false>
DI void gemm_core(const u16* As, int lda, int nks, const bf16x8* __restrict__ Wf, int KS, const int (&tile)[NT], f32x16 (&acc)[NT][2], int lane) {
  bf16x8 bq[PD][NT];
  gemm_pro<NT, PD>(Wf, KS, tile, lane, bq);
  gemm_main<NT, PD, SWAP>(As, lda, nks, Wf, KS, tile, acc, lane, bq);
}

template <int NT, int PD>
DI void gemm8_pro(const i32x4* __restrict__ Wf, int KS, const int (&tile)[NT], int lane, i32x4 (&bq)[PD][NT]) {
#pragma unroll
  for (int d = 0; d < PD; ++d)
#pragma unroll
    for (int t = 0; t < NT; ++t) bq[d][t] = Wf[((size_t)tile[t] * KS + d) * 64 + lane];
}
template <int NT, int PD>
DI void gemm8_main(const signed char* As, int lda, int nks, const i32x4* __restrict__ Wf, int KS, const int (&tile)[NT], i32x16 (&acc)[NT][2], int lane, i32x4 (&bq)[PD][NT]) {
  const i32x4* a0p = (const i32x4*)(As + (lane & 31) * lda + 16 * (lane >> 5));
  const i32x4* a1p = (const i32x4*)(As + ((lane & 31) + 32) * lda + 16 * (lane >> 5));
  const i32x4* bp[NT];
#pragma unroll
  for (int t = 0; t < NT; ++t) bp[t] = Wf + (size_t)tile[t] * KS * 64 + lane;
#pragma unroll 1
  for (int ks = 0; ks < nks; ks += PD) {
#pragma unroll
    for (int d = 0; d < PD; ++d) {
      const i32x4 a0 = a0p[2 * (ks + d)], a1 = a1p[2 * (ks + d)];
      const int kn = (ks + d + PD < nks) ? (ks + d + PD) : (ks + d);
#pragma unroll
      for (int t = 0; t < NT; ++t) {
        const i32x4 b = bq[d][t];
        bq[d][t] = bp[t][kn * 64];
        acc[t][0] = MFMA8(b, a0, acc[t][0]);
        acc[t][1] = MFMA8(b, a1, acc[t][1]);
      }
    }
  }
}

DI void conv_frag(const float* __restrict__ W, long sk, long sn, int K, int N, const float* ks1, const float* ks2, int ksplit, bf16x8* out, int gtid, int gthreads) {
  const int KS = K / 16; const int total = (N / 32) * KS * 64;
  for (int i = gtid; i < total; i += gthreads) {
    const int lane = i & 63; const int t = i >> 6; const int ks = t % KS; const int nt = t / KS;
    const int n = nt * 32 + (lane & 31); const int k0 = ks * 16 + 8 * (lane >> 5);
    float v[8];
#pragma unroll
    for (int j = 0; j < 8; ++j) {
      const int k = k0 + j;
      float s = 1.f;
      if (ks1) s = (k < ksplit) ? ks1[k] : ks2[k - ksplit];
      v[j] = W[(long)k * sk + (long)n * sn] * s;
    }
    u32x4 o; o[0] = pk2(v[0], v[1]); o[1] = pk2(v[2], v[3]); o[2] = pk2(v[4], v[5]); o[3] = pk2(v[6], v[7]);
    out[i] = __builtin_bit_cast(bf16x8, o);
  }
}

DI void conv_one(const float* __restrict__ W, long sk, int KS, const float* ks1, const float* ks2, int ksplit, bf16x8* out, int i) {
  const int lane = i & 63; const int t = i >> 6; const int ks = t % KS; const int nt = t / KS;
  const int n = nt * 32 + (lane & 31); const int k0 = ks * 16 + 8 * (lane >> 5);
  float v[8];
#pragma unroll
  for (int j = 0; j < 8; ++j) v[j] = W[(long)(k0 + j) * sk + n];
  if (ks1) {
#pragma unroll
    for (int j = 0; j < 8; ++j) { const int k = k0 + j; v[j] *= (k < ksplit) ? ks1[k] : ks2[k - ksplit]; }
  }
  u32x4 o; o[0] = pk2(v[0], v[1]); o[1] = pk2(v[2], v[3]); o[2] = pk2(v[4], v[5]); o[3] = pk2(v[6], v[7]);
  out[i] = __builtin_bit_cast(bf16x8, o);
}

DI void phase0(KP p, char* smem) {
  const int tid = threadIdx.x; const int gtid = blockIdx.x * NTHREADS + tid; const int gthreads = gridDim.x * NTHREADS;
  for (int i = gtid; i < NTOK; i += gthreads) { p.ssq_lru[i] = 0.f; p.ssq_mla[i] = 0.f; }
  if (gtid < 16) p.invfreq[gtid] = pow(10000.0, -(double)gtid / 16.0);
  {
    float* cact = (float*)smem;
    float* red = (float*)(smem + 65536);
    const int lane = tid & 63, wv = tid >> 6;
    for (int item = blockIdx.x; item < 192; item += gridDim.x) {
      const int cg = item >> 1, bh = item & 1;
      for (int i = tid; i < 16 * DM; i += NTHREADS) { const int bb = i >> 10, k = i & 1023; const float v = p.c[(bh * 16 + bb) * DM + k]; cact[k * 16 + bb] = v / (1.f + __expf(-v)); }
      __syncthreads();
      float acc[16];
#pragma unroll
      for (int bb = 0; bb < 16; ++bb) acc[bb] = 0.f;
      const float* wp = p.w_ada + (size_t)(wv * 128) * 6144 + cg * 64 + lane;
#pragma unroll 32
      for (int kk = 0; kk < 128; ++kk) {
        const float w = wp[(size_t)kk * 6144];
        const f32x4* cp = (const f32x4*)(cact + (wv * 128 + kk) * 16);
#pragma unroll
        for (int q = 0; q < 4; ++q) { const f32x4 cv = cp[q]; acc[4 * q] += cv[0] * w; acc[4 * q + 1] += cv[1] * w; acc[4 * q + 2] += cv[2] * w; acc[4 * q + 3] += cv[3] * w; }
      }
#pragma unroll
      for (int bb = 0; bb < 16; ++bb) red[(wv * 16 + bb) * 64 + lane] = acc[bb];
      __syncthreads();
      for (int o = tid; o < 1024; o += NTHREADS) {
        const int bb = o >> 6, c2 = o & 63;
        float sum = 0.f;
#pragma unroll
        for (int w8 = 0; w8 < 8; ++w8) sum += red[(w8 * 16 + bb) * 64 + c2];
        p.mod[(size_t)(bh * 16 + bb) * 6144 + cg * 64 + c2] = sum + p.b_ada[cg * 64 + c2];
      }
      __syncthreads();
    }
  }
  {
    constexpr int N_IN = 45 * 64 * 64, N_UQ = 24 * 16 * 64, N_UKV = 32 * 8 * 64, N_LRU = 16 * 512, N_OUT = 32 * 64 * 64;
    for (int i = gtid; i < N_IN + N_UQ + N_UKV + N_LRU + N_OUT; i += gthreads) {
      int j = i;
      if (j < N_OUT) { conv_one(p.w_out, 1024, 64, p.lru_out_g, p.mla_out_g, 512, p.Wf_out, j); continue; }
      j -= N_OUT;
      if (j < N_IN) { conv_one(p.w_in, INW, 64, nullptr, nullptr, 0, p.Wf_in, j); continue; }
      j -= N_IN;
      if (j < N_UQ) { conv_one(p.w_uq, 768, 16, p.q_norm_g, p.q_norm_g, 256, p.Wf_uq, j); continue; }
      j -= N_UQ;
      if (j < N_UKV) { conv_one(p.w_ukv, 1024, 8, p.kv_norm_g, p.kv_norm_g, 128, p.Wf_ukv, j); continue; }
      j -= N_UKV;
      { const int h = j >> 10, m = (j >> 9) & 1, f = j & 511; conv_one((m ? p.lru_wx : p.lru_wa) + h * 4096, 64, 4, nullptr, nullptr, 0, (m ? p.Wf_x : p.Wf_a) + h * 512, f); }
    }
  }
  {
    float* kl = (float*)smem;
    float* wl = (float*)(smem + 67584);
    const int lane = tid & 63, wv = tid >> 6, l31 = lane & 31, lh = lane >> 5;
    for (int item = blockIdx.x; item < 256; item += gridDim.x) {
      const int hp = item >> 4, cc = item & 15;
      __syncthreads();
#pragma unroll
      for (int i = 0; i < 8; ++i) { const int e = tid + NTHREADS * i; const int r = e >> 5, q = e & 31; *(f32x4*)(kl + r * 132 + q * 4) = *(const f32x4*)(p.peer_keys + (size_t)hp * 16384 + r * 128 + q * 4); }
#pragma unroll
      for (int i = 0; i < 4; ++i) { const int e = tid + NTHREADS * i; const int c = e >> 5, q = e & 31; *(f32x4*)(wl + c * 132 + q * 4) = *(const f32x4*)(p.peer_wq + (size_t)(cc * 64 + c) * 2048 + hp * 128 + q * 4); }
      __syncthreads();
      const int rt = wv >> 1, ct = wv & 1;
      const float* ap = kl + (rt * 32 + l31) * 132 + 8 * lh;
      const float* bp = wl + (ct * 32 + l31) * 132 + 8 * lh;
      f32x16 acc = zero16();
#pragma unroll
      for (int ks = 0; ks < 8; ++ks) {
        const f32x4 a0 = *(const f32x4*)(ap + 16 * ks), a1 = *(const f32x4*)(ap + 16 * ks + 4);
        const f32x4 b0 = *(const f32x4*)(bp + 16 * ks), b1 = *(const f32x4*)(bp + 16 * ks + 4);
        u32x4 av, bv;
        av[0] = pk2(a0[0], a0[1]); av[1] = pk2(a0[2], a0[3]); av[2] = pk2(a1[0], a1[1]); av[3] = pk2(a1[2], a1[3]);
        bv[0] = pk2(b0[0], b0[1]); bv[1] = pk2(b0[2], b0[3]); bv[2] = pk2(b1[0], b1[1]); bv[3] = pk2(b1[2], b1[3]);
        acc = MFMA32(__builtin_bit_cast(bf16x8, av), __builtin_bit_cast(bf16x8, bv), acc);
      }
      float* dst = p.Wsf + (size_t)(hp * 128 + rt * 32) * 1024 + cc * 64 + ct * 32 + l31;
#pragma unroll
      for (int r = 0; r < 16; ++r) dst[(size_t)crow(r, lh) * 1024] = acc[r];
    }
    __syncthreads();
  }
#if QBITS == 8
  {
    const int lane = tid & 63; const int gw = gtid >> 6; const int nw = gthreads >> 6;
    for (int row = gw; row < 32768; row += nw) {
      const int r = row & 16383; const bool isv = row >= 16384;
      const f32x4* src = (const f32x4*)((isv ? p.peer_v : p.peer_u) + (size_t)r * 1024) + lane * 4;
      f32x4 a[4];
#pragma unroll
      for (int i = 0; i < 4; ++i) a[i] = src[i];
#if QBITS == 8
      float am = 0.f;
#pragma unroll
      for (int i = 0; i < 4; ++i)
#pragma unroll
        for (int j = 0; j < 4; ++j) am = fmaxf(am, fabsf(a[i][j]));
      am = wave_max(am);
      const float inv = am > 0.f ? 127.f / am : 0.f;
      u32x4 o;
#pragma unroll
      for (int i = 0; i < 4; ++i) {
        unsigned w = 0;
#pragma unroll
        for (int j = 0; j < 4; ++j) { const int q = (int)__builtin_rintf(a[i][j] * inv) + 128; w |= (unsigned)q << (8 * j); }
        o[i] = w;
      }
      ((u32x4*)(isv ? p.Vq : p.Uq))[(size_t)r * 64 + lane] = o;
      const float step = am * (1.f / 127.f);
      if (lane == 0) p.uscale[r * 4 + (isv ? 1 : 0)] = step;
      float ns = 0.f;
#pragma unroll
      for (int i = 0; i < 4; ++i) ns += (float)(o[i] & 255u) + (float)((o[i] >> 8) & 255u) + (float)((o[i] >> 16) & 255u) + (float)(o[i] >> 24);
      ns = wave_sum(ns);
      if (lane == 0 && !isv) p.uscale[r * 4 + 2] = step * 128.f * ns;
#else
      float ssum = 0.f;
#pragma unroll
      for (int i = 0; i < 4; ++i)
#pragma unroll
        for (int j = 0; j < 4; ++j) ssum += a[i][j] * a[i][j];
      ssum = wave_sum(ssum);
      const float rms = sqrtf(ssum * (1.f / 1024.f));
      const float step = (isv ? 0.49f : 0.3352f) * rms;
      const float inv = step > 0.f ? 1.f / step : 0.f;
      u32x2 o;
#pragma unroll
      for (int jd = 0; jd < 2; ++jd) {
        unsigned w = 0;
#pragma unroll
        for (int e = 0; e < 8; ++e) {
          const float x = a[(8 * jd + e) >> 2][(8 * jd + e) & 3];
          if (isv) {
            const float m = fabsf(x) * inv;
            const int mag = (m > 0.25f) + (m > 0.75f) + (m > 1.25f) + (m > 1.75f) + (m > 2.5f) + (m > 3.5f) + (m > 5.0f);
            w |= (unsigned)(mag | (x < 0.f ? 8 : 0)) << (4 * e);
          } else {
            int q = (int)__builtin_rintf(x * inv + 7.5f); q = q < 0 ? 0 : (q > 15 ? 15 : q);
            w |= (unsigned)q << (8 * (e & 3) + 4 * (e >> 2));
          }
        }
        o[jd] = w;
      }
      ((u32x2*)(p.Uq + (size_t)r * 1024))[2 * lane + (isv ? 1 : 0)] = o;
      if (lane == 0) p.uscale[r * 4 + (isv ? 1 : 0)] = step;
      float ns = 0.f;
#pragma unroll
      for (int jd = 0; jd < 2; ++jd)
#pragma unroll
        for (int e = 0; e < 8; ++e) ns += (float)((o[jd] >> (4 * e)) & 15u);
      ns = wave_sum(ns);
      if (lane == 0 && !isv) p.uscale[r * 4 + 2] = step * 128.f * ns;
#endif
    }
  }
#else
  {
    const int lane = tid & 63; const int gw = gtid >> 6; const int nw = gthreads >> 6;
    for (int r = gw; r < 16384; r += nw) {
      const f32x4* su = (const f32x4*)(p.peer_u + (size_t)r * 1024) + lane * 4;
      const f32x4* sv = (const f32x4*)(p.peer_v + (size_t)r * 1024) + lane * 4;
      f32x4 au[4], av[4];
#pragma unroll
      for (int i = 0; i < 4; ++i) { au[i] = su[i]; av[i] = sv[i]; }
      float ssu = 0.f, ssv = 0.f;
#pragma unroll
      for (int i = 0; i < 4; ++i)
#pragma unroll
        for (int j = 0; j < 4; ++j) { ssu += au[i][j] * au[i][j]; ssv += av[i][j] * av[i][j]; }
      ssu = wave_sum(ssu); ssv = wave_sum(ssv);
      const float ustep = 0.3352f * sqrtf(ssu * (1.f / 1024.f)), vstep = 0.49f * sqrtf(ssv * (1.f / 1024.f));
      const float uinv = ustep > 0.f ? 1.f / ustep : 0.f, vinv = vstep > 0.f ? 1.f / vstep : 0.f;
      u32x4 o;
      float ns = 0.f;
#pragma unroll
      for (int jd = 0; jd < 2; ++jd) {
        unsigned wu = 0, wv = 0;
#pragma unroll
        for (int e = 0; e < 8; ++e) {
          const float xu = au[(8 * jd + e) >> 2][(8 * jd + e) & 3], xv = av[(8 * jd + e) >> 2][(8 * jd + e) & 3];
          int q = (int)__builtin_rintf(xu * uinv + 7.5f); q = q < 0 ? 0 : (q > 15 ? 15 : q);
          wu |= (unsigned)q << (8 * (e & 3) + 4 * (e >> 2)); ns += (float)q;
          const float m = fabsf(xv) * vinv;
          const int mag = (m > 0.25f) + (m > 0.75f) + (m > 1.25f) + (m > 1.75f) + (m > 2.5f) + (m > 3.5f) + (m > 5.0f);
          wv |= (unsigned)(mag | (xv < 0.f ? 8 : 0)) << (4 * e);
        }
        o[jd] = wu; o[2 + jd] = wv;
      }
      ((u32x4*)(p.Uq + (size_t)r * 1024))[lane] = o;
      ns = wave_sum(ns);
      if (lane == 0) *(f32x4*)(p.uscale + r * 4) = (f32x4){ustep, vstep, ustep * 128.f * ns, 0.f};
    }
  }
#endif
}

DI void ws_quant(KP p) {
  const int lane = threadIdx.x & 63; const int gw = (blockIdx.x * NTHREADS + threadIdx.x) >> 6; const int nw = (gridDim.x * NTHREADS) >> 6;
  for (int row = gw; row < 2048; row += nw) {
    const f32x4* src = (const f32x4*)(p.Wsf + (size_t)row * 1024 + lane * 16);
    f32x4 v[4];
    float m = 0.f;
#pragma unroll
    for (int q = 0; q < 4; ++q) { v[q] = src[q]; m = fmaxf(fmaxf(m, fmaxf(fabsf(v[q][0]), fabsf(v[q][1]))), fmaxf(fabsf(v[q][2]), fabsf(v[q][3]))); }
    m = wave_max(m);
    const float inv = m > 0.f ? 127.f / m : 0.f;
    i32x4 o;
#pragma unroll
    for (int q = 0; q < 4; ++q) {
      unsigned w = 0;
#pragma unroll
      for (int j = 0; j < 4; ++j) w |= ((unsigned)(int)__builtin_rintf(v[q][j] * inv) & 255u) << (8 * j);
      o[q] = (int)w;
    }
    p.Wf_s[(size_t)((row >> 5) * 32 + (lane >> 1)) * 64 + (row & 31) + 32 * (lane & 1)] = o;
    if (lane == 0) p.wsc[row] = m * (1.f / 127.f);
  }
}

DI void phase1(KP p, char* smem) {
  const int tid = threadIdx.x, wave = __builtin_amdgcn_readfirstlane(tid >> 6);
  u16* hA = (u16*)smem;
  float* cs = (float*)(smem + 132096);
  float* ssq = (float*)(smem + 132096 + 8192);
  constexpr int LDL = 424;
  ws_quant(p);
  for (int tile = blockIdx.x; tile < NTOK / 64; tile += gridDim.x) {
    int lane_o = tid & 63; asm volatile("" : "+v"(lane_o));
    const int lane = lane_o, l31 = lane & 31, lh = lane >> 5;
    const int tok0 = tile * 64; const int b = tok0 / SEQ; const int s0 = tok0 % SEQ;
    const float* modb = p.mod + (size_t)b * 6144;
    for (int i = tid; i < 1024; i += NTHREADS) {
      const int r = i >> 4, j = i & 15;
      const double ang = (double)p.pos[tok0 + r] * p.invfreq[j];
      double rev = ang * 0.15915494309189535; rev -= floor(rev);
      const float rf = (float)rev;
      cs[2 * i] = __builtin_amdgcn_cosf(rf); cs[2 * i + 1] = __builtin_amdgcn_sinf(rf);
    }
    if (tid < 128) ssq[tid] = 0.f;
    {
      f32x4 cm[4], ca[4];
#pragma unroll
      for (int i = 0; i < 4; ++i) {
        const int col = i * 256 + lane * 4;
        const f32x4 g = *(const f32x4*)(p.norm1_g + col); const f32x4 sc = *(const f32x4*)(modb + 1024 + col);
        cm[i] = g * (sc + 1.0f); ca[i] = *(const f32x4*)(modb + col);
      }
#pragma unroll 2
      for (int rr = 0; rr < 8; rr += 4) {
        f32x4 xv[4][4];
#pragma unroll
        for (int q = 0; q < 4; ++q)
#pragma unroll
          for (int i = 0; i < 4; ++i) xv[q][i] = *(const f32x4*)(p.x + (size_t)(tok0 + wave * 8 + rr + q) * DM + i * 256 + lane * 4);
#pragma unroll
        for (int q = 0; q < 4; ++q) {
          float ss = 0.f;
#pragma unroll
          for (int i = 0; i < 4; ++i) ss += xv[q][i][0] * xv[q][i][0] + xv[q][i][1] * xv[q][i][1] + xv[q][i][2] * xv[q][i][2] + xv[q][i][3] * xv[q][i][3];
          ss = wave_sum(ss);
          const float rs = rsqrtf(ss * (1.f / 1024.f) + EPS);
          const int row = wave * 8 + rr + q;
#pragma unroll
          for (int i = 0; i < 4; ++i) {
            const f32x4 h = xv[q][i] * rs * cm[i] + ca[i];
            u32x2 o; o[0] = pk2(h[0], h[1]); o[1] = pk2(h[2], h[3]);
            *(u32x2*)(hA + row * LDA + i * 256 + lane * 4) = o;
          }
        }
      }
    }
    __syncthreads();
    bf16x8 ring1[8][2];
    const bool has2 = (wave + 40) < 45;
    { const int tl0[2] = {wave, wave + 8}; gemm_pro<2, 8>(p.Wf_in, 64, tl0, lane, ring1); }
#pragma unroll 1
    for (int pass = 0; pass < 2; ++pass) {
      f32x16 acc[2][2];
#pragma unroll
      for (int t = 0; t < 2; ++t) { acc[t][0] = zero16(); acc[t][1] = zero16(); }
      const int tl[2] = {wave + 16 * pass, wave + 16 * pass + 8};
      gemm_main<2, 8, false, true>(hA, LDA, 64, p.Wf_in, 64, tl, acc, lane, ring1);
      { const int tn[2] = {wave + 16 * (pass + 1), (pass == 0 || has2) ? wave + 16 * (pass + 1) + 8 : wave + 32}; gemm_pro<2, 8>(p.Wf_in, 64, tn, lane, ring1); }
      int el_ = lane; asm volatile("" : "+v"(el_));
      const int l31 = el_ & 31, lh = el_ >> 5;
      u16* dstb[2];
#pragma unroll
      for (int t = 0; t < 2; ++t) { const int col = tl[t] * 32 + l31; dstb[t] = (col < 512) ? (p.xlru + col) : (p.gate + (col - 512)); }
#pragma unroll
      for (int rt = 0; rt < 2; ++rt)
#pragma unroll
        for (int r = 0; r < 16; ++r) {
          const size_t ro = (size_t)(tok0 + rt * 32 + crow(r, lh)) * 512;
#pragma unroll
          for (int t = 0; t < 2; ++t) dstb[t][ro] = f2bf(acc[t][rt][r]);
        }
    }
    {
      f32x16 acc[2][2];
#pragma unroll
      for (int t = 0; t < 2; ++t) { acc[t][0] = zero16(); acc[t][1] = zero16(); }
      const int tl[2] = {wave + 32, has2 ? wave + 40 : wave + 32};
      gemm_main<2, 8, false, true>(hA, LDA, 64, p.Wf_in, 64, tl, acc, lane, ring1);
      int el_ = lane; asm volatile("" : "+v"(el_));
      const int l31 = el_ & 31, lh = el_ >> 5;
      __syncthreads();
      u16* lat = hA;
#pragma unroll
      for (int t = 0; t < 2; ++t) {
        if (t == 1 && !has2) continue;
        const int lc = tl[t] * 32 - 1024 + l31;
        if (tl[t] < 44) {
          float sq[32];
#pragma unroll
          for (int rt = 0; rt < 2; ++rt)
#pragma unroll
            for (int r = 0; r < 16; ++r) { const float v = acc[t][rt][r]; sq[rt * 16 + r] = v * v; }
          const float tot = reduce32(sq, lane);
          __hip_atomic_fetch_add(&ssq[(tl[t] < 40 ? 0 : 64) + (l31 >> 4) * 32 + crow(l31 & 15, lh)], tot, __ATOMIC_RELAXED, __HIP_MEMORY_SCOPE_WORKGROUP);
        }
#pragma unroll
        for (int rt = 0; rt < 2; ++rt)
#pragma unroll
          for (int r = 0; r < 16; ++r) {
            const int row = rt * 32 + crow(r, lh);
            const float v = acc[t][rt][r];
            if (lc < 384) {
              lat[row * LDL + lc] = f2bf(v);
            } else {
              const float pv = lane_xor_f<16>(v, lane);
              const int j = lc - 384; const int jj = j & 15;
              const float co = cs[(row * 16 + jj) * 2], si = cs[(row * 16 + jj) * 2 + 1];
              const float o = (j < 16) ? (v * co - pv * si) : (v * co + pv * si);
              p.Kr[(size_t)(tok0 + row) * 32 + j] = f2bf(o);
            }
          }
      }
    }
    __syncthreads();
    {
      const u16* lat = hA;
      const float qscale = 0.10206207261596577f * 1.4426950408889634f;
      const int jj = l31 & 15;
#pragma unroll 1
      for (int pass = 0; pass < 2; ++pass) {
        f32x16 acc[2][2];
#pragma unroll
        for (int t = 0; t < 2; ++t) { acc[t][0] = zero16(); acc[t][1] = zero16(); }
        const int tl[2] = {pass == 0 ? wave : wave + 16, pass == 0 ? wave + 8 : wave + 16};
        gemm_core<2>(lat, LDL, 16, p.Wf_uq, 16, tl, acc, lane);
        int el_ = lane; asm volatile("" : "+v"(el_));
        const int l31 = el_ & 31, lh = el_ >> 5;
#pragma unroll
        for (int rt = 0; rt < 2; ++rt)
#pragma unroll
          for (int r = 0; r < 16; ++r) {
            const int row = rt * 32 + crow(r, lh);
            const float rs = rsqrtf(ssq[row] * (1.f / 256.f) + EPS) * qscale;
            const float co = cs[(row * 16 + jj) * 2], si = cs[(row * 16 + jj) * 2 + 1];
#pragma unroll
            for (int t = 0; t < 2; ++t) {
              if (t == 1 && pass == 1) continue;
              const int head = tl[t] / 3, part = tl[t] % 3;
              float v = acc[t][rt][r] * rs;
              if (part == 2) {
                const float pv = lane_xor_f<16>(v, lane);
                v = (l31 < 16) ? (v * co - pv * si) : (v * co + pv * si);
              }
              p.Q[((size_t)(b * 8 + head) * SEQ + s0 + row) * 96 + part * 32 + l31] = f2bf(v);
            }
          }
      }
#pragma unroll 1
      for (int pass = 0; pass < 2; ++pass) {
        f32x16 acc[2][2];
#pragma unroll
        for (int t = 0; t < 2; ++t) { acc[t][0] = zero16(); acc[t][1] = zero16(); }
        const int tl[2] = {wave + 16 * pass, wave + 16 * pass + 8};
        gemm_core<2>(lat + 256, LDL, 8, p.Wf_ukv, 8, tl, acc, lane);
        int el_ = lane; asm volatile("" : "+v"(el_));
        const int l31 = el_ & 31, lh = el_ >> 5;
#pragma unroll
        for (int rt = 0; rt < 2; ++rt)
#pragma unroll
          for (int g = 0; g < 4; ++g) {
            const int row = rt * 32 + 8 * g + 4 * lh;
            float rs4[4];
#pragma unroll
            for (int q = 0; q < 4; ++q) rs4[q] = rsqrtf(ssq[64 + row + q] * (1.f / 128.f) + EPS);
#pragma unroll
            for (int t = 0; t < 2; ++t) {
              const int head = tl[t] >> 2, sub = tl[t] & 3;
              float v4[4];
#pragma unroll
              for (int q = 0; q < 4; ++q) v4[q] = acc[t][rt][4 * g + q] * rs4[q];
              if (sub < 2) {
#pragma unroll
                for (int q = 0; q < 4; ++q) p.Kn[((size_t)(b * 8 + head) * SEQ + s0 + row + q) * 64 + sub * 32 + l31] = f2bf(v4[q]);
              } else {
                const int d = (sub - 2) * 32 + l31;
                u32x2 o; o[0] = pk2(v4[0], v4[1]); o[1] = pk2(v4[2], v4[3]);
                *(u32x2*)(p.Vt + ((size_t)(b * 8 + head) * 64 + d) * SEQ + s0 + row) = o;
              }
            }
          }
      }
    }
    __syncthreads();
  }
}

DI void lru_item(KP p, char* smem, int item) {
  const int tid = threadIdx.x, lane = tid & 63, wave = __builtin_amdgcn_readfirstlane(tid >> 6);
  const int l31 = lane & 31, lh = lane >> 5;
  const int b = item >> 3, cb = item & 7;
  const int c = lane; const int ch = cb * 64 + c; const int tg = wave;
  const float cw0_ = p.conv_w[ch], cw1_ = p.conv_w[512 + ch], cw2_ = p.conv_w[1024 + ch], cw3_ = p.conv_w[1536 + ch], cbias_ = p.conv_b[ch];
  const float ba_ = p.lru_ba[ch], bx_ = p.lru_bx[ch];
  const float sp_ = log1pf(__expf(-p.lru_lambda[ch]));
  float carry = 0.f;
  const u16* xl = p.xlru + (size_t)b * SEQ * 512 + ch;
  const u16* gt = p.gate + (size_t)b * SEQ * 512 + ch;
  u16* yo = p.y + (size_t)b * SEQ * 1024 + ch;
  const int mat = wave >> 2, rt = (wave >> 1) & 1, ct = wave & 1;
  const bf16x8* wf = (mat == 0 ? p.Wf_a : p.Wf_x) + cb * 512 + ct * 256 + lane;
  bf16x8 bw[4];
#pragma unroll
  for (int ks = 0; ks < 4; ++ks) bw[ks] = wf[ks * 64];
  constexpr int NCH = SEQ / 64;
  u16 xin_n[11], gv_n[8];
#pragma unroll
  for (int i = 0; i < 11; ++i) { const int t = tg * 8 - 3 + i; xin_n[i] = (t >= 0) ? xl[(size_t)t * 512] : (u16)0; }
#pragma unroll
  for (int i = 0; i < 8; ++i) gv_n[i] = gt[(size_t)(tg * 8 + i) * 512];
  float xcB[8], gvB[8], xcC[8], gvC[8], avD[8], bvD[8], gvD[8];
#pragma unroll
  for (int i = 0; i < 8; ++i) { xcB[i] = gvB[i] = xcC[i] = gvC[i] = avD[i] = bvD[i] = gvD[i] = 0.f; }
  float cw0 = cw0_, cw1 = cw1_, cw2 = cw2_, cw3 = cw3_, cbias = cbias_, ba = ba_, bx = bx_, sp = sp_;
  asm volatile("" : "+v"(cw0), "+v"(cw1), "+v"(cw2), "+v"(cw3), "+v"(cbias), "+v"(ba), "+v"(bx), "+v"(sp));
#pragma unroll
  for (int ks = 0; ks < 4; ++ks) asm volatile("" : "+v"(bw[ks]));
  __syncthreads();
#pragma unroll 1
  for (int it = 0; it < NCH + 3; ++it) {
    float xcA[8], gvA[8], avC[8], bvC[8];
    if (it < NCH) {
      const int t0 = it * 64 + tg * 8;
      float xin[11];
#pragma unroll
      for (int i = 0; i < 11; ++i) xin[i] = bf2f(xin_n[i]);
#pragma unroll
      for (int i = 0; i < 8; ++i) gvA[i] = bf2f(gv_n[i]);
      if (it + 1 < NCH) {
#pragma unroll
        for (int i = 0; i < 11; ++i) xin_n[i] = xl[(size_t)(t0 + 64 - 3 + i) * 512];
#pragma unroll
        for (int i = 0; i < 8; ++i) gv_n[i] = gt[(size_t)(t0 + 64 + i) * 512];
      }
      u16* xcb = (u16*)(smem + (it & 1) * 9216);
#pragma unroll
      for (int i = 0; i < 8; ++i) {
        xcA[i] = cbias + cw0 * xin[i] + cw1 * xin[i + 1] + cw2 * xin[i + 2] + cw3 * xin[i + 3];
        xcb[(tg * 8 + i) * 72 + c] = f2bf(xcA[i]);
      }
    } else {
#pragma unroll
      for (int i = 0; i < 8; ++i) { xcA[i] = 0.f; gvA[i] = 0.f; }
    }
    if (it >= 1 && it - 1 < NCH) {
      const u16* xcb = (const u16*)(smem + ((it - 1) & 1) * 9216);
      float* pm = (float*)(smem + 18432 + ((it - 1) & 1) * 33280) + mat * 4160;
      f32x16 acc = zero16();
      const bf16x8* ap = (const bf16x8*)(xcb + (rt * 32 + l31) * 72 + 8 * lh);
#pragma unroll
      for (int ks = 0; ks < 4; ++ks) acc = MFMA32(ap[2 * ks], bw[ks], acc);
#pragma unroll
      for (int r = 0; r < 16; ++r) pm[(rt * 32 + crow(r, lh)) * 65 + ct * 32 + l31] = acc[r];
    }
    if (it >= 2 && it - 2 < NCH) {
      const float* pre = (const float*)(smem + 18432 + ((it - 2) & 1) * 33280);
      float* seg = (float*)(smem + 84992 + ((it - 2) & 1) * 4096);
      float A = 1.f, Bc = 0.f;
#pragma unroll
      for (int i = 0; i < 8; ++i) {
        const int tl = tg * 8 + i;
        const float r = sigmoidf_(pre[tl * 65 + c] + ba);
        const float ig = sigmoidf_(pre[4160 + tl * 65 + c] + bx);
        const float log_a = -8.f * r * sp;
        const float a = __builtin_amdgcn_exp2f(1.4426950408889634f * log_a);
        const float z = 2.f * log_a;
        const float om = (z > -0.25f) ? one_minus_exp_small(z) : -expm1f(z);
        const float m = __builtin_amdgcn_sqrtf(om);
        avC[i] = a; bvC[i] = m * ig * xcC[i];
        A *= a; Bc = a * Bc + bvC[i];
      }
      seg[(tg * 64 + c) * 2] = A; seg[(tg * 64 + c) * 2 + 1] = Bc;
    } else {
#pragma unroll
      for (int i = 0; i < 8; ++i) { avC[i] = 0.f; bvC[i] = 0.f; }
    }
    if (it >= 3) {
      const int t0 = (it - 3) * 64 + tg * 8;
      const float* seg = (const float*)(smem + 84992 + ((it - 3) & 1) * 4096);
      float h = carry, hin = 0.f;
#pragma unroll
      for (int s2 = 0; s2 < 8; ++s2) {
        if (s2 == tg) hin = h;
        h = seg[(s2 * 64 + c) * 2] * h + seg[(s2 * 64 + c) * 2 + 1];
      }
      carry = h;
      h = hin;
      float sq[8];
#pragma unroll
      for (int i = 0; i < 8; ++i) {
        h = avD[i] * h + bvD[i];
        const float yv = gelu_tanh(gvD[i]) * h;
        yo[(size_t)(t0 + i) * 1024] = f2bf(yv);
        sq[i] = yv * yv;
      }
      const float tot = reduce8(sq, lane);
      if ((lane & 7) == 0) unsafeAtomicAdd(p.ssq_lru + (size_t)b * SEQ + t0 + (lane >> 3), tot);
    }
#pragma unroll
    for (int i = 0; i < 8; ++i) {
      avD[i] = avC[i]; bvD[i] = bvC[i]; gvD[i] = gvC[i];
      xcC[i] = xcB[i]; gvC[i] = gvB[i];
      xcB[i] = xcA[i]; gvB[i] = gvA[i];
    }
    __syncthreads();
  }
}

DI void attn_unit(KP p, char* smem, int b, int hd, int qb) {
  const int tid = threadIdx.x, lane = tid & 63, wave = __builtin_amdgcn_readfirstlane(tid >> 6);
  const int l31 = lane & 31, lh = lane >> 5;
  const int q0 = qb * 256 + wave * 32;
  const size_t bh = (size_t)(b * 8 + hd);
  const int nkt = qb * 4 + 4;
  const int qidx = q0 + l31;
  const int skey = tid >> 3, schn = tid & 7;
  const int rkey = (tid & 255) >> 2, rchn = tid & 3;
  const u16* kn_src = p.Kn + (bh * SEQ + skey) * 64 + schn * 8;
  const u16* kr_src = p.Kr + ((size_t)b * SEQ + rkey) * 32 + rchn * 8;
  const u16* vt_src = p.Vt + (bh * 64 + skey) * SEQ + schn * 8;
  u32x4 rk, rr, rv;
  rk = *(const u32x4*)(kn_src); rv = *(const u32x4*)(vt_src);
  if (tid < 256) rr = *(const u32x4*)(kr_src);
  bf16x8 qf[6];
  {
    const bf16x8* qp = (const bf16x8*)(p.Q + (bh * SEQ + q0 + l31) * 96 + 8 * lh);
#pragma unroll
    for (int ks = 0; ks < 6; ++ks) qf[ks] = qp[2 * ks];
  }
  __syncthreads();
  {
    u16* Kl = (u16*)smem; u16* Vl = (u16*)(smem + 13312);
    *(u32x4*)(Kl + skey * 104 + schn * 8) = rk;
    if (tid < 256) *(u32x4*)(Kl + rkey * 104 + 64 + rchn * 8) = rr;
    *(u32x4*)(Vl + skey * 72 + schn * 8) = rv;
  }
  __syncthreads();
#pragma unroll
  for (int ks = 0; ks < 6; ++ks) asm volatile("" : "+v"(qf[ks]));
  f32x16 o0 = zero16(), o1 = zero16();
  float m_run = -1e30f, l_run = 0.f;
  for (int kt = 0; kt < nkt; ++kt) {
    const u16* Kl = (const u16*)(smem + (kt & 1) * 22528);
    const u16* Vl = (const u16*)(smem + (kt & 1) * 22528 + 13312);
    const bool more = (kt + 1) < nkt;
    if (more) {
      rk = *(const u32x4*)(kn_src + (size_t)(kt + 1) * 64 * 64);
      rv = *(const u32x4*)(vt_src + (kt + 1) * 64);
      if (tid < 256) rr = *(const u32x4*)(kr_src + (size_t)(kt + 1) * 64 * 32);
    }
    if (kt * 64 <= q0 + 31) {
      f32x16 s[2];
      bf16x8 kfr[2][6];
#pragma unroll
      for (int st = 0; st < 2; ++st) {
        const bf16x8* kp = (const bf16x8*)(Kl + (st * 32 + l31) * 104 + 8 * lh);
#pragma unroll
        for (int ks = 0; ks < 6; ++ks) kfr[st][ks] = kp[2 * ks];
      }
#pragma unroll
      for (int st = 0; st < 2; ++st) {
        s[st] = zero16();
#pragma unroll
        for (int ks = 0; ks < 6; ++ks) s[st] = MFMA32(kfr[st][ks], qf[ks], s[st]);
      }
      u32x2 vfr[2][4][2];
#pragma unroll
      for (int dt = 0; dt < 2; ++dt)
#pragma unroll
        for (int c4 = 0; c4 < 4; ++c4) {
          const int kbase = c4 * 16 + 4 * lh;
          vfr[dt][c4][0] = *(const u32x2*)(Vl + (dt * 32 + l31) * 72 + kbase);
          vfr[dt][c4][1] = *(const u32x2*)(Vl + (dt * 32 + l31) * 72 + kbase + 8);
        }
      if (kt * 64 + 63 > q0) {
#pragma unroll
        for (int st = 0; st < 2; ++st)
#pragma unroll
          for (int r = 0; r < 16; ++r) { const int key = kt * 64 + st * 32 + crow(r, lh); if (key > qidx) s[st][r] = -1e30f; }
      }
      float mloc = s[0][0];
#pragma unroll
      for (int st = 0; st < 2; ++st)
#pragma unroll
        for (int r = 0; r < 16; ++r) mloc = fmaxf(mloc, s[st][r]);
      mloc = max_xor32(mloc);
      const float m_new = fmaxf(m_run, mloc);
      const float alpha = __builtin_amdgcn_exp2f(m_run - m_new);
      m_run = m_new;
      float lsum = 0.f;
#pragma unroll
      for (int st = 0; st < 2; ++st)
#pragma unroll
        for (int r = 0; r < 16; ++r) { const float e = __builtin_amdgcn_exp2f(s[st][r] - m_new); s[st][r] = e; lsum += e; }
      l_run = l_run * alpha + lsum;
#pragma unroll
      for (int r = 0; r < 16; ++r) { o0[r] *= alpha; o1[r] *= alpha; }
#pragma unroll
      for (int st = 0; st < 2; ++st)
#pragma unroll
        for (int s2 = 0; s2 < 2; ++s2) {
          u32x4 pw;
#pragma unroll
          for (int j = 0; j < 4; ++j) pw[j] = pk2(s[st][8 * s2 + 2 * j], s[st][8 * s2 + 2 * j + 1]);
          const bf16x8 pf = __builtin_bit_cast(bf16x8, pw);
          const int c4 = st * 2 + s2;
          {
            u32x4 vv; vv[0] = vfr[0][c4][0][0]; vv[1] = vfr[0][c4][0][1]; vv[2] = vfr[0][c4][1][0]; vv[3] = vfr[0][c4][1][1];
            o0 = MFMA32(__builtin_bit_cast(bf16x8, vv), pf, o0);
          }
          {
            u32x4 vv; vv[0] = vfr[1][c4][0][0]; vv[1] = vfr[1][c4][0][1]; vv[2] = vfr[1][c4][1][0]; vv[3] = vfr[1][c4][1][1];
            o1 = MFMA32(__builtin_bit_cast(bf16x8, vv), pf, o1);
          }
        }
    }
    if (more) {
      u16* Kn2 = (u16*)(smem + ((kt + 1) & 1) * 22528); u16* Vn2 = (u16*)(smem + ((kt + 1) & 1) * 22528 + 13312);
      *(u32x4*)(Kn2 + skey * 104 + schn * 8) = rk;
      if (tid < 256) *(u32x4*)(Kn2 + rkey * 104 + 64 + rchn * 8) = rr;
      *(u32x4*)(Vn2 + skey * 72 + schn * 8) = rv;
    }
    __syncthreads();
  }
  const float ltot = sum_xor32(l_run);
  const float inv = 1.f / ltot;
  float ss = 0.f;
  u16* yrow = p.y + ((size_t)b * SEQ + qidx) * 1024 + 512 + hd * 64;
#pragma unroll
  for (int g = 0; g < 4; ++g) {
    float v0[4], v1[4];
#pragma unroll
    for (int q = 0; q < 4; ++q) { v0[q] = o0[4 * g + q] * inv; v1[q] = o1[4 * g + q] * inv; ss += v0[q] * v0[q] + v1[q] * v1[q]; }
    u32x2 a; a[0] = pk2(v0[0], v0[1]); a[1] = pk2(v0[2], v0[3]);
    u32x2 c2; c2[0] = pk2(v1[0], v1[1]); c2[1] = pk2(v1[2], v1[3]);
    *(u32x2*)(yrow + 8 * g + 4 * lh) = a;
    *(u32x2*)(yrow + 32 + 8 * g + 4 * lh) = c2;
  }
  ss = sum_xor32(ss);
  if (lh == 0) unsafeAtomicAdd(p.ssq_mla + (size_t)b * SEQ + qidx, ss);
}

DI void phase2(KP p, char* smem) {
  for (int item = blockIdx.x; item < 256; item += gridDim.x) lru_item(p, smem, item);
  for (int it = blockIdx.x; it < 1024; it += gridDim.x) {
    const int j = it & 3; const int bh = it >> 2; const int hd = bh & 7; const int b = bh >> 3;
    attn_unit(p, smem, b, hd, 7 - j);
    attn_unit(p, smem, b, hd, j);
  }
}

DI void sort128_asc(unsigned& k0, unsigned& k1, int lane) {
#pragma unroll
  for (int k = 2; k <= 128; k <<= 1) {
#pragma unroll
    for (int j = k >> 1; j > 0; j >>= 1) {
      if (j == 64) {
        const unsigned lo = k0 < k1 ? k0 : k1, hi = k0 < k1 ? k1 : k0; k0 = lo; k1 = hi;
      } else {
        const unsigned o0 = (j == 1) ? lane_xor_u<1>(k0, lane) : (j == 2) ? lane_xor_u<2>(k0, lane) : (j == 4) ? lane_xor_u<4>(k0, lane) : (j == 8) ? lane_xor_u<8>(k0, lane) : (j == 16) ? lane_xor_u<16>(k0, lane) : lane_xor_u<32>(k0, lane);
        const unsigned o1 = (j == 1) ? lane_xor_u<1>(k1, lane) : (j == 2) ? lane_xor_u<2>(k1, lane) : (j == 4) ? lane_xor_u<4>(k1, lane) : (j == 8) ? lane_xor_u<8>(k1, lane) : (j == 16) ? lane_xor_u<16>(k1, lane) : lane_xor_u<32>(k1, lane);
        const bool lower = (lane & j) == 0;
        const bool asc0 = (k == 128) ? true : ((lane & k) == 0);
        const bool asc1 = (k == 128) ? true : (k == 64 ? false : ((lane & k) == 0));
        const unsigned mn0 = k0 < o0 ? k0 : o0, mx0 = k0 < o0 ? o0 : k0;
        const unsigned mn1 = k1 < o1 ? k1 : o1, mx1 = k1 < o1 ? o1 : k1;
        k0 = (asc0 == lower) ? mn0 : mx0;
        k1 = (asc1 == lower) ? mn1 : mx1;
      }
    }
  }
}
#if QBITS == 8
typedef u32x4 qrow_t;
#else
typedef u32x2 qrow_t;
#endif
constexpr int QROWB = (QBITS == 8) ? 1024 : 512;
DI void ga_load(__amdgpu_buffer_rsrc_t rs, int iv, int gl, int voff_u, int voff_v, qrow_t (&uq)[8], qrow_t (&vq)[8]) {
#pragma unroll
  for (int k = 0; k < 8; ++k) {
    const int so = __builtin_amdgcn_readlane(iv, gl + k);
#if QBITS == 8
    uq[k] = __builtin_amdgcn_raw_buffer_load_b128(rs, voff_u, so, 0);
    vq[k] = __builtin_amdgcn_raw_buffer_load_b128(rs, voff_v, so, 0);
#else
    const u32x4 rec = __builtin_amdgcn_raw_buffer_load_b128(rs, voff_u, so, 16);
    uq[k] = (u32x2){rec[0], rec[1]}; vq[k] = (u32x2){rec[2], rec[3]};
#endif
  }
}
DI unsigned qword(const qrow_t& r, int j) {
#if QBITS == 8
  return r[j];
#else
  const unsigned w0 = r[j >> 1];
  return (j & 1) ? ((w0 >> 4) & 0x0f0f0f0fu) : (w0 & 0x0f0f0f0fu);
#endif
}
#if QBITS == 8
typedef f32x2 oacc_t;
constexpr float OACC_SCALE = 1.f;
#else
typedef h16x2 oacc_t;
constexpr float OACC_SCALE = 16.f;
#endif
DI void ga_compute(float gsel, float asel, float bsel, int gl, int lane, float kt, float hscale, const unsigned (&hq)[4],
                   const qrow_t (&uq)[8], const qrow_t (&vq)[8], oacc_t (&oacc)[8], float& csum) {
  const float mg = __shfl(gsel, gl + (lane >> 3));
  const float ma = __shfl(asel, gl + (lane >> 3));
  const float mb = __shfl(bsel, gl + (lane >> 3));
  float pp[8];
#pragma unroll
  for (int k = 0; k < 8; ++k) {
#if QBITS == 8
    unsigned d = 0;
#pragma unroll
    for (int j = 0; j < 4; ++j) d = __builtin_amdgcn_udot4(qword(uq[k], j), hq[j], d, false);
#else
    unsigned dh = __builtin_amdgcn_udot8(uq[k][0], hq[0], 0u, false); dh = __builtin_amdgcn_udot8(uq[k][1], hq[1], dh, false);
    unsigned dl = __builtin_amdgcn_udot8(uq[k][0], hq[2], 0u, false); dl = __builtin_amdgcn_udot8(uq[k][1], hq[3], dl, false);
    const unsigned d = dh * 16u + dl;
#endif
    pp[k] = (float)d;
  }
  const float s1 = reduce8(pp, lane);
  const float pre = hscale * (ma * (s1 - kt) - mb);
  const float cf = mg * gelu_tanh(pre);
  csum += cf;
#if QBITS != 8
  const _Float16 cfs = (_Float16)(cf * OACC_SCALE);
  const unsigned cfp = __builtin_bit_cast(unsigned, (h16x2){cfs, cfs});
#endif
#pragma unroll
  for (int k = 0; k < 8; ++k) {
#if QBITS == 8
    const float c = __uint_as_float(__builtin_amdgcn_readlane(__float_as_uint(cf), 8 * k));
    const f32x2 cc = {c, c};
#pragma unroll
    for (int j = 0; j < 4; ++j) {
      unsigned w = qword(vq[k], j);
      asm volatile("" : "+v"(w));
      const f32x2 v0 = {(float)(w & 255u), (float)((w >> 8) & 255u)}, v1 = {(float)((w >> 16) & 255u), (float)(w >> 24)};
      oacc[2 * j] = v0 * cc + oacc[2 * j];
      oacc[2 * j + 1] = v1 * cc + oacc[2 * j + 1];
    }
#else
    const h16x2 cc = __builtin_bit_cast(h16x2, (unsigned)__builtin_amdgcn_readlane((int)cfp, 8 * k));
#pragma unroll
    for (int jd = 0; jd < 2; ++jd) {
      const unsigned w = vq[k][jd];
      oacc[4 * jd + 0] = __builtin_amdgcn_cvt_scalef32_pk_f16_fp4(w, 1.0f, 0) * cc + oacc[4 * jd + 0];
      oacc[4 * jd + 1] = __builtin_amdgcn_cvt_scalef32_pk_f16_fp4(w, 1.0f, 1) * cc + oacc[4 * jd + 1];
      oacc[4 * jd + 2] = __builtin_amdgcn_cvt_scalef32_pk_f16_fp4(w, 1.0f, 2) * cc + oacc[4 * jd + 2];
      oacc[4 * jd + 3] = __builtin_amdgcn_cvt_scalef32_pk_f16_fp4(w, 1.0f, 3) * cc + oacc[4 * jd + 3];
    }
#endif
  }
}

DI void ins16(float (&lst)[16], float x, const int P) {
#pragma unroll
  for (int i = 0; i < 16; ++i) if (i >= P) { const float hi = fmaxf(lst[i], x); x = fminf(lst[i], x); lst[i] = hi; }
}
DI void ce_desc(float& a, float& b) { const float hi = fmaxf(a, b), lo = fminf(a, b); a = hi; b = lo; }
DI void sort16_desc(float (&a)[16]) {
#define CE_(i, j) ce_desc(a[i], a[j]);
  CE_(0, 13) CE_(1, 12) CE_(2, 15) CE_(3, 14) CE_(4, 8) CE_(5, 6) CE_(7, 11) CE_(9, 10)
  CE_(0, 5) CE_(1, 7) CE_(2, 9) CE_(3, 4) CE_(6, 13) CE_(8, 14) CE_(10, 15) CE_(11, 12)
  CE_(0, 1) CE_(2, 3) CE_(4, 5) CE_(6, 8) CE_(7, 9) CE_(10, 11) CE_(12, 13) CE_(14, 15)
  CE_(0, 2) CE_(1, 3) CE_(4, 10) CE_(5, 11) CE_(6, 7) CE_(8, 9) CE_(12, 14) CE_(13, 15)
  CE_(1, 2) CE_(3, 12) CE_(4, 6) CE_(5, 7) CE_(8, 10) CE_(9, 11) CE_(13, 14)
  CE_(1, 4) CE_(2, 6) CE_(5, 8) CE_(7, 10) CE_(9, 13) CE_(11, 14)
  CE_(2, 4) CE_(3, 6) CE_(9, 12) CE_(11, 13)
  CE_(3, 5) CE_(6, 8) CE_(7, 9) CE_(10, 12)
  CE_(3, 4) CE_(5, 6) CE_(7, 8) CE_(9, 10) CE_(11, 12)
  CE_(6, 7) CE_(8, 9)
#undef CE_
}
DI void merge16_desc(float (&x)[16], const float (&y)[16]) {
#pragma unroll
  for (int i = 0; i < 16; ++i) x[i] = fmaxf(x[i], y[15 - i]);
#pragma unroll
  for (int d = 8; d >= 1; d >>= 1)
#pragma unroll
    for (int i = 0; i < 16; ++i)
      if ((i & d) == 0) ce_desc(x[i], x[i + d]);
}
DI void merge_partner(float (&lst)[16], int lane) {
  float o[16];
#pragma unroll
  for (int i = 0; i < 16; ++i) o[i] = other_xor32(lst[i], lane);
  float c[16];
#pragma unroll
  for (int i = 0; i < 16; ++i) c[i] = fmaxf(lst[i], o[15 - i]);
#pragma unroll
  for (int d = 8; d >= 1; d >>= 1) {
#pragma unroll
    for (int i = 0; i < 16; ++i) {
      if ((i & d) == 0) { const float hi = fmaxf(c[i], c[i + d]), lo = fminf(c[i], c[i + d]); c[i] = hi; c[i + d] = lo; }
    }
  }
#pragma unroll
  for (int i = 0; i < 16; ++i) lst[i] = c[i];
}

DI void phase3(KP p, char* smem) {
  const int tid = threadIdx.x, wave = __builtin_amdgcn_readfirstlane(tid >> 6);
  u16* A = (u16*)smem;
  float* ssq2 = (float*)(smem + 146944);
  signed char* A8 = (signed char*)smem;
  float* hs = (float*)(smem + 146944 + 256);
  constexpr int ELD = 132;
  int* eidx = (int*)(smem + 66560);
  float* egate = (float*)(smem + 100352);
  float* g2s = (float*)(smem + 134144);
  float* fgs = (float*)(smem + 138240);
  char* scr = p.scratch + (size_t)blockIdx.x * 655360;
  float* x1s = (float*)scr;
  u16* qp = (u16*)(scr + 262144);
  for (int tile = blockIdx.x; tile < NTOK / 64; tile += gridDim.x) {
    int lane_o = tid & 63; asm volatile("" : "+v"(lane_o));
    const int lane = lane_o, l31 = lane & 31, lh = lane >> 5;
    const int tok0 = tile * 64; const int b = tok0 / SEQ;
    const float* modb = p.mod + (size_t)b * 6144;
#pragma unroll
    for (int bt = 0; bt < 2; ++bt) {
      u32x4 yv[4][2]; float sl[4], sm[4];
#pragma unroll
      for (int q = 0; q < 4; ++q) {
        const int tok = tok0 + wave * 8 + bt * 4 + q;
        sl[q] = p.ssq_lru[tok]; sm[q] = p.ssq_mla[tok];
#pragma unroll
        for (int i = 0; i < 2; ++i) yv[q][i] = *(const u32x4*)(p.y + (size_t)tok * 1024 + (i * 64 + lane) * 8);
      }
#pragma unroll
      for (int q = 0; q < 4; ++q) {
        const int row = wave * 8 + bt * 4 + q;
        const float rl = rsqrtf(sl[q] * (1.f / 512.f) + EPS), rm = rsqrtf(sm[q] * (1.f / 512.f) + EPS);
#pragma unroll
        for (int i = 0; i < 2; ++i) {
          const u32x4 v = yv[q][i];
          const float sc = i == 0 ? rl : rm;
          u32x4 o;
#pragma unroll
          for (int j = 0; j < 4; ++j) o[j] = pk2(bflo(v[j]) * sc, bfhi(v[j]) * sc);
          *(u32x4*)(A + row * LDA + (i * 64 + lane) * 8) = o;
        }
      }
    }
    __syncthreads();
    bf16x8 ring3[8][2];
    { const int tl0[2] = {wave, wave + 8}; gemm_pro<2, 8>(p.Wf_out, 64, tl0, lane, ring3); }
#pragma unroll 1
    for (int pass = 0; pass < 2; ++pass) {
      f32x16 acc[2][2];
#pragma unroll
      for (int t = 0; t < 2; ++t) { acc[t][0] = zero16(); acc[t][1] = zero16(); }
      const int tl[2] = {pass * 16 + wave, pass * 16 + wave + 8};
      gemm_main<2, 8, false, true>(A, LDA, 64, p.Wf_out, 64, tl, acc, lane, ring3);
      if (pass == 0) { const int tn[2] = {16 + wave, 16 + wave + 8}; gemm_pro<2, 8>(p.Wf_out, 64, tn, lane, ring3); }
      int el_ = lane; asm volatile("" : "+v"(el_));
      const int l31 = el_ & 31, lh = el_ >> 5;
      float g1[2];
#pragma unroll
      for (int t = 0; t < 2; ++t) g1[t] = modb[2048 + tl[t] * 32 + l31];
#pragma unroll
      for (int rt = 0; rt < 2; ++rt)
#pragma unroll
        for (int r = 0; r < 16; ++r) {
          const int row = rt * 32 + crow(r, lh);
#pragma unroll
          for (int t = 0; t < 2; ++t) {
            const int col = tl[t] * 32 + l31;
            x1s[row * 1024 + col] = g1[t] * acc[t][rt][r];
          }
        }
    }
    __builtin_amdgcn_sched_barrier(0);
    for (int i = tid; i < 256; i += NTHREADS) { *(f32x4*)(g2s + i * 4) = *(const f32x4*)(modb + 5120 + i * 4); *(f32x4*)(fgs + i * 4) = *(const f32x4*)(p.final_g + i * 4); }
    f32x4 xg[2][4];
#pragma unroll
    for (int q = 0; q < 2; ++q)
#pragma unroll
      for (int i = 0; i < 4; ++i) xg[q][i] = *(const f32x4*)(p.x + (size_t)(tok0 + wave * 8 + q) * DM + (i >> 1) * 512 + lane * 8 + (i & 1) * 4);
    __syncthreads();
    {
      f32x4 cm[4], ca[4];
#pragma unroll
      for (int i = 0; i < 4; ++i) {
        const int col = (i >> 1) * 512 + lane * 8 + (i & 1) * 4;
        const f32x4 g = *(const f32x4*)(p.norm2_g + col); const f32x4 sc = *(const f32x4*)(modb + 4096 + col);
        cm[i] = g * (sc + 1.0f); ca[i] = *(const f32x4*)(modb + 3072 + col);
      }
#pragma unroll
      for (int bt = 0; bt < 4; ++bt) {
        f32x4 x1v[2][4];
#pragma unroll
        for (int q = 0; q < 2; ++q)
#pragma unroll
          for (int i = 0; i < 4; ++i) x1v[q][i] = *(const f32x4*)(x1s + (wave * 8 + bt * 2 + q) * 1024 + (i >> 1) * 512 + lane * 8 + (i & 1) * 4);
#pragma unroll
        for (int q = 0; q < 2; ++q)
#pragma unroll
          for (int i = 0; i < 4; ++i) x1v[q][i] += xg[q][i];
        if (bt < 3) {
#pragma unroll
          for (int q = 0; q < 2; ++q)
#pragma unroll
            for (int i = 0; i < 4; ++i) xg[q][i] = *(const f32x4*)(p.x + (size_t)(tok0 + wave * 8 + bt * 2 + 2 + q) * DM + (i >> 1) * 512 + lane * 8 + (i & 1) * 4);
        }
#pragma unroll
        for (int q = 0; q < 2; ++q) {
          const int row = wave * 8 + bt * 2 + q;
          float ss = 0.f;
#pragma unroll
          for (int i = 0; i < 4; ++i) {
            *(f32x4*)(x1s + row * 1024 + (i >> 1) * 512 + lane * 8 + (i & 1) * 4) = x1v[q][i];
#pragma unroll
            for (int j = 0; j < 4; ++j) ss += x1v[q][i][j] * x1v[q][i][j];
          }
          ss = wave_sum(ss);
          const float rs = rsqrtf(ss * (1.f / 1024.f) + EPS);
          f32x4 hv[4];
          float hmax = 0.f;
#pragma unroll
          for (int i = 0; i < 4; ++i) {
            hv[i] = x1v[q][i] * rs * cm[i] + ca[i];
#pragma unroll
            for (int j = 0; j < 4; ++j) hmax = fmaxf(hmax, fabsf(hv[i][j]));
          }
          hmax = wave_max(hmax);
          const float hinv = hmax > 0.f ? 127.f / hmax : 0.f;
#pragma unroll
          for (int i = 0; i < 2; ++i) {
            u32x2 o;
#pragma unroll
            for (int hh = 0; hh < 2; ++hh) {
              unsigned w = 0;
#pragma unroll
              for (int j = 0; j < 4; ++j) w |= ((unsigned)(int)__builtin_rintf(hv[2 * i + hh][j] * hinv) & 255u) << (8 * j);
              o[hh] = w;
            }
            *(u32x2*)(A8 + row * LDA8 + i * 512 + lane * 8) = o;
          }
          if (lane == 0) hs[row] = hmax * (1.f / 127.f);
        }
      }
    }
    __syncthreads();
    float s12[2][16];
    i32x4 ring8[8][2];
    { const int t0[2] = {wave * 8, wave * 8 + 1}; gemm8_pro<2, 8>(p.Wf_s, 32, t0, lane, ring8); }
#pragma unroll 1
    for (int ph = 0; ph < 2; ++ph) {
      const int hd = wave;
      float lst0[16], lst1[16];
#pragma unroll
      for (int i = 0; i < 16; ++i) { lst0[i] = -3.0e38f; lst1[i] = -3.0e38f; }
#pragma unroll 1
      for (int mtp = 0; mtp < 2; ++mtp) {
        i32x16 acc[2][2];
#pragma unroll
        for (int t = 0; t < 2; ++t)
#pragma unroll
          for (int r = 0; r < 16; ++r) { acc[t][0][r] = 0; acc[t][1][r] = 0; }
        const int tl[2] = {(hd * 2 + ph) * 4 + 2 * mtp, (hd * 2 + ph) * 4 + 2 * mtp + 1};
        gemm8_main<2, 8>(A8, LDA8, 32, p.Wf_s, 32, tl, acc, lane, ring8);
        if (ph * 2 + mtp < 3) { const int pn = ph * 2 + mtp + 1; const int tn[2] = {wave * 8 + 2 * pn, wave * 8 + 2 * pn + 1}; gemm8_pro<2, 8>(p.Wf_s, 32, tn, lane, ring8); }
        int el_ = lane; asm volatile("" : "+v"(el_));
        const int lh = el_ >> 5;
#pragma unroll
        for (int t = 0; t < 2; ++t) {
          f32x4 w4[4];
#pragma unroll
          for (int g = 0; g < 4; ++g) w4[g] = *(const f32x4*)(p.wsc + tl[t] * 32 + 8 * g + 4 * lh);
          float nv[16];
#pragma unroll
          for (int r = 0; r < 16; ++r) nv[r] = __uint_as_float((__float_as_uint((float)acc[t][0][r] * w4[r >> 2][r & 3]) & 0xffffff80u) | (unsigned)((2 * mtp + t) * 32 + crow(r, lh)));
          sort16_desc(nv);
          if (t == 0 && mtp == 0) {
#pragma unroll
            for (int r = 0; r < 16; ++r) lst0[r] = nv[r];
          } else merge16_desc(lst0, nv);
#pragma unroll
          for (int r = 0; r < 16; ++r) nv[r] = __uint_as_float((__float_as_uint((float)acc[t][1][r] * w4[r >> 2][r & 3]) & 0xffffff80u) | (unsigned)((2 * mtp + t) * 32 + crow(r, lh)));
          sort16_desc(nv);
          if (t == 0 && mtp == 0) {
#pragma unroll
            for (int r = 0; r < 16; ++r) lst1[r] = nv[r];
          } else merge16_desc(lst1, nv);
        }
      }
      merge_partner(lst0, lane);
      merge_partner(lst1, lane);
      if (ph == 0) {
#pragma unroll
        for (int i = 0; i < 16; ++i) s12[0][i] = lh ? lst1[i] : lst0[i];
      } else {
#pragma unroll
        for (int i = 0; i < 16; ++i) s12[1][i] = lh ? lst1[i] : lst0[i];
      }
    }
    {
      const int hd = wave;
      unsigned long long t1lo = 0, t1hi = 0, t2lo = 0, t2hi = 0;
#pragma unroll
      for (int i = 0; i < 8; ++i) {
        t1lo |= (unsigned long long)(__float_as_uint(s12[0][i]) & 127u) << (8 * i);
        t1hi |= (unsigned long long)(__float_as_uint(s12[0][8 + i]) & 127u) << (8 * i);
        t2lo |= (unsigned long long)(__float_as_uint(s12[1][i]) & 127u) << (8 * i);
        t2hi |= (unsigned long long)(__float_as_uint(s12[1][8 + i]) & 127u) << (8 * i);
      }
      const float hst = hs[lh * 32 + l31];
      float bv[16];
#pragma unroll
      for (int j = 0; j < 16; ++j) {
        const float sv = (s12[0][0] + s12[1][j]) * hst;
        bv[j] = __uint_as_float((__float_as_uint(sv) & 0xffffff00u) | (unsigned)j);
      }
#pragma unroll
      for (int i = 1; i < 16; ++i) {
#pragma unroll
        for (int j = 0; j < 16; ++j)
          if ((i + 1) * (j + 1) <= 16) {
            const float sv = (s12[0][i] + s12[1][j]) * hst;
            ins16(bv, __uint_as_float((__float_as_uint(sv) & 0xffffff00u) | (unsigned)(i * 16 + j)), (i + 1) * (j + 1) - 1);
          }
      }
      int bi[16];
#pragma unroll
      for (int k = 0; k < 16; ++k) {
        const unsigned code = __float_as_uint(bv[k]) & 255u;
        const unsigned ci = code >> 4, cj = code & 15u;
        const unsigned long long w1 = (ci & 8u) ? t1hi : t1lo, w2 = (cj & 8u) ? t2hi : t2lo;
        const unsigned i1 = (unsigned)(w1 >> ((ci & 7u) * 8)) & 0xffu, i2 = (unsigned)(w2 >> ((cj & 7u) * 8)) & 0xffu;
        bi[k] = (int)(i1 * 128u + i2);
      }
      float esum = 0.f, ev[16];
#pragma unroll
      for (int i = 0; i < 16; ++i) { ev[i] = __expf(bv[i] - bv[0]); esum += ev[i]; }
      const float einv = 1.f / esum;
      {
        const int row = lh * 32 + l31;
#pragma unroll
        for (int i4 = 0; i4 < 4; ++i4) {
          *(i32x4*)(eidx + row * ELD + hd * 16 + i4 * 4) = (i32x4){bi[i4 * 4], bi[i4 * 4 + 1], bi[i4 * 4 + 2], bi[i4 * 4 + 3]};
          *(f32x4*)(egate + row * ELD + hd * 16 + i4 * 4) = (f32x4){ev[i4 * 4] * einv, ev[i4 * 4 + 1] * einv, ev[i4 * 4 + 2] * einv, ev[i4 * 4 + 3] * einv};
        }
      }
    }
    __syncthreads();
    const __amdgpu_buffer_rsrc_t qrs = __builtin_amdgcn_make_buffer_rsrc((void*)p.Uq, 0, 2 * 16384 * QROWB, 0x00020000);
    const int voff_u = (QBITS == 8) ? lane * 16 : lane * 16, voff_v = voff_u + 16384 * QROWB;
    int n_ia, n_ib; float n_ga, n_gb, n_ua, n_ub, n_ba, n_bb, n_kt, n_hscale; unsigned n_hq[4];
    qrow_t bufA_u[8], bufA_v[8], bufB_u[8], bufB_v[8];
#define GA_PREP(ROW)                                                                                                              \
    {                                                                                                                             \
      const int prow = (ROW);                                                                                                     \
      n_ia = eidx[prow * ELD + lane]; n_ib = eidx[prow * ELD + 64 + lane];                                                        \
      n_ga = egate[prow * ELD + lane]; n_gb = egate[prow * ELD + 64 + lane];                                                      \
      {     \
        unsigned k0 = ((unsigned)n_ia << 7) | (unsigned)lane, k1 = ((unsigned)n_ib << 7) | (unsigned)(64 + lane);                 \
        sort128_asc(k0, k1, lane);                                                                                                \
        const int p0 = (int)(k0 & 127u), p1 = (int)(k1 & 127u);                                                                   \
        const f32x4 sa = ((const f32x4*)p.uscale)[k0 >> 7], sb = ((const f32x4*)p.uscale)[k1 >> 7];        \
        const float ga0 = __shfl(n_ga, p0 & 63), gb0 = __shfl(n_gb, p0 & 63), ga1 = __shfl(n_ga, p1 & 63), gb1 = __shfl(n_gb, p1 & 63); \
        n_ia = (int)(k0 >> 7) * (QBITS == 8 ? QROWB : 2 * QROWB); n_ib = (int)(k1 >> 7) * (QBITS == 8 ? QROWB : 2 * QROWB);       \
        n_ga = ((p0 & 64) ? gb0 : ga0) * sa[1]; n_gb = ((p1 & 64) ? gb1 : ga1) * sb[1];                                           \
        n_ua = sa[0]; n_ub = sb[0]; n_ba = sa[2]; n_bb = sb[2];                                                                   \
      }                                                                                                                           \
      u32x4 hc = *(const u32x4*)(A8 + prow * LDA8 + lane * 16);        \
      _Pragma("unroll") for (int j = 0; j < 4; ++j) hc[j] ^= 0x80808080u;                                                         \
      n_hscale = hs[prow];                                                                                                        \
      unsigned hsi = 0;                                                                                                           \
      _Pragma("unroll") for (int j = 0; j < 4; ++j) hsi = __builtin_amdgcn_udot4(hc[j], 0x01010101u, hsi, false);                 \
      const float hsum = (float)hsi;                                                                                              \
      if (QBITS == 8) {                                                                                                           \
        _Pragma("unroll") for (int j = 0; j < 4; ++j) n_hq[j] = hc[j];                                                            \
      } else {               \
        _Pragma("unroll") for (int jd = 0; jd < 2; ++jd) {                                                                        \
          n_hq[jd] = ((hc[2 * jd] >> 4) & 0x0f0f0f0fu) | (hc[2 * jd + 1] & 0xf0f0f0f0u);                                          \
          n_hq[2 + jd] = (hc[2 * jd] & 0x0f0f0f0fu) | ((hc[2 * jd + 1] & 0x0f0f0f0fu) << 4);                                      \
        }                                                                                                                         \
      }                                                                                                                           \
      n_kt = (QBITS == 8 ? 128.f : 7.5f) * (wave_sum(hsum) - 131072.f);                                                           \
    }
    GA_PREP(wave)
    ga_load(qrs, n_ia, 0, voff_u, voff_v, bufA_u, bufA_v);
#pragma unroll 1
    for (int rr = 0; rr < 8; ++rr) {
      const int row = rr * 8 + wave; const int tok = tok0 + row;
      const int ia = n_ia, ib = n_ib; const float ga = n_ga, gb = n_gb, ua = n_ua, ub = n_ub, ba = n_ba, bb = n_bb, kt = n_kt, hscale = n_hscale;
      unsigned hq[4];
#pragma unroll
      for (int j = 0; j < 4; ++j) hq[j] = n_hq[j];
      f32x4 xv4[4];
#pragma unroll
      for (int q = 0; q < 4; ++q) xv4[q] = *(const f32x4*)(x1s + row * 1024 + lane * 16 + q * 4);
      if (rr + 1 < 8) GA_PREP(row + 8)
      oacc_t oacc[8];
#pragma unroll
      for (int j = 0; j < 8; ++j) { oacc[j][0] = 0; oacc[j][1] = 0; }
      float csum = 0.f;
#pragma unroll 1
      for (int half = 0; half < 2; ++half) {
        const int iv = half ? ib : ia, ivn = half ? n_ia : ib;
        const float gs = half ? gb : ga, us = half ? ub : ua, bs = half ? bb : ba;
        const bool has_next = (half == 0) || (rr + 1 < 8);
#pragma unroll 1
        for (int g8 = 0; g8 < 8; g8 += 2) {
          ga_load(qrs, iv, (g8 + 1) * 8, voff_u, voff_v, bufB_u, bufB_v);
          ga_compute(gs, us, bs, g8 * 8, lane, kt, hscale, hq, bufA_u, bufA_v, oacc, csum);
          if (g8 + 2 < 8) ga_load(qrs, iv, (g8 + 2) * 8, voff_u, voff_v, bufA_u, bufA_v);
          else if (has_next) ga_load(qrs, ivn, 0, voff_u, voff_v, bufA_u, bufA_v);
          ga_compute(gs, us, bs, (g8 + 1) * 8, lane, kt, hscale, hq, bufB_u, bufB_v, oacc, csum);
        }
      }
      {
#if QBITS == 8
        const float corr = wave_sum(csum) * (128.f / 8.f);
#pragma unroll
        for (int j = 0; j < 8; ++j) oacc[j] = oacc[j] - corr;
#endif
      }
      float xo[16]; float ss = 0.f;
#pragma unroll
      for (int q = 0; q < 4; ++q) {
        const int col = lane * 16 + q * 4;
        const f32x4 xv = xv4[q];
        const f32x4 g2 = *(const f32x4*)(g2s + col);
#pragma unroll
        for (int j = 0; j < 4; ++j) { const float v = xv[j] + g2[j] * ((float)oacc[q * 2 + (j >> 1)][j & 1] * (1.f / OACC_SCALE)); xo[q * 4 + j] = v; ss += v * v; }
      }
      ss = wave_sum(ss);
      const float rs = rsqrtf(ss * (1.f / 1024.f) + EPS);
#pragma unroll
      for (int q = 0; q < 4; ++q) {
        const int col = lane * 16 + q * 4;
        const f32x4 fg = *(const f32x4*)(fgs + col);
        f32x4 o;
#pragma unroll
        for (int j = 0; j < 4; ++j) o[j] = xo[q * 4 + j] * rs * fg[j];
        *(f32x4*)(p.out + (size_t)tok * DM + col) = o;
      }
    }
#undef GA_PREP
    __syncthreads();
  }
}

template <int MODE>
__global__ void __launch_bounds__(NTHREADS) mk_fwd(Params p) {
  extern __shared__ __attribute__((aligned(16))) char smem[];
  if (MODE < 0) {
    cg::grid_group grid = cg::this_grid();
    typedef const __attribute__((address_space(4))) Params* KPP;
    { KPP kp = (KPP)__builtin_amdgcn_kernarg_segment_ptr(); asm volatile("" : "+s"(kp)); phase0(*kp, smem); }
    grid.sync();
    { KPP kp = (KPP)__builtin_amdgcn_kernarg_segment_ptr(); asm volatile("" : "+s"(kp)); phase1(*kp, smem); }
    grid.sync();
    { KPP kp = (KPP)__builtin_amdgcn_kernarg_segment_ptr(); asm volatile("" : "+s"(kp)); phase2(*kp, smem); }
    grid.sync();
    { KPP kp = (KPP)__builtin_amdgcn_kernarg_segment_ptr(); asm volatile("" : "+s"(kp)); phase3(*kp, smem); }
#ifdef PROBE_P3X2
    grid.sync();
    phase3(p, smem);
#endif
#ifdef PROBE_P1X2
    grid.sync();
    phase1(p, smem);
#endif
  } else {
    typedef const __attribute__((address_space(4))) Params* KPP;
    KPP kp = (KPP)__builtin_amdgcn_kernarg_segment_ptr();
    if (MODE == 0) phase0(*kp, smem);
    if (MODE == 1) phase1(*kp, smem);
    if (MODE == 2) phase2(*kp, smem);
    if (MODE == 3) phase3(*kp, smem);
  }
}

static size_t align_up(size_t v) { return (v + 255) & ~(size_t)255; }

extern "C" void kernel_launch(void* const* d_in, const int* in_sizes, int n_in, void* d_out, int out_size, void* d_ws, size_t ws_size, hipStream_t stream) {
  static int grid = 0;
  if (grid == 0) {
    int dev = 0, cus = 0, per_cu = 0;
    (void)hipGetDevice(&dev);
    (void)hipDeviceGetAttribute(&cus, hipDeviceAttributeMultiprocessorCount, dev);
#if N_LAUNCH_MODE == 1
    (void)hipFuncSetAttribute((const void*)mk_fwd<-1>, hipFuncAttributeMaxDynamicSharedMemorySize, LDS_BYTES);
    (void)hipOccupancyMaxActiveBlocksPerMultiprocessor(&per_cu, (const void*)mk_fwd<-1>, NTHREADS, LDS_BYTES);
#else
    (void)hipFuncSetAttribute((const void*)mk_fwd<0>, hipFuncAttributeMaxDynamicSharedMemorySize, LDS_BYTES);
    (void)hipFuncSetAttribute((const void*)mk_fwd<1>, hipFuncAttributeMaxDynamicSharedMemorySize, LDS_BYTES);
    (void)hipFuncSetAttribute((const void*)mk_fwd<2>, hipFuncAttributeMaxDynamicSharedMemorySize, LDS_BYTES);
    (void)hipFuncSetAttribute((const void*)mk_fwd<3>, hipFuncAttributeMaxDynamicSharedMemorySize, LDS_BYTES);
    (void)hipOccupancyMaxActiveBlocksPerMultiprocessor(&per_cu, (const void*)mk_fwd<3>, NTHREADS, LDS_BYTES);
#endif
    if (per_cu < 1) { fprintf(stderr, "kernel_launch: occupancy query says %d blocks/CU\n", per_cu); per_cu = 1; }
    if (per_cu > 1) per_cu = 1;
    grid = cus * per_cu;
    if (grid > 256) grid = 256;
    (void)hipGetLastError();
  }
  Params p{};
  const float* const* fin = (const float* const*)d_in;
  p.x = fin[0]; p.c = fin[1]; p.pos = (const int*)d_in[2];
  p.w_ada = fin[3]; p.b_ada = fin[4]; p.norm1_g = fin[5]; p.w_in = fin[6]; p.conv_w = fin[7]; p.conv_b = fin[8];
  p.lru_wa = fin[9]; p.lru_ba = fin[10]; p.lru_wx = fin[11]; p.lru_bx = fin[12]; p.lru_lambda = fin[13];
  p.q_norm_g = fin[14]; p.w_uq = fin[15]; p.kv_norm_g = fin[16]; p.w_ukv = fin[17]; p.lru_out_g = fin[18]; p.mla_out_g = fin[19];
  p.w_out = fin[20]; p.norm2_g = fin[21]; p.peer_wq = fin[22]; p.peer_keys = fin[23]; p.peer_u = fin[24]; p.peer_v = fin[25]; p.final_g = fin[26];
  p.out = (float*)d_out;
  char* w = (char*)d_ws; size_t off = 0;
  auto take = [&](size_t bytes) { char* r = w + off; off = align_up(off + bytes); return r; };
  p.mod = (float*)take((size_t)NB * 6144 * 4);
  p.ssq_lru = (float*)take((size_t)NTOK * 4);
  p.ssq_mla = (float*)take((size_t)NTOK * 4);
  p.invfreq = (double*)take(16 * 8);
  p.Wf_in = (bf16x8*)take((size_t)INW * 1024 * 2);
  p.Wf_uq = (bf16x8*)take((size_t)768 * 256 * 2);
  p.Wf_ukv = (bf16x8*)take((size_t)1024 * 128 * 2);
  p.Wf_a = (bf16x8*)take((size_t)8 * 64 * 64 * 2);
  p.Wf_x = (bf16x8*)take((size_t)8 * 64 * 64 * 2);
  p.Wf_out = (bf16x8*)take((size_t)1024 * 1024 * 2);
  p.Wf_s = (i32x4*)take((size_t)2048 * 1024);
  p.Wsf = (float*)take((size_t)2048 * 1024 * 4);
  p.wsmaxp = (float*)take((size_t)2048 * 16 * 4);
  p.wsc = (float*)take((size_t)2048 * 4);
  p.Uq = (unsigned char*)take((size_t)2 * 16384 * QROWB);
  p.Vq = p.Uq + (size_t)16384 * QROWB;
  p.uscale = (float*)take((size_t)16384 * 16);
  p.vscale = p.uscale; p.ubias = p.uscale;
  p.xlru = (u16*)take((size_t)NTOK * 512 * 2);
  p.gate = (u16*)take((size_t)NTOK * 512 * 2);
  p.Q = (u16*)take((size_t)NTOK * 768 * 2);
  p.Kn = (u16*)take((size_t)NTOK * 512 * 2);
  p.Kr = (u16*)take((size_t)NTOK * 32 * 2);
  p.Vt = (u16*)take((size_t)NTOK * 512 * 2);
  p.y = (u16*)take((size_t)NTOK * 1024 * 2);
  p.scratch = take((size_t)256 * 655360);
  if (off > ws_size) { fprintf(stderr, "kernel_launch: workspace too small: need %zu have %zu\n", off, ws_size); return; }
#if N_LAUNCH_MODE == 1
  void* args[] = {&p};
  hipError_t e = hipLaunchCooperativeKernel((const void*)mk_fwd<-1>, dim3(grid), dim3(NTHREADS), args, LDS_BYTES, stream);
  if (e != hipSuccess) fprintf(stderr, "cooperative launch failed: %s (grid %d)\n", hipGetErrorString(e), grid);
#else
  hipLaunchKernelGGL(mk_fwd<0>, dim3(grid), dim3(NTHREADS), LDS_BYTES, stream, p);
  hipLaunchKernelGGL(mk_fwd<1>, dim3(grid), dim3(NTHREADS), LDS_BYTES, stream, p);
  hipLaunchKernelGGL(mk_fwd<2>, dim3(grid), dim3(NTHREADS), LDS_BYTES, stream, p);
  hipLaunchKernelGGL(mk_fwd<3>, dim3(grid), dim3(NTHREADS), LDS_BYTES, stream, p);
#endif
}
```
